# Optimizing an MI355X kernel written in HIP

```python
import math
import jax
import jax.numpy as jnp
from jax import lax
import numpy as np

D_MODEL = 1024
BATCH = 4
SEQ = 8192
DEPTH = 1
DEC_BATCH = 32
DEC_SEQ = 8
PAST_LEN = 16384
PAGE_SIZE = 128

A_GROUPS = ((128, 1), (512, 4), (2048, 16))
A_HEADS_PER_GROUP = 4
A_HEADS = A_HEADS_PER_GROUP * len(A_GROUPS)
A_HEAD_DIM = 128
A_WIDTH = A_HEADS * A_HEAD_DIM
A_OUT = A_HEADS_PER_GROUP * A_HEAD_DIM
REL_BUCKETS = 32
REL_MAX_DIST = 2048
B_HEADS = 4
B_DK = 128
B_DV = 256
B_QK = B_HEADS * B_DK
B_V = B_HEADS * B_DV
B_GATE_RANK = 16
B_GATE_NORM = 16.0
B_CHUNK = 64
MEM_LEN = 256
M_HEADS = 4
M_HEAD_DIM = D_MODEL // M_HEADS
M_WIDTH = M_HEADS * M_HEAD_DIM
D_FF = -(-8 * D_MODEL // (3 * 256)) * 256
IN_WIDTHS = (A_WIDTH, A_WIDTH, A_WIDTH, B_QK, B_QK, B_V, B_V, B_GATE_RANK, D_MODEL, D_MODEL)
EPS = 1e-6
NEG_INF = -1e30

kernel_name = 'hybrid_dilated_gla_decoder_step'


def rmsnorm(x, g):
    x32 = x.astype(jnp.float32)
    y = x32 * lax.rsqrt(jnp.mean(x32 * x32, axis=-1, keepdims=True) + EPS)
    return (y * g.astype(jnp.float32)).astype(x.dtype)


def t5_bucket(n):
    max_exact = REL_BUCKETS // 2
    nf = jnp.maximum(n, 1).astype(jnp.float32)
    large = max_exact + (jnp.log(nf / max_exact) / math.log(REL_MAX_DIST / max_exact)
                         * (REL_BUCKETS - max_exact)).astype(jnp.int32)
    return jnp.where(n < max_exact, n, jnp.minimum(large, REL_BUCKETS - 1))


def softmax_with_lse(s):
    mx = jnp.max(s, axis=-1, keepdims=True)
    p = jnp.exp(s - mx)
    den = jnp.sum(p, axis=-1, keepdims=True)
    return p / den, (mx + jnp.log(den))[..., 0]


def split_columns(t):
    parts, start = [], 0
    for w in IN_WIDTHS:
        parts.append(t[..., start:start + w])
        start += w
    return parts


def dilated_prompt(q, k, v, bias_tab, window, dil):
    bsz, seq, heads, dh = q.shape
    nk = window // dil
    span = dil * nk
    s_pad = -(-seq // span) * span
    m = s_pad // dil
    nb = m // nk

    def to_blocks(t):
        t = jnp.pad(t, ((0, 0), (0, s_pad - seq), (0, 0), (0, 0)))
        t = t.reshape(bsz, m, dil, heads, dh).transpose(0, 2, 1, 3, 4)
        return t.reshape(bsz, dil, nb, nk, heads, dh)

    def band(t):
        prev = jnp.pad(t[:, :, :-1], ((0, 0), (0, 0), (1, 0), (0, 0), (0, 0), (0, 0)))
        return jnp.concatenate([prev, t], axis=3)

    qb = to_blocks(q)
    kband = band(to_blocks(k))
    vband = band(to_blocks(v))
    i = jnp.arange(nk)[:, None]
    j = jnp.arange(2 * nk)[None, :]
    dsub = nk + i - j
    in_band = (dsub >= 0) & (dsub <= nk)
    blk = jnp.arange(nb)[:, None, None]
    valid = in_band[None] & (blk * nk + j[None] - nk >= 0)
    bias = bias_tab[t5_bucket(jnp.maximum(dsub, 0) * dil)].transpose(2, 0, 1)
    s = jnp.einsum('brnqhd,brnkhd->brnhqk', qb, kband).astype(jnp.float32) * (dh ** -0.5)
    s = s + bias.astype(jnp.float32)[None, None, None]
    s = jnp.where(valid[None, None, :, None], s, NEG_INF)
    p, lse = softmax_with_lse(s)
    o = jnp.einsum('brnhqk,brnkhd->brnqhd', p.astype(v.dtype), vband)
    o = o.reshape(bsz, dil, m, heads, dh).transpose(0, 2, 1, 3, 4).reshape(bsz, s_pad, heads, dh)[:, :seq]
    lse = lse.transpose(0, 1, 2, 4, 3).reshape(bsz, dil, m, heads).transpose(0, 2, 1, 3)
    lse = lse.reshape(bsz, s_pad, heads)[:, :seq]
    return o, lse


def dilated_sample(q, k, v, buf_k, buf_v, bias_tab, window, dil):
    bsz, seq, heads, dh = q.shape
    wb = buf_k.shape[1]
    nk = window // dil
    kc = jnp.concatenate([buf_k, k], axis=1)
    vc = jnp.concatenate([buf_v, v], axis=1)
    steps = jnp.arange(nk + 1)
    idx = wb + jnp.arange(seq)[:, None] - steps[None, :] * dil
    valid = idx >= 0
    idx = jnp.maximum(idx, 0)
    kg = kc[:, idx]
    vg = vc[:, idx]
    bias = bias_tab[t5_bucket(steps * dil)].T
    s = jnp.einsum('bqhd,bqkhd->bhqk', q, kg).astype(jnp.float32) * (dh ** -0.5)
    s = s + bias.astype(jnp.float32)[None, :, None, :]
    s = jnp.where(valid[None, None], s, NEG_INF)
    p, lse = softmax_with_lse(s)
    o = jnp.einsum('bhqk,bqkhd->bqhd', p.astype(v.dtype), vg)
    return o, lse.transpose(0, 2, 1)


def combine_dilations(outs, lses):
    w = jax.nn.softmax(jnp.stack(lses, axis=0), axis=0)
    o = jnp.sum(w[..., None] * jnp.stack(outs, axis=0).astype(jnp.float32), axis=0)
    return o.astype(outs[0].dtype)


def gla_chunked(q, k, v, logf, s0, chunk):
    bsz, seq, heads, dk = q.shape
    dv = v.shape[-1]
    nc = seq // chunk

    def prep(t):
        t = t.astype(jnp.float32).reshape(bsz, nc, chunk, heads, t.shape[-1])
        return t.transpose(1, 0, 3, 2, 4)

    qc = prep(q) * (dk ** -0.5)
    kc, vc, fc = prep(k), prep(v), prep(logf)
    mask = jnp.tril(jnp.ones((chunk, chunk), dtype=bool))
    mid = chunk // 2

    def step(state, inp):
        qx, kx, vx, fx = inp
        b = jnp.cumsum(fx, axis=2)
        bm = b[:, :, mid:mid + 1]
        blast = b[:, :, -1:]
        o_inter = jnp.einsum('bhcd,bhde->bhce', qx * jnp.exp(b), state)
        a = jnp.einsum('bhid,bhjd->bhij', qx * jnp.exp(b - bm), kx * jnp.exp(bm - b))
        a = jnp.where(mask, a, 0.0)
        o = o_inter + jnp.einsum('bhij,bhje->bhie', a, vx)
        state = jnp.exp(blast[:, :, 0])[..., None] * state + jnp.einsum('bhcd,bhce->bhde', kx * jnp.exp(blast - b), vx)
        return state, o

    s_fin, o = lax.scan(step, s0.astype(jnp.float32), (qc, kc, vc, fc))
    o = o.transpose(1, 0, 3, 2, 4).reshape(bsz, seq, heads, dv)
    return o, s_fin


def memory_kv(mem, g, w_mk, w_mv):
    bsz, mlen, _ = mem.shape
    m = rmsnorm(mem, g)
    k = (m @ w_mk).reshape(bsz, mlen, M_HEADS, M_HEAD_DIM)
    v = (m @ w_mv).reshape(bsz, mlen, M_HEADS, M_HEAD_DIM)
    return jnp.stack([k, v], axis=2)


def cross_attend(h, mem_kv, w_mq, w_mo):
    bsz, seq, _ = h.shape
    q = (h @ w_mq).reshape(bsz, seq, M_HEADS, M_HEAD_DIM)
    s = jnp.einsum('bqhd,bmhd->bhqm', q, mem_kv[:, :, 0]).astype(jnp.float32) * (M_HEAD_DIM ** -0.5)
    p = jax.nn.softmax(s, axis=-1).astype(h.dtype)
    o = jnp.einsum('bhqm,bmhd->bqhd', p, mem_kv[:, :, 1])
    return o.reshape(bsz, seq, M_WIDTH) @ w_mo


def trunk_layer(x, mem_kv, gla_s0, gla_chunk, win_bufs, rel_bias, lw):
    (n_mix_pre, n_mix_post, w_in, w_f2, b_f2, gla_norm, w_proj_a, w_proj_b, w_out,
     n_mem_pre, n_mem_post, w_mq, w_mo, n_ffn_pre, n_ffn_post, w_gate, w_up, w_down) = lw
    bsz, seq, _ = x.shape
    h = rmsnorm(x, n_mix_pre)
    qa, ka, va, qb, kb, vb, gb, fb, gate_a, gate_b = split_columns(h @ w_in)
    qa = qa.reshape(bsz, seq, A_HEADS, A_HEAD_DIM)
    ka = ka.reshape(bsz, seq, A_HEADS, A_HEAD_DIM)
    va = va.reshape(bsz, seq, A_HEADS, A_HEAD_DIM)
    outs, lses, win_new = [], [], []
    for gi, (window, dil) in enumerate(A_GROUPS):
        hs = slice(gi * A_HEADS_PER_GROUP, (gi + 1) * A_HEADS_PER_GROUP)
        tab = rel_bias[:, hs]
        qg, kg, vg = qa[:, :, hs], ka[:, :, hs], va[:, :, hs]
        if win_bufs is None:
            o, l = dilated_prompt(qg, kg, vg, tab, window, dil)
            keep = min(window, seq)
            win_new.append(jnp.stack([kg[:, seq - keep:], vg[:, seq - keep:]], axis=2))
        else:
            buf = win_bufs[gi]
            o, l = dilated_sample(qg, kg, vg, buf[:, :, 0], buf[:, :, 1], tab, window, dil)
            win_new.append(jnp.stack([kg, vg], axis=2))
        outs.append(o)
        lses.append(l)
    ya = combine_dilations(outs, lses).reshape(bsz, seq, A_OUT) @ w_proj_a
    qb = qb.reshape(bsz, seq, B_HEADS, B_DK)
    kb = kb.reshape(bsz, seq, B_HEADS, B_DK)
    vb = vb.reshape(bsz, seq, B_HEADS, B_DV)
    logf = jax.nn.log_sigmoid((fb @ w_f2 + b_f2).astype(jnp.float32)) / B_GATE_NORM
    logf = logf.reshape(bsz, seq, B_HEADS, B_DK)
    ob, s_new = gla_chunked(qb, kb, vb, logf, gla_s0, gla_chunk)
    ob = rmsnorm(ob.astype(x.dtype), gla_norm) * jax.nn.silu(gb).reshape(bsz, seq, B_HEADS, B_DV)
    yb = ob.reshape(bsz, seq, B_V) @ w_proj_b
    mix = (jax.nn.sigmoid(gate_a) * ya + jax.nn.sigmoid(gate_b) * yb) @ w_out
    x = x + rmsnorm(mix, n_mix_post)
    h = rmsnorm(x, n_mem_pre)
    x = x + rmsnorm(cross_attend(h, mem_kv, w_mq, w_mo), n_mem_post)
    h = rmsnorm(x, n_ffn_pre)
    ffn = (jax.nn.silu(h @ w_gate) * (h @ w_up)) @ w_down
    x = x + rmsnorm(ffn, n_ffn_post)
    return x, win_new, s_new.astype(x.dtype)


def setup_inputs(seed: int = 0) -> dict:
    key = jax.random.key(seed)
    ks = iter(jax.random.split(key, 32))
    f32 = jnp.float32

    def nrm(shape, scale=1.0):
        return jax.random.normal(next(ks), shape, f32) * scale

    def gain(shape):
        return 1.0 + 0.05 * nrm(shape)

    in_total = sum(IN_WIDTHS)
    wb = [min(w, PAST_LEN) for w, _ in A_GROUPS]
    return {
        'x_prompt': nrm((BATCH, SEQ, D_MODEL)),
        'x_sample': nrm((DEC_BATCH, DEC_SEQ, D_MODEL)),
        'cache_win1_kv': nrm((DEPTH, DEC_BATCH, wb[0], 2, A_HEADS_PER_GROUP, A_HEAD_DIM)),
        'cache_win2_kv': nrm((DEPTH, DEC_BATCH, wb[1], 2, A_HEADS_PER_GROUP, A_HEAD_DIM)),
        'cache_win3_kv': nrm((DEPTH, DEC_BATCH, wb[2], 2, A_HEADS_PER_GROUP, A_HEAD_DIM)),
        'state_gla': nrm((DEPTH, DEC_BATCH, B_HEADS, B_DK, B_DV), 0.5),
        'cache_mem_kv': nrm((DEPTH, DEC_BATCH, MEM_LEN, 2, M_HEADS, M_HEAD_DIM)),
        'mem_prompt': nrm((BATCH, MEM_LEN, D_MODEL)),
        'rel_bias': nrm((REL_BUCKETS, A_HEADS), 0.5),
        'norm_mix_pre': gain((DEPTH, D_MODEL)),
        'norm_mix_post': gain((DEPTH, D_MODEL)),
        'w_in': nrm((DEPTH, D_MODEL, in_total), D_MODEL ** -0.5),
        'w_f2': nrm((DEPTH, B_GATE_RANK, B_QK), B_GATE_RANK ** -0.5),
        'b_f2': nrm((DEPTH, B_QK), 0.1),
        'gla_norm': gain((DEPTH, B_DV)),
        'w_proj_a': nrm((DEPTH, A_OUT, D_MODEL), A_OUT ** -0.5),
        'w_proj_b': nrm((DEPTH, B_V, D_MODEL), B_V ** -0.5),
        'w_out': nrm((DEPTH, D_MODEL, D_MODEL), D_MODEL ** -0.5),
        'norm_memtok': gain((DEPTH, D_MODEL)),
        'w_mk': nrm((DEPTH, D_MODEL, M_WIDTH), D_MODEL ** -0.5),
        'w_mv': nrm((DEPTH, D_MODEL, M_WIDTH), D_MODEL ** -0.5),
        'norm_mem_pre': gain((DEPTH, D_MODEL)),
        'norm_mem_post': gain((DEPTH, D_MODEL)),
        'w_mq': nrm((DEPTH, D_MODEL, M_WIDTH), D_MODEL ** -0.5),
        'w_mo': nrm((DEPTH, M_WIDTH, D_MODEL), M_WIDTH ** -0.5),
        'norm_ffn_pre': gain((DEPTH, D_MODEL)),
        'norm_ffn_post': gain((DEPTH, D_MODEL)),
        'w_ffn_gate': nrm((DEPTH, D_MODEL, D_FF), D_MODEL ** -0.5),
        'w_ffn_up': nrm((DEPTH, D_MODEL, D_FF), D_MODEL ** -0.5),
        'w_ffn_down': nrm((DEPTH, D_FF, D_MODEL), D_FF ** -0.5),
    }


def reference(x_prompt, x_sample, cache_win1_kv, cache_win2_kv, cache_win3_kv, state_gla, cache_mem_kv,
              mem_prompt, rel_bias, norm_mix_pre, norm_mix_post, w_in, w_f2, b_f2, gla_norm, w_proj_a,
              w_proj_b, w_out, norm_memtok, w_mk, w_mv, norm_mem_pre, norm_mem_post, w_mq, w_mo,
              norm_ffn_pre, norm_ffn_post, w_ffn_gate, w_ffn_up, w_ffn_down):
    yp, ys = x_prompt, x_sample
    p_w1, p_w2, p_w3, p_gla, p_mem = [], [], [], [], []
    s_w1, s_w2, s_w3, s_gla = [], [], [], []
    for l in range(DEPTH):
        lw = (norm_mix_pre[l], norm_mix_post[l], w_in[l], w_f2[l], b_f2[l], gla_norm[l], w_proj_a[l],
              w_proj_b[l], w_out[l], norm_mem_pre[l], norm_mem_post[l], w_mq[l], w_mo[l],
              norm_ffn_pre[l], norm_ffn_post[l], w_ffn_gate[l], w_ffn_up[l], w_ffn_down[l])
        mem_kv_p = memory_kv(mem_prompt, norm_memtok[l], w_mk[l], w_mv[l])
        s0 = jnp.zeros((x_prompt.shape[0], B_HEADS, B_DK, B_DV), jnp.float32)
        yp, win_p, gla_p = trunk_layer(yp, mem_kv_p, s0, min(B_CHUNK, x_prompt.shape[1]), None, rel_bias, lw)
        bufs = (cache_win1_kv[l], cache_win2_kv[l], cache_win3_kv[l])
        ys, win_s, gla_s = trunk_layer(ys, cache_mem_kv[l], state_gla[l], x_sample.shape[1], bufs, rel_bias, lw)
        p_w1.append(win_p[0])
        p_w2.append(win_p[1])
        p_w3.append(win_p[2])
        p_gla.append(gla_p)
        p_mem.append(mem_kv_p)
        s_w1.append(win_s[0])
        s_w2.append(win_s[1])
        s_w3.append(win_s[2])
        s_gla.append(gla_s)
    return (yp, ys, jnp.stack(p_w1), jnp.stack(p_w2), jnp.stack(p_w3), jnp.stack(p_gla), jnp.stack(p_mem),
            jnp.stack(s_w1), jnp.stack(s_w2), jnp.stack(s_w3), jnp.stack(s_gla))
```

```cpp
#include <hip/hip_runtime.h>
#include <hip/hip_cooperative_groups.h>
#include <cstdio>
#include <cstdint>
namespace cg = cooperative_groups;
#define LAS __attribute__((address_space(3)))
namespace pg8 {
#define PG8_LAS __attribute__((address_space(3)))
typedef unsigned short bf16_t;
typedef short bf16x8 __attribute__((ext_vector_type(8)));
typedef float f32x4 __attribute__((ext_vector_type(4)));
typedef unsigned u32x4 __attribute__((ext_vector_type(4)));
constexpr int BM = 256, BK = 64, HALF = 128, HTB = HALF * BK * 2  , STAGE_BYTES = 8 * HTB, NXCD = 8, WGM = 8;

__host__ __device__ __forceinline__ int lds_byte(int r, int c) { const int st = (r >> 4) * 2 + (c >> 5), rr = r & 15, cc = c & 31, ob = rr * 64 + cc * 2; return st * 1024 + (ob ^ (((ob >> 9) & 1) << 5)); }
__host__ __device__ __forceinline__ void stage_rc(int b, int& R, int& C) { const int st = b / 1024, sb = b % 1024, swz = sb ^ (((sb >> 9) & 1) << 5); R = (st >> 1) * 16 + swz / 64; C = (st & 1) * 32 + (swz % 64) / 2; }
__host__ __device__ __forceinline__ int perm32(int rho) { const int n = rho >> 4, i = rho & 15; return 8 * (i >> 2) + 4 * n + (i & 3); }

struct Unit { int pm, pn; };
struct Gemm { const bf16_t* A; const bf16_t* Bt; int M, N, K; };

struct StaticOrder {
    int nM, nN, nwg, G, c;
    __host__ __device__ void init(int M, int N, int G_, int c_) { nM = M / BM; nN = N / BM; nwg = nM * nN; G = G_; c = c_; }
    __host__ __device__ bool next(int i, Unit& u) const {
        const long L = (long)i * G + c; if (L >= nwg) return false;
        int wgid = (int)L; { const int q = nwg / NXCD, r = nwg % NXCD, xcd = wgid % NXCD, off = wgid / NXCD; wgid = (xcd < r ? xcd * (q + 1) : r * (q + 1) + (xcd - r) * q) + off; }
        const int nig = WGM * nN, gid = wgid / nig, fm = gid * WGM, gsz = (nM - fm) < WGM ? (nM - fm) : WGM;
        u.pm = fm + ((wgid % nig) % gsz); u.pn = (wgid % nig) / gsz; return true;
    }
    __device__ __forceinline__ void a_ready(const Unit&) const {}
    __device__ __forceinline__ void done(const Unit&) const {}
};

__device__ __forceinline__ unsigned cvt_pk_bf16(float lo, float hi) { unsigned r; asm volatile("v_cvt_pk_bf16_f32 %0, %1, %2" : "=v"(r) : "v"(lo), "v"(hi)); return r; }
typedef float f32x2 __attribute__((ext_vector_type(2)));
__device__ __forceinline__ f32x2 gelu_pk(f32x2 v) {
    const f32x2 av = __builtin_elementwise_abs(v), d = av * 0.2316418882f + 1.0f;
    f32x2 t; t.x = __builtin_amdgcn_rcpf(d.x); t.y = __builtin_amdgcn_rcpf(d.y);
    f32x2 q = t * 0.5307027145f + (-0.7265760135f); q = q * t + 0.7107068705f; q = q * t + (-0.142248368f); q = q * t + 0.127414796f; q = q * t;
    const f32x2 s = (v * v) * (-0.72134752044f);
    f32x2 e; e.x = __builtin_amdgcn_exp2f(s.x); e.y = __builtin_amdgcn_exp2f(s.y);
    const f32x2 m = v * (q * e), r = v - m;
    f32x2 o; o.x = v.x < 0.f ? m.x : r.x; o.y = v.y < 0.f ? m.y : r.y; return o;
}

template <int ACT  > struct EpiBf16 {
    static constexpr bool PERM = true, AFTER_DRAIN = false; static_assert(ACT == 0 || ACT == 1, "EpiBf16: ACT is 0 (none) or 1 (gelu_pk)");
    bf16_t* O; int ldc; const float* bias; int split_cols; size_t split_stride; float scale0;
    __device__ __forceinline__ void operator()(const f32x4 (&acc)[2][2][4][2], const Unit& u, int wr, int wc, int fr, int fq) const {
        const int row0 = u.pm * BM + wr * 64 + fr; int colt = u.pn * BM; bf16_t* base = O;
        float sc = 1.f; if (split_cols) { const int t = colt / split_cols; base += (size_t)t * split_stride; colt -= t * split_cols; if (t == 0) sc = scale0; }
        const int col0 = colt + wc * 32 + 8 * fq, bcol0 = u.pn * BM + wc * 32 + 8 * fq;
        f32x4 bv[2][2];
#pragma unroll
        for (int bj = 0; bj < 2; ++bj)
#pragma unroll
            for (int n = 0; n < 2; ++n) bv[bj][n] = bias ? *(const f32x4*)(bias + bcol0 + bj * HALF + 4 * n) : (f32x4){0.f, 0.f, 0.f, 0.f};
#pragma unroll
        for (int ai = 0; ai < 2; ++ai)
#pragma unroll
            for (int m = 0; m < 4; ++m) { bf16_t* rowp = base + (size_t)(row0 + ai * HALF + m * 16) * ldc + col0;
#pragma unroll
                for (int bj = 0; bj < 2; ++bj) { f32x4 v0 = acc[ai][bj][m][0] + bv[bj][0], v1 = acc[ai][bj][m][1] + bv[bj][1];
                    if (ACT == 1) { f32x2 a = gelu_pk((f32x2){v0[0], v0[1]}), b = gelu_pk((f32x2){v0[2], v0[3]}), c = gelu_pk((f32x2){v1[0], v1[1]}), d = gelu_pk((f32x2){v1[2], v1[3]});
                        v0 = (f32x4){a.x, a.y, b.x, b.y}; v1 = (f32x4){c.x, c.y, d.x, d.y}; }
                    v0 = v0 * sc; v1 = v1 * sc; u32x4 w; w.x = cvt_pk_bf16(v0[0], v0[1]); w.y = cvt_pk_bf16(v0[2], v0[3]); w.z = cvt_pk_bf16(v1[0], v1[1]); w.w = cvt_pk_bf16(v1[2], v1[3]);
                    *(u32x4*)(rowp + bj * HALF) = w; } }
    }
};

struct PanelStats {
    unsigned* xbuf;
    unsigned* cnt;
    unsigned* tmo;
    int ntn; float eps;
    unsigned code;
    __device__ __forceinline__ bool run(const f32x4 (&v)[2][2][4][2], const Unit& u, int wr, int wc, int fr, int fq, PG8_LAS unsigned char* lds, int wid, int lane) const {
        typedef float f32x2v __attribute__((ext_vector_type(2)));
        PG8_LAS f32x2v* P = (PG8_LAS f32x2v*)lds;
        PG8_LAS f32x2v* S = (PG8_LAS f32x2v*)(lds + 8192);
        PG8_LAS unsigned* flag = (PG8_LAS unsigned*)(lds + 8192 + 2048);
#pragma unroll
        for (int ai = 0; ai < 2; ++ai)
#pragma unroll
            for (int m = 0; m < 4; ++m) {
                float s = 0.f;
#pragma unroll
                for (int bj = 0; bj < 2; ++bj)
#pragma unroll
                    for (int n = 0; n < 2; ++n) { const f32x4 x = v[ai][bj][m][n]; s += (x[0] + x[1]) + (x[2] + x[3]); }
                s += __shfl_xor(s, 16); s += __shfl_xor(s, 32);
                const float mw = s * (1.0f / 64.0f); float q = 0.f;
#pragma unroll
                for (int bj = 0; bj < 2; ++bj)
#pragma unroll
                    for (int n = 0; n < 2; ++n) { const f32x4 d = v[ai][bj][m][n] - mw; q += (d[0] * d[0] + d[1] * d[1]) + (d[2] * d[2] + d[3] * d[3]); }
                q += __shfl_xor(q, 16); q += __shfl_xor(q, 32);
                if (fq == 0) P[(ai * HALF + wr * 64 + m * 16 + fr) * 4 + wc] = (f32x2v){mw, q};
            }
        asm volatile("s_waitcnt lgkmcnt(0)" ::: "memory"); __builtin_amdgcn_s_barrier(); asm volatile("" ::: "memory");
#if defined(BROKEN_EXCHANGE_NO_WAIT)
#warning BROKEN CONTROL BUILD: the row-statistics exchange does not wait; results are wrong by design
        if (blockIdx.x >= 64) { const long long t0_ = clock64(); while (clock64() - t0_ < 60000) __builtin_amdgcn_s_sleep(8); }
#endif
        const int row = wid * 32 + (lane & 31);
        if (lane < 32) {
            const f32x2v a = P[row * 4 + 0], b = P[row * 4 + 1], c = P[row * 4 + 2], d = P[row * 4 + 3];
            const float mt = (a.x + b.x + c.x + d.x) * 0.25f;
            const float da = a.x - mt, db = b.x - mt, dc = c.x - mt, dd = d.x - mt;
            const float m2 = (a.y + b.y) + (c.y + d.y) + 64.0f * ((da * da + db * db) + (dc * dc + dd * dd));
            unsigned long long* slot = (unsigned long long*)xbuf + ((size_t)(u.pm * BM + row) * 4 + u.pn);
            __hip_atomic_store(slot, ((unsigned long long)__float_as_uint(m2) << 32) | __float_as_uint(mt), __ATOMIC_RELAXED, __HIP_MEMORY_SCOPE_AGENT);
        }
        asm volatile("s_waitcnt vmcnt(0)" ::: "memory");
        if (lane == 0) __hip_atomic_fetch_add(cnt + 64 * u.pm, 1u, __ATOMIC_RELAXED, __HIP_MEMORY_SCOPE_AGENT);
        if (wid == 0) {
            bool dead = false; const unsigned long long t0 = __builtin_amdgcn_s_memrealtime(); const unsigned want = 8u * (unsigned)ntn;
            for (;;) {
#if defined(BROKEN_EXCHANGE_NO_WAIT)
                break;
#endif
                if ((unsigned)__builtin_amdgcn_readfirstlane(__hip_atomic_load(cnt + 64 * u.pm, __ATOMIC_RELAXED, __HIP_MEMORY_SCOPE_AGENT)) >= want) break;
                if (__builtin_amdgcn_s_memrealtime() - t0 > 2000000ull) {
                    if (lane == 0) { unsigned expect = 0u; __hip_atomic_compare_exchange_strong(tmo + 1, &expect, code | (unsigned)(u.pm & 0xff), __ATOMIC_RELAXED, __ATOMIC_RELAXED, __HIP_MEMORY_SCOPE_AGENT);
                                     __hip_atomic_store(tmo, 1u, __ATOMIC_RELAXED, __HIP_MEMORY_SCOPE_AGENT); }
                    dead = true; break; }
                __builtin_amdgcn_s_sleep(2);
            }
            __builtin_amdgcn_fence(__ATOMIC_ACQUIRE, "agent");
            if (lane == 0) flag[0] = dead ? 1u : 0u;
        }
        asm volatile("s_waitcnt vmcnt(0) lgkmcnt(0)" ::: "memory"); __builtin_amdgcn_s_barrier(); asm volatile("" ::: "memory");
        const bool bad = flag[0] != 0u;
        if (lane < 32) {
            const unsigned long long* slot = (const unsigned long long*)xbuf + (size_t)(u.pm * BM + row) * 4; float mt[4], m2[4]; float ms = 0.f;
#pragma unroll
            for (int t = 0; t < 4; ++t) { if (t < ntn) { const unsigned long long w = __hip_atomic_load(slot + t, __ATOMIC_RELAXED, __HIP_MEMORY_SCOPE_AGENT); mt[t] = __uint_as_float((unsigned)w); m2[t] = __uint_as_float((unsigned)(w >> 32)); } else { mt[t] = 0.f; m2[t] = 0.f; } ms += mt[t]; }
            const float mean = ms / (float)ntn; float q = 0.f;
#pragma unroll
            for (int t = 0; t < 4; ++t) if (t < ntn) { const float dm = mt[t] - mean; q += m2[t] + 256.0f * dm * dm; }
            S[row] = (f32x2v){mean, 1.0f / sqrtf(q / (256.0f * (float)ntn) + eps)};
        }
        asm volatile("s_waitcnt lgkmcnt(0)" ::: "memory"); __builtin_amdgcn_s_barrier(); asm volatile("" ::: "memory");
        return bad;
    }
};
struct EpiLnRes {
    static constexpr bool PERM = false, AFTER_DRAIN = true;
    const float* base; float* out; int ldc; const float* bias; PanelStats st; unsigned poison;
    __device__ __forceinline__ void fused(f32x4 (&acc)[2][2][4][2], const Unit& u, int wr, int wc, int fr, int fq, PG8_LAS unsigned char* lds, int wid, int lane) const {
        typedef float f32x2v __attribute__((ext_vector_type(2)));
        const PG8_LAS f32x2v* S = (const PG8_LAS f32x2v*)(lds + 8192);
        const int col0 = u.pn * BM + wc * 32 + 4 * fq;
#pragma unroll
        for (int bj = 0; bj < 2; ++bj)
#pragma unroll
            for (int n = 0; n < 2; ++n) { const f32x4 bv = bias ? *(const f32x4*)(bias + col0 + bj * HALF + n * 16) : (f32x4){0.f, 0.f, 0.f, 0.f};
#pragma unroll
                for (int ai = 0; ai < 2; ++ai)
#pragma unroll
                    for (int m = 0; m < 4; ++m) acc[ai][bj][m][n] += bv; }
        f32x4 pre[4][2][2];
#pragma unroll
        for (int m = 0; m < 4; ++m) { const size_t off = (size_t)(u.pm * BM + wr * 64 + m * 16 + fr) * ldc + col0;
#pragma unroll
            for (int bj = 0; bj < 2; ++bj)
#pragma unroll
                for (int n = 0; n < 2; ++n) pre[m][bj][n] = *(const f32x4*)(base + off + bj * HALF + n * 16); }
        const bool bad = st.run(acc, u, wr, wc, fr, fq, lds, wid, lane) || poison != 0u;
        const float qnan = __builtin_nanf("");
#pragma unroll
        for (int ai = 0; ai < 2; ++ai)
#pragma unroll
            for (int m = 0; m < 4; ++m) { const int r = ai * HALF + wr * 64 + m * 16 + fr; const f32x2v sr = S[r]; const size_t off = (size_t)(u.pm * BM + r) * ldc + col0;
#pragma unroll
                for (int bj = 0; bj < 2; ++bj)
#pragma unroll
                    for (int n = 0; n < 2; ++n) { const f32x4 bs = ai == 0 ? pre[m][bj][n] : *(const f32x4*)(base + off + bj * HALF + n * 16); f32x4 o = bs + (acc[ai][bj][m][n] - sr.x) * sr.y;
                        if (bad) o = (f32x4){qnan, qnan, qnan, qnan}; *(f32x4*)(out + off + bj * HALF + n * 16) = o; }
                if (m & 1) asm volatile("" ::: "memory"); }
    }
};
struct EpiLnResLn {
    static constexpr bool PERM = false, AFTER_DRAIN = true;
    const float* base; float* out; bf16_t* xn; int ldc; const float* bias; PanelStats st1, st2; unsigned poison;
    __device__ __forceinline__ void fused(f32x4 (&acc)[2][2][4][2], const Unit& u, int wr, int wc, int fr, int fq, PG8_LAS unsigned char* lds, int wid, int lane) const {
        typedef float f32x2v __attribute__((ext_vector_type(2))); typedef unsigned u32x2v __attribute__((ext_vector_type(2)));
        const PG8_LAS f32x2v* S = (const PG8_LAS f32x2v*)(lds + 8192);
        const int col0 = u.pn * BM + wc * 32 + 4 * fq;
#pragma unroll
        for (int bj = 0; bj < 2; ++bj)
#pragma unroll
            for (int n = 0; n < 2; ++n) { const f32x4 bv = bias ? *(const f32x4*)(bias + col0 + bj * HALF + n * 16) : (f32x4){0.f, 0.f, 0.f, 0.f};
#pragma unroll
                for (int ai = 0; ai < 2; ++ai)
#pragma unroll
                    for (int m = 0; m < 4; ++m) acc[ai][bj][m][n] += bv; }
        bool bad = st1.run(acc, u, wr, wc, fr, fq, lds, wid, lane) || poison != 0u;
        const float qnan = __builtin_nanf("");
#pragma unroll
        for (int ai = 0; ai < 2; ++ai)
#pragma unroll
            for (int m = 0; m < 4; ++m) { const int r = ai * HALF + wr * 64 + m * 16 + fr; const f32x2v sr = S[r]; const size_t off = (size_t)(u.pm * BM + r) * ldc + col0;
#pragma unroll
                for (int bj = 0; bj < 2; ++bj)
#pragma unroll
                    for (int n = 0; n < 2; ++n) { const f32x4 bs = *(const f32x4*)(base + off + bj * HALF + n * 16); acc[ai][bj][m][n] = bs + (acc[ai][bj][m][n] - sr.x) * sr.y; }
                asm volatile("" : "+v"(acc[ai][0][m][0]), "+v"(acc[ai][0][m][1]), "+v"(acc[ai][1][m][0]), "+v"(acc[ai][1][m][1]));
                if (m & 1) asm volatile("" ::: "memory"); }
        const bool bad1 = bad;
        bad = st2.run(acc, u, wr, wc, fr, fq, lds, wid, lane) || bad;
#pragma unroll
        for (int ai = 0; ai < 2; ++ai)
#pragma unroll
            for (int m = 0; m < 4; ++m) { const int r = ai * HALF + wr * 64 + m * 16 + fr; const f32x2v sr = S[r]; const size_t off = (size_t)(u.pm * BM + r) * ldc + col0;
#pragma unroll
                for (int bj = 0; bj < 2; ++bj)
#pragma unroll
                    for (int n = 0; n < 2; ++n) { const f32x4 x1 = acc[ai][bj][m][n]; *(f32x4*)(out + off + bj * HALF + n * 16) = bad1 ? (f32x4){qnan, qnan, qnan, qnan} : x1;
                        const f32x4 o = (x1 - sr.x) * sr.y; u32x2v w; w.x = cvt_pk_bf16(o[0], o[1]); w.y = cvt_pk_bf16(o[2], o[3]);
                        if (bad) { w.x = 0x7fc07fc0u; w.y = 0x7fc07fc0u; } *(u32x2v*)(xn + off + bj * HALF + n * 16) = w; }
                asm volatile("" ::: "memory"); }
    }
};

template <class Epi, class Sched, bool ALIGN_EPI = false, bool SP2 = false>
__device__ __forceinline__ void gemm_phase(PG8_LAS unsigned char* lds, const Gemm g, const Sched& S, const Epi& E, const int wave_id) {
    const int lane = __builtin_amdgcn_mbcnt_hi(~0u, __builtin_amdgcn_mbcnt_lo(~0u, 0u)), wid = wave_id, tid = wid * 64 + lane, wr = wid >> 2, wc = wid & 3, fr = lane & 15, fq = lane >> 4;
    const int K = g.K, nt = K / BK;
    unsigned voffA[2], voffB[2];
#pragma unroll
    for (int i = 0; i < 2; ++i) { int R, C; stage_rc(tid * 16 + i * 8192, R, C); const int Rb = Epi::PERM ? ((R & ~31) + perm32(R & 31)) : R;
        voffA[i] = (unsigned)(R * K + C) * 2u; voffB[i] = (unsigned)(Rb * K + C) * 2u; }
    const size_t kstep = (size_t)(BK * 2);
    const size_t hstep = (size_t)HALF * K * 2;
    const size_t tstep = 2 * hstep;
    const unsigned ldsw = (unsigned)wid * 1024u;
    const int aoff = lds_byte(wr * 64 + fr, fq * 8), boff = lds_byte(wc * 32 + fr, fq * 8);
#define PG8_SA(b, h) (((b) * 2 + (h)) * HTB)
#define PG8_SB(b, h) ((4 + (b) * 2 + (h)) * HTB)
#define PG8_STAGE(bufoff, gbase, voff) do { _Pragma("unroll") for (int _i = 0; _i < 2; ++_i) \
        __builtin_amdgcn_global_load_lds((const unsigned*)((const char*)(gbase) + (voff)[_i]), (PG8_LAS unsigned*)(lds + (bufoff) + ldsw + _i * 8192), 16, 0, 0); } while (0)
#define PG8_LDA(dst, b, h) do { _Pragma("unroll") for (int m = 0; m < 4; ++m) _Pragma("unroll") for (int k = 0; k < 2; ++k) dst[m][k] = *(const PG8_LAS bf16x8*)(lds + PG8_SA(b, h) + aoff + m * 2048 + k * 1024); } while (0)
#define PG8_LDB(dst, b, h) do { _Pragma("unroll") for (int n = 0; n < 2; ++n) _Pragma("unroll") for (int k = 0; k < 2; ++k) dst[n][k] = *(const PG8_LAS bf16x8*)(lds + PG8_SB(b, h) + boff + n * 2048 + k * 1024); } while (0)
#define PG8_MMA(ai, bj, At, Bt) do { __builtin_amdgcn_s_setprio(1); _Pragma("unroll") for (int m = 0; m < 4; ++m) _Pragma("unroll") for (int n = 0; n < 2; ++n) _Pragma("unroll") for (int k = 0; k < 2; ++k) \
        acc[ai][bj][m][n] = __builtin_amdgcn_mfma_f32_16x16x32_bf16(Bt[n][k], At[m][k], acc[ai][bj][m][n], 0, 0, 0); __builtin_amdgcn_s_setprio(0); } while (0)
#define PG8_WAIT_V(n) asm volatile("s_waitcnt vmcnt(" #n ")" ::: "memory")
#define PG8_WAIT_L(n) asm volatile("s_waitcnt lgkmcnt(" #n ")" ::: "memory")
#define PG8_BAR __builtin_amdgcn_s_barrier()
#define PG8_SCHED __builtin_amdgcn_sched_barrier(0)
    Unit cur, nxt; int ui = 0;
    if (!S.next(0, cur)) return;
    f32x4 acc[2][2][4][2];
#pragma unroll
    for (int a = 0; a < 2; ++a)
#pragma unroll
        for (int b = 0; b < 2; ++b)
#pragma unroll
            for (int m = 0; m < 4; ++m)
#pragma unroll
                for (int n = 0; n < 2; ++n) acc[a][b][m][n] = (f32x4){0.f, 0.f, 0.f, 0.f};
    bf16x8 At[4][2], B0[2][2], B1[2][2];
    const char* cA = (const char*)g.A + (size_t)cur.pm * tstep; const char* cB = (const char*)g.Bt + (size_t)cur.pn * tstep;
    S.a_ready(cur);
    if constexpr (SP2) {
        PG8_STAGE(PG8_SB(0, 0), cB, voffB); PG8_STAGE(PG8_SB(0, 1), cB + hstep, voffB); PG8_STAGE(PG8_SA(0, 0), cA, voffA); PG8_STAGE(PG8_SA(0, 1), cA + hstep, voffA);
        if (wr == 1) PG8_BAR;
        PG8_WAIT_V(2); PG8_BAR;
        PG8_STAGE(PG8_SB(1, 0), cB + kstep, voffB); PG8_STAGE(PG8_SA(1, 0), cA + kstep, voffA); PG8_STAGE(PG8_SB(1, 1), cB + hstep + kstep, voffB);
        PG8_WAIT_V(6); PG8_BAR;
    } else {
        PG8_STAGE(PG8_SB(0, 0), cB, voffB); PG8_STAGE(PG8_SA(0, 0), cA, voffA); PG8_STAGE(PG8_SB(0, 1), cB + hstep, voffB); PG8_STAGE(PG8_SA(0, 1), cA + hstep, voffA);
        if (wr == 1) PG8_BAR;
        PG8_WAIT_V(4); PG8_BAR;
        PG8_STAGE(PG8_SB(1, 0), cB + kstep, voffB); PG8_STAGE(PG8_SA(1, 0), cA + kstep, voffA); PG8_STAGE(PG8_SB(1, 1), cB + hstep + kstep, voffB);
        PG8_WAIT_V(6); PG8_BAR;
    }
    for (;;) {
        const bool has_next = S.next(ui + 1, nxt);
        const char* nA = has_next ? (const char*)g.A + (size_t)nxt.pm * tstep : cA; const char* nB = has_next ? (const char*)g.Bt + (size_t)nxt.pn * tstep : cB;
        for (int t = 0; t < nt; t += 2) {
            const bool last = (t == nt - 2);
            const char* a1 = cA + (size_t)(t + 1) * kstep;
            const char* a2 = last ? nA : cA + (size_t)(t + 2) * kstep; const char* b2 = last ? nB : cB + (size_t)(t + 2) * kstep;
            const char* a3 = a2 + kstep; const char* b3 = b2 + kstep;
            if (last && has_next) S.a_ready(nxt);
            if constexpr (SP2) {
            PG8_LDB(B0, 0, 0); PG8_LDB(B1, 0, 1); PG8_SCHED; PG8_LDA(At, 0, 0); PG8_STAGE(PG8_SA(1, 1), a1 + hstep, voffA);
            PG8_WAIT_V(8); PG8_WAIT_L(0); PG8_BAR; PG8_MMA(0, 0, At, B0); PG8_MMA(0, 1, At, B1); PG8_BAR; PG8_SCHED;
            PG8_LDA(At, 0, 1); PG8_STAGE(PG8_SB(0, 0), b2, voffB); PG8_STAGE(PG8_SB(0, 1), b2 + hstep, voffB); PG8_STAGE(PG8_SA(0, 0), a2, voffA);
            PG8_WAIT_V(8); PG8_WAIT_L(0); PG8_BAR; PG8_MMA(1, 0, At, B0); PG8_MMA(1, 1, At, B1); PG8_BAR; PG8_SCHED;
            PG8_LDB(B0, 1, 0); PG8_LDB(B1, 1, 1); PG8_SCHED; PG8_LDA(At, 1, 0); PG8_STAGE(PG8_SA(0, 1), a2 + hstep, voffA);
            PG8_WAIT_V(8); PG8_WAIT_L(0); PG8_BAR; PG8_MMA(0, 0, At, B0); PG8_MMA(0, 1, At, B1); PG8_BAR; PG8_SCHED;
            PG8_LDA(At, 1, 1); PG8_STAGE(PG8_SB(1, 0), b3, voffB); PG8_STAGE(PG8_SB(1, 1), b3 + hstep, voffB); PG8_STAGE(PG8_SA(1, 0), a3, voffA);
            PG8_WAIT_V(8); PG8_WAIT_L(0); PG8_BAR; PG8_MMA(1, 0, At, B0); PG8_MMA(1, 1, At, B1); PG8_BAR; PG8_SCHED;
            } else {
            PG8_LDB(B0, 0, 0); PG8_SCHED; PG8_LDA(At, 0, 0); PG8_STAGE(PG8_SA(1, 1), a1 + hstep, voffA);
            PG8_WAIT_L(8); PG8_BAR; PG8_WAIT_L(0); PG8_MMA(0, 0, At, B0); PG8_BAR; PG8_SCHED;
            PG8_LDB(B1, 0, 1); PG8_STAGE(PG8_SB(0, 0), b2, voffB);
            PG8_BAR; PG8_WAIT_L(0); PG8_MMA(0, 1, At, B1); PG8_BAR;
            PG8_LDA(At, 0, 1); PG8_STAGE(PG8_SA(0, 0), a2, voffA);
            PG8_BAR; PG8_WAIT_L(0); PG8_MMA(1, 0, At, B0); PG8_BAR; PG8_SCHED;
            PG8_STAGE(PG8_SB(0, 1), b2 + hstep, voffB);
            PG8_WAIT_V(6); PG8_BAR; PG8_MMA(1, 1, At, B1); PG8_BAR;
            PG8_LDB(B0, 1, 0); PG8_SCHED; PG8_LDA(At, 1, 0); PG8_STAGE(PG8_SA(0, 1), a2 + hstep, voffA);
            PG8_WAIT_L(8); PG8_BAR; PG8_WAIT_L(0); PG8_MMA(0, 0, At, B0); PG8_BAR; PG8_SCHED;
            PG8_LDB(B1, 1, 1); PG8_STAGE(PG8_SB(1, 0), b3, voffB);
            PG8_BAR; PG8_WAIT_L(0); PG8_MMA(0, 1, At, B1); PG8_BAR;
            PG8_LDA(At, 1, 1); PG8_STAGE(PG8_SA(1, 0), a3, voffA);
            PG8_BAR; PG8_WAIT_L(0); PG8_MMA(1, 0, At, B0); PG8_BAR; PG8_SCHED;
            PG8_STAGE(PG8_SB(1, 1), b3 + hstep, voffB);
            PG8_WAIT_V(6); PG8_BAR; PG8_MMA(1, 1, At, B1); PG8_BAR;
            }
        }
        if constexpr (ALIGN_EPI) { if (wr == 0) PG8_BAR; }
        if constexpr (!Epi::AFTER_DRAIN) { E(acc, cur, wr, wc, fr, fq); S.done(cur); }
        if (!has_next) break;
#pragma unroll
        for (int a = 0; a < 2; ++a)
#pragma unroll
            for (int b = 0; b < 2; ++b)
#pragma unroll
                for (int m = 0; m < 4; ++m)
#pragma unroll
                    for (int n = 0; n < 2; ++n) acc[a][b][m][n] = (f32x4){0.f, 0.f, 0.f, 0.f};
        cur = nxt; cA = nA; cB = nB; ++ui;
        if constexpr (ALIGN_EPI) { if (wr == 1) PG8_BAR; }
    }
    PG8_WAIT_V(0);
    if constexpr (!ALIGN_EPI) { if (wr == 0) PG8_BAR; }
    PG8_BAR;
    if constexpr (Epi::AFTER_DRAIN) { E.fused(acc, cur, wr, wc, fr, fq, lds, wid, lane); S.done(cur); }
#undef PG8_SA
#undef PG8_SB
#undef PG8_STAGE
#undef PG8_LDA
#undef PG8_LDB
#undef PG8_MMA
#undef PG8_WAIT_V
#undef PG8_WAIT_L
#undef PG8_BAR
#undef PG8_SCHED
}
}

typedef __attribute__((address_space(1))) unsigned gu32;
#define RLX_AGENT __ATOMIC_RELAXED, __HIP_MEMORY_SCOPE_AGENT
#define XB_TMO      128
#define XB_XCNT(j)  (256  + 64 * (j))
#define XB_XSUB(j)  (1280 + 64 * (j))
#define XB_XGEN(j)  (2304 + 64 * (j))
#define XB_TOP      3328
#define XB_TOPGEN   3392
#define XCD_BAR_WORDS 3456
#define XB_SPIN_CAP (1u << 18)

__device__ __forceinline__ unsigned xb_ld(unsigned* p)              { return __hip_atomic_load(p, __ATOMIC_RELAXED, __HIP_MEMORY_SCOPE_AGENT); }
__device__ __forceinline__ unsigned xb_add(unsigned* p, unsigned v) { return __hip_atomic_fetch_add(p, v, __ATOMIC_RELAXED, __HIP_MEMORY_SCOPE_AGENT); }
__device__ __forceinline__ unsigned xb_xcc_id() { return (unsigned)__builtin_amdgcn_s_getreg((3 << 11) | 20) & 0xFu; }
#define XB_SPIN(cond, bar) do { unsigned _sp = 0; while (cond) { __builtin_amdgcn_s_sleep(1); \
    if ((++_sp & 255u) == 0u) { if (xb_ld(&(bar)[XB_TMO])) break; if (_sp > XB_SPIN_CAP) { atomicAdd(&(bar)[XB_TMO], 1u); break; } } } } while (0)

struct XcdBarrier {
    unsigned* bar; unsigned x;
    volatile LAS unsigned* st;
};

__device__ __forceinline__ XcdBarrier xcd_barrier_post(unsigned* bar, volatile LAS unsigned* st, bool leader) {
    XcdBarrier b; b.bar = bar; b.x = xb_xcc_id(); b.st = st;
    if (leader) (void)xb_add(&bar[XB_XCNT(b.x)], 1u);
    return b;
}
__device__ __forceinline__ void xcd_barrier_complete(unsigned* bar, unsigned x, unsigned& nloc, unsigned& nx) {
    const unsigned G = gridDim.x * gridDim.y * gridDim.z;
    unsigned sum, cnt, mine, sp = 0u;
    for (;;) {
        sum = 0u; cnt = 0u; mine = 0u;
#pragma unroll
        for (unsigned j = 0; j < 16; ++j) { const unsigned c = xb_ld(&bar[XB_XCNT(j)]); sum += c; cnt += (c > 0u) ? 1u : 0u; mine = (j == x) ? c : mine; }
        if (sum == G) break;
        __builtin_amdgcn_s_sleep(1);
        if ((++sp & 255u) == 0u) { if (xb_ld(&bar[XB_TMO])) break; if (sp > XB_SPIN_CAP) { atomicAdd(&bar[XB_TMO], 1u); break; } }
    }
    nloc = mine > 0u ? mine : 1u; nx = cnt > 0u ? cnt : 1u;
}

__device__ __forceinline__ void xcd_barrier(const XcdBarrier& b, bool leader) {
    asm volatile("s_waitcnt vmcnt(0)" ::: "memory");
    __syncthreads();
    if (leader) {
        unsigned* bar = b.bar;
        __builtin_amdgcn_s_waitcnt(0);
        unsigned nloc = b.st[0], nx = b.st[1];
        if (nloc == 0u) { xcd_barrier_complete(bar, b.x, nloc, nx); b.st[0] = nloc; b.st[1] = nx; }
        const unsigned old = xb_add(&bar[XB_XSUB(b.x)], 1u);
        const unsigned gen = old / nloc;
        if (old + 1u == (gen + 1u) * nloc) {
            __builtin_amdgcn_fence(__ATOMIC_RELEASE, "agent");
            asm volatile("s_waitcnt vmcnt(0)" ::: "memory");
            const unsigned og = xb_add(&bar[XB_TOP], 1u);
            const unsigned tg = og / nx;
            if (og + 1u == (tg + 1u) * nx) xb_add(&bar[XB_TOPGEN], 1u);
            else XB_SPIN(xb_ld(&bar[XB_TOPGEN]) == tg, bar);
            __builtin_amdgcn_fence(__ATOMIC_ACQUIRE, "agent");
            xb_add(&bar[XB_XGEN(b.x)], 1u);
            asm volatile("s_waitcnt vmcnt(0)" ::: "memory");
        } else {
            XB_SPIN(xb_ld(&bar[XB_XGEN(b.x)]) == gen, bar);
            __builtin_amdgcn_fence(__ATOMIC_ACQUIRE, "agent");
            asm volatile("s_waitcnt vmcnt(0)" ::: "memory");
        }
    }
    __syncthreads();
}

#define DI __device__ __forceinline__

typedef unsigned short bf16_t;
typedef short bf16x8 __attribute__((ext_vector_type(8)));
typedef short bf16x4 __attribute__((ext_vector_type(4)));
typedef float f32x2 __attribute__((ext_vector_type(2)));
typedef float f32x4 __attribute__((ext_vector_type(4)));
typedef float f32x16 __attribute__((ext_vector_type(16)));
typedef unsigned u32x2 __attribute__((ext_vector_type(2)));
typedef unsigned u32x4 __attribute__((ext_vector_type(4)));
typedef __bf16 hwbf16x2 __attribute__((ext_vector_type(2)));

constexpr int DM = 1024, NB = 4, SEQ = 8192, DB = 32, DS = 8;
constexpr int MP = NB * SEQ;
constexpr int MS = DB * DS;
constexpr int MT = MP + MS;
constexpr int NIN_SRC = 9744, NIN = 9984;
constexpr int DFF = 2816;
constexpr float EPS = 1e-6f;
constexpr float LOG2E = 1.4426950408889634f;
constexpr float QA_SCALE = 0.08838834764831845f * LOG2E;
constexpr float QB_SCALE = 0.08838834764831845f;
constexpr float Q2_SCALE = 0.0625f * LOG2E;

constexpr size_t O_Y = 0, O_W1P = 33816576, O_W2P = 34340864, O_W3P = 36438016, O_GLAP = 44826624, O_MEMP = 45350912,
                 O_W1S = 47448064, O_W2S = 47710208, O_W3S = 47972352, O_GLAS = 48234496, O_TOTAL = 52428800;

constexpr size_t MiB = 1u << 20;
constexpr size_t WS_CTL = 0, WS_WIN = 1 * MiB, WS_WMKV = 21 * MiB, WS_WPA = 25 * MiB, WS_WPB = 26 * MiB, WS_WOUT = 28 * MiB, WS_WMQ = 30 * MiB,
                 WS_WMO = 32 * MiB, WS_WGU = 34 * MiB, WS_WDN = 45 * MiB, WS_XB = 51 * MiB, WS_MEMB = 116 * MiB, WS_RS = 118 * MiB, WS_SSQ = 119 * MiB,
                 WS_FB = 122 * MiB, WS_MK = 125 * MiB, WS_MVT = 127 * MiB, WS_LSE = 129 * MiB, WS_QA = 131 * MiB, WS_KA = 228 * MiB, WS_VA = 325 * MiB,
                 WS_QB = 422 * MiB, WS_KB = 455 * MiB, WS_VB = 488 * MiB, WS_SGB = 553 * MiB, WS_SGA = 618 * MiB, WS_SGBT = 683 * MiB, WS_OAG = 748 * MiB,
                 WS_YAIN = 845 * MiB, WS_OBN = 878 * MiB, WS_END = 943 * MiB;
constexpr size_t WS_TMP = 131 * MiB, WS_MIXIN = 196 * MiB, WS_MIX = 261 * MiB, WS_Q2 = 326 * MiB, WS_O2 = 391 * MiB, WS_H = 488 * MiB;
constexpr size_t WS_RSMEM = WS_RS + 512 * 1024;
static_assert(WS_WIN + (size_t)NIN * 1024 * 2 <= WS_WMKV && WS_WDN + (size_t)1024 * DFF * 2 <= WS_XB && WS_XB + (size_t)MT * 1024 * 2 <= WS_MEMB, "ws map 1");
static_assert(WS_QA + (size_t)MT * 1536 * 2 <= WS_KA && WS_QB + (size_t)MT * 512 * 2 <= WS_KB && WS_VB + (size_t)MT * 1024 * 2 <= WS_SGB, "ws map 2");
static_assert(WS_OAG + (size_t)3 * MT * 512 * 2 <= WS_YAIN && WS_YAIN + (size_t)MT * 512 * 2 <= WS_OBN && WS_OBN + (size_t)MT * 1024 * 2 <= WS_END, "ws map 3");
static_assert(WS_H + (size_t)MT * DFF * 2 <= WS_OAG && WS_O2 + (size_t)MT * 1024 * 2 <= WS_VB && WS_SSQ + (size_t)MT * 16 * 4 <= WS_FB && WS_LSE + (size_t)MT * 12 * 4 <= WS_QA, "ws map 4");

constexpr int LDS_BYTES = 147456;
constexpr int NTHREADS = 512;

DI unsigned pk2(float lo, float hi) { f32x2 v = {lo, hi}; hwbf16x2 b = __builtin_convertvector(v, hwbf16x2); return __builtin_bit_cast(unsigned, b); }
DI float bflo(unsigned w) { return __uint_as_float(w << 16); }
DI float bfhi(unsigned w) { return __uint_as_float(w & 0xffff0000u); }
DI float bf1(bf16_t h) { return __uint_as_float((unsigned)h << 16); }
DI bf16_t f2bf(float f) { return (bf16_t)(pk2(f, 0.f) & 0xffffu); }
DI float wave_sum(float v) {
#pragma unroll
    for (int o = 1; o < 64; o <<= 1) v += __shfl_xor(v, o);
    return v;
}
DI float fsigmoid(float x) { return __builtin_amdgcn_rcpf(1.f + __expf(-x)); }
#define LDS_WAIT() asm volatile("s_waitcnt lgkmcnt(0)" ::: "memory")
#define MFMA32(a, b, c) __builtin_amdgcn_mfma_f32_32x32x16_bf16((a), (b), (c), 0, 0, 0)
DI int crow(int reg, int h) { return (reg & 3) + 8 * (reg >> 2) + 4 * h; }
DI bf16x8 pack_step(const f32x16& x, int s) {
    u32x4 p;
    p[0] = pk2(x[8 * s + 0], x[8 * s + 1]); p[1] = pk2(x[8 * s + 2], x[8 * s + 3]); p[2] = pk2(x[8 * s + 4], x[8 * s + 5]); p[3] = pk2(x[8 * s + 6], x[8 * s + 7]);
    return __builtin_bit_cast(bf16x8, p);
}
DI bf16x8 cat8(u32x2 lo, u32x2 hi) { u32x4 p; p[0] = lo[0]; p[1] = lo[1]; p[2] = hi[0]; p[3] = hi[1]; return __builtin_bit_cast(bf16x8, p); }

struct Args {
    const float* in[30];
    float* out;
    unsigned char* ws;
    int ph_lo, ph_hi;
};

struct Ctx {
    const float* const* in;
    float* out; unsigned char* ws;
    LAS unsigned char* lds;
    int wave, G, bid;
};
DI int lane_id() { return __builtin_amdgcn_mbcnt_hi(~0u, __builtin_amdgcn_mbcnt_lo(~0u, 0u)); }
DI int lane_id_here() { int l = lane_id(); asm volatile("" : "+v"(l)); return l; }

DI void p0_transpose_item(const float* __restrict__ W, int ldw, int src_col0, int nvalid, const float* __restrict__ gain,
                          bf16_t* __restrict__ WT, int K, int dst_row0, int kb, LAS float* scr, int lane) {
    const int k0 = 64 * kb;
#pragma unroll 8
    for (int i = 0; i < 32; ++i) {
        const int kk = 2 * i + (lane >> 5), n = lane & 31;
        float v = 0.f;
        if (n < nvalid) v = W[(size_t)(k0 + kk) * ldw + src_col0 + n];
        if (gain) v *= gain[k0 + kk];
        scr[kk * 33 + n] = v;
    }
    LDS_WAIT(); asm volatile("" ::: "memory");
    const int c = lane & 7;
#pragma unroll
    for (int j = 0; j < 4; ++j) {
        const int n = (lane >> 3) + 8 * j; const LAS float* s = scr + (8 * c) * 33 + n;
        u32x4 o; o.x = pk2(s[0 * 33], s[1 * 33]); o.y = pk2(s[2 * 33], s[3 * 33]); o.z = pk2(s[4 * 33], s[5 * 33]); o.w = pk2(s[6 * 33], s[7 * 33]);
        *(u32x4*)(WT + (size_t)(dst_row0 + n) * K + k0 + 8 * c) = o;
    }
    LDS_WAIT(); asm volatile("" ::: "memory");
}
DI void p0_row(const float* __restrict__ xrow, bf16_t* __restrict__ orow, float* __restrict__ rs_out, int lane) {
    const f32x4* xr = (const f32x4*)xrow + lane;
    f32x4 v[4]; float s = 0.f;
#pragma unroll
    for (int j = 0; j < 4; ++j) { v[j] = xr[64 * j]; s += (v[j].x * v[j].x + v[j].y * v[j].y) + (v[j].z * v[j].z + v[j].w * v[j].w); }
    s = wave_sum(s);
    u32x2* o8 = (u32x2*)orow + lane;
#pragma unroll
    for (int j = 0; j < 4; ++j) { u32x2 w; w.x = pk2(v[j].x, v[j].y); w.y = pk2(v[j].z, v[j].w); o8[64 * j] = w; }
    if (lane == 0) *rs_out = rsqrtf(s * (1.f / 1024.f) + EPS);
}
DI void p0_prologue(const Ctx& C) {
    const int lane = lane_id();
    LAS float* scr = (LAS float*)(C.lds + C.wave * 16384);
    const int gw = C.bid * 8 + C.wave, NGW = C.G * 8;
    const float* const* in = C.in;
    unsigned char* ws = C.ws;
    constexpr int I_IN = 16 * 312, I_MK = 16 * 32, I_PA = 8 * 32, I_SQ = 16 * 32, I_GU = 16 * 176, I_DN = 44 * 32;
    constexpr int NITEMS = I_IN + 2 * I_MK + I_PA + 4 * I_SQ + I_GU + I_DN;
    for (int it = gw; it < NITEMS; it += NGW) {
        int r = it;
        if (r < I_IN) {
            const int G = r % 312, kb = r / 312; int src, nv;
            if (G < 240) { src = 32 * G; nv = 32; } else if (G < 304) { src = 7696 + 32 * (G - 240); nv = 32; } else if (G == 304) { src = 7680; nv = 16; } else { src = 0; nv = 0; }
            p0_transpose_item(in[11], NIN_SRC, src, nv, in[9], (bf16_t*)(ws + WS_WIN), 1024, 32 * G, kb, scr, lane); continue; }
        r -= I_IN;
        if (r < I_MK) { p0_transpose_item(in[19], 1024, 32 * (r % 32), 32, in[18], (bf16_t*)(ws + WS_WMKV), 1024, 32 * (r % 32), r / 32, scr, lane); continue; } r -= I_MK;
        if (r < I_MK) { p0_transpose_item(in[20], 1024, 32 * (r % 32), 32, in[18], (bf16_t*)(ws + WS_WMKV), 1024, 1024 + 32 * (r % 32), r / 32, scr, lane); continue; } r -= I_MK;
        if (r < I_PA) { p0_transpose_item(in[15], 1024, 32 * (r % 32), 32, nullptr, (bf16_t*)(ws + WS_WPA), 512, 32 * (r % 32), r / 32, scr, lane); continue; } r -= I_PA;
        if (r < I_SQ) { p0_transpose_item(in[16], 1024, 32 * (r % 32), 32, nullptr, (bf16_t*)(ws + WS_WPB), 1024, 32 * (r % 32), r / 32, scr, lane); continue; } r -= I_SQ;
        if (r < I_SQ) { p0_transpose_item(in[17], 1024, 32 * (r % 32), 32, nullptr, (bf16_t*)(ws + WS_WOUT), 1024, 32 * (r % 32), r / 32, scr, lane); continue; } r -= I_SQ;
        if (r < I_SQ) { p0_transpose_item(in[23], 1024, 32 * (r % 32), 32, in[21], (bf16_t*)(ws + WS_WMQ), 1024, 32 * (r % 32), r / 32, scr, lane); continue; } r -= I_SQ;
        if (r < I_SQ) { p0_transpose_item(in[24], 1024, 32 * (r % 32), 32, nullptr, (bf16_t*)(ws + WS_WMO), 1024, 32 * (r % 32), r / 32, scr, lane); continue; } r -= I_SQ;
        if (r < I_GU) {
            const int G = r % 176, kb = r / 176, j = G >> 3, sub = G & 7;
            const float* W = sub < 4 ? in[27] : in[28];
            p0_transpose_item(W, DFF, 128 * j + 32 * (sub & 3), 32, in[25], (bf16_t*)(ws + WS_WGU), 1024, 32 * G, kb, scr, lane); continue; }
        r -= I_GU;
        p0_transpose_item(in[29], 1024, 32 * (r % 32), 32, nullptr, (bf16_t*)(ws + WS_WDN), DFF, 32 * (r % 32), r / 32, scr, lane);
    }
    bf16_t* XB = (bf16_t*)(ws + WS_XB); float* RS = (float*)(ws + WS_RS);
    for (int m = gw; m < MT; m += NGW) {
        const float* src = m < MP ? in[0] + (size_t)m * 1024 : in[1] + (size_t)(m - MP) * 1024;
        p0_row(src, XB + (size_t)m * 1024, RS + m, lane);
    }
    bf16_t* MEMB = (bf16_t*)(ws + WS_MEMB); float* RSM = (float*)(ws + WS_RSMEM);
    for (int m = gw; m < 1024; m += NGW) p0_row(in[7] + (size_t)m * 1024, MEMB + (size_t)m * 1024, RSM + m, lane);
}

DI void st_bf16x8(bf16_t* p, f32x4 v0, f32x4 v1) {
    u32x4 w; w.x = pk2(v0[0], v0[1]); w.y = pk2(v0[2], v0[3]); w.z = pk2(v1[0], v1[1]); w.w = pk2(v1[2], v1[3]);
    *(u32x4*)p = w;
}
struct EpiIn {
    static constexpr bool PERM = true, AFTER_DRAIN = false;
    const float* rs; unsigned char* ws; float* out;
    DI void operator()(const f32x4 (&acc)[2][2][4][2], const pg8::Unit& u, int wr, int wc, int fr, int fq) const {
        const int pn = u.pn, rbase = u.pm * 256 + wr * 64 + fr, cl = wc * 32 + 8 * fq;
        if (pn == 38) {
            if (wc == 0 && fq < 2) {
                float* FB = (float*)(ws + WS_FB);
#pragma unroll
                for (int ai = 0; ai < 2; ++ai)
#pragma unroll
                    for (int m = 0; m < 4; ++m) { const int row = rbase + ai * 128 + m * 16; const float r = rs[row];
                        *(f32x4*)(FB + (size_t)row * 16 + 8 * fq) = acc[ai][0][m][0] * r; *(f32x4*)(FB + (size_t)row * 16 + 8 * fq + 4) = acc[ai][0][m][1] * r; }
            }
            return;
        }
        bf16_t* dst; int ldc, cbase; float sc = 1.f; int act = 0;
        if (pn < 6)       { dst = (bf16_t*)(ws + WS_QA); ldc = 1536; cbase = pn * 256; sc = QA_SCALE; }
        else if (pn < 12) { dst = (bf16_t*)(ws + WS_KA); ldc = 1536; cbase = (pn - 6) * 256; }
        else if (pn < 18) { dst = (bf16_t*)(ws + WS_VA); ldc = 1536; cbase = (pn - 12) * 256; }
        else if (pn < 20) { dst = (bf16_t*)(ws + WS_QB); ldc = 512; cbase = (pn - 18) * 256; sc = QB_SCALE; }
        else if (pn < 22) { dst = (bf16_t*)(ws + WS_KB); ldc = 512; cbase = (pn - 20) * 256; }
        else if (pn < 26) { dst = (bf16_t*)(ws + WS_VB); ldc = 1024; cbase = (pn - 22) * 256; }
        else if (pn < 30) { dst = (bf16_t*)(ws + WS_SGB); ldc = 1024; cbase = (pn - 26) * 256; act = 1; }
        else if (pn < 34) { dst = (bf16_t*)(ws + WS_SGA); ldc = 1024; cbase = (pn - 30) * 256; act = 2; }
        else              { dst = (bf16_t*)(ws + WS_SGBT); ldc = 1024; cbase = (pn - 34) * 256; act = 2; }
        const bool iskv = (pn >= 6 && pn < 18);
        const bool maywin = iskv && (u.pm == 128 || (u.pm & 31) >= 24);
        const int kv = pn >= 12 ? 1 : 0, pc = (pn - 6) % 6, g = pc >> 1, cg0 = (pc & 1) * 256, keep = 128 << (2 * g);
        const size_t offp = g == 0 ? O_W1P : (g == 1 ? O_W2P : O_W3P), offs = g == 0 ? O_W1S : (g == 1 ? O_W2S : O_W3S);
#pragma unroll
        for (int ai = 0; ai < 2; ++ai)
#pragma unroll
            for (int m = 0; m < 4; ++m) {
                const int row = rbase + ai * 128 + m * 16; const float r = rs[row];
                bf16_t* rowp = dst + (size_t)row * ldc + cbase + cl;
                float* wp = nullptr;
                if (maywin) {
                    if (row >= MP) wp = out + offs + ((size_t)(row - MP) * 2 + kv) * 512 + cg0 + cl;
                    else { const int b = row >> 13, t = row & 8191; if (t >= SEQ - keep) wp = out + offp + ((size_t)(b * keep + t - (SEQ - keep)) * 2 + kv) * 512 + cg0 + cl; }
                }
#pragma unroll
                for (int bj = 0; bj < 2; ++bj) {
                    f32x4 v0 = acc[ai][bj][m][0] * r, v1 = acc[ai][bj][m][1] * r;
                    if (wp) { *(f32x4*)(wp + bj * 128) = v0; *(f32x4*)(wp + bj * 128 + 4) = v1; }
                    if (act) {
#pragma unroll
                        for (int i = 0; i < 4; ++i) { const float s0 = fsigmoid(v0[i]), s1 = fsigmoid(v1[i]); v0[i] = act == 1 ? v0[i] * s0 : s0; v1[i] = act == 1 ? v1[i] * s1 : s1; }
                    }
                    st_bf16x8(rowp + bj * 128, v0 * sc, v1 * sc);
                }
            }
    }
};
struct EpiMemKV {
    static constexpr bool PERM = true, AFTER_DRAIN = false;
    const float* rs; unsigned char* ws; float* out;
    DI void operator()(const f32x4 (&acc)[2][2][4][2], const pg8::Unit& u, int wr, int wc, int fr, int fq) const {
        const int pn = u.pn, rbase = u.pm * 256 + wr * 64 + fr, cl = wc * 32 + 8 * fq, kv = pn >> 2, c0 = (pn & 3) * 256 + cl;
        bf16_t* MK = (bf16_t*)(ws + WS_MK); bf16_t* MVT = (bf16_t*)(ws + WS_MVT);
#pragma unroll
        for (int ai = 0; ai < 2; ++ai)
#pragma unroll
            for (int m = 0; m < 4; ++m) {
                const int row = rbase + ai * 128 + m * 16; const float r = rs[row];
                float* op = out + O_MEMP + ((size_t)row * 2 + kv) * 1024 + c0;
#pragma unroll
                for (int bj = 0; bj < 2; ++bj) {
                    const f32x4 v0 = acc[ai][bj][m][0] * r, v1 = acc[ai][bj][m][1] * r;
                    *(f32x4*)(op + bj * 128) = v0; *(f32x4*)(op + bj * 128 + 4) = v1;
                    if (kv == 0) st_bf16x8(MK + (size_t)row * 1024 + c0 + bj * 128, v0, v1);
                    else {
                        bf16_t* vp = MVT + ((size_t)(row >> 8) * 1024 + c0 + bj * 128) * 256 + (row & 255);
#pragma unroll
                        for (int i = 0; i < 4; ++i) { vp[(size_t)i * 256] = f2bf(v0[i]); vp[(size_t)(i + 4) * 256] = f2bf(v1[i]); }
                    }
                }
            }
    }
};

constexpr int GL_QP = 0, GL_KP = 17408, GL_KPT = 34816, GL_VT = 53248, GL_OT = 90112, GL_FB = 123904, GL_PFX = 128000, GL_EBL = 136192,
              GL_WF2 = 136704, GL_BF2 = 144896, GL_GN = 145408, GL_END = 146432;
constexpr int QP_PITCH = 272, KT_PITCH = 144, OT_PITCH = 528;
static_assert(GL_END <= LDS_BYTES, "gla lds");

DI float logsig16(float z) {
    const float a = fabsf(z);
    return (fminf(z, 0.f) - __logf(1.f + __expf(-a))) * 0.0625f;
}

DI void gla_prompt_item(const Ctx& C, int b, int h) {
    LAS unsigned char* lds = C.lds;
    const int lane = lane_id_here(), w = C.wave, tid = w * 64 + lane, r = lane & 31, hh = lane >> 5;
    unsigned char* ws = C.ws;
    const bf16_t* QB = (const bf16_t*)(ws + WS_QB); const bf16_t* KB = (const bf16_t*)(ws + WS_KB); const bf16_t* VB = (const bf16_t*)(ws + WS_VB);
    const bf16_t* SGB = (const bf16_t*)(ws + WS_SGB); const float* FB = (const float*)(ws + WS_FB); bf16_t* OBN = (bf16_t*)(ws + WS_OBN);
    const size_t tok0 = (size_t)b * SEQ;
    {
        const float* wf2 = C.in[12]; const float* bf2 = C.in[13]; const float* gn = C.in[14];
        LAS float* WF = (LAS float*)(lds + GL_WF2);
        for (int i = tid; i < 16 * 128; i += NTHREADS) WF[i] = wf2[(size_t)(i >> 7) * 512 + h * 128 + (i & 127)];
        if (tid < 128) ((LAS float*)(lds + GL_BF2))[tid] = bf2[h * 128 + tid];
        if (tid < 256) ((LAS float*)(lds + GL_GN))[tid] = gn[tid];
    }
    const int cg = tid & 31, rg = tid >> 5;
    const int orow = tid >> 3, occ = tid & 7;
    f32x16 S[4];
#pragma unroll
    for (int i = 0; i < 4; ++i)
#pragma unroll
        for (int j = 0; j < 16; ++j) S[i][j] = 0.f;
    u32x2 q4[4], k4[4]; u32x4 vreg[4]; f32x4 fbreg = {0.f, 0.f, 0.f, 0.f};
#define GLA_ISSUE_LOADS(chn) do { const size_t t0_ = tok0 + (size_t)(chn) * 64; \
        _Pragma("unroll") for (int i = 0; i < 4; ++i) { \
            q4[i] = *(const u32x2*)(QB + (t0_ + 4 * rg + i) * 512 + h * 128 + 4 * cg); \
            k4[i] = *(const u32x2*)(KB + (t0_ + 4 * rg + i) * 512 + h * 128 + 4 * cg); \
            vreg[i] = *(const u32x4*)(VB + (t0_ + lane) * 1024 + h * 256 + 32 * w + 8 * i); \
            } \
        if (tid < 256) fbreg = *(const f32x4*)(FB + t0_ * 16 + tid * 4); } while (0)
    GLA_ISSUE_LOADS(0);
    __syncthreads();
    for (int ch = 0; ch < SEQ / 64; ++ch) {
        if (tid < 256) *(LAS f32x4*)(lds + GL_FB + tid * 16) = fbreg;
        {
            LAS bf16_t* VT = (LAS bf16_t*)(lds + GL_VT);
#pragma unroll
            for (int i = 0; i < 4; ++i)
#pragma unroll
                for (int j = 0; j < 4; ++j) {
                    const unsigned wv = vreg[i][j]; const int e = 32 * w + 8 * i + 2 * j;
                    VT[e * (KT_PITCH / 2) + lane] = (bf16_t)(wv & 0xffffu); VT[(e + 1) * (KT_PITCH / 2) + lane] = (bf16_t)(wv >> 16);
                }
        }
        __syncthreads();
        float bl[4][4];
        {
            const LAS float* WF = (const LAS float*)(lds + GL_WF2); const LAS float* FBs = (const LAS float*)(lds + GL_FB);
            const f32x4 bb = *(const LAS f32x4*)(lds + GL_BF2 + 16 * cg);
            f32x4 z[4] = {bb, bb, bb, bb};
#pragma unroll
            for (int j4 = 0; j4 < 4; ++j4) {
                f32x4 f[4];
#pragma unroll
                for (int i = 0; i < 4; ++i) f[i] = *(const LAS f32x4*)(FBs + (4 * rg + i) * 16 + 4 * j4);
#pragma unroll
                for (int jj = 0; jj < 4; ++jj) {
                    const f32x4 wv = *(const LAS f32x4*)(WF + (4 * j4 + jj) * 128 + 4 * cg);
#pragma unroll
                    for (int i = 0; i < 4; ++i) z[i] += wv * f[i][jj];
                }
            }
#pragma unroll
            for (int c = 0; c < 4; ++c) {
                float run = 0.f;
#pragma unroll
                for (int i = 0; i < 4; ++i) { run += logsig16(z[i][c]); bl[i][c] = run; }
            }
            *(LAS f32x4*)(lds + GL_PFX + (rg * 128 + 4 * cg) * 4) = (f32x4){bl[3][0], bl[3][1], bl[3][2], bl[3][3]};
        }
        __syncthreads();
        {
            f32x4 pre = {0.f, 0.f, 0.f, 0.f}, tot = {0.f, 0.f, 0.f, 0.f};
#pragma unroll
            for (int g = 0; g < 16; ++g) { const f32x4 p = *(const LAS f32x4*)(lds + GL_PFX + (g * 128 + 4 * cg) * 4); tot += p; if (g < rg) pre += p; }
            if (rg == 0) *(LAS f32x4*)(lds + GL_EBL + 16 * cg) = (f32x4){__expf(tot[0]), __expf(tot[1]), __expf(tot[2]), __expf(tot[3])};
            float kq[4][4];
#pragma unroll
            for (int i = 0; i < 4; ++i) {
                float qv[4] = {bflo(q4[i][0]), bfhi(q4[i][0]), bflo(q4[i][1]), bfhi(q4[i][1])};
                float kv[4] = {bflo(k4[i][0]), bfhi(k4[i][0]), bflo(k4[i][1]), bfhi(k4[i][1])};
                float qo[4];
#pragma unroll
                for (int c = 0; c < 4; ++c) { const float bv = pre[c] + bl[i][c]; const float e = __expf(bv); qo[c] = qv[c] * e; kq[i][c] = kv[c] * __builtin_amdgcn_rcpf(e); }
                u32x2 wq; wq.x = pk2(qo[0], qo[1]); wq.y = pk2(qo[2], qo[3]);
                u32x2 wk; wk.x = pk2(kq[i][0], kq[i][1]); wk.y = pk2(kq[i][2], kq[i][3]);
                *(LAS u32x2*)(lds + GL_QP + (4 * rg + i) * QP_PITCH + 8 * cg) = wq;
                *(LAS u32x2*)(lds + GL_KP + (4 * rg + i) * QP_PITCH + 8 * cg) = wk;
            }
#pragma unroll
            for (int c = 0; c < 4; ++c) { u32x2 wt; wt.x = pk2(kq[0][c], kq[1][c]); wt.y = pk2(kq[2][c], kq[3][c]);
                *(LAS u32x2*)(lds + GL_KPT + (4 * cg + c) * KT_PITCH + 8 * rg) = wt; }
        }
        __syncthreads();
        f32x16 O[2];
#pragma unroll
        for (int i = 0; i < 2; ++i)
#pragma unroll
            for (int j = 0; j < 16; ++j) O[i][j] = 0.f;
        {
#pragma unroll
            for (int dt = 0; dt < 4; ++dt)
#pragma unroll
                for (int s = 0; s < 2; ++s) {
                    const bf16x8 sb = pack_step(S[dt], s);
#pragma unroll
                    for (int ct = 0; ct < 2; ++ct) {
                        const LAS unsigned char* p = lds + GL_QP + (32 * ct + r) * QP_PITCH + (32 * dt + 16 * s + 4 * hh) * 2;
                        const bf16x8 a = cat8(*(const LAS u32x2*)p, *(const LAS u32x2*)(p + 16));
                        O[ct] = MFMA32(a, sb, O[ct]);
                    }
                    __builtin_amdgcn_sched_barrier(0);
                }
        }
        {
#pragma unroll
            for (int ct = 0; ct < 2; ++ct)
#pragma unroll
                for (int jt = 0; jt <= ct; ++jt) {
                    f32x16 X;
#pragma unroll
                    for (int j = 0; j < 16; ++j) X[j] = 0.f;
#pragma unroll
                    for (int s8 = 0; s8 < 8; ++s8) {
                        const bf16x8 a = *(const LAS bf16x8*)(lds + GL_KP + (32 * jt + r) * QP_PITCH + (16 * s8 + 8 * hh) * 2);
                        const bf16x8 bq = *(const LAS bf16x8*)(lds + GL_QP + (32 * ct + r) * QP_PITCH + (16 * s8 + 8 * hh) * 2);
                        X = MFMA32(a, bq, X);
                    }
                    if (jt == ct) {
#pragma unroll
                        for (int j = 0; j < 16; ++j) if (crow(j, hh) > r) X[j] = 0.f;
                    }
#pragma unroll
                    for (int s = 0; s < 2; ++s) {
                        const bf16x8 xa = pack_step(X, s);
                        const LAS unsigned char* p = lds + GL_VT + (32 * w + r) * KT_PITCH + (32 * jt + 16 * s + 4 * hh) * 2;
                        const bf16x8 vb = cat8(*(const LAS u32x2*)p, *(const LAS u32x2*)(p + 16));
                        O[ct] = MFMA32(xa, vb, O[ct]);
                    }
                    __builtin_amdgcn_sched_barrier(0);
                }
        }
        __builtin_amdgcn_sched_barrier(0);
        u32x4 sgbcur[4];
#pragma unroll
        for (int i = 0; i < 4; ++i) sgbcur[i] = *(const u32x4*)(SGB + (tok0 + (size_t)ch * 64 + orow) * 1024 + h * 256 + 32 * occ + 8 * i);
        if (ch + 1 < SEQ / 64) GLA_ISSUE_LOADS(ch + 1);
        __builtin_amdgcn_sched_barrier(0);
        {
#pragma unroll
            for (int dt = 0; dt < 4; ++dt) {
#pragma unroll
                for (int s = 0; s < 4; ++s) {
                    const bf16x8 a = *(const LAS bf16x8*)(lds + GL_KPT + (32 * dt + r) * KT_PITCH + (16 * s + 8 * hh) * 2);
                    const bf16x8 vb = *(const LAS bf16x8*)(lds + GL_VT + (32 * w + r) * KT_PITCH + (16 * s + 8 * hh) * 2);
                    S[dt] = MFMA32(a, vb, S[dt]);
                }
#pragma unroll
                for (int g4 = 0; g4 < 4; ++g4) {
                    const f32x4 e = *(const LAS f32x4*)(lds + GL_EBL + (32 * dt + 8 * g4 + 4 * hh) * 4);
#pragma unroll
                    for (int i = 0; i < 4; ++i) S[dt][4 * g4 + i] *= e[i];
                }
                __builtin_amdgcn_sched_barrier(0);
            }
        }
        {
            LAS bf16_t* OT = (LAS bf16_t*)(lds + GL_OT);
#pragma unroll
            for (int ct = 0; ct < 2; ++ct)
#pragma unroll
                for (int j = 0; j < 16; ++j) OT[(32 * ct + crow(j, hh)) * (OT_PITCH / 2) + 32 * w + r] = f2bf(O[ct][j]);
        }
        __syncthreads();
        {
            float v[32]; float ss = 0.f;
#pragma unroll
            for (int i = 0; i < 4; ++i) {
                const u32x4 wv = *(const LAS u32x4*)(lds + GL_OT + orow * OT_PITCH + 64 * occ + 16 * i);
#pragma unroll
                for (int j = 0; j < 4; ++j) { v[8 * i + 2 * j] = bflo(wv[j]); v[8 * i + 2 * j + 1] = bfhi(wv[j]); }
            }
#pragma unroll
            for (int i = 0; i < 32; ++i) ss += v[i] * v[i];
            ss += __shfl_xor(ss, 1); ss += __shfl_xor(ss, 2); ss += __shfl_xor(ss, 4);
            const float rinv = rsqrtf(ss * (1.f / 256.f) + EPS);
            bf16_t* op = OBN + (tok0 + (size_t)ch * 64 + orow) * 1024 + h * 256 + 32 * occ;
#pragma unroll
            for (int i = 0; i < 4; ++i) {
                const f32x4 g0 = *(const LAS f32x4*)(lds + GL_GN + (32 * occ + 8 * i) * 4), g1 = *(const LAS f32x4*)(lds + GL_GN + (32 * occ + 8 * i + 4) * 4);
                const u32x4 sg = sgbcur[i];
                u32x4 o;
                o[0] = pk2(v[8 * i + 0] * rinv * g0[0] * bflo(sg[0]), v[8 * i + 1] * rinv * g0[1] * bfhi(sg[0]));
                o[1] = pk2(v[8 * i + 2] * rinv * g0[2] * bflo(sg[1]), v[8 * i + 3] * rinv * g0[3] * bfhi(sg[1]));
                o[2] = pk2(v[8 * i + 4] * rinv * g1[0] * bflo(sg[2]), v[8 * i + 5] * rinv * g1[1] * bfhi(sg[2]));
                o[3] = pk2(v[8 * i + 6] * rinv * g1[2] * bflo(sg[3]), v[8 * i + 7] * rinv * g1[3] * bfhi(sg[3]));
                *(u32x4*)(op + 8 * i) = o;
            }
        }
    }
    {
        int t2 = lane_id_here(); asm volatile("" : "+v"(t2));
        const int r2 = t2 & 31, h2 = (t2 >> 5) & 1, w2 = w;
        float* gp = C.out + O_GLAP + (size_t)(b * 4 + h) * 128 * 256 + 32 * w2 + r2;
#pragma unroll
        for (int dt = 0; dt < 4; ++dt)
#pragma unroll
            for (int j = 0; j < 16; ++j) gp[(size_t)(32 * dt + crow(j, h2)) * 256] = S[dt][j];
    }
    __syncthreads();
}

constexpr int GS_QP = 0, GS_KM = 4096, GS_EBL = 8192, GS_AM = 8704, GS_VS = 8960, GS_OS = 17152, GS_RED = 33536, GS_FB = 33792, GS_END = 34304;
DI void gla_sample_item(const Ctx& C, int b, int h) {
    LAS unsigned char* lds = C.lds; const int tid = C.wave * 64 + lane_id_here(); unsigned char* ws = C.ws;
    const bf16_t* QB = (const bf16_t*)(ws + WS_QB); const bf16_t* KB = (const bf16_t*)(ws + WS_KB); const bf16_t* VB = (const bf16_t*)(ws + WS_VB);
    const bf16_t* SGB = (const bf16_t*)(ws + WS_SGB); const float* FB = (const float*)(ws + WS_FB); bf16_t* OBN = (bf16_t*)(ws + WS_OBN);
    const size_t row0 = (size_t)MP + (size_t)b * 8;
    LAS float* QPt = (LAS float*)(lds + GS_QP); LAS float* KMt = (LAS float*)(lds + GS_KM); LAS float* EBLs = (LAS float*)(lds + GS_EBL);
    LAS float* AM = (LAS float*)(lds + GS_AM); LAS float* VS = (LAS float*)(lds + GS_VS); LAS float* OS = (LAS float*)(lds + GS_OS);
    LAS float* RED = (LAS float*)(lds + GS_RED); LAS float* FBs = (LAS float*)(lds + GS_FB);
    if (tid < 128) FBs[tid] = FB[row0 * 16 + tid];
    for (int i = tid; i < 8 * 256; i += NTHREADS) VS[i] = bf1(VB[(row0 + (i >> 8)) * 1024 + h * 256 + (i & 255)]);
    __syncthreads();
    if (tid < 128) {
        const int d = tid; const float* wf2 = C.in[12]; const float* bf2 = C.in[13];
        float wcol[16];
#pragma unroll
        for (int j = 0; j < 16; ++j) wcol[j] = wf2[(size_t)j * 512 + h * 128 + d];
        const float bb = bf2[h * 128 + d];
        float run = 0.f;
#pragma unroll
        for (int c = 0; c < 8; ++c) {
            float z = bb;
#pragma unroll
            for (int j = 0; j < 16; ++j) z += FBs[c * 16 + j] * wcol[j];
            run += logsig16(z);
            const float e = __expf(run);
            QPt[d * 8 + c] = bf1(QB[(row0 + c) * 512 + h * 128 + d]) * e;
            KMt[d * 8 + c] = bf1(KB[(row0 + c) * 512 + h * 128 + d]) / e;
        }
        EBLs[d] = __expf(run);
    }
    __syncthreads();
    if (tid < 64) {
        const int c = tid >> 3, j = tid & 7; float a = 0.f;
        for (int d = 0; d < 128; ++d) a += QPt[d * 8 + c] * KMt[d * 8 + j];
        AM[c * 8 + j] = j <= c ? a : 0.f;
    }
    const int e = tid & 255, half = tid >> 8;
    const float* S0 = C.in[5] + ((size_t)(b * 4 + h) * 128) * 256; float* S1 = C.out + O_GLAS + ((size_t)(b * 4 + h) * 128) * 256;
    float vv[8], oo[8];
#pragma unroll
    for (int c = 0; c < 8; ++c) { vv[c] = VS[c * 256 + e]; oo[c] = 0.f; }
    for (int dd = 0; dd < 64; ++dd) {
        const int d = half * 64 + dd;
        const float s = S0[(size_t)d * 256 + e];
        const f32x4 qa = *(const LAS f32x4*)(QPt + d * 8), qb = *(const LAS f32x4*)(QPt + d * 8 + 4);
        const f32x4 ka = *(const LAS f32x4*)(KMt + d * 8), kb = *(const LAS f32x4*)(KMt + d * 8 + 4);
        float acc = s;
#pragma unroll
        for (int c = 0; c < 4; ++c) { oo[c] += qa[c] * s; oo[c + 4] += qb[c] * s; acc += ka[c] * vv[c]; acc += kb[c] * vv[c + 4]; }
        S1[(size_t)d * 256 + e] = acc * EBLs[d];
    }
#pragma unroll
    for (int c = 0; c < 8; ++c) OS[(half * 8 + c) * 256 + e] = oo[c];
    __syncthreads();
    {
        const int c = tid >> 6, l = tid & 63;
        float o[4]; float ss = 0.f;
#pragma unroll
        for (int i = 0; i < 4; ++i) {
            const int ee = 4 * l + i; float a = OS[c * 256 + ee] + OS[(8 + c) * 256 + ee];
#pragma unroll
            for (int j = 0; j < 8; ++j) a += AM[c * 8 + j] * VS[j * 256 + ee];
            o[i] = a; ss += a * a;
        }
        ss = wave_sum(ss);
        const float rinv = rsqrtf(ss * (1.f / 256.f) + EPS);
        const float* gn = C.in[14];
        u32x2 wv;
        const bf16_t* sg = SGB + (row0 + c) * 1024 + h * 256 + 4 * l;
        wv.x = pk2(o[0] * rinv * gn[4 * l] * bf1(sg[0]), o[1] * rinv * gn[4 * l + 1] * bf1(sg[1]));
        wv.y = pk2(o[2] * rinv * gn[4 * l + 2] * bf1(sg[2]), o[3] * rinv * gn[4 * l + 3] * bf1(sg[3]));
        *(u32x2*)(OBN + (row0 + c) * 1024 + h * 256 + 4 * l) = wv;
    }
    __syncthreads();
}

__device__ const unsigned char T5_BUCKET[387] = {0,1,2,3,4,5,6,7,8,9,10,11,12,13,14,15,16,16,16,16,16,16,17,17,17,17,17,17,17,17,18,18,18,18,18,18,18,18,18,18,19,19,19,19,19,19,19,19,19,19,19,19,19,19,20,20,20,20,20,20,20,20,20,20,20,20,20,20,20,20,20,20,20,21,21,21,21,21,21,21,21,21,21,21,21,21,21,21,21,21,21,21,21,21,21,21,21,21,21,22,22,22,22,22,22,22,22,22,22,22,22,22,22,22,22,22,22,22,22,22,22,22,22,22,22,22,22,22,22,0,4,8,12,16,16,17,17,18,18,19,19,19,19,20,20,20,20,20,21,21,21,21,21,21,22,22,22,22,22,22,22,22,22,23,23,23,23,23,23,23,23,23,23,23,23,24,24,24,24,24,24,24,24,24,24,24,24,24,24,24,24,25,25,25,25,25,25,25,25,25,25,25,25,25,25,25,25,25,25,25,25,25,26,26,26,26,26,26,26,26,26,26,26,26,26,26,26,26,26,26,26,26,26,26,26,26,26,26,26,26,26,26,27,27,27,27,27,27,27,27,27,27,27,27,27,27,27,27,0,16,18,19,20,21,21,22,22,23,23,23,24,24,24,24,25,25,25,25,25,26,26,26,26,26,26,26,26,27,27,27,27,27,27,27,27,27,27,28,28,28,28,28,28,28,28,28,28,28,28,28,29,29,29,29,29,29,29,29,29,29,29,29,29,29,29,29,29,29,30,30,30,30,30,30,30,30,30,30,30,30,30,30,30,30,30,30,30,30,30,30,30,30,30,31,31,31,31,31,31,31,31,31,31,31,31,31,31,31,31,31,31,31,31,31,31,31,31,31,31,31,31,31,31,31,31,31,31};

constexpr int AT_V = 0, AT_VP = 272, AT_VW = 32 * AT_VP, AT_BT = 8 * AT_VW, AT_END = AT_BT + 387 * 4 + 12;
static_assert(AT_END <= LDS_BYTES, "attn lds");

DI void attn_bias_table(const Ctx& C, int slot, int tid) {
    LAS float* BT = (LAS float*)(C.lds + AT_BT);
    if (tid < 387) { const int g = tid / 129; BT[tid] = C.in[8][(int)T5_BUCKET[tid] * 12 + 4 * g + slot] * LOG2E; }
}

DI void attn_prompt_wave(const Ctx& C, int b, int slot, int g, int res, int m0, int lane) {
    const int r = lane & 31, hh = lane >> 5, dil = 1 << (2 * g), hd = 4 * g + slot;
    unsigned char* ws = C.ws;
    const bf16_t* QA = (const bf16_t*)(ws + WS_QA) + hd * 128; const bf16_t* KA = (const bf16_t*)(ws + WS_KA) + hd * 128; const bf16_t* VA = (const bf16_t*)(ws + WS_VA) + hd * 128;
    LAS unsigned char* VL = C.lds + AT_V + C.wave * AT_VW;
    const LAS float* BT = (const LAS float*)(C.lds + AT_BT) + g * 129;
    const size_t rowb = (size_t)b * SEQ;
    bf16x8 qf[8];
    {
        const bf16_t* qp = QA + (rowb + (size_t)(m0 + r) * dil + res) * 1536 + 8 * hh;
#pragma unroll
        for (int s = 0; s < 8; ++s) qf[s] = *(const bf16x8*)(qp + 16 * s);
    }
    f32x16 P[5];
#pragma unroll
    for (int kt = 0; kt < 5; ++kt) {
        int mk = m0 - 128 + 32 * kt + r; mk = mk < 0 ? 0 : mk;
        const bf16_t* kp = KA + (rowb + (size_t)mk * dil + res) * 1536 + 8 * hh;
        f32x16 acc;
#pragma unroll
        for (int j = 0; j < 16; ++j) acc[j] = 0.f;
#pragma unroll
        for (int s = 0; s < 8; ++s) { const bf16x8 kf = *(const bf16x8*)(kp + 16 * s); acc = MFMA32(kf, qf[s], acc); }
        P[kt] = acc;
        __builtin_amdgcn_sched_barrier(0);
    }
    float mx = -1e30f;
#pragma unroll
    for (int kt = 0; kt < 5; ++kt)
#pragma unroll
        for (int j = 0; j < 16; ++j) {
            const int kr = 32 * kt + crow(j, hh);
            const int dsub = 128 + r - kr;
            const bool ok = (dsub >= 0) && (dsub <= 128) && (m0 - 128 + kr >= 0);
            const int di = dsub < 0 ? 0 : (dsub > 128 ? 128 : dsub);
            const float sv = ok ? P[kt][j] + BT[di] : -1e30f;
            P[kt][j] = sv; mx = fmaxf(mx, sv);
        }
    mx = fmaxf(mx, __shfl_xor(mx, 32));
    float den = 0.f;
#pragma unroll
    for (int kt = 0; kt < 5; ++kt)
#pragma unroll
        for (int j = 0; j < 16; ++j) { const float p = __builtin_amdgcn_exp2f(P[kt][j] - mx); P[kt][j] = p; den += p; }
    den += __shfl_xor(den, 32);
    f32x16 O[4];
#pragma unroll
    for (int i = 0; i < 4; ++i)
#pragma unroll
        for (int j = 0; j < 16; ++j) O[i][j] = 0.f;
#pragma unroll
    for (int kt = 0; kt < 5; ++kt) {
        __builtin_amdgcn_sched_barrier(0);
        {
            u32x4 vv[8];
#pragma unroll
            for (int i = 0; i < 8; ++i) {
                int mk = m0 - 128 + 32 * kt + 4 * i + (lane >> 4); mk = mk < 0 ? 0 : mk;
                vv[i] = *(const u32x4*)(VA + (rowb + (size_t)mk * dil + res) * 1536 + 8 * (lane & 15));
            }
            LDS_WAIT(); asm volatile("" ::: "memory");
#pragma unroll
            for (int i = 0; i < 8; ++i) *(LAS u32x4*)(VL + (4 * i + (lane >> 4)) * AT_VP + 16 * (lane & 15)) = vv[i];
            LDS_WAIT(); asm volatile("" ::: "memory");
        }
#pragma unroll
        for (int s = 0; s < 2; ++s) {
            const bf16x8 pb = pack_step(P[kt], s);
#pragma unroll
            for (int dt = 0; dt < 4; ++dt) {
                const LAS bf16_t* vp = (const LAS bf16_t*)(VL + (16 * s + 4 * hh) * AT_VP) + 32 * dt + r;
                u32x4 w;
                w[0] = (unsigned)vp[0 * (AT_VP / 2)] | ((unsigned)vp[1 * (AT_VP / 2)] << 16);
                w[1] = (unsigned)vp[2 * (AT_VP / 2)] | ((unsigned)vp[3 * (AT_VP / 2)] << 16);
                w[2] = (unsigned)vp[8 * (AT_VP / 2)] | ((unsigned)vp[9 * (AT_VP / 2)] << 16);
                w[3] = (unsigned)vp[10 * (AT_VP / 2)] | ((unsigned)vp[11 * (AT_VP / 2)] << 16);
                O[dt] = MFMA32(__builtin_bit_cast(bf16x8, w), pb, O[dt]);
            }
            __builtin_amdgcn_sched_barrier(0);
        }
    }
    const float inv = __builtin_amdgcn_rcpf(den);
    const size_t qrow = rowb + (size_t)(m0 + r) * dil + res;
    bf16_t* op = (bf16_t*)(ws + WS_OAG) + ((size_t)g * MT + qrow) * 512 + slot * 128 + 4 * hh;
#pragma unroll
    for (int dt = 0; dt < 4; ++dt)
#pragma unroll
        for (int g4 = 0; g4 < 4; ++g4) {
            u32x2 w; w.x = pk2(O[dt][4 * g4] * inv, O[dt][4 * g4 + 1] * inv); w.y = pk2(O[dt][4 * g4 + 2] * inv, O[dt][4 * g4 + 3] * inv);
            *(u32x2*)(op + 32 * dt + 8 * g4) = w;
        }
    if (hh == 0) ((float*)(ws + WS_LSE))[qrow * 12 + hd] = mx + __builtin_amdgcn_logf(den);
}

DI void attn_prompt_item(const Ctx& C, int b, int slot, int span) {
    const int w = C.wave, T0 = span * 512;
    __syncthreads();
    attn_bias_table(C, slot, w * 64 + lane_id_here());
    __syncthreads();
    for (int idx = w; idx < 48; idx += 8) {
        int g, res, m0;
        if (idx < 16) { g = 0; res = 0; m0 = T0 + 32 * idx; }
        else if (idx < 32) { g = 1; res = (idx - 16) >> 2; m0 = (T0 >> 2) + 32 * ((idx - 16) & 3); }
        else { g = 2; res = idx - 32; m0 = T0 >> 4; }
        attn_prompt_wave(C, b, slot, g, res, m0, lane_id_here());
    }
    __syncthreads();
    {
        unsigned char* ws = C.ws; const int tid = C.wave * 64 + lane_id_here();
        const size_t row = (size_t)b * SEQ + T0 + tid;
        const float* lse = (const float*)(ws + WS_LSE) + row * 12 + slot;
        const float l0 = lse[0], l1 = lse[4], l2 = lse[8];
        const float lm = fmaxf(l0, fmaxf(l1, l2));
        float w0 = __builtin_amdgcn_exp2f(l0 - lm), w1 = __builtin_amdgcn_exp2f(l1 - lm), w2 = __builtin_amdgcn_exp2f(l2 - lm);
        const float ws_ = __builtin_amdgcn_rcpf(w0 + w1 + w2); w0 *= ws_; w1 *= ws_; w2 *= ws_;
        const bf16_t* o0 = (const bf16_t*)(ws + WS_OAG) + row * 512 + slot * 128;
        const bf16_t* o1 = o0 + (size_t)MT * 512; const bf16_t* o2 = o1 + (size_t)MT * 512;
        bf16_t* yo = (bf16_t*)(ws + WS_YAIN) + row * 512 + slot * 128;
#pragma unroll 4
        for (int i = 0; i < 16; ++i) {
            const u32x4 a = *(const u32x4*)(o0 + 8 * i), bq = *(const u32x4*)(o1 + 8 * i), c = *(const u32x4*)(o2 + 8 * i);
            u32x4 o;
#pragma unroll
            for (int j = 0; j < 4; ++j) o[j] = pk2(w0 * bflo(a[j]) + w1 * bflo(bq[j]) + w2 * bflo(c[j]), w0 * bfhi(a[j]) + w1 * bfhi(bq[j]) + w2 * bfhi(c[j]));
            *(u32x4*)(yo + 8 * i) = o;
        }
    }
}

constexpr int AS_OS = 0, AS_LS = 3 * 8 * 128 * 4, AS_END = AS_LS + 96 + 16;
static_assert(AS_END <= AT_BT, "sample attn lds");
DI void attn_sample_item(const Ctx& C, int b, int slot) {
    const int lane = lane_id_here(), w = C.wave, tid = w * 64 + lane;
    unsigned char* ws = C.ws;
    __syncthreads();
    attn_bias_table(C, slot, tid);
    __syncthreads();
    LAS float* OS = (LAS float*)(C.lds + AS_OS); LAS float* LS = (LAS float*)(C.lds + AS_LS);
    for (int idx = w; idx < 24; idx += 8) {
        const int g = idx >> 3, t = idx & 7, dil = 1 << (2 * g), wb = 128 << (2 * g), hd = 4 * g + slot;
        const LAS float* BT = (const LAS float*)(C.lds + AT_BT) + g * 129;
        const float* cache = C.in[2 + g] + (size_t)b * wb * 1024 + slot * 128;
        const float* neww = C.out + (g == 0 ? O_W1S : (g == 1 ? O_W2S : O_W3S)) + (size_t)b * 8 * 1024 + slot * 128;
        const bf16_t* qp = (const bf16_t*)(ws + WS_QA) + ((size_t)MP + b * 8 + t) * 1536 + hd * 128 + 2 * lane;
        const float q0 = bf1(qp[0]), q1 = bf1(qp[1]);
        float sc0 = -1e30f, sc1 = -1e30f, sc2 = -1e30f;
        for (int j = 0; j <= 128; ++j) {
            const int id = wb + t - j * dil;
            const float* kr = id >= wb ? neww + (size_t)(id - wb) * 1024 : cache + (size_t)id * 1024;
            const f32x2 kk = *(const f32x2*)(kr + 2 * lane);
            const float s = wave_sum(q0 * kk.x + q1 * kk.y) + BT[j];
            if (lane == (j & 63)) { if (j < 64) sc0 = s; else if (j < 128) sc1 = s; else sc2 = s; }
        }
        float mx = fmaxf(sc0, fmaxf(sc1, sc2));
#pragma unroll
        for (int o = 1; o < 64; o <<= 1) mx = fmaxf(mx, __shfl_xor(mx, o));
        sc0 = __builtin_amdgcn_exp2f(sc0 - mx); sc1 = __builtin_amdgcn_exp2f(sc1 - mx); sc2 = __builtin_amdgcn_exp2f(sc2 - mx);
        const float den = wave_sum(sc0 + sc1 + sc2);
        float o0 = 0.f, o1 = 0.f;
        for (int j = 0; j <= 128; ++j) {
            const int id = wb + t - j * dil;
            const float* vr = (id >= wb ? neww + (size_t)(id - wb) * 1024 : cache + (size_t)id * 1024) + 512;
            const f32x2 vv = *(const f32x2*)(vr + 2 * lane);
            const float src = j < 64 ? sc0 : (j < 128 ? sc1 : sc2);
            const float p = __uint_as_float(__builtin_amdgcn_readlane(__float_as_uint(src), j & 63));
            o0 += p * vv.x; o1 += p * vv.y;
        }
        const float inv = 1.f / den;
        OS[(g * 8 + t) * 128 + 2 * lane] = o0 * inv; OS[(g * 8 + t) * 128 + 2 * lane + 1] = o1 * inv;
        if (lane == 0) LS[g * 8 + t] = mx + __builtin_amdgcn_logf(den);
    }
    __syncthreads();
    {
        const int t = tid >> 6, d = 2 * (tid & 63);
        const float l0 = LS[t], l1 = LS[8 + t], l2 = LS[16 + t];
        const float lm = fmaxf(l0, fmaxf(l1, l2));
        float w0 = __builtin_amdgcn_exp2f(l0 - lm), w1 = __builtin_amdgcn_exp2f(l1 - lm), w2 = __builtin_amdgcn_exp2f(l2 - lm);
        const float ws_ = 1.f / (w0 + w1 + w2); w0 *= ws_; w1 *= ws_; w2 *= ws_;
        const float a = w0 * OS[t * 128 + d] + w1 * OS[(8 + t) * 128 + d] + w2 * OS[(16 + t) * 128 + d];
        const float c = w0 * OS[t * 128 + d + 1] + w1 * OS[(8 + t) * 128 + d + 1] + w2 * OS[(16 + t) * 128 + d + 1];
        *(unsigned*)((bf16_t*)(ws + WS_YAIN) + ((size_t)MP + b * 8 + t) * 512 + slot * 128 + d) = pk2(a, c);
    }
    __syncthreads();
}

DI void ld_bf16x8(const bf16_t* p, f32x4& a, f32x4& b) {
    const u32x4 w = *(const u32x4*)p;
    a = (f32x4){bflo(w.x), bfhi(w.x), bflo(w.y), bfhi(w.y)}; b = (f32x4){bflo(w.z), bfhi(w.z), bflo(w.w), bfhi(w.w)};
}
template <int MODE> struct EpiGate {
    static constexpr bool PERM = true, AFTER_DRAIN = false;
    const bf16_t* G; const bf16_t* T; bf16_t* D;
    DI void operator()(const f32x4 (&acc)[2][2][4][2], const pg8::Unit& u, int wr, int wc, int fr, int fq) const {
        const int rbase = u.pm * 256 + wr * 64 + fr, c0 = u.pn * 256 + wc * 32 + 8 * fq;
#pragma unroll
        for (int ai = 0; ai < 2; ++ai)
#pragma unroll
            for (int m = 0; m < 4; ++m) {
                const size_t off = (size_t)(rbase + ai * 128 + m * 16) * 1024 + c0;
#pragma unroll
                for (int bj = 0; bj < 2; ++bj) {
                    f32x4 g0, g1; ld_bf16x8(G + off + bj * 128, g0, g1);
                    f32x4 v0 = acc[ai][bj][m][0] * g0, v1 = acc[ai][bj][m][1] * g1;
                    if (MODE == 1) { f32x4 t0, t1; ld_bf16x8(T + off + bj * 128, t0, t1); v0 += t0; v1 += t1; }
                    st_bf16x8(D + off + bj * 128, v0, v1);
                }
            }
    }
};
struct EpiBranch {
    static constexpr bool PERM = true, AFTER_DRAIN = false;
    bf16_t* D; float* ssq;
    DI void operator()(const f32x4 (&acc)[2][2][4][2], const pg8::Unit& u, int wr, int wc, int fr, int fq) const {
        const int rbase = u.pm * 256 + wr * 64 + fr, c0 = u.pn * 256 + wc * 32 + 8 * fq;
#pragma unroll
        for (int ai = 0; ai < 2; ++ai)
#pragma unroll
            for (int m = 0; m < 4; ++m) {
                const int row = rbase + ai * 128 + m * 16; const size_t off = (size_t)row * 1024 + c0;
                float s = 0.f;
#pragma unroll
                for (int bj = 0; bj < 2; ++bj) {
                    const f32x4 v0 = acc[ai][bj][m][0], v1 = acc[ai][bj][m][1];
                    s += (v0[0] * v0[0] + v0[1] * v0[1]) + (v0[2] * v0[2] + v0[3] * v0[3]) + (v1[0] * v1[0] + v1[1] * v1[1]) + (v1[2] * v1[2] + v1[3] * v1[3]);
                    st_bf16x8(D + off + bj * 128, v0, v1);
                }
                s += __shfl_xor(s, 16); s += __shfl_xor(s, 32);
                if (fq == 0) ssq[(size_t)row * 16 + 4 * u.pn + wc] = s;
            }
    }
};
struct EpiRowScale {
    static constexpr bool PERM = true, AFTER_DRAIN = false;
    const float* rs; bf16_t* D; float scale;
    DI void operator()(const f32x4 (&acc)[2][2][4][2], const pg8::Unit& u, int wr, int wc, int fr, int fq) const {
        const int rbase = u.pm * 256 + wr * 64 + fr, c0 = u.pn * 256 + wc * 32 + 8 * fq;
#pragma unroll
        for (int ai = 0; ai < 2; ++ai)
#pragma unroll
            for (int m = 0; m < 4; ++m) {
                const int row = rbase + ai * 128 + m * 16; const float r = rs[row] * scale; const size_t off = (size_t)row * 1024 + c0;
#pragma unroll
                for (int bj = 0; bj < 2; ++bj) st_bf16x8(D + off + bj * 128, acc[ai][bj][m][0] * r, acc[ai][bj][m][1] * r);
            }
    }
};
struct EpiGateUp {
    static constexpr bool PERM = true, AFTER_DRAIN = false;
    const float* rs; bf16_t* H;
    DI void operator()(const f32x4 (&acc)[2][2][4][2], const pg8::Unit& u, int wr, int wc, int fr, int fq) const {
        const int rbase = u.pm * 256 + wr * 64 + fr, c0 = u.pn * 128 + wc * 32 + 8 * fq;
#pragma unroll
        for (int ai = 0; ai < 2; ++ai)
#pragma unroll
            for (int m = 0; m < 4; ++m) {
                const int row = rbase + ai * 128 + m * 16; const float r = rs[row];
                f32x4 g0 = acc[ai][0][m][0] * r, g1 = acc[ai][0][m][1] * r; const f32x4 u0 = acc[ai][1][m][0] * r, u1 = acc[ai][1][m][1] * r;
#pragma unroll
                for (int i = 0; i < 4; ++i) { g0[i] = g0[i] * fsigmoid(g0[i]) * u0[i]; g1[i] = g1[i] * fsigmoid(g1[i]) * u1[i]; }
                st_bf16x8(H + (size_t)row * DFF + c0, g0, g1);
            }
    }
};

template <bool FIRST, bool LAST> DI void resid_pass(const Ctx& C, const float* gain) {
    const int lane = lane_id_here(); const int gw = C.bid * 8 + C.wave, NGW = C.G * 8;
    unsigned char* ws = C.ws;
    const bf16_t* BR = (const bf16_t*)(ws + WS_MIX); const float* SSQ = (const float*)(ws + WS_SSQ);
    bf16_t* XB = (bf16_t*)(ws + WS_XB); float* RS = (float*)(ws + WS_RS);
    f32x4 gv[4];
#pragma unroll
    for (int j = 0; j < 4; ++j) gv[j] = ((const f32x4*)gain)[lane + 64 * j];
    for (int m = gw; m < MT; m += NGW) {
        const float* xo = FIRST ? (m < MP ? C.in[0] + (size_t)m * 1024 : C.in[1] + (size_t)(m - MP) * 1024) : C.out + (size_t)m * 1024;
        float sq = lane < 16 ? SSQ[(size_t)m * 16 + lane] : 0.f;
        sq = wave_sum(sq);
        const float rb = rsqrtf(sq * (1.f / 1024.f) + EPS);
        f32x4 v[4]; float s = 0.f;
#pragma unroll
        for (int j = 0; j < 4; ++j) {
            const u32x2 bw = ((const u32x2*)(BR + (size_t)m * 1024))[lane + 64 * j];
            const f32x4 xv = ((const f32x4*)xo)[lane + 64 * j];
            f32x4 bv = (f32x4){bflo(bw.x), bfhi(bw.x), bflo(bw.y), bfhi(bw.y)};
            v[j] = xv + bv * rb * gv[j];
            s += (v[j].x * v[j].x + v[j].y * v[j].y) + (v[j].z * v[j].z + v[j].w * v[j].w);
        }
#pragma unroll
        for (int j = 0; j < 4; ++j) ((f32x4*)(C.out + (size_t)m * 1024))[lane + 64 * j] = v[j];
        if (!LAST) {
            s = wave_sum(s);
#pragma unroll
            for (int j = 0; j < 4; ++j) { u32x2 w; w.x = pk2(v[j].x, v[j].y); w.y = pk2(v[j].z, v[j].w); ((u32x2*)(XB + (size_t)m * 1024))[lane + 64 * j] = w; }
            if (lane == 0) RS[m] = rsqrtf(s * (1.f / 1024.f) + EPS);
        }
    }
}

DI void xattn_prompt_wave(const Ctx& C, int blk, int h, int lane) {
    const int r = lane & 31, hh = lane >> 5;
    unsigned char* ws = C.ws;
    const size_t row0 = (size_t)blk * 32; const int b = blk >> 8;
    const bf16_t* Q = (const bf16_t*)(ws + WS_Q2) + (row0 + r) * 1024 + h * 256 + 8 * hh;
    const bf16_t* K = (const bf16_t*)(ws + WS_MK) + ((size_t)b * 256 + r) * 1024 + h * 256 + 8 * hh;
    const bf16_t* VT = (const bf16_t*)(ws + WS_MVT) + ((size_t)b * 1024 + h * 256 + r) * 256 + 4 * hh;
    f32x16 P[8];
#pragma unroll
    for (int kt = 0; kt < 8; ++kt)
#pragma unroll
        for (int j = 0; j < 16; ++j) P[kt][j] = 0.f;
#pragma unroll 2
    for (int s = 0; s < 16; ++s) {
        const bf16x8 qf = *(const bf16x8*)(Q + 16 * s);
#pragma unroll
        for (int kt = 0; kt < 8; ++kt) { const bf16x8 kf = *(const bf16x8*)(K + (size_t)kt * 32 * 1024 + 16 * s); P[kt] = MFMA32(kf, qf, P[kt]); }
    }
    float mx = -1e30f;
#pragma unroll
    for (int kt = 0; kt < 8; ++kt)
#pragma unroll
        for (int j = 0; j < 16; ++j) mx = fmaxf(mx, P[kt][j]);
    mx = fmaxf(mx, __shfl_xor(mx, 32));
    float den = 0.f;
    bf16x8 pb[8][2];
#pragma unroll
    for (int kt = 0; kt < 8; ++kt) {
#pragma unroll
        for (int j = 0; j < 16; ++j) { const float p = __builtin_amdgcn_exp2f(P[kt][j] - mx); P[kt][j] = p; den += p; }
        pb[kt][0] = pack_step(P[kt], 0); pb[kt][1] = pack_step(P[kt], 1);
    }
    den += __shfl_xor(den, 32);
    const float inv = __builtin_amdgcn_rcpf(den);
    bf16_t* op = (bf16_t*)(ws + WS_O2) + (row0 + r) * 1024 + h * 256 + 4 * hh;
#pragma unroll 1
    for (int half = 0; half < 2; ++half) {
        f32x16 O[4];
#pragma unroll
        for (int i = 0; i < 4; ++i)
#pragma unroll
            for (int j = 0; j < 16; ++j) O[i][j] = 0.f;
#pragma unroll
        for (int kt = 0; kt < 8; ++kt)
#pragma unroll
            for (int s = 0; s < 2; ++s)
#pragma unroll
                for (int dt = 0; dt < 4; ++dt) {
                    const bf16_t* vp = VT + (size_t)(128 * half + 32 * dt) * 256 + 32 * kt + 16 * s;
                    const bf16x8 a = cat8(*(const u32x2*)vp, *(const u32x2*)(vp + 8));
                    O[dt] = MFMA32(a, pb[kt][s], O[dt]);
                }
#pragma unroll
        for (int dt = 0; dt < 4; ++dt)
#pragma unroll
            for (int g4 = 0; g4 < 4; ++g4) {
                u32x2 w; w.x = pk2(O[dt][4 * g4] * inv, O[dt][4 * g4 + 1] * inv); w.y = pk2(O[dt][4 * g4 + 2] * inv, O[dt][4 * g4 + 3] * inv);
                *(u32x2*)(op + 128 * half + 32 * dt + 8 * g4) = w;
            }
    }
}
constexpr int XS_Q = 0, XS_SC = 8192, XS_END = 16384;
DI void xattn_sample_item(const Ctx& C, int b, int h) {
    const int lane = lane_id_here(), w = C.wave, tid = w * 64 + lane;
    unsigned char* ws = C.ws;
    LAS float* QS = (LAS float*)(C.lds + XS_Q); LAS float* SC = (LAS float*)(C.lds + XS_SC);
    const float* cache = C.in[6] + (size_t)b * 256 * 2048 + h * 256;
    __syncthreads();
    for (int i = tid; i < 8 * 256; i += NTHREADS) QS[i] = bf1(((const bf16_t*)(ws + WS_Q2))[((size_t)MP + b * 8 + (i >> 8)) * 1024 + h * 256 + (i & 255)]);
    __syncthreads();
    {
        f32x4 q[8];
#pragma unroll
        for (int t = 0; t < 8; ++t) q[t] = *(const LAS f32x4*)(QS + t * 256 + 4 * lane);
        for (int mm = 0; mm < 32; ++mm) {
            const int m = 32 * w + mm;
            const f32x4 kk = *(const f32x4*)(cache + (size_t)m * 2048 + 4 * lane);
#pragma unroll
            for (int t = 0; t < 8; ++t) {
                const float s = wave_sum(q[t].x * kk.x + q[t].y * kk.y + q[t].z * kk.z + q[t].w * kk.w);
                if (lane == 0) SC[t * 256 + m] = s;
            }
        }
    }
    __syncthreads();
    {
        float v[4]; float mx = -1e30f;
#pragma unroll
        for (int i = 0; i < 4; ++i) { v[i] = SC[w * 256 + lane + 64 * i]; mx = fmaxf(mx, v[i]); }
#pragma unroll
        for (int o = 1; o < 64; o <<= 1) mx = fmaxf(mx, __shfl_xor(mx, o));
        float den = 0.f;
#pragma unroll
        for (int i = 0; i < 4; ++i) { v[i] = __builtin_amdgcn_exp2f(v[i] - mx); den += v[i]; }
        den = wave_sum(den);
        const float inv = 1.f / den;
#pragma unroll
        for (int i = 0; i < 4; ++i) SC[w * 256 + lane + 64 * i] = v[i] * inv;
    }
    __syncthreads();
    {
        const int d = tid & 255, t0 = (tid >> 8) * 4;
        float o[4] = {0.f, 0.f, 0.f, 0.f};
        for (int m = 0; m < 256; ++m) {
            const float vv = cache[(size_t)m * 2048 + 1024 + d];
#pragma unroll
            for (int t = 0; t < 4; ++t) o[t] += SC[(t0 + t) * 256 + m] * vv;
        }
#pragma unroll
        for (int t = 0; t < 4; ++t) ((bf16_t*)(ws + WS_O2))[((size_t)MP + b * 8 + t0 + t) * 1024 + h * 256 + d] = f2bf(o[t]);
    }
    __syncthreads();
}

#ifndef MK_N_LAUNCHES
#define MK_N_LAUNCHES 1
#endif
constexpr int N_PHASES = 13;

__global__ void __launch_bounds__(NTHREADS, 2) fwd_megakernel(Args args) {
    extern __shared__ __attribute__((aligned(16))) unsigned char lds_raw[];
    cg::grid_group grid = cg::this_grid();
    Ctx C;
    C.in = args.in; C.out = args.out; C.ws = args.ws;
    C.lds = (LAS unsigned char*)lds_raw;
    C.wave = __builtin_amdgcn_readfirstlane(threadIdx.x >> 6);
    C.G = gridDim.x; C.bid = blockIdx.x;
    const int lo = args.ph_lo, hi = args.ph_hi;
    unsigned char* ws = args.ws;
#define IN(k) (lo <= (k) && (k) < hi)
    volatile LAS unsigned* MISC = (volatile LAS unsigned*)(C.lds + LDS_BYTES - 64);
    const bool leader = (C.wave == 0) && (lane_id() == 0);
    if (leader) { MISC[0] = 0u; MISC[1] = 0u; }
    __syncthreads();
    XcdBarrier xbar = xcd_barrier_post((unsigned*)(ws + WS_CTL), MISC, leader);
#define SEAM(k) do { if (IN(k) && IN((k) + 1)) { if ((k) == 0) grid.sync(); else xcd_barrier(xbar, (C.wave == 0) && (lane_id() == 0)); } } while (0)

    if (IN(0)) { p0_prologue(C); }
    SEAM(0);
    if (IN(1)) {
        {
            pg8::Gemm g{(const bf16_t*)(ws + WS_XB), (const bf16_t*)(ws + WS_WIN), MT, NIN, 1024};
            pg8::StaticOrder S; S.init(MT, NIN, C.G, C.bid);
            EpiIn E{(const float*)(ws + WS_RS), ws, args.out};
            pg8::gemm_phase<EpiIn, pg8::StaticOrder, true, true>(C.lds, g, S, E, C.wave);
        }
        {
            pg8::Gemm g{(const bf16_t*)(ws + WS_MEMB), (const bf16_t*)(ws + WS_WMKV), 1024, 2048, 1024};
            pg8::StaticOrder S; S.init(1024, 2048, C.G, C.G - 1 - C.bid);
            EpiMemKV E{(const float*)(ws + WS_RSMEM), ws, args.out};
            pg8::gemm_phase<EpiMemKV, pg8::StaticOrder, true, true>(C.lds, g, S, E, C.wave);
        }
    }
    SEAM(1);
    if (IN(2)) {
        __syncthreads();
        if (C.bid < 16) gla_prompt_item(C, C.bid >> 2, C.bid & 3);
        else {
            for (int it = C.bid - 16; it < 512; it += C.G - 16) {
                if (it < 256) attn_prompt_item(C, it >> 6, (it >> 4) & 3, it & 15);
                else if (it < 384) attn_sample_item(C, (it - 256) >> 2, (it - 256) & 3);
                else gla_sample_item(C, (it - 384) >> 2, (it - 384) & 3);
            }
        }
    }
    SEAM(2);
    if (IN(3)) {
        {
            pg8::Gemm g{(const bf16_t*)(ws + WS_YAIN), (const bf16_t*)(ws + WS_WPA), MT, 1024, 512};
            pg8::StaticOrder S; S.init(MT, 1024, C.G, C.bid);
            EpiGate<0> E{(const bf16_t*)(ws + WS_SGA), nullptr, (bf16_t*)(ws + WS_TMP)};
            pg8::gemm_phase<EpiGate<0>, pg8::StaticOrder, true, true>(C.lds, g, S, E, C.wave);
        }
        {
            pg8::Gemm g{(const bf16_t*)(ws + WS_OBN), (const bf16_t*)(ws + WS_WPB), MT, 1024, 1024};
            pg8::StaticOrder S; S.init(MT, 1024, C.G, C.bid);
            EpiGate<1> E{(const bf16_t*)(ws + WS_SGBT), (const bf16_t*)(ws + WS_TMP), (bf16_t*)(ws + WS_MIXIN)};
            pg8::gemm_phase<EpiGate<1>, pg8::StaticOrder, true, true>(C.lds, g, S, E, C.wave);
        }
    }
    SEAM(3);
    if (IN(4)) {
        pg8::Gemm g{(const bf16_t*)(ws + WS_MIXIN), (const bf16_t*)(ws + WS_WOUT), MT, 1024, 1024};
        pg8::StaticOrder S; S.init(MT, 1024, C.G, C.bid);
        EpiBranch E{(bf16_t*)(ws + WS_MIX), (float*)(ws + WS_SSQ)};
        pg8::gemm_phase<EpiBranch, pg8::StaticOrder, true, true>(C.lds, g, S, E, C.wave);
    }
    SEAM(4);
    if (IN(5)) resid_pass<true, false>(C, args.in[10]);
    SEAM(5);
    if (IN(6)) {
        pg8::Gemm g{(const bf16_t*)(ws + WS_XB), (const bf16_t*)(ws + WS_WMQ), MT, 1024, 1024};
        pg8::StaticOrder S; S.init(MT, 1024, C.G, C.bid);
        EpiRowScale E{(const float*)(ws + WS_RS), (bf16_t*)(ws + WS_Q2), Q2_SCALE};
        pg8::gemm_phase<EpiRowScale, pg8::StaticOrder, true, true>(C.lds, g, S, E, C.wave);
    }
    SEAM(6);
    if (IN(7)) {
        for (int it = C.bid; it < 128; it += C.G) xattn_sample_item(C, it >> 2, it & 3);
        for (int it = C.bid * 8 + C.wave; it < 4096; it += C.G * 8) xattn_prompt_wave(C, it >> 2, it & 3, lane_id_here());
    }
    SEAM(7);
    if (IN(8)) {
        pg8::Gemm g{(const bf16_t*)(ws + WS_O2), (const bf16_t*)(ws + WS_WMO), MT, 1024, 1024};
        pg8::StaticOrder S; S.init(MT, 1024, C.G, C.bid);
        EpiBranch E{(bf16_t*)(ws + WS_MIX), (float*)(ws + WS_SSQ)};
        pg8::gemm_phase<EpiBranch, pg8::StaticOrder, true, true>(C.lds, g, S, E, C.wave);
    }
    SEAM(8);
    if (IN(9)) resid_pass<false, false>(C, args.in[22]);
    SEAM(9);
    if (IN(10)) {
        pg8::Gemm g{(const bf16_t*)(ws + WS_XB), (const bf16_t*)(ws + WS_WGU), MT, 2 * DFF, 1024};
        pg8::StaticOrder S; S.init(MT, 2 * DFF, C.G, C.bid);
        EpiGateUp E{(const float*)(ws + WS_RS), (bf16_t*)(ws + WS_H)};
        pg8::gemm_phase<EpiGateUp, pg8::StaticOrder, true, true>(C.lds, g, S, E, C.wave);
    }
    SEAM(10);
    if (IN(11)) {
        pg8::Gemm g{(const bf16_t*)(ws + WS_H), (const bf16_t*)(ws + WS_WDN), MT, 1024, DFF};
        pg8::StaticOrder S; S.init(MT, 1024, C.G, C.bid);
        EpiBranch E{(bf16_t*)(ws + WS_MIX), (float*)(ws + WS_SSQ)};
        pg8::gemm_phase<EpiBranch, pg8::StaticOrder, true, true>(C.lds, g, S, E, C.wave);
    }
    SEAM(11);
    if (IN(12)) resid_pass<false, true>(C, args.in[26]);
#undef IN
#undef SEAM
}

extern "C" void kernel_launch(void* const* d_in, const int* in_sizes, int n_in, void* d_out, int out_size, void* d_ws, size_t ws_size, hipStream_t stream) {
    static int grid = 0;
    if (grid == 0) {
        if (n_in != 30 || out_size != (int)O_TOTAL || ws_size < WS_END) {
            fprintf(stderr, "kernel_launch: unexpected problem (n_in %d, out %d, ws %zu; need ws >= %zu); nothing launched\n", n_in, out_size, ws_size, (size_t)WS_END);
            grid = -1; return;
        }
        int dev = 0, cus = 0, per_cu = 0;
        (void)hipGetDevice(&dev);
        (void)hipDeviceGetAttribute(&cus, hipDeviceAttributeMultiprocessorCount, dev);
        (void)hipFuncSetAttribute((const void*)fwd_megakernel, hipFuncAttributeMaxDynamicSharedMemorySize, LDS_BYTES);
        (void)hipOccupancyMaxActiveBlocksPerMultiprocessor(&per_cu, (const void*)fwd_megakernel, NTHREADS, LDS_BYTES);
        if (per_cu < 1) { fprintf(stderr, "kernel_launch: occupancy query says %d blocks per CU\n", per_cu); per_cu = 1; }
        (void)hipGetLastError();
        grid = cus;
        if (grid > 256) grid = 256;
    }
    if (grid < 0) return;
    (void)hipMemsetAsync((char*)d_ws + WS_CTL, 0, 65536, stream);
    Args a{};
    for (int i = 0; i < 30; ++i) a.in[i] = (const float*)d_in[i];
    a.out = (float*)d_out; a.ws = (unsigned char*)d_ws;
#if MK_N_LAUNCHES == 1
    a.ph_lo = 0; a.ph_hi = N_PHASES;
    void* kargs[] = {&a};
    hipError_t e = hipLaunchCooperativeKernel((const void*)fwd_megakernel, dim3(grid), dim3(NTHREADS), kargs, LDS_BYTES, stream);
    if (e != hipSuccess) fprintf(stderr, "cooperative launch failed: %s (grid %d)\n", hipGetErrorString(e), grid);
#else
    for (int p = 0; p < N_PHASES; ++p) {
        a.ph_lo = p; a.ph_hi = p + 1;
        hipLaunchKernelGGL(fwd_megakernel, dim3(grid), dim3(NTHREADS), LDS_BYTES, stream, a);
    }
#endif
}
```

```cpp
#include <hip/hip_runtime.h>
#include <hip/hip_cooperative_groups.h>
#include <cstdio>
#include <cstdint>
namespace cg = cooperative_groups;
#define LAS __attribute__((address_space(3)))
namespace pg8 {
#define PG8_LAS __attribute__((address_space(3)))
typedef unsigned short bf16_t;
typedef short bf16x8 __attribute__((ext_vector_type(8)));
typedef float f32x4 __attribute__((ext_vector_type(4)));
typedef unsigned u32x4 __attribute__((ext_vector_type(4)));
constexpr int BM = 256, BK = 64, HALF = 128, HTB = HALF * BK * 2  , STAGE_BYTES = 8 * HTB, NXCD = 8, WGM = 8;

__host__ __device__ __forceinline__ int lds_byte(int r, int c) { const int st = (r >> 4) * 2 + (c >> 5), rr = r & 15, cc = c & 31, ob = rr * 64 + cc * 2; return st * 1024 + (ob ^ (((ob >> 9) & 1) << 5)); }
__host__ __device__ __forceinline__ void stage_rc(int b, int& R, int& C) { const int st = b / 1024, sb = b % 1024, swz = sb ^ (((sb >> 9) & 1) << 5); R = (st >> 1) * 16 + swz / 64; C = (st & 1) * 32 + (swz % 64) / 2; }
__host__ __device__ __forceinline__ int perm32(int rho) { const int n = rho >> 4, i = rho & 15; return 8 * (i >> 2) + 4 * n + (i & 3); }

struct Unit { int pm, pn; };
struct Gemm { const bf16_t* A; const bf16_t* Bt; int M, N, K; };

struct StaticOrder {
    int nM, nN, nwg, G, c;
    __host__ __device__ void init(int M, int N, int G_, int c_) { nM = M / BM; nN = N / BM; nwg = nM * nN; G = G_; c = c_; }
    __host__ __device__ bool next(int i, Unit& u) const {
        const long L = (long)i * G + c; if (L >= nwg) return false;
        int wgid = (int)L; { const int q = nwg / NXCD, r = nwg % NXCD, xcd = wgid % NXCD, off = wgid / NXCD; wgid = (xcd < r ? xcd * (q + 1) : r * (q + 1) + (xcd - r) * q) + off; }
        const int nig = WGM * nN, gid = wgid / nig, fm = gid * WGM, gsz = (nM - fm) < WGM ? (nM - fm) : WGM;
        u.pm = fm + ((wgid % nig) % gsz); u.pn = (wgid % nig) / gsz; return true;
    }
    __device__ __forceinline__ void a_ready(const Unit&) const {}
    __device__ __forceinline__ void done(const Unit&) const {}
};

__device__ __forceinline__ unsigned cvt_pk_bf16(float lo, float hi) { unsigned r; asm volatile("v_cvt_pk_bf16_f32 %0, %1, %2" : "=v"(r) : "v"(lo), "v"(hi)); return r; }
typedef float f32x2 __attribute__((ext_vector_type(2)));
__device__ __forceinline__ f32x2 gelu_pk(f32x2 v) {
    const f32x2 av = __builtin_elementwise_abs(v), d = av * 0.2316418882f + 1.0f;
    f32x2 t; t.x = __builtin_amdgcn_rcpf(d.x); t.y = __builtin_amdgcn_rcpf(d.y);
    f32x2 q = t * 0.5307027145f + (-0.7265760135f); q = q * t + 0.7107068705f; q = q * t + (-0.142248368f); q = q * t + 0.127414796f; q = q * t;
    const f32x2 s = (v * v) * (-0.72134752044f);
    f32x2 e; e.x = __builtin_amdgcn_exp2f(s.x); e.y = __builtin_amdgcn_exp2f(s.y);
    const f32x2 m = v * (q * e), r = v - m;
    f32x2 o; o.x = v.x < 0.f ? m.x : r.x; o.y = v.y < 0.f ? m.y : r.y; return o;
}

template <int ACT  > struct EpiBf16 {
    static constexpr bool PERM = true, AFTER_DRAIN = false, HAS_MID = false; static_assert(ACT == 0 || ACT == 1, "EpiBf16: ACT is 0 (none) or 1 (gelu_pk)");
    bf16_t* O; int ldc; const float* bias; int split_cols; size_t split_stride; float scale0;
    __device__ __forceinline__ void operator()(const f32x4 (&acc)[2][2][4][2], const Unit& u, int wr, int wc, int fr, int fq) const {
        const int row0 = u.pm * BM + wr * 64 + fr; int colt = u.pn * BM; bf16_t* base = O;
        float sc = 1.f; if (split_cols) { const int t = colt / split_cols; base += (size_t)t * split_stride; colt -= t * split_cols; if (t == 0) sc = scale0; }
        const int col0 = colt + wc * 32 + 8 * fq, bcol0 = u.pn * BM + wc * 32 + 8 * fq;
        f32x4 bv[2][2];
#pragma unroll
        for (int bj = 0; bj < 2; ++bj)
#pragma unroll
            for (int n = 0; n < 2; ++n) bv[bj][n] = bias ? *(const f32x4*)(bias + bcol0 + bj * HALF + 4 * n) : (f32x4){0.f, 0.f, 0.f, 0.f};
#pragma unroll
        for (int ai = 0; ai < 2; ++ai)
#pragma unroll
            for (int m = 0; m < 4; ++m) { bf16_t* rowp = base + (size_t)(row0 + ai * HALF + m * 16) * ldc + col0;
#pragma unroll
                for (int bj = 0; bj < 2; ++bj) { f32x4 v0 = acc[ai][bj][m][0] + bv[bj][0], v1 = acc[ai][bj][m][1] + bv[bj][1];
                    if (ACT == 1) { f32x2 a = gelu_pk((f32x2){v0[0], v0[1]}), b = gelu_pk((f32x2){v0[2], v0[3]}), c = gelu_pk((f32x2){v1[0], v1[1]}), d = gelu_pk((f32x2){v1[2], v1[3]});
                        v0 = (f32x4){a.x, a.y, b.x, b.y}; v1 = (f32x4){c.x, c.y, d.x, d.y}; }
                    v0 = v0 * sc; v1 = v1 * sc; u32x4 w; w.x = cvt_pk_bf16(v0[0], v0[1]); w.y = cvt_pk_bf16(v0[2], v0[3]); w.z = cvt_pk_bf16(v1[0], v1[1]); w.w = cvt_pk_bf16(v1[2], v1[3]);
                    *(u32x4*)(rowp + bj * HALF) = w; } }
    }
};

struct PanelStats {
    unsigned* xbuf;
    unsigned* cnt;
    unsigned* tmo;
    int ntn; float eps;
    unsigned code;
    __device__ __forceinline__ bool run(const f32x4 (&v)[2][2][4][2], const Unit& u, int wr, int wc, int fr, int fq, PG8_LAS unsigned char* lds, int wid, int lane) const {
        typedef float f32x2v __attribute__((ext_vector_type(2)));
        PG8_LAS f32x2v* P = (PG8_LAS f32x2v*)lds;
        PG8_LAS f32x2v* S = (PG8_LAS f32x2v*)(lds + 8192);
        PG8_LAS unsigned* flag = (PG8_LAS unsigned*)(lds + 8192 + 2048);
#pragma unroll
        for (int ai = 0; ai < 2; ++ai)
#pragma unroll
            for (int m = 0; m < 4; ++m) {
                float s = 0.f;
#pragma unroll
                for (int bj = 0; bj < 2; ++bj)
#pragma unroll
                    for (int n = 0; n < 2; ++n) { const f32x4 x = v[ai][bj][m][n]; s += (x[0] + x[1]) + (x[2] + x[3]); }
                s += __shfl_xor(s, 16); s += __shfl_xor(s, 32);
                const float mw = s * (1.0f / 64.0f); float q = 0.f;
#pragma unroll
                for (int bj = 0; bj < 2; ++bj)
#pragma unroll
                    for (int n = 0; n < 2; ++n) { const f32x4 d = v[ai][bj][m][n] - mw; q += (d[0] * d[0] + d[1] * d[1]) + (d[2] * d[2] + d[3] * d[3]); }
                q += __shfl_xor(q, 16); q += __shfl_xor(q, 32);
                if (fq == 0) P[(ai * HALF + wr * 64 + m * 16 + fr) * 4 + wc] = (f32x2v){mw, q};
            }
        asm volatile("s_waitcnt lgkmcnt(0)" ::: "memory"); __builtin_amdgcn_s_barrier(); asm volatile("" ::: "memory");
#if defined(BROKEN_EXCHANGE_NO_WAIT)
#warning BROKEN CONTROL BUILD: the row-statistics exchange does not wait; results are wrong by design
        if (blockIdx.x >= 64) { const long long t0_ = clock64(); while (clock64() - t0_ < 60000) __builtin_amdgcn_s_sleep(8); }
#endif
        const int row = wid * 32 + (lane & 31);
        if (lane < 32) {
            const f32x2v a = P[row * 4 + 0], b = P[row * 4 + 1], c = P[row * 4 + 2], d = P[row * 4 + 3];
            const float mt = (a.x + b.x + c.x + d.x) * 0.25f;
            const float da = a.x - mt, db = b.x - mt, dc = c.x - mt, dd = d.x - mt;
            const float m2 = (a.y + b.y) + (c.y + d.y) + 64.0f * ((da * da + db * db) + (dc * dc + dd * dd));
            unsigned long long* slot = (unsigned long long*)xbuf + ((size_t)(u.pm * BM + row) * 4 + u.pn);
            __hip_atomic_store(slot, ((unsigned long long)__float_as_uint(m2) << 32) | __float_as_uint(mt), __ATOMIC_RELAXED, __HIP_MEMORY_SCOPE_AGENT);
        }
        asm volatile("s_waitcnt vmcnt(0)" ::: "memory");
        if (lane == 0) __hip_atomic_fetch_add(cnt + 64 * u.pm, 1u, __ATOMIC_RELAXED, __HIP_MEMORY_SCOPE_AGENT);
        if (wid == 0) {
            bool dead = false; const unsigned long long t0 = __builtin_amdgcn_s_memrealtime(); const unsigned want = 8u * (unsigned)ntn;
            for (;;) {
#if defined(BROKEN_EXCHANGE_NO_WAIT)
                break;
#endif
                if ((unsigned)__builtin_amdgcn_readfirstlane(__hip_atomic_load(cnt + 64 * u.pm, __ATOMIC_RELAXED, __HIP_MEMORY_SCOPE_AGENT)) >= want) break;
                if (__builtin_amdgcn_s_memrealtime() - t0 > 2000000ull) {
                    if (lane == 0) { unsigned expect = 0u; __hip_atomic_compare_exchange_strong(tmo + 1, &expect, code | (unsigned)(u.pm & 0xff), __ATOMIC_RELAXED, __ATOMIC_RELAXED, __HIP_MEMORY_SCOPE_AGENT);
                                     __hip_atomic_store(tmo, 1u, __ATOMIC_RELAXED, __HIP_MEMORY_SCOPE_AGENT); }
                    dead = true; break; }
                __builtin_amdgcn_s_sleep(2);
            }
            __builtin_amdgcn_fence(__ATOMIC_ACQUIRE, "agent");
            if (lane == 0) flag[0] = dead ? 1u : 0u;
        }
        asm volatile("s_waitcnt vmcnt(0) lgkmcnt(0)" ::: "memory"); __builtin_amdgcn_s_barrier(); asm volatile("" ::: "memory");
        const bool bad = flag[0] != 0u;
        if (lane < 32) {
            const unsigned long long* slot = (const unsigned long long*)xbuf + (size_t)(u.pm * BM + row) * 4; float mt[4], m2[4]; float ms = 0.f;
#pragma unroll
            for (int t = 0; t < 4; ++t) { if (t < ntn) { const unsigned long long w = __hip_atomic_load(slot + t, __ATOMIC_RELAXED, __HIP_MEMORY_SCOPE_AGENT); mt[t] = __uint_as_float((unsigned)w); m2[t] = __uint_as_float((unsigned)(w >> 32)); } else { mt[t] = 0.f; m2[t] = 0.f; } ms += mt[t]; }
            const float mean = ms / (float)ntn; float q = 0.f;
#pragma unroll
            for (int t = 0; t < 4; ++t) if (t < ntn) { const float dm = mt[t] - mean; q += m2[t] + 256.0f * dm * dm; }
            S[row] = (f32x2v){mean, 1.0f / sqrtf(q / (256.0f * (float)ntn) + eps)};
        }
        asm volatile("s_waitcnt lgkmcnt(0)" ::: "memory"); __builtin_amdgcn_s_barrier(); asm volatile("" ::: "memory");
        return bad;
    }
};
struct EpiLnRes {
    static constexpr bool PERM = false, AFTER_DRAIN = true, HAS_MID = false;
    const float* base; float* out; int ldc; const float* bias; PanelStats st; unsigned poison;
    __device__ __forceinline__ void fused(f32x4 (&acc)[2][2][4][2], const Unit& u, int wr, int wc, int fr, int fq, PG8_LAS unsigned char* lds, int wid, int lane) const {
        typedef float f32x2v __attribute__((ext_vector_type(2)));
        const PG8_LAS f32x2v* S = (const PG8_LAS f32x2v*)(lds + 8192);
        const int col0 = u.pn * BM + wc * 32 + 4 * fq;
#pragma unroll
        for (int bj = 0; bj < 2; ++bj)
#pragma unroll
            for (int n = 0; n < 2; ++n) { const f32x4 bv = bias ? *(const f32x4*)(bias + col0 + bj * HALF + n * 16) : (f32x4){0.f, 0.f, 0.f, 0.f};
#pragma unroll
                for (int ai = 0; ai < 2; ++ai)
#pragma unroll
                    for (int m = 0; m < 4; ++m) acc[ai][bj][m][n] += bv; }
        f32x4 pre[4][2][2];
#pragma unroll
        for (int m = 0; m < 4; ++m) { const size_t off = (size_t)(u.pm * BM + wr * 64 + m * 16 + fr) * ldc + col0;
#pragma unroll
            for (int bj = 0; bj < 2; ++bj)
#pragma unroll
                for (int n = 0; n < 2; ++n) pre[m][bj][n] = *(const f32x4*)(base + off + bj * HALF + n * 16); }
        const bool bad = st.run(acc, u, wr, wc, fr, fq, lds, wid, lane) || poison != 0u;
        const float qnan = __builtin_nanf("");
#pragma unroll
        for (int ai = 0; ai < 2; ++ai)
#pragma unroll
            for (int m = 0; m < 4; ++m) { const int r = ai * HALF + wr * 64 + m * 16 + fr; const f32x2v sr = S[r]; const size_t off = (size_t)(u.pm * BM + r) * ldc + col0;
#pragma unroll
                for (int bj = 0; bj < 2; ++bj)
#pragma unroll
                    for (int n = 0; n < 2; ++n) { const f32x4 bs = ai == 0 ? pre[m][bj][n] : *(const f32x4*)(base + off + bj * HALF + n * 16); f32x4 o = bs + (acc[ai][bj][m][n] - sr.x) * sr.y;
                        if (bad) o = (f32x4){qnan, qnan, qnan, qnan}; *(f32x4*)(out + off + bj * HALF + n * 16) = o; }
                if (m & 1) asm volatile("" ::: "memory"); }
    }
};
struct EpiLnResLn {
    static constexpr bool PERM = false, AFTER_DRAIN = true, HAS_MID = false;
    const float* base; float* out; bf16_t* xn; int ldc; const float* bias; PanelStats st1, st2; unsigned poison;
    __device__ __forceinline__ void fused(f32x4 (&acc)[2][2][4][2], const Unit& u, int wr, int wc, int fr, int fq, PG8_LAS unsigned char* lds, int wid, int lane) const {
        typedef float f32x2v __attribute__((ext_vector_type(2))); typedef unsigned u32x2v __attribute__((ext_vector_type(2)));
        const PG8_LAS f32x2v* S = (const PG8_LAS f32x2v*)(lds + 8192);
        const int col0 = u.pn * BM + wc * 32 + 4 * fq;
#pragma unroll
        for (int bj = 0; bj < 2; ++bj)
#pragma unroll
            for (int n = 0; n < 2; ++n) { const f32x4 bv = bias ? *(const f32x4*)(bias + col0 + bj * HALF + n * 16) : (f32x4){0.f, 0.f, 0.f, 0.f};
#pragma unroll
                for (int ai = 0; ai < 2; ++ai)
#pragma unroll
                    for (int m = 0; m < 4; ++m) acc[ai][bj][m][n] += bv; }
        bool bad = st1.run(acc, u, wr, wc, fr, fq, lds, wid, lane) || poison != 0u;
        const float qnan = __builtin_nanf("");
#pragma unroll
        for (int ai = 0; ai < 2; ++ai)
#pragma unroll
            for (int m = 0; m < 4; ++m) { const int r = ai * HALF + wr * 64 + m * 16 + fr; const f32x2v sr = S[r]; const size_t off = (size_t)(u.pm * BM + r) * ldc + col0;
#pragma unroll
                for (int bj = 0; bj < 2; ++bj)
#pragma unroll
                    for (int n = 0; n < 2; ++n) { const f32x4 bs = *(const f32x4*)(base + off + bj * HALF + n * 16); acc[ai][bj][m][n] = bs + (acc[ai][bj][m][n] - sr.x) * sr.y; }
                asm volatile("" : "+v"(acc[ai][0][m][0]), "+v"(acc[ai][0][m][1]), "+v"(acc[ai][1][m][0]), "+v"(acc[ai][1][m][1]));
                if (m & 1) asm volatile("" ::: "memory"); }
        const bool bad1 = bad;
        bad = st2.run(acc, u, wr, wc, fr, fq, lds, wid, lane) || bad;
#pragma unroll
        for (int ai = 0; ai < 2; ++ai)
#pragma unroll
            for (int m = 0; m < 4; ++m) { const int r = ai * HALF + wr * 64 + m * 16 + fr; const f32x2v sr = S[r]; const size_t off = (size_t)(u.pm * BM + r) * ldc + col0;
#pragma unroll
                for (int bj = 0; bj < 2; ++bj)
#pragma unroll
                    for (int n = 0; n < 2; ++n) { const f32x4 x1 = acc[ai][bj][m][n]; *(f32x4*)(out + off + bj * HALF + n * 16) = bad1 ? (f32x4){qnan, qnan, qnan, qnan} : x1;
                        const f32x4 o = (x1 - sr.x) * sr.y; u32x2v w; w.x = cvt_pk_bf16(o[0], o[1]); w.y = cvt_pk_bf16(o[2], o[3]);
                        if (bad) { w.x = 0x7fc07fc0u; w.y = 0x7fc07fc0u; } *(u32x2v*)(xn + off + bj * HALF + n * 16) = w; }
                asm volatile("" ::: "memory"); }
    }
};

template <class Epi, class Sched, bool ALIGN_EPI = false, bool SP2 = false>
__device__ __forceinline__ void gemm_phase(PG8_LAS unsigned char* lds, const Gemm g, const Sched& S, const Epi& E, const int wave_id) {
    const int lane = __builtin_amdgcn_mbcnt_hi(~0u, __builtin_amdgcn_mbcnt_lo(~0u, 0u)), wid = wave_id, tid = wid * 64 + lane, wr = wid >> 2, wc = wid & 3, fr = lane & 15, fq = lane >> 4;
    const int K = g.K, nt = K / BK;
    unsigned voffA[2], voffB[2];
#pragma unroll
    for (int i = 0; i < 2; ++i) { int R, C; stage_rc(tid * 16 + i * 8192, R, C); const int Rb = Epi::PERM ? ((R & ~31) + perm32(R & 31)) : R;
        voffA[i] = (unsigned)(R * K + C) * 2u; voffB[i] = (unsigned)(Rb * K + C) * 2u; }
    const size_t kstep = (size_t)(BK * 2);
    const size_t hstep = (size_t)HALF * K * 2;
    const size_t tstep = 2 * hstep;
    const unsigned ldsw = (unsigned)wid * 1024u;
    const int aoff = lds_byte(wr * 64 + fr, fq * 8), boff = lds_byte(wc * 32 + fr, fq * 8);
#define PG8_SA(b, h) (((b) * 2 + (h)) * HTB)
#define PG8_SB(b, h) ((4 + (b) * 2 + (h)) * HTB)
#define PG8_STAGE(bufoff, gbase, voff) do { _Pragma("unroll") for (int _i = 0; _i < 2; ++_i) \
        __builtin_amdgcn_global_load_lds((const unsigned*)((const char*)(gbase) + (voff)[_i]), (PG8_LAS unsigned*)(lds + (bufoff) + ldsw + _i * 8192), 16, 0, 0); } while (0)
#define PG8_LDA(dst, b, h) do { _Pragma("unroll") for (int m = 0; m < 4; ++m) _Pragma("unroll") for (int k = 0; k < 2; ++k) dst[m][k] = *(const PG8_LAS bf16x8*)(lds + PG8_SA(b, h) + aoff + m * 2048 + k * 1024); } while (0)
#define PG8_LDB(dst, b, h) do { _Pragma("unroll") for (int n = 0; n < 2; ++n) _Pragma("unroll") for (int k = 0; k < 2; ++k) dst[n][k] = *(const PG8_LAS bf16x8*)(lds + PG8_SB(b, h) + boff + n * 2048 + k * 1024); } while (0)
#define PG8_MMA(ai, bj, At, Bt) do { __builtin_amdgcn_s_setprio(1); _Pragma("unroll") for (int m = 0; m < 4; ++m) _Pragma("unroll") for (int n = 0; n < 2; ++n) _Pragma("unroll") for (int k = 0; k < 2; ++k) \
        acc[ai][bj][m][n] = __builtin_amdgcn_mfma_f32_16x16x32_bf16(Bt[n][k], At[m][k], acc[ai][bj][m][n], 0, 0, 0); __builtin_amdgcn_s_setprio(0); } while (0)
#define PG8_WAIT_V(n) asm volatile("s_waitcnt vmcnt(" #n ")" ::: "memory")
#define PG8_WAIT_L(n) asm volatile("s_waitcnt lgkmcnt(" #n ")" ::: "memory")
#define PG8_BAR __builtin_amdgcn_s_barrier()
#define PG8_SCHED __builtin_amdgcn_sched_barrier(0)
    Unit cur, nxt; int ui = 0;
    if (!S.next(0, cur)) return;
    f32x4 acc[2][2][4][2];
#pragma unroll
    for (int a = 0; a < 2; ++a)
#pragma unroll
        for (int b = 0; b < 2; ++b)
#pragma unroll
            for (int m = 0; m < 4; ++m)
#pragma unroll
                for (int n = 0; n < 2; ++n) acc[a][b][m][n] = (f32x4){0.f, 0.f, 0.f, 0.f};
    bf16x8 At[4][2], B0[2][2], B1[2][2];
    const char* cA = (const char*)g.A + (size_t)cur.pm * tstep; const char* cB = (const char*)g.Bt + (size_t)cur.pn * tstep;
    S.a_ready(cur);
    if constexpr (SP2) {
        PG8_STAGE(PG8_SB(0, 0), cB, voffB); PG8_STAGE(PG8_SB(0, 1), cB + hstep, voffB); PG8_STAGE(PG8_SA(0, 0), cA, voffA); PG8_STAGE(PG8_SA(0, 1), cA + hstep, voffA);
        if (wr == 1) PG8_BAR;
        PG8_WAIT_V(2); PG8_BAR;
        PG8_STAGE(PG8_SB(1, 0), cB + kstep, voffB); PG8_STAGE(PG8_SA(1, 0), cA + kstep, voffA); PG8_STAGE(PG8_SB(1, 1), cB + hstep + kstep, voffB);
        PG8_WAIT_V(6); PG8_BAR;
    } else {
        PG8_STAGE(PG8_SB(0, 0), cB, voffB); PG8_STAGE(PG8_SA(0, 0), cA, voffA); PG8_STAGE(PG8_SB(0, 1), cB + hstep, voffB); PG8_STAGE(PG8_SA(0, 1), cA + hstep, voffA);
        if (wr == 1) PG8_BAR;
        PG8_WAIT_V(4); PG8_BAR;
        PG8_STAGE(PG8_SB(1, 0), cB + kstep, voffB); PG8_STAGE(PG8_SA(1, 0), cA + kstep, voffA); PG8_STAGE(PG8_SB(1, 1), cB + hstep + kstep, voffB);
        PG8_WAIT_V(6); PG8_BAR;
    }
    for (;;) {
        const bool has_next = S.next(ui + 1, nxt);
        const char* nA = has_next ? (const char*)g.A + (size_t)nxt.pm * tstep : cA; const char* nB = has_next ? (const char*)g.Bt + (size_t)nxt.pn * tstep : cB;
        for (int t = 0; t < nt; t += 2) {
            if constexpr (Epi::HAS_MID) { if (t == E.mid_t) E.mid(acc, cur, wr, wc, fr, fq); }
            const bool last = (t == nt - 2);
            const char* a1 = cA + (size_t)(t + 1) * kstep;
            const char* a2 = last ? nA : cA + (size_t)(t + 2) * kstep; const char* b2 = last ? nB : cB + (size_t)(t + 2) * kstep;
            const char* a3 = a2 + kstep; const char* b3 = b2 + kstep;
            if (last && has_next) S.a_ready(nxt);
            if constexpr (SP2) {
            PG8_LDB(B0, 0, 0); PG8_LDB(B1, 0, 1); PG8_SCHED; PG8_LDA(At, 0, 0); PG8_STAGE(PG8_SA(1, 1), a1 + hstep, voffA);
            PG8_WAIT_V(8); PG8_WAIT_L(0); PG8_BAR; PG8_MMA(0, 0, At, B0); PG8_MMA(0, 1, At, B1); PG8_BAR; PG8_SCHED;
            PG8_LDA(At, 0, 1); PG8_STAGE(PG8_SB(0, 0), b2, voffB); PG8_STAGE(PG8_SB(0, 1), b2 + hstep, voffB); PG8_STAGE(PG8_SA(0, 0), a2, voffA);
            PG8_WAIT_V(8); PG8_WAIT_L(0); PG8_BAR; PG8_MMA(1, 0, At, B0); PG8_MMA(1, 1, At, B1); PG8_BAR; PG8_SCHED;
            PG8_LDB(B0, 1, 0); PG8_LDB(B1, 1, 1); PG8_SCHED; PG8_LDA(At, 1, 0); PG8_STAGE(PG8_SA(0, 1), a2 + hstep, voffA);
            PG8_WAIT_V(8); PG8_WAIT_L(0); PG8_BAR; PG8_MMA(0, 0, At, B0); PG8_MMA(0, 1, At, B1); PG8_BAR; PG8_SCHED;
            PG8_LDA(At, 1, 1); PG8_STAGE(PG8_SB(1, 0), b3, voffB); PG8_STAGE(PG8_SB(1, 1), b3 + hstep, voffB); PG8_STAGE(PG8_SA(1, 0), a3, voffA);
            PG8_WAIT_V(8); PG8_WAIT_L(0); PG8_BAR; PG8_MMA(1, 0, At, B0); PG8_MMA(1, 1, At, B1); PG8_BAR; PG8_SCHED;
            } else {
            PG8_LDB(B0, 0, 0); PG8_SCHED; PG8_LDA(At, 0, 0); PG8_STAGE(PG8_SA(1, 1), a1 + hstep, voffA);
            PG8_WAIT_L(8); PG8_BAR; PG8_WAIT_L(0); PG8_MMA(0, 0, At, B0); PG8_BAR; PG8_SCHED;
            PG8_LDB(B1, 0, 1); PG8_STAGE(PG8_SB(0, 0), b2, voffB);
            PG8_BAR; PG8_WAIT_L(0); PG8_MMA(0, 1, At, B1); PG8_BAR;
            PG8_LDA(At, 0, 1); PG8_STAGE(PG8_SA(0, 0), a2, voffA);
            PG8_BAR; PG8_WAIT_L(0); PG8_MMA(1, 0, At, B0); PG8_BAR; PG8_SCHED;
            PG8_STAGE(PG8_SB(0, 1), b2 + hstep, voffB);
            PG8_WAIT_V(6); PG8_BAR; PG8_MMA(1, 1, At, B1); PG8_BAR;
            PG8_LDB(B0, 1, 0); PG8_SCHED; PG8_LDA(At, 1, 0); PG8_STAGE(PG8_SA(0, 1), a2 + hstep, voffA);
            PG8_WAIT_L(8); PG8_BAR; PG8_WAIT_L(0); PG8_MMA(0, 0, At, B0); PG8_BAR; PG8_SCHED;
            PG8_LDB(B1, 1, 1); PG8_STAGE(PG8_SB(1, 0), b3, voffB);
            PG8_BAR; PG8_WAIT_L(0); PG8_MMA(0, 1, At, B1); PG8_BAR;
            PG8_LDA(At, 1, 1); PG8_STAGE(PG8_SA(1, 0), a3, voffA);
            PG8_BAR; PG8_WAIT_L(0); PG8_MMA(1, 0, At, B0); PG8_BAR; PG8_SCHED;
            PG8_STAGE(PG8_SB(1, 1), b3 + hstep, voffB);
            PG8_WAIT_V(6); PG8_BAR; PG8_MMA(1, 1, At, B1); PG8_BAR;
            }
        }
        if constexpr (ALIGN_EPI) { if (wr == 0) PG8_BAR; }
        if constexpr (!Epi::AFTER_DRAIN) { E(acc, cur, wr, wc, fr, fq); S.done(cur); }
        if (!has_next) break;
#pragma unroll
        for (int a = 0; a < 2; ++a)
#pragma unroll
            for (int b = 0; b < 2; ++b)
#pragma unroll
                for (int m = 0; m < 4; ++m)
#pragma unroll
                    for (int n = 0; n < 2; ++n) acc[a][b][m][n] = (f32x4){0.f, 0.f, 0.f, 0.f};
        cur = nxt; cA = nA; cB = nB; ++ui;
        if constexpr (ALIGN_EPI) { if (wr == 1) PG8_BAR; }
    }
    PG8_WAIT_V(0);
    if constexpr (!ALIGN_EPI) { if (wr == 0) PG8_BAR; }
    PG8_BAR;
    if constexpr (Epi::AFTER_DRAIN) { E.fused(acc, cur, wr, wc, fr, fq, lds, wid, lane); S.done(cur); }
#undef PG8_SA
#undef PG8_SB
#undef PG8_STAGE
#undef PG8_LDA
#undef PG8_LDB
#undef PG8_MMA
#undef PG8_WAIT_V
#undef PG8_WAIT_L
#undef PG8_BAR
#undef PG8_SCHED
}
}

typedef __attribute__((address_space(1))) unsigned gu32;
#define RLX_AGENT __ATOMIC_RELAXED, __HIP_MEMORY_SCOPE_AGENT
#define XB_TMO      128
#define XB_XCNT(j)  (256  + 64 * (j))
#define XB_XSUB(j)  (1280 + 64 * (j))
#define XB_XGEN(j)  (2304 + 64 * (j))
#define XB_TOP      3328
#define XB_TOPGEN   3392
#define XCD_BAR_WORDS 3456
#define XB_SPIN_CAP (1u << 18)

__device__ __forceinline__ unsigned xb_ld(unsigned* p)              { return __hip_atomic_load(p, __ATOMIC_RELAXED, __HIP_MEMORY_SCOPE_AGENT); }
__device__ __forceinline__ unsigned xb_add(unsigned* p, unsigned v) { return __hip_atomic_fetch_add(p, v, __ATOMIC_RELAXED, __HIP_MEMORY_SCOPE_AGENT); }
__device__ __forceinline__ unsigned xb_xcc_id() { return (unsigned)__builtin_amdgcn_s_getreg((3 << 11) | 20) & 0xFu; }
#define XB_SPIN(cond, bar) do { unsigned _sp = 0; while (cond) { __builtin_amdgcn_s_sleep(1); \
    if ((++_sp & 255u) == 0u) { if (xb_ld(&(bar)[XB_TMO])) break; if (_sp > XB_SPIN_CAP) { atomicAdd(&(bar)[XB_TMO], 1u); break; } } } } while (0)

struct XcdBarrier {
    unsigned* bar; unsigned x;
    volatile LAS unsigned* st;
};

__device__ __forceinline__ XcdBarrier xcd_barrier_post(unsigned* bar, volatile LAS unsigned* st, bool leader) {
    XcdBarrier b; b.bar = bar; b.x = xb_xcc_id(); b.st = st;
    if (leader) (void)xb_add(&bar[XB_XCNT(b.x)], 1u);
    return b;
}
__device__ __forceinline__ void xcd_barrier_complete(unsigned* bar, unsigned x, unsigned& nloc, unsigned& nx) {
    const unsigned G = gridDim.x * gridDim.y * gridDim.z;
    unsigned sum, cnt, mine, sp = 0u;
    for (;;) {
        sum = 0u; cnt = 0u; mine = 0u;
#pragma unroll
        for (unsigned j = 0; j < 16; ++j) { const unsigned c = xb_ld(&bar[XB_XCNT(j)]); sum += c; cnt += (c > 0u) ? 1u : 0u; mine = (j == x) ? c : mine; }
        if (sum == G) break;
        __builtin_amdgcn_s_sleep(1);
        if ((++sp & 255u) == 0u) { if (xb_ld(&bar[XB_TMO])) break; if (sp > XB_SPIN_CAP) { atomicAdd(&bar[XB_TMO], 1u); break; } }
    }
    nloc = mine > 0u ? mine : 1u; nx = cnt > 0u ? cnt : 1u;
}

__device__ __forceinline__ void xcd_barrier(const XcdBarrier& b, bool leader) {
    asm volatile("s_waitcnt vmcnt(0)" ::: "memory");
    __syncthreads();
    if (leader) {
        unsigned* bar = b.bar;
        __builtin_amdgcn_s_waitcnt(0);
        unsigned nloc = b.st[0], nx = b.st[1];
        if (nloc == 0u) { xcd_barrier_complete(bar, b.x, nloc, nx); b.st[0] = nloc; b.st[1] = nx; }
        const unsigned old = xb_add(&bar[XB_XSUB(b.x)], 1u);
        const unsigned gen = old / nloc;
        if (old + 1u == (gen + 1u) * nloc) {
            __builtin_amdgcn_fence(__ATOMIC_RELEASE, "agent");
            asm volatile("s_waitcnt vmcnt(0)" ::: "memory");
            const unsigned og = xb_add(&bar[XB_TOP], 1u);
            const unsigned tg = og / nx;
            if (og + 1u == (tg + 1u) * nx) xb_add(&bar[XB_TOPGEN], 1u);
            else XB_SPIN(xb_ld(&bar[XB_TOPGEN]) == tg, bar);
            __builtin_amdgcn_fence(__ATOMIC_ACQUIRE, "agent");
            xb_add(&bar[XB_XGEN(b.x)], 1u);
            asm volatile("s_waitcnt vmcnt(0)" ::: "memory");
        } else {
            XB_SPIN(xb_ld(&bar[XB_XGEN(b.x)]) == gen, bar);
            __builtin_amdgcn_fence(__ATOMIC_ACQUIRE, "agent");
            asm volatile("s_waitcnt vmcnt(0)" ::: "memory");
        }
    }
    __syncthreads();
}

#define DI __device__ __forceinline__

typedef unsigned short bf16_t;
typedef short bf16x8 __attribute__((ext_vector_type(8)));
typedef short bf16x4 __attribute__((ext_vector_type(4)));
typedef float f32x2 __attribute__((ext_vector_type(2)));
typedef float f32x4 __attribute__((ext_vector_type(4)));
typedef float f32x16 __attribute__((ext_vector_type(16)));
typedef unsigned u32x2 __attribute__((ext_vector_type(2)));
typedef unsigned u32x4 __attribute__((ext_vector_type(4)));
typedef __bf16 hwbf16x2 __attribute__((ext_vector_type(2)));

constexpr int DM = 1024, NB = 4, SEQ = 8192, DB = 32, DS = 8;
constexpr int MP = NB * SEQ;
constexpr int MS = DB * DS;
constexpr int MT = MP + MS;
constexpr int NIN_SRC = 9744, NIN = 9984;
constexpr int DFF = 2816;
constexpr float EPS = 1e-6f;
constexpr float LOG2E = 1.4426950408889634f;
constexpr float QA_SCALE = 0.08838834764831845f * LOG2E;
constexpr float QB_SCALE = 0.08838834764831845f;
constexpr float Q2_SCALE = 0.0625f * LOG2E;

constexpr size_t O_Y = 0, O_W1P = 33816576, O_W2P = 34340864, O_W3P = 36438016, O_GLAP = 44826624, O_MEMP = 45350912,
                 O_W1S = 47448064, O_W2S = 47710208, O_W3S = 47972352, O_GLAS = 48234496, O_TOTAL = 52428800;

constexpr size_t MiB = 1u << 20;
constexpr size_t WS_CTL = 0, WS_WIN = 1 * MiB, WS_WMKV = 21 * MiB, WS_WPA = 25 * MiB, WS_WPB = 26 * MiB, WS_WOUT = 28 * MiB, WS_WMQ = 30 * MiB,
                 WS_WMO = 32 * MiB, WS_WGU = 34 * MiB, WS_WDN = 45 * MiB, WS_XB = 51 * MiB, WS_MEMB = 116 * MiB, WS_RS = 118 * MiB, WS_SSQ = 119 * MiB,
                 WS_FB = 122 * MiB, WS_MK = 125 * MiB, WS_MVT = 127 * MiB, WS_LSE = 129 * MiB, WS_QA = 131 * MiB, WS_KA = 228 * MiB, WS_VA = 325 * MiB,
                 WS_QB = 422 * MiB, WS_KB = 455 * MiB, WS_VB = 488 * MiB, WS_SGB = 553 * MiB, WS_SGA = 618 * MiB, WS_SGBT = 683 * MiB, WS_OAG = 748 * MiB,
                 WS_YAIN = 845 * MiB, WS_OBN = 878 * MiB, WS_END = 943 * MiB;
constexpr size_t WS_TMP = 131 * MiB, WS_MIXIN = 196 * MiB, WS_MIX = 261 * MiB, WS_Q2 = 326 * MiB, WS_O2 = 391 * MiB, WS_H = 488 * MiB;
constexpr size_t WS_RSMEM = WS_RS + 512 * 1024;
static_assert(WS_WIN + (size_t)NIN * 1024 * 2 <= WS_WMKV && WS_WDN + (size_t)1024 * DFF * 2 <= WS_XB && WS_XB + (size_t)MT * 1024 * 2 <= WS_MEMB, "ws map 1");
static_assert(WS_QA + (size_t)MT * 1536 * 2 <= WS_KA && WS_QB + (size_t)MT * 512 * 2 <= WS_KB && WS_VB + (size_t)MT * 1024 * 2 <= WS_SGB, "ws map 2");
static_assert(WS_OAG + (size_t)3 * MT * 512 * 2 <= WS_YAIN && WS_YAIN + (size_t)MT * 512 * 2 <= WS_OBN && WS_OBN + (size_t)MT * 1024 * 2 <= WS_END, "ws map 3");
static_assert(WS_H + (size_t)MT * DFF * 2 <= WS_OAG && WS_O2 + (size_t)MT * 1024 * 2 <= WS_VB && WS_SSQ + (size_t)MT * 16 * 4 <= WS_FB && WS_LSE + (size_t)MT * 12 * 4 <= WS_QA, "ws map 4");

constexpr int LDS_BYTES = 147456;
constexpr int NTHREADS = 512;

DI unsigned pk2(float lo, float hi) { f32x2 v = {lo, hi}; hwbf16x2 b = __builtin_convertvector(v, hwbf16x2); return __builtin_bit_cast(unsigned, b); }
DI float bflo(unsigned w) { return __uint_as_float(w << 16); }
DI float bfhi(unsigned w) { return __uint_as_float(w & 0xffff0000u); }
DI float bf1(bf16_t h) { return __uint_as_float((unsigned)h << 16); }
DI bf16_t f2bf(float f) { return (bf16_t)(pk2(f, 0.f) & 0xffffu); }
template <int CTRL, int ROW_MASK> DI float dpp_f(float v) {
    return __builtin_bit_cast(float, __builtin_amdgcn_update_dpp(0, __builtin_bit_cast(int, v), CTRL, ROW_MASK, 0xf, false));
}
DI float wave_sum(float v) {
    v += dpp_f<0xB1, 0xf>(v);
    v += dpp_f<0x4E, 0xf>(v);
    v += dpp_f<0x141, 0xf>(v);
    v += dpp_f<0x140, 0xf>(v);
    v += dpp_f<0x142, 0xa>(v);
    v += dpp_f<0x143, 0xc>(v);
    return __builtin_bit_cast(float, __builtin_amdgcn_ds_bpermute(63 * 4, __builtin_bit_cast(int, v)));
}
template <int CTRL, int ROW_MASK> DI float dpp_keep(float v) {
    return __builtin_bit_cast(float, __builtin_amdgcn_update_dpp(__builtin_bit_cast(int, v), __builtin_bit_cast(int, v), CTRL, ROW_MASK, 0xf, false));
}
DI float wave_max(float v) {
    v = fmaxf(v, dpp_keep<0xB1, 0xf>(v));
    v = fmaxf(v, dpp_keep<0x4E, 0xf>(v));
    v = fmaxf(v, dpp_keep<0x141, 0xf>(v));
    v = fmaxf(v, dpp_keep<0x140, 0xf>(v));
    v = fmaxf(v, dpp_keep<0x142, 0xa>(v));
    v = fmaxf(v, dpp_keep<0x143, 0xc>(v));
    return __builtin_bit_cast(float, __builtin_amdgcn_readlane(__builtin_bit_cast(int, v), 63));
}
DI float fsigmoid(float x) { return __builtin_amdgcn_rcpf(1.f + __expf(-x)); }
#define LDS_WAIT() asm volatile("s_waitcnt lgkmcnt(0)" ::: "memory")
#define LDS_BARRIER() do { asm volatile("s_waitcnt lgkmcnt(0)" ::: "memory"); __builtin_amdgcn_s_barrier(); asm volatile("" ::: "memory"); } while (0)
#define MFMA32(a, b, c) __builtin_amdgcn_mfma_f32_32x32x16_bf16((a), (b), (c), 0, 0, 0)
DI int crow(int reg, int h) { return (reg & 3) + 8 * (reg >> 2) + 4 * h; }
DI bf16x8 pack_step(const f32x16& x, int s) {
    u32x4 p;
    p[0] = pk2(x[8 * s + 0], x[8 * s + 1]); p[1] = pk2(x[8 * s + 2], x[8 * s + 3]); p[2] = pk2(x[8 * s + 4], x[8 * s + 5]); p[3] = pk2(x[8 * s + 6], x[8 * s + 7]);
    return __builtin_bit_cast(bf16x8, p);
}
DI bf16x8 cat8(u32x2 lo, u32x2 hi) { u32x4 p; p[0] = lo[0]; p[1] = lo[1]; p[2] = hi[0]; p[3] = hi[1]; return __builtin_bit_cast(bf16x8, p); }

struct Args {
    const float* in[30];
    float* out;
    unsigned char* ws;
    int ph_lo, ph_hi;
};

struct Ctx {
    const float* const* in;
    float* out; unsigned char* ws;
    LAS unsigned char* lds;
    int wave, G, bid;
};
DI int lane_id() { return __builtin_amdgcn_mbcnt_hi(~0u, __builtin_amdgcn_mbcnt_lo(~0u, 0u)); }
DI int lane_id_here() { int l = lane_id(); asm volatile("" : "+v"(l)); return l; }

DI void p0_transpose_item(const float* __restrict__ W, int ldw, int src_col0, int nvalid, const float* __restrict__ gain,
                          bf16_t* __restrict__ WT, int K, int dst_row0, int kb, LAS float* scr, int lane, int kofs = 0) {
    const int k0 = 64 * kb;
    {
        const int kr = lane >> 3, n4 = 4 * (lane & 7);
        f32x4 v[8];
        if (nvalid > 0) {
            const float* wp = W + (size_t)(k0 + kr) * ldw + src_col0 + (n4 < nvalid ? n4 : 0);
#pragma unroll
            for (int i = 0; i < 8; ++i) v[i] = __builtin_nontemporal_load((const f32x4*)(wp + (size_t)(8 * i) * ldw));
        }
#pragma unroll
        for (int i = 0; i < 8; ++i) {
            const int kk = kr + 8 * i;
            f32x4 t = (nvalid > 0 && n4 < nvalid) ? v[i] : (f32x4){0.f, 0.f, 0.f, 0.f};
            if (gain) t = t * gain[k0 + kk];
            LAS float* d = scr + kk * 33 + n4;
            d[0] = t[0]; d[1] = t[1]; d[2] = t[2]; d[3] = t[3];
        }
    }
    LDS_WAIT(); asm volatile("" ::: "memory");
    const int c = lane & 7;
#pragma unroll
    for (int j = 0; j < 4; ++j) {
        const int n = (lane >> 3) + 8 * j; const LAS float* s = scr + (8 * c) * 33 + n;
        u32x4 o; o.x = pk2(s[0 * 33], s[1 * 33]); o.y = pk2(s[2 * 33], s[3 * 33]); o.z = pk2(s[4 * 33], s[5 * 33]); o.w = pk2(s[6 * 33], s[7 * 33]);
        *(u32x4*)(WT + (size_t)(dst_row0 + n) * K + kofs + k0 + 8 * c) = o;
    }
    LDS_WAIT(); asm volatile("" ::: "memory");
}
template <int NR> DI void p0_rows(const float* const (&xrow)[NR], bf16_t* const (&orow)[NR], float* const (&rs_out)[NR], int lane) {
    f32x4 v[NR][4];
#pragma unroll
    for (int q = 0; q < NR; ++q)
#pragma unroll
        for (int j = 0; j < 4; ++j) v[q][j] = __builtin_nontemporal_load((const f32x4*)xrow[q] + lane + 64 * j);
#pragma unroll
    for (int q = 0; q < NR; ++q) {
        float s = 0.f;
#pragma unroll
        for (int j = 0; j < 4; ++j) s += (v[q][j].x * v[q][j].x + v[q][j].y * v[q][j].y) + (v[q][j].z * v[q][j].z + v[q][j].w * v[q][j].w);
        s = wave_sum(s);
        const float r = rsqrtf(s * (1.f / 1024.f) + EPS);
        u32x2* o8 = (u32x2*)orow[q] + lane;
#pragma unroll
        for (int j = 0; j < 4; ++j) { u32x2 w; w.x = pk2(v[q][j].x * r, v[q][j].y * r); w.y = pk2(v[q][j].z * r, v[q][j].w * r); o8[64 * j] = w; }
        if (lane == 0) *rs_out[q] = r;
    }
}
DI void p0_prologue(const Ctx& C) {
    const int lane = lane_id();
    LAS float* scr = (LAS float*)(C.lds + C.wave * 16384);
    const int gw = C.bid * 8 + C.wave, NGW = C.G * 8;
    const float* const* in = C.in;
    unsigned char* ws = C.ws;
    constexpr int I_IN = 16 * 312, I_MK = 16 * 32, I_PA = 8 * 32, I_SQ = 16 * 32, I_GU = 16 * 176, I_DN = 44 * 32;
    constexpr int NITEMS = I_IN + 2 * I_MK + I_PA + 4 * I_SQ + I_GU + I_DN;
    for (int it = gw; it < NITEMS; it += NGW) {
        int r = it;
        if (r < I_IN) {
            const int G = r % 312, kb = r / 312; int src, nv;
            if (G < 240) { src = 32 * G; nv = 32; } else if (G < 304) { src = 7696 + 32 * (G - 240); nv = 32; } else if (G == 304) { src = 7680; nv = 16; } else { src = 0; nv = 0; }
            p0_transpose_item(in[11], NIN_SRC, src, nv, in[9], (bf16_t*)(ws + WS_WIN), 1024, 32 * G, kb, scr, lane); continue; }
        r -= I_IN;
        if (r < I_MK) { p0_transpose_item(in[19], 1024, 32 * (r % 32), 32, in[18], (bf16_t*)(ws + WS_WMKV), 1024, 32 * (r % 32), r / 32, scr, lane); continue; } r -= I_MK;
        if (r < I_MK) { p0_transpose_item(in[20], 1024, 32 * (r % 32), 32, in[18], (bf16_t*)(ws + WS_WMKV), 1024, 1024 + 32 * (r % 32), r / 32, scr, lane); continue; } r -= I_MK;
        if (r < I_PA) { p0_transpose_item(in[15], 1024, 32 * (r % 32), 32, nullptr, (bf16_t*)(ws + WS_WPA), 1536, 32 * (r % 32), r / 32, scr, lane, 0); continue; } r -= I_PA;
        if (r < I_SQ) { p0_transpose_item(in[16], 1024, 32 * (r % 32), 32, nullptr, (bf16_t*)(ws + WS_WPA), 1536, 32 * (r % 32), r / 32, scr, lane, 512); continue; } r -= I_SQ;
        if (r < I_SQ) { p0_transpose_item(in[17], 1024, 32 * (r % 32), 32, nullptr, (bf16_t*)(ws + WS_WOUT), 1024, 32 * (r % 32), r / 32, scr, lane); continue; } r -= I_SQ;
        if (r < I_SQ) { p0_transpose_item(in[23], 1024, 32 * (r % 32), 32, in[21], (bf16_t*)(ws + WS_WMQ), 1024, 32 * (r % 32), r / 32, scr, lane); continue; } r -= I_SQ;
        if (r < I_SQ) { p0_transpose_item(in[24], 1024, 32 * (r % 32), 32, nullptr, (bf16_t*)(ws + WS_WMO), 1024, 32 * (r % 32), r / 32, scr, lane); continue; } r -= I_SQ;
        if (r < I_GU) {
            const int G = r % 176, kb = r / 176, j = G >> 3, sub = G & 7;
            const float* W = sub < 4 ? in[27] : in[28];
            p0_transpose_item(W, DFF, 128 * j + 32 * (sub & 3), 32, in[25], (bf16_t*)(ws + WS_WGU), 1024, 32 * G, kb, scr, lane); continue; }
        r -= I_GU;
        p0_transpose_item(in[29], 1024, 32 * (r % 32), 32, nullptr, (bf16_t*)(ws + WS_WDN), DFF, 32 * (r % 32), r / 32, scr, lane);
    }
    bf16_t* XB = (bf16_t*)(ws + WS_XB); float* RS = (float*)(ws + WS_RS);
    for (int m = gw; m < MT; m += 4 * NGW) {
        if (m + 3 * NGW < MT) {
            const float* src[4]; bf16_t* dst[4]; float* rsp[4];
#pragma unroll
            for (int q = 0; q < 4; ++q) { const int mm = m + q * NGW; src[q] = mm < MP ? in[0] + (size_t)mm * 1024 : in[1] + (size_t)(mm - MP) * 1024; dst[q] = XB + (size_t)mm * 1024; rsp[q] = RS + mm; }
            p0_rows<4>(src, dst, rsp, lane);
        } else {
            for (int mm = m; mm < MT; mm += NGW) {
                const float* src[1] = {mm < MP ? in[0] + (size_t)mm * 1024 : in[1] + (size_t)(mm - MP) * 1024}; bf16_t* dst[1] = {XB + (size_t)mm * 1024}; float* rsp[1] = {RS + mm};
                p0_rows<1>(src, dst, rsp, lane);
            }
        }
    }
    bf16_t* MEMB = (bf16_t*)(ws + WS_MEMB); float* RSM = (float*)(ws + WS_RSMEM);
    for (int m = gw; m < 1024; m += NGW) { const float* src[1] = {in[7] + (size_t)m * 1024}; bf16_t* dst[1] = {MEMB + (size_t)m * 1024}; float* rsp[1] = {RSM + m}; p0_rows<1>(src, dst, rsp, lane); }
}

DI void st_bf16x8(bf16_t* p, f32x4 v0, f32x4 v1) {
    u32x4 w; w.x = pk2(v0[0], v0[1]); w.y = pk2(v0[2], v0[3]); w.z = pk2(v1[0], v1[1]); w.w = pk2(v1[2], v1[3]);
    *(u32x4*)p = w;
}
DI void st_rowpair(bf16_t* row_base, int k, u32x2 a, u32x2 b, int hh) {
    const auto r0 = __builtin_amdgcn_permlane32_swap(a.x, b.x, false, false);
    const auto r1 = __builtin_amdgcn_permlane32_swap(a.y, b.y, false, false);
    u32x4 w; w.x = r0[0]; w.y = r1[0]; w.z = r0[1]; w.w = r1[1];
    *(u32x4*)(row_base + 8 * k + 8 * hh) = w;
}
DI void st_bf16x8_nt(bf16_t* p, f32x4 v0, f32x4 v1) {
    u32x4 w; w.x = pk2(v0[0], v0[1]); w.y = pk2(v0[2], v0[3]); w.z = pk2(v1[0], v1[1]); w.w = pk2(v1[2], v1[3]);
    __builtin_nontemporal_store(w, (u32x4*)p);
}
DI int attn_prow(int row, int g) {
    if (row >= MP) return row;
    const int t = row & 8191, sh = 2 * g;
    return (row & ~8191) + ((t & ((1 << sh) - 1)) << (13 - sh)) + (t >> sh);
}
struct EpiIn {
    static constexpr bool PERM = true, AFTER_DRAIN = false, HAS_MID = false;
    const float* rs; unsigned char* ws; float* out;
    DI void operator()(const f32x4 (&acc)[2][2][4][2], const pg8::Unit& u, int wr, int wc, int fr, int fq) const {
        const int pn = u.pn, rbase = u.pm * 256 + wr * 64 + fr, cl = wc * 32 + 8 * fq;
        if (pn == 38) {
            if (wc == 0 && fq < 2) {
                float* FB = (float*)(ws + WS_FB);
#pragma unroll
                for (int ai = 0; ai < 2; ++ai)
#pragma unroll
                    for (int m = 0; m < 4; ++m) { const int row = rbase + ai * 128 + m * 16;
                        *(f32x4*)(FB + (size_t)row * 16 + 8 * fq) = acc[ai][0][m][0]; *(f32x4*)(FB + (size_t)row * 16 + 8 * fq + 4) = acc[ai][0][m][1]; }
            }
            return;
        }
        bf16_t* dst; int ldc, cbase; float sc = 1.f; int act = 0;
        int perm_g = -1;
        if (pn < 6)       { perm_g = pn >> 1; dst = (bf16_t*)(ws + WS_QA) + (size_t)(4 * perm_g + 2 * (pn & 1)) * MT * 128; ldc = 128; cbase = 0; sc = QA_SCALE; }
        else if (pn < 12) { perm_g = (pn - 6) >> 1; dst = (bf16_t*)(ws + WS_KA) + (size_t)(4 * perm_g + 2 * (pn & 1)) * MT * 128; ldc = 128; cbase = 0; }
        else if (pn < 18) { perm_g = (pn - 12) >> 1; dst = (bf16_t*)(ws + WS_VA) + (size_t)(4 * perm_g + 2 * (pn & 1)) * MT * 128; ldc = 128; cbase = 0; }
        else if (pn < 20) { dst = (bf16_t*)(ws + WS_QB); ldc = 512; cbase = (pn - 18) * 256; sc = QB_SCALE; }
        else if (pn < 22) { dst = (bf16_t*)(ws + WS_KB); ldc = 512; cbase = (pn - 20) * 256; }
        else if (pn < 26) { dst = (bf16_t*)(ws + WS_VB); ldc = 1024; cbase = (pn - 22) * 256; }
        else if (pn < 30) { dst = (bf16_t*)(ws + WS_SGB); ldc = 1024; cbase = (pn - 26) * 256; act = 1; }
        else if (pn < 34) { dst = (bf16_t*)(ws + WS_SGA); ldc = 1024; cbase = (pn - 30) * 256; act = 2; }
        else              { dst = (bf16_t*)(ws + WS_SGBT); ldc = 1024; cbase = (pn - 34) * 256; act = 2; }
        const bool iskv = (pn >= 6 && pn < 18);
        const bool maywin = iskv && (u.pm == 128 || (u.pm & 31) >= 24);
        const int kv = pn >= 12 ? 1 : 0, pc = (pn - 6) % 6, g = pc >> 1, cg0 = (pc & 1) * 256, keep = 128 << (2 * g);
        const size_t offp = g == 0 ? O_W1P : (g == 1 ? O_W2P : O_W3P), offs = g == 0 ? O_W1S : (g == 1 ? O_W2S : O_W3S);
#pragma unroll
        for (int ai = 0; ai < 2; ++ai)
#pragma unroll
            for (int m = 0; m < 4; ++m) {
                const int row = rbase + ai * 128 + m * 16;
                bf16_t* rowp = dst + (size_t)(perm_g >= 0 ? attn_prow(row, perm_g) : row) * ldc + cbase + cl;
                float* wp = nullptr;
                if (maywin) {
                    if (row >= MP) wp = out + offs + ((size_t)(row - MP) * 2 + kv) * 512 + cg0 + cl;
                    else { const int b = row >> 13, t = row & 8191; if (t >= SEQ - keep) wp = out + offp + ((size_t)(b * keep + t - (SEQ - keep)) * 2 + kv) * 512 + cg0 + cl; }
                }
#pragma unroll
                for (int bj = 0; bj < 2; ++bj) {
                    f32x4 v0 = acc[ai][bj][m][0], v1 = acc[ai][bj][m][1];
                    if (wp) { *(f32x4*)(wp + bj * 128) = v0; *(f32x4*)(wp + bj * 128 + 4) = v1; }
                    if (act) {
#pragma unroll
                        for (int i = 0; i < 4; ++i) { const float s0 = fsigmoid(v0[i]), s1 = fsigmoid(v1[i]); v0[i] = act == 1 ? v0[i] * s0 : s0; v1[i] = act == 1 ? v1[i] * s1 : s1; }
                    }
                    st_bf16x8_nt(rowp + (perm_g >= 0 ? (size_t)bj * MT * 128 : (size_t)bj * 128), v0 * sc, v1 * sc);
                }
            }
    }
};
struct EpiMemKV {
    static constexpr bool PERM = true, AFTER_DRAIN = false, HAS_MID = false;
    const float* rs; unsigned char* ws; float* out;
    DI void operator()(const f32x4 (&acc)[2][2][4][2], const pg8::Unit& u, int wr, int wc, int fr, int fq) const {
        const int pn = u.pn, rbase = u.pm * 256 + wr * 64 + fr, cl = wc * 32 + 8 * fq, kv = pn >> 2, c0 = (pn & 3) * 256 + cl;
        bf16_t* MK = (bf16_t*)(ws + WS_MK); bf16_t* MVT = (bf16_t*)(ws + WS_MVT);
#pragma unroll
        for (int ai = 0; ai < 2; ++ai)
#pragma unroll
            for (int m = 0; m < 4; ++m) {
                const int row = rbase + ai * 128 + m * 16;
                float* op = out + O_MEMP + ((size_t)row * 2 + kv) * 1024 + c0;
#pragma unroll
                for (int bj = 0; bj < 2; ++bj) {
                    const f32x4 v0 = acc[ai][bj][m][0], v1 = acc[ai][bj][m][1];
                    *(f32x4*)(op + bj * 128) = v0; *(f32x4*)(op + bj * 128 + 4) = v1;
                    if (kv == 0) st_bf16x8(MK + (size_t)row * 1024 + c0 + bj * 128, v0, v1);
                    else {
                        bf16_t* vp = MVT + ((size_t)(row >> 8) * 1024 + c0 + bj * 128) * 256 + (row & 255);
#pragma unroll
                        for (int i = 0; i < 4; ++i) { vp[(size_t)i * 256] = f2bf(v0[i]); vp[(size_t)(i + 4) * 256] = f2bf(v1[i]); }
                    }
                }
            }
    }
};

struct EpiNull {
    static constexpr bool PERM = true, AFTER_DRAIN = false, HAS_MID = false;
    float* sink;
    DI void operator()(const f32x4 (&acc)[2][2][4][2], const pg8::Unit& u, int wr, int wc, int fr, int fq) const {
        float s = 0.f;
#pragma unroll
        for (int ai = 0; ai < 2; ++ai)
#pragma unroll
            for (int bj = 0; bj < 2; ++bj)
#pragma unroll
                for (int m = 0; m < 4; ++m)
#pragma unroll
                    for (int n = 0; n < 2; ++n) s += acc[ai][bj][m][n][0] + acc[ai][bj][m][n][1] + acc[ai][bj][m][n][2] + acc[ai][bj][m][n][3];
        if (fr == 0 && fq == 0) sink[(u.pm * 64 + u.pn) * 8 + wr * 4 + wc] = s;
    }
};

constexpr int GL_QP = 0, GL_KP = 17408, GL_KPT = 34816, GL_VT = 53248, GL_OT = 90112, GL_FB = 123904, GL_PFX = 128000, GL_EBL = 136192,
              GL_WF2 = 136704, GL_BF2 = 144896, GL_GN = 145408, GL_END = 146432;
constexpr int QP_PITCH = 272, KT_PITCH = 144, OT_PITCH = 528;
static_assert(GL_END <= LDS_BYTES, "gla lds");

DI float logsig16(float z) {
    const float a = fabsf(z);
    return (fminf(z, 0.f) - __logf(1.f + __expf(-a))) * 0.0625f;
}

constexpr int GL_XF = GL_OT;
constexpr size_t WS_OIG = WS_XB, WS_DSG = 943 * MiB, WS_QPG = 959 * MiB, WS_EBLG = 991 * MiB, WS_END2 = 992 * MiB;
static_assert(WS_OIG + (size_t)2048 * 32768 <= WS_MEMB && WS_DSG >= WS_END && WS_DSG + (size_t)256 * 65536 <= WS_QPG && WS_QPG + (size_t)2048 * 16384 <= WS_EBLG && WS_EBLG + MiB <= WS_END2, "gla ws map");

DI void gla_load_consts(const Ctx& C, int h, int tid) {
    LAS unsigned char* lds = C.lds;
    const float* wf2 = C.in[12]; const float* bf2 = C.in[13]; const float* gn = C.in[14];
    LAS float* WF = (LAS float*)(lds + GL_WF2);
    for (int i = tid; i < 16 * 128; i += NTHREADS) WF[i] = wf2[(size_t)(i >> 7) * 512 + h * 128 + (i & 127)];
    if (tid < 128) ((LAS float*)(lds + GL_BF2))[tid] = bf2[h * 128 + tid];
    if (tid < 256) ((LAS float*)(lds + GL_GN))[tid] = gn[tid];
}

constexpr int NSUB = 8, NUNIT = 16 * (128 / NSUB);
constexpr int GL_CUM = GL_GN;
DI void gla_pass_a_unit(const Ctx& C, int unit) {
    LAS unsigned char* lds = C.lds;
    const int lane = lane_id_here(), w = C.wave, tid = w * 64 + lane, r = lane & 31, hh = lane >> 5;
    const int bh = unit / (128 / NSUB), sc = unit % (128 / NSUB), b = bh >> 2, h = bh & 3;
    unsigned char* ws = C.ws;
    const bf16_t* QB = (const bf16_t*)(ws + WS_QB); const bf16_t* KB = (const bf16_t*)(ws + WS_KB); const bf16_t* VB = (const bf16_t*)(ws + WS_VB);
    const float* FB = (const float*)(ws + WS_FB);
    const size_t tok0 = (size_t)b * SEQ + (size_t)sc * NSUB * 64;
    const int cg = tid & 31, rg = tid >> 5;
    u32x2 q4[4], k4[4]; u32x4 vreg[4]; f32x4 fbreg = {0.f, 0.f, 0.f, 0.f};
#define GLA_ISSUE_LOADS(jn) do { const size_t t0_ = tok0 + (size_t)(jn) * 64; \
        _Pragma("unroll") for (int i = 0; i < 4; ++i) { \
            q4[i] = *(const u32x2*)(QB + (t0_ + 4 * rg + i) * 512 + h * 128 + 4 * cg); \
            k4[i] = *(const u32x2*)(KB + (t0_ + 4 * rg + i) * 512 + h * 128 + 4 * cg); \
            vreg[i] = *(const u32x4*)(VB + (t0_ + lane) * 1024 + h * 256 + 32 * w + 8 * i); } \
        if (tid < 256) fbreg = *(const f32x4*)(FB + t0_ * 16 + tid * 4); } while (0)
    GLA_ISSUE_LOADS(0);
    LDS_BARRIER();
    gla_load_consts(C, h, tid);
    if (tid < 128) ((LAS float*)(lds + GL_CUM))[tid] = 1.f;
    f32x16 S[4];
#pragma unroll
    for (int i = 0; i < 4; ++i)
#pragma unroll
        for (int j = 0; j < 16; ++j) S[i][j] = 0.f;
    for (int jc = 0; jc < NSUB; ++jc) {
        const size_t cunit = (size_t)bh * 128 + sc * NSUB + jc;
        if (tid < 256) *(LAS f32x4*)(lds + GL_FB + tid * 16) = fbreg;
        {
            LAS bf16_t* VT = (LAS bf16_t*)(lds + GL_VT);
#pragma unroll
            for (int i = 0; i < 4; ++i)
#pragma unroll
                for (int j = 0; j < 4; ++j) {
                    const unsigned wv = vreg[i][j]; const int e = 32 * w + 8 * i + 2 * j;
                    VT[e * (KT_PITCH / 2) + lane] = (bf16_t)(wv & 0xffffu); VT[(e + 1) * (KT_PITCH / 2) + lane] = (bf16_t)(wv >> 16);
                }
        }
        LDS_BARRIER();
        float bl[4][4];
        {
            const LAS float* WF = (const LAS float*)(lds + GL_WF2); const LAS float* FBs = (const LAS float*)(lds + GL_FB);
            const f32x4 bb = *(const LAS f32x4*)(lds + GL_BF2 + 16 * cg);
            f32x4 z[4] = {bb, bb, bb, bb};
#pragma unroll
            for (int j4 = 0; j4 < 4; ++j4) {
                f32x4 f[4];
#pragma unroll
                for (int i = 0; i < 4; ++i) f[i] = *(const LAS f32x4*)(FBs + (4 * rg + i) * 16 + 4 * j4);
#pragma unroll
                for (int jj = 0; jj < 4; ++jj) {
                    const f32x4 wv = *(const LAS f32x4*)(WF + (4 * j4 + jj) * 128 + 4 * cg);
#pragma unroll
                    for (int i = 0; i < 4; ++i) z[i] += wv * f[i][jj];
                }
            }
#pragma unroll
            for (int c = 0; c < 4; ++c) {
                float run = 0.f;
#pragma unroll
                for (int i = 0; i < 4; ++i) { run += logsig16(z[i][c]); bl[i][c] = run; }
            }
            *(LAS f32x4*)(lds + GL_PFX + (rg * 128 + 4 * cg) * 4) = (f32x4){bl[3][0], bl[3][1], bl[3][2], bl[3][3]};
        }
        LDS_BARRIER();
        f32x4 ebnew = {1.f, 1.f, 1.f, 1.f};
        {
            f32x4 pre = {0.f, 0.f, 0.f, 0.f}, tot = {0.f, 0.f, 0.f, 0.f};
#pragma unroll
            for (int g = 0; g < 16; ++g) { const f32x4 p = *(const LAS f32x4*)(lds + GL_PFX + (g * 128 + 4 * cg) * 4); tot += p; if (g < rg) pre += p; }
            const f32x4 cum = *(const LAS f32x4*)(lds + GL_CUM + 16 * cg);
            ebnew = (f32x4){__expf(tot[0]), __expf(tot[1]), __expf(tot[2]), __expf(tot[3])};
            if (rg == 0) *(LAS f32x4*)(lds + GL_EBL + 16 * cg) = ebnew;
            float kq[4][4];
            bf16_t* QPG = (bf16_t*)(ws + WS_QPG) + cunit * 8192;
#pragma unroll
            for (int i = 0; i < 4; ++i) {
                float qv[4] = {bflo(q4[i][0]), bfhi(q4[i][0]), bflo(q4[i][1]), bfhi(q4[i][1])};
                float kv[4] = {bflo(k4[i][0]), bfhi(k4[i][0]), bflo(k4[i][1]), bfhi(k4[i][1])};
                float qo[4];
#pragma unroll
                for (int c = 0; c < 4; ++c) { const float bv = pre[c] + bl[i][c]; const float e = __expf(bv); qo[c] = qv[c] * e; kq[i][c] = kv[c] * __builtin_amdgcn_rcpf(e); }
                u32x2 wq; wq.x = pk2(qo[0], qo[1]); wq.y = pk2(qo[2], qo[3]);
                u32x2 wk; wk.x = pk2(kq[i][0], kq[i][1]); wk.y = pk2(kq[i][2], kq[i][3]);
                u32x2 wg; wg.x = pk2(qo[0] * cum[0], qo[1] * cum[1]); wg.y = pk2(qo[2] * cum[2], qo[3] * cum[3]);
                *(LAS u32x2*)(lds + GL_QP + (4 * rg + i) * QP_PITCH + 8 * cg) = wq;
                *(LAS u32x2*)(lds + GL_KP + (4 * rg + i) * QP_PITCH + 8 * cg) = wk;
                *(u32x2*)(QPG + (4 * rg + i) * 128 + 4 * cg) = wg;
            }
#pragma unroll
            for (int c = 0; c < 4; ++c) { u32x2 wt; wt.x = pk2(kq[0][c], kq[1][c]); wt.y = pk2(kq[2][c], kq[3][c]);
                *(LAS u32x2*)(lds + GL_KPT + (4 * cg + c) * KT_PITCH + 8 * rg) = wt; }
        }
        LDS_BARRIER();
        if (rg == 0) { const f32x4 cum = *(const LAS f32x4*)(lds + GL_CUM + 16 * cg); *(LAS f32x4*)(lds + GL_CUM + 16 * cg) = cum * ebnew; }
        f32x16 O[2];
#pragma unroll
        for (int i = 0; i < 2; ++i)
#pragma unroll
            for (int j = 0; j < 16; ++j) O[i][j] = 0.f;
        if (jc > 0) {
#pragma unroll
            for (int dt = 0; dt < 4; ++dt)
#pragma unroll
                for (int s = 0; s < 2; ++s) {
                    const bf16x8 sb = pack_step(S[dt], s);
#pragma unroll
                    for (int ct = 0; ct < 2; ++ct) {
                        const LAS unsigned char* p = lds + GL_QP + (32 * ct + r) * QP_PITCH + (32 * dt + 16 * s + 4 * hh) * 2;
                        const bf16x8 a = cat8(*(const LAS u32x2*)p, *(const LAS u32x2*)(p + 16));
                        O[ct] = MFMA32(a, sb, O[ct]);
                    }
                    __builtin_amdgcn_sched_barrier(0);
                }
        }
        if (w < 3) {
            const int jt = w == 2 ? 1 : 0, ct = w == 0 ? 0 : 1;
            f32x16 X;
#pragma unroll
            for (int j = 0; j < 16; ++j) X[j] = 0.f;
#pragma unroll
            for (int s8 = 0; s8 < 8; ++s8) {
                const bf16x8 a = *(const LAS bf16x8*)(lds + GL_KP + (32 * jt + r) * QP_PITCH + (16 * s8 + 8 * hh) * 2);
                const bf16x8 bq = *(const LAS bf16x8*)(lds + GL_QP + (32 * ct + r) * QP_PITCH + (16 * s8 + 8 * hh) * 2);
                X = MFMA32(a, bq, X);
            }
            if (jt == ct) {
#pragma unroll
                for (int j = 0; j < 16; ++j) if (crow(j, hh) > r) X[j] = 0.f;
            }
            *(LAS u32x4*)(lds + GL_XF + ((w * 2 + 0) * 64 + lane) * 16) = __builtin_bit_cast(u32x4, pack_step(X, 0));
            *(LAS u32x4*)(lds + GL_XF + ((w * 2 + 1) * 64 + lane) * 16) = __builtin_bit_cast(u32x4, pack_step(X, 1));
        }
        __builtin_amdgcn_sched_barrier(0);
        if (jc + 1 < NSUB) GLA_ISSUE_LOADS(jc + 1);
        __builtin_amdgcn_sched_barrier(0);
        {
#pragma unroll
            for (int dt = 0; dt < 4; ++dt) {
#pragma unroll
                for (int s = 0; s < 4; ++s) {
                    const bf16x8 a = *(const LAS bf16x8*)(lds + GL_KPT + (32 * dt + r) * KT_PITCH + (16 * s + 8 * hh) * 2);
                    const bf16x8 vb = *(const LAS bf16x8*)(lds + GL_VT + (32 * w + r) * KT_PITCH + (16 * s + 8 * hh) * 2);
                    S[dt] = MFMA32(a, vb, S[dt]);
                }
#pragma unroll
                for (int g4 = 0; g4 < 4; ++g4) {
                    const f32x4 e = *(const LAS f32x4*)(lds + GL_EBL + (32 * dt + 8 * g4 + 4 * hh) * 4);
#pragma unroll
                    for (int i = 0; i < 4; ++i) S[dt][4 * g4 + i] *= e[i];
                }
                __builtin_amdgcn_sched_barrier(0);
            }
        }
        LDS_BARRIER();
        {
#pragma unroll
            for (int ct = 0; ct < 2; ++ct)
#pragma unroll
                for (int jt = 0; jt <= ct; ++jt) {
                    const int tile = ct == 0 ? 0 : (jt == 0 ? 1 : 2);
#pragma unroll
                    for (int s = 0; s < 2; ++s) {
                        const bf16x8 xa = *(const LAS bf16x8*)(lds + GL_XF + ((tile * 2 + s) * 64 + lane) * 16);
                        const LAS unsigned char* p = lds + GL_VT + (32 * w + r) * KT_PITCH + (32 * jt + 16 * s + 4 * hh) * 2;
                        const bf16x8 vb = cat8(*(const LAS u32x2*)p, *(const LAS u32x2*)(p + 16));
                        O[ct] = MFMA32(xa, vb, O[ct]);
                    }
                }
            u32x2* OIG = (u32x2*)(ws + WS_OIG) + cunit * 4096 + w * 64 + lane;
#pragma unroll
            for (int ct = 0; ct < 2; ++ct)
#pragma unroll
                for (int g4 = 0; g4 < 4; ++g4) { u32x2 o; o.x = pk2(O[ct][4 * g4], O[ct][4 * g4 + 1]); o.y = pk2(O[ct][4 * g4 + 2], O[ct][4 * g4 + 3]); OIG[(ct * 4 + g4) * 512] = o; }
        }
    }
#undef GLA_ISSUE_LOADS
    {
        int l2 = lane_id_here(); const int w2 = w;
        u32x4* DSG = (u32x4*)(ws + WS_DSG) + (size_t)unit * 4096 + w2 * 64 + l2;
#pragma unroll
        for (int dt = 0; dt < 4; ++dt) { DSG[(dt * 2 + 0) * 512] = __builtin_bit_cast(u32x4, pack_step(S[dt], 0)); DSG[(dt * 2 + 1) * 512] = __builtin_bit_cast(u32x4, pack_step(S[dt], 1)); }
        const int t2 = w2 * 64 + l2;
        if (t2 < 128) ((float*)(ws + WS_EBLG))[(size_t)unit * 128 + t2] = ((const LAS float*)(lds + GL_CUM))[t2];
    }
}

DI void gla_pass_b(const Ctx& C) {
    const int lane = lane_id_here(), tid = C.wave * 64 + lane, gid = C.bid * NTHREADS + tid;
    unsigned char* ws = C.ws;
    constexpr int UPB = 128 / NSUB;
    for (int id = gid; id < 16 * 8192; id += C.G * NTHREADS) {
        const int bh = id >> 13, f = (id >> 1) & 4095, half = id & 1;
        const int fl = f & 63, fw = (f >> 6) & 7, fs = (f >> 9) & 1, fdt = f >> 10;
        const int d0 = 32 * fdt + 16 * fs + 8 * half + 4 * (fl >> 5), e = 32 * fw + (fl & 31);
        u32x2* p = (u32x2*)(ws + WS_DSG) + ((size_t)bh * UPB * 4096 + f) * 2 + half;
        const float* eb = (const float*)(ws + WS_EBLG) + (size_t)bh * UPB * 128 + d0;
        float s0 = 0.f, s1 = 0.f, s2 = 0.f, s3 = 0.f;
#pragma unroll
        for (int u = 0; u < UPB; ++u) {
            const u32x2 ds = p[(size_t)u * 8192];
            const f32x4 ev = *(const f32x4*)(eb + u * 128);
            u32x2 st; st.x = pk2(s0, s1); st.y = pk2(s2, s3);
            p[(size_t)u * 8192] = st;
            s0 = ev[0] * s0 + bflo(ds.x); s1 = ev[1] * s1 + bfhi(ds.x); s2 = ev[2] * s2 + bflo(ds.y); s3 = ev[3] * s3 + bfhi(ds.y);
        }
        float* gp = C.out + O_GLAP + ((size_t)bh * 128 + d0) * 256 + e;
        gp[0] = s0; gp[256] = s1; gp[512] = s2; gp[768] = s3;
    }
}

DI void gla_pass_c(const Ctx& C) {
    LAS unsigned char* lds = C.lds;
    const int lane = lane_id_here(), w = C.wave, tid = w * 64 + lane, r = lane & 31, hh = lane >> 5;
    unsigned char* ws = C.ws;
    const int orow = tid >> 3, occ = tid & 7;
#define GLC_QLOAD(un) do { const u32x4* q_ = (const u32x4*)((const bf16_t*)(ws + WS_QPG) + (size_t)(un) * 8192); qst0 = q_[tid]; qst1 = q_[tid + 512]; } while (0)
#define GLC_QWRITE() do { *(LAS u32x4*)(lds + GL_QP + (tid >> 4) * QP_PITCH + 16 * (tid & 15)) = qst0; *(LAS u32x4*)(lds + GL_QP + (32 + (tid >> 4)) * QP_PITCH + 16 * (tid & 15)) = qst1; } while (0)
    const bool xs = C.G == 256;
#define GLC_UNIT(li) (xs ? (((li) & ~255) | (((li) & 7) << 5) | (((li) >> 3) & 31)) : (li))
    int li = C.bid;
    int unit = GLC_UNIT(li);
    u32x4 qst0 = {0u, 0u, 0u, 0u}, qst1 = {0u, 0u, 0u, 0u};
    if (li < 2048) GLC_QLOAD(unit);
    LDS_BARRIER();
    GLC_QWRITE();
    if (tid < 256) ((LAS float*)(lds + GL_GN))[tid] = C.in[14][tid];
    LDS_BARRIER();
    for (; li < 2048; li += C.G, unit = GLC_UNIT(li)) {
        const int bh = unit >> 7, ch = unit & 127, b = bh >> 2, h = bh & 3;
        const size_t t0 = (size_t)b * SEQ + (size_t)ch * 64;
        const int nli = li + C.G, nxt = nli < 2048 ? GLC_UNIT(nli) : 2048;
        u32x4 sgb[4];
#pragma unroll
        for (int i = 0; i < 4; ++i) sgb[i] = *(const u32x4*)((const bf16_t*)(ws + WS_SGB) + (t0 + orow) * 1024 + h * 256 + 32 * occ + 8 * i);
        f32x16 O[2];
        {
            const u32x2* OIG = (const u32x2*)(ws + WS_OIG) + (size_t)unit * 4096 + w * 64 + lane;
#pragma unroll
            for (int ct = 0; ct < 2; ++ct)
#pragma unroll
                for (int g4 = 0; g4 < 4; ++g4) { const u32x2 o = OIG[(ct * 4 + g4) * 512]; O[ct][4 * g4] = bflo(o.x); O[ct][4 * g4 + 1] = bfhi(o.x); O[ct][4 * g4 + 2] = bflo(o.y); O[ct][4 * g4 + 3] = bfhi(o.y); }
        }
        {
            const u32x4* SCG = (const u32x4*)(ws + WS_DSG) + (size_t)(bh * (128 / NSUB) + ch / NSUB) * 4096 + w * 64 + lane;
            u32x4 scg[8];
#pragma unroll
            for (int i = 0; i < 8; ++i) scg[i] = SCG[i * 512];
            if (nxt < 2048) GLC_QLOAD(nxt);
#pragma unroll
            for (int dt = 0; dt < 4; ++dt)
#pragma unroll
                for (int s = 0; s < 2; ++s) {
                    const bf16x8 sb = __builtin_bit_cast(bf16x8, scg[dt * 2 + s]);
#pragma unroll
                    for (int ct = 0; ct < 2; ++ct) {
                        const LAS unsigned char* p = lds + GL_QP + (32 * ct + r) * QP_PITCH + (32 * dt + 16 * s + 4 * hh) * 2;
                        const bf16x8 a = cat8(*(const LAS u32x2*)p, *(const LAS u32x2*)(p + 16));
                        O[ct] = MFMA32(a, sb, O[ct]);
                    }
                }
        }
        LDS_BARRIER();
        if (nxt < 2048) GLC_QWRITE();
        {
            LAS bf16_t* OT = (LAS bf16_t*)(lds + GL_OT);
#pragma unroll
            for (int ct = 0; ct < 2; ++ct)
#pragma unroll
                for (int j = 0; j < 16; ++j) OT[(32 * ct + crow(j, hh)) * (OT_PITCH / 2) + 32 * w + r] = f2bf(O[ct][j]);
        }
        LDS_BARRIER();
        {
            float v[32]; float ss = 0.f;
#pragma unroll
            for (int i = 0; i < 4; ++i) {
                const u32x4 wv = *(const LAS u32x4*)(lds + GL_OT + orow * OT_PITCH + 64 * occ + 16 * i);
#pragma unroll
                for (int j = 0; j < 4; ++j) { v[8 * i + 2 * j] = bflo(wv[j]); v[8 * i + 2 * j + 1] = bfhi(wv[j]); }
            }
#pragma unroll
            for (int i = 0; i < 32; ++i) ss += v[i] * v[i];
            ss += __shfl_xor(ss, 1); ss += __shfl_xor(ss, 2); ss += __shfl_xor(ss, 4);
            const float rinv = rsqrtf(ss * (1.f / 256.f) + EPS);
            bf16_t* op = (bf16_t*)(ws + WS_YAIN) + (t0 + orow) * 1536 + 512 + h * 256 + 32 * occ;
#pragma unroll
            for (int i = 0; i < 4; ++i) {
                const f32x4 g0 = *(const LAS f32x4*)(lds + GL_GN + (32 * occ + 8 * i) * 4), g1 = *(const LAS f32x4*)(lds + GL_GN + (32 * occ + 8 * i + 4) * 4);
                const u32x4 sg = sgb[i];
                u32x4 o;
                o[0] = pk2(v[8 * i + 0] * rinv * g0[0] * bflo(sg[0]), v[8 * i + 1] * rinv * g0[1] * bfhi(sg[0]));
                o[1] = pk2(v[8 * i + 2] * rinv * g0[2] * bflo(sg[1]), v[8 * i + 3] * rinv * g0[3] * bfhi(sg[1]));
                o[2] = pk2(v[8 * i + 4] * rinv * g1[0] * bflo(sg[2]), v[8 * i + 5] * rinv * g1[1] * bfhi(sg[2]));
                o[3] = pk2(v[8 * i + 6] * rinv * g1[2] * bflo(sg[3]), v[8 * i + 7] * rinv * g1[3] * bfhi(sg[3]));
                *(u32x4*)(op + 8 * i) = o;
            }
        }
    }
#undef GLC_QLOAD
#undef GLC_QWRITE
#undef GLC_UNIT
}

constexpr int GS_QP = 0, GS_KM = 4096, GS_EBL = 8192, GS_AM = 8704, GS_VS = 8960, GS_OS = 34304, GS_RED = 33536, GS_FB = 33792, GS_OS2 = 85248, GS_END = GS_OS2 + 32768;
static_assert(GS_OS + 32768 <= 69632 && GS_END <= LDS_BYTES - 64, "gla sample lds");
DI void gla_sample_item(const Ctx& C, int b, int h) {
    LAS unsigned char* lds = C.lds; const int tid = C.wave * 64 + lane_id_here(); unsigned char* ws = C.ws;
    const bf16_t* QB = (const bf16_t*)(ws + WS_QB); const bf16_t* KB = (const bf16_t*)(ws + WS_KB); const bf16_t* VB = (const bf16_t*)(ws + WS_VB);
    const bf16_t* SGB = (const bf16_t*)(ws + WS_SGB); const float* FB = (const float*)(ws + WS_FB); bf16_t* OBN = (bf16_t*)(ws + WS_YAIN) + 512;
    const size_t row0 = (size_t)MP + (size_t)b * 8;
    LAS float* QPt = (LAS float*)(lds + GS_QP); LAS float* KMt = (LAS float*)(lds + GS_KM); LAS float* EBLs = (LAS float*)(lds + GS_EBL);
    LAS float* AM = (LAS float*)(lds + GS_AM); LAS float* VS = (LAS float*)(lds + GS_VS); LAS float* OS = (LAS float*)(lds + GS_OS);
    LAS float* RED = (LAS float*)(lds + GS_RED); LAS float* FBs = (LAS float*)(lds + GS_FB);
    const int e4 = 4 * (tid & 63), grp = C.wave;
    const float* S0 = C.in[5] + ((size_t)(b * 4 + h) * 128) * 256; float* S1 = C.out + O_GLAS + ((size_t)(b * 4 + h) * 128) * 256;
    f32x4 st[16];
#pragma unroll
    for (int i = 0; i < 16; ++i) st[i] = __builtin_nontemporal_load((const f32x4*)(S0 + (size_t)(grp * 16 + i) * 256 + e4));
    LDS_BARRIER();
    if (tid < 128) FBs[tid] = FB[row0 * 16 + tid];
    for (int i = tid; i < 8 * 256; i += NTHREADS) VS[i] = bf1(VB[(row0 + (i >> 8)) * 1024 + h * 256 + (i & 255)]);
    LDS_BARRIER();
    if (tid < 128) {
        const int d = tid; const float* wf2 = C.in[12]; const float* bf2 = C.in[13];
        float wcol[16];
#pragma unroll
        for (int j = 0; j < 16; ++j) wcol[j] = wf2[(size_t)j * 512 + h * 128 + d];
        const float bb = bf2[h * 128 + d];
        float run = 0.f;
#pragma unroll
        for (int c = 0; c < 8; ++c) {
            float z = bb;
#pragma unroll
            for (int j = 0; j < 16; ++j) z += FBs[c * 16 + j] * wcol[j];
            run += logsig16(z);
            const float e = __expf(run);
            QPt[d * 8 + c] = bf1(QB[(row0 + c) * 512 + h * 128 + d]) * e;
            KMt[d * 8 + c] = bf1(KB[(row0 + c) * 512 + h * 128 + d]) / e;
        }
        EBLs[d] = __expf(run);
    }
    LDS_BARRIER();
    if (tid < 64) {
        const int c = tid >> 3, j = tid & 7; float a = 0.f;
        for (int d = 0; d < 128; ++d) a += QPt[d * 8 + c] * KMt[d * 8 + j];
        AM[c * 8 + j] = j <= c ? a : 0.f;
    }
    f32x4 vv[8], oo[8];
#pragma unroll
    for (int c = 0; c < 8; ++c) { vv[c] = *(const LAS f32x4*)(VS + c * 256 + e4); oo[c] = f32x4{0.f, 0.f, 0.f, 0.f}; }
#pragma unroll
    for (int i = 0; i < 16; ++i) {
        const int d = grp * 16 + i;
        const f32x4 s4 = st[i];
        const f32x4 qa = *(const LAS f32x4*)(QPt + d * 8), qb = *(const LAS f32x4*)(QPt + d * 8 + 4);
        const f32x4 ka = *(const LAS f32x4*)(KMt + d * 8), kb = *(const LAS f32x4*)(KMt + d * 8 + 4);
        f32x4 acc = s4;
#pragma unroll
        for (int c = 0; c < 4; ++c) { oo[c] += qa[c] * s4; oo[c + 4] += qb[c] * s4; acc += ka[c] * vv[c]; acc += kb[c] * vv[c + 4]; }
        const float eb = EBLs[d];
        __builtin_nontemporal_store(acc * eb, (f32x4*)(S1 + (size_t)d * 256 + e4));
    }
    {
        LAS float* OSg = (LAS float*)(lds + (grp < 4 ? GS_OS + grp * 8192 : GS_OS2 + (grp - 4) * 8192));
#pragma unroll
        for (int c = 0; c < 8; ++c) *(LAS f32x4*)(OSg + c * 256 + e4) = oo[c];
    }
    LDS_BARRIER();
    {
        const int c = tid >> 6, l = tid & 63;
        float o[4]; float ss = 0.f;
#pragma unroll
        for (int i = 0; i < 4; ++i) {
            const int ee = 4 * l + i; float a = 0.f;
#pragma unroll
            for (int g2 = 0; g2 < 8; ++g2) a += ((const LAS float*)(lds + (g2 < 4 ? GS_OS + g2 * 8192 : GS_OS2 + (g2 - 4) * 8192)))[c * 256 + ee];
#pragma unroll
            for (int j = 0; j < 8; ++j) a += AM[c * 8 + j] * VS[j * 256 + ee];
            o[i] = a; ss += a * a;
        }
        ss = wave_sum(ss);
        const float rinv = rsqrtf(ss * (1.f / 256.f) + EPS);
        const float* gn = C.in[14];
        u32x2 wv;
        const bf16_t* sg = SGB + (row0 + c) * 1024 + h * 256 + 4 * l;
        wv.x = pk2(o[0] * rinv * gn[4 * l] * bf1(sg[0]), o[1] * rinv * gn[4 * l + 1] * bf1(sg[1]));
        wv.y = pk2(o[2] * rinv * gn[4 * l + 2] * bf1(sg[2]), o[3] * rinv * gn[4 * l + 3] * bf1(sg[3]));
        *(u32x2*)(OBN + (row0 + c) * 1536 + h * 256 + 4 * l) = wv;
    }
    LDS_BARRIER();
}

__device__ const unsigned char T5_BUCKET[387] = {0,1,2,3,4,5,6,7,8,9,10,11,12,13,14,15,16,16,16,16,16,16,17,17,17,17,17,17,17,17,18,18,18,18,18,18,18,18,18,18,19,19,19,19,19,19,19,19,19,19,19,19,19,19,20,20,20,20,20,20,20,20,20,20,20,20,20,20,20,20,20,20,20,21,21,21,21,21,21,21,21,21,21,21,21,21,21,21,21,21,21,21,21,21,21,21,21,21,21,22,22,22,22,22,22,22,22,22,22,22,22,22,22,22,22,22,22,22,22,22,22,22,22,22,22,22,22,22,22,0,4,8,12,16,16,17,17,18,18,19,19,19,19,20,20,20,20,20,21,21,21,21,21,21,22,22,22,22,22,22,22,22,22,23,23,23,23,23,23,23,23,23,23,23,23,24,24,24,24,24,24,24,24,24,24,24,24,24,24,24,24,25,25,25,25,25,25,25,25,25,25,25,25,25,25,25,25,25,25,25,25,25,26,26,26,26,26,26,26,26,26,26,26,26,26,26,26,26,26,26,26,26,26,26,26,26,26,26,26,26,26,26,27,27,27,27,27,27,27,27,27,27,27,27,27,27,27,27,0,16,18,19,20,21,21,22,22,23,23,23,24,24,24,24,25,25,25,25,25,26,26,26,26,26,26,26,26,27,27,27,27,27,27,27,27,27,27,28,28,28,28,28,28,28,28,28,28,28,28,28,29,29,29,29,29,29,29,29,29,29,29,29,29,29,29,29,29,29,30,30,30,30,30,30,30,30,30,30,30,30,30,30,30,30,30,30,30,30,30,30,30,30,30,31,31,31,31,31,31,31,31,31,31,31,31,31,31,31,31,31,31,31,31,31,31,31,31,31,31,31,31,31,31,31,31,31,31};

constexpr int AT_V = 0, AT_VP = 272, AT_VW = 32 * AT_VP, AT_BT = 8 * AT_VW, AT_RT = AT_BT + 12 * 129 * 4, AT_END = AT_RT + 12 * 192 * 4;
static_assert(AT_END <= LDS_BYTES, "attn lds");

DI void attn_bias_tables(const Ctx& C, int tid) {
    LAS float* BT = (LAS float*)(C.lds + AT_BT); LAS float* RT = (LAS float*)(C.lds + AT_RT);
    for (int i = tid; i < 12 * 129; i += NTHREADS) { const int hd = i / 129, ds = i % 129; BT[i] = C.in[8][(int)T5_BUCKET[(hd >> 2) * 129 + ds] * 12 + hd] * LOG2E; }
    for (int i = tid; i < 12 * 192; i += NTHREADS) {
        const int hd = i / 192, k = i % 192, dsub = 159 - k;
        RT[i] = (dsub >= 0 && dsub <= 128) ? C.in[8][(int)T5_BUCKET[(hd >> 2) * 129 + dsub] * 12 + hd] * LOG2E : -1e30f;
    }
}

DI void attn_prompt_wave(const Ctx& C, int b, int slot, int g, int res, int m0, int lane) {
    const int r = lane & 31, hh = lane >> 5, dil = 1 << (2 * g), hd = 4 * g + slot;
    unsigned char* ws = C.ws;
    const bf16_t* QA = (const bf16_t*)(ws + WS_QA) + (size_t)hd * MT * 128; const bf16_t* KA = (const bf16_t*)(ws + WS_KA) + (size_t)hd * MT * 128;
    const bf16_t* VA = (const bf16_t*)(ws + WS_VA) + (size_t)hd * MT * 128;
    LAS unsigned char* VL = C.lds + AT_V + C.wave * AT_VW;
    const size_t rowb = (size_t)b * SEQ + (size_t)res * (SEQ >> (2 * g));
    bf16x8 qf[8];
    {
        const bf16_t* qp = QA + (rowb + (size_t)(m0 + r)) * 128 + 8 * hh;
#pragma unroll
        for (int s = 0; s < 8; ++s) qf[s] = *(const bf16x8*)(qp + 16 * s);
    }
    f32x16 P[5];
    u32x4 ka[8], kb[8];
    const size_t lane_off = (size_t)(lane >> 4) * 128 + 8 * (lane & 15);
#define ATT_LOADROWS(dst, base, kt_) do { const int mkb_ = (m0 - 128 + 32 * (kt_)) < 0 ? 0 : (m0 - 128 + 32 * (kt_)); \
        const bf16_t* tp_ = base + (rowb + (size_t)mkb_) * 128 + lane_off; \
        _Pragma("unroll") for (int i = 0; i < 8; ++i) dst[i] = *(const u32x4*)(tp_ + (size_t)i * 512); } while (0)
#define ATT_STAGE(src) do { LDS_WAIT(); asm volatile("" ::: "memory"); \
        _Pragma("unroll") for (int i = 0; i < 8; ++i) *(LAS u32x4*)(VL + (4 * i + (lane >> 4)) * AT_VP + 16 * (lane & 15)) = src[i]; \
        LDS_WAIT(); asm volatile("" ::: "memory"); } while (0)
#define ATT_QK(kt_) do { f32x16 acc_; _Pragma("unroll") for (int j = 0; j < 16; ++j) acc_[j] = 0.f; \
        _Pragma("unroll") for (int s = 0; s < 8; ++s) { const bf16x8 kf_ = *(const LAS bf16x8*)(VL + r * AT_VP + (16 * s + 8 * hh) * 2); acc_ = MFMA32(kf_, qf[s], acc_); } P[kt_] = acc_; } while (0)
    ATT_LOADROWS(ka, KA, 0); ATT_LOADROWS(kb, KA, 1); __builtin_amdgcn_sched_barrier(0);
    ATT_STAGE(ka); ATT_LOADROWS(ka, KA, 2); __builtin_amdgcn_sched_barrier(0); ATT_QK(0); __builtin_amdgcn_sched_barrier(0);
    ATT_STAGE(kb); ATT_LOADROWS(kb, KA, 3); __builtin_amdgcn_sched_barrier(0); ATT_QK(1); __builtin_amdgcn_sched_barrier(0);
    ATT_STAGE(ka); ATT_LOADROWS(ka, KA, 4); __builtin_amdgcn_sched_barrier(0); ATT_QK(2); __builtin_amdgcn_sched_barrier(0);
    ATT_STAGE(kb); __builtin_amdgcn_sched_barrier(0); ATT_QK(3); __builtin_amdgcn_sched_barrier(0);
    ATT_STAGE(ka); __builtin_amdgcn_sched_barrier(0); ATT_QK(4); __builtin_amdgcn_sched_barrier(0);
#undef ATT_QK
    u32x4 vv[8], vw[8];
#define ATT_LOADV(dst, kt_) ATT_LOADROWS(dst, VA, kt_)
    ATT_LOADV(vv, 0); ATT_LOADV(vw, 1);
    __builtin_amdgcn_sched_barrier(0);
    float mx = -1e30f;
    {
        const LAS float* rt = (const LAS float*)(C.lds + AT_RT) + hd * 192 + (31 - r + 4 * hh);
#pragma unroll
        for (int kt = 0; kt < 5; ++kt)
#pragma unroll
            for (int j = 0; j < 16; ++j) { const float sv = P[kt][j] + rt[32 * kt + (j & 3) + 8 * (j >> 2)]; P[kt][j] = sv; }
        if (m0 < 128) {
#pragma unroll
            for (int kt = 0; kt < 5; ++kt)
#pragma unroll
                for (int j = 0; j < 16; ++j) if (m0 - 128 + 32 * kt + crow(j, hh) < 0) P[kt][j] = -1e30f;
        }
#pragma unroll
        for (int kt = 0; kt < 5; ++kt)
#pragma unroll
            for (int j = 0; j < 16; ++j) mx = fmaxf(mx, P[kt][j]);
    }
    mx = fmaxf(mx, __shfl_xor(mx, 32));
    float den = 0.f;
#pragma unroll
    for (int kt = 0; kt < 5; ++kt)
#pragma unroll
        for (int j = 0; j < 16; ++j) { const float p = __builtin_amdgcn_exp2f(P[kt][j] - mx); P[kt][j] = p; den += p; }
    den += __shfl_xor(den, 32);
    f32x16 O[4];
#pragma unroll
    for (int i = 0; i < 4; ++i)
#pragma unroll
        for (int j = 0; j < 16; ++j) O[i][j] = 0.f;
#pragma unroll
    for (int kt = 0; kt < 5; ++kt) {
        __builtin_amdgcn_sched_barrier(0);
        LDS_WAIT(); asm volatile("" ::: "memory");
        if ((kt & 1) == 0) {
#pragma unroll
            for (int i = 0; i < 8; ++i) *(LAS u32x4*)(VL + (4 * i + (lane >> 4)) * AT_VP + 16 * (lane & 15)) = vv[i];
            LDS_WAIT(); asm volatile("" ::: "memory");
            if (kt + 2 < 5) ATT_LOADV(vv, kt + 2);
        } else {
#pragma unroll
            for (int i = 0; i < 8; ++i) *(LAS u32x4*)(VL + (4 * i + (lane >> 4)) * AT_VP + 16 * (lane & 15)) = vw[i];
            LDS_WAIT(); asm volatile("" ::: "memory");
            if (kt + 2 < 5) ATT_LOADV(vw, kt + 2);
        }
        __builtin_amdgcn_sched_barrier(0);
        {
            u32x2 tl[2][4], th[2][4];
            const unsigned va = (unsigned)(size_t)VL + (unsigned)((4 * hh + ((lane & 15) >> 2)) * AT_VP + (16 * ((lane >> 4) & 1) + 4 * (lane & 3)) * 2);
            asm volatile(
                "ds_read_b64_tr_b16 %0, %16\n\tds_read_b64_tr_b16 %1, %16 offset:64\n\tds_read_b64_tr_b16 %2, %16 offset:128\n\tds_read_b64_tr_b16 %3, %16 offset:192\n\t"
                "ds_read_b64_tr_b16 %4, %16 offset:2176\n\tds_read_b64_tr_b16 %5, %16 offset:2240\n\tds_read_b64_tr_b16 %6, %16 offset:2304\n\tds_read_b64_tr_b16 %7, %16 offset:2368\n\t"
                "ds_read_b64_tr_b16 %8, %16 offset:4352\n\tds_read_b64_tr_b16 %9, %16 offset:4416\n\tds_read_b64_tr_b16 %10, %16 offset:4480\n\tds_read_b64_tr_b16 %11, %16 offset:4544\n\t"
                "ds_read_b64_tr_b16 %12, %16 offset:6528\n\tds_read_b64_tr_b16 %13, %16 offset:6592\n\tds_read_b64_tr_b16 %14, %16 offset:6656\n\tds_read_b64_tr_b16 %15, %16 offset:6720\n\t"
                "s_waitcnt lgkmcnt(0)"
                : "=&v"(tl[0][0]), "=&v"(tl[0][1]), "=&v"(tl[0][2]), "=&v"(tl[0][3]), "=&v"(th[0][0]), "=&v"(th[0][1]), "=&v"(th[0][2]), "=&v"(th[0][3]),
                  "=&v"(tl[1][0]), "=&v"(tl[1][1]), "=&v"(tl[1][2]), "=&v"(tl[1][3]), "=&v"(th[1][0]), "=&v"(th[1][1]), "=&v"(th[1][2]), "=&v"(th[1][3])
                : "v"(va) : "memory");
            __builtin_amdgcn_sched_barrier(0);
#pragma unroll
            for (int s = 0; s < 2; ++s) {
                const bf16x8 pb = pack_step(P[kt], s);
#pragma unroll
                for (int dt = 0; dt < 4; ++dt) O[dt] = MFMA32(cat8(tl[s][dt], th[s][dt]), pb, O[dt]);
            }
            __builtin_amdgcn_sched_barrier(0);
        }
    }
#undef ATT_LOADV
#undef ATT_LOADROWS
#undef ATT_STAGE
    const float inv = __builtin_amdgcn_rcpf(den);
    const size_t qrow = rowb + (size_t)(m0 + r);
    bf16_t* op = (bf16_t*)(ws + WS_OAG) + ((size_t)hd * MT + qrow) * 128;
#pragma unroll
    for (int dt = 0; dt < 4; ++dt)
#pragma unroll
        for (int g4 = 0; g4 < 4; g4 += 2) {
            u32x2 wa, wb;
            wa.x = pk2(O[dt][4 * g4] * inv, O[dt][4 * g4 + 1] * inv); wa.y = pk2(O[dt][4 * g4 + 2] * inv, O[dt][4 * g4 + 3] * inv);
            wb.x = pk2(O[dt][4 * g4 + 4] * inv, O[dt][4 * g4 + 5] * inv); wb.y = pk2(O[dt][4 * g4 + 6] * inv, O[dt][4 * g4 + 7] * inv);
            st_rowpair(op, 4 * dt + g4, wa, wb, hh);
        }
    if (hh == 0) ((float*)(ws + WS_LSE))[((size_t)g * MT + qrow) * 4 + slot] = mx + __builtin_amdgcn_logf(den);
}

DI void attn_combine_chunk(unsigned char* ws, size_t row, int slot, int ck) {
    const size_t r0 = row, r1 = (size_t)attn_prow((int)row, 1), r2 = (size_t)attn_prow((int)row, 2);
    const float* lse = (const float*)(ws + WS_LSE) + slot;
    const float l0 = lse[r0 * 4], l1 = lse[((size_t)MT + r1) * 4], l2 = lse[((size_t)2 * MT + r2) * 4];
    const float lm = fmaxf(l0, fmaxf(l1, l2));
    float w0 = __builtin_amdgcn_exp2f(l0 - lm), w1 = __builtin_amdgcn_exp2f(l1 - lm), w2 = __builtin_amdgcn_exp2f(l2 - lm);
    const float ws_ = __builtin_amdgcn_rcpf(w0 + w1 + w2); w0 *= ws_; w1 *= ws_; w2 *= ws_;
    const bf16_t* ob = (const bf16_t*)(ws + WS_OAG) + 8 * ck;
    const u32x4 a = *(const u32x4*)(ob + ((size_t)slot * MT + r0) * 128), bq = *(const u32x4*)(ob + ((size_t)(4 + slot) * MT + r1) * 128), c = *(const u32x4*)(ob + ((size_t)(8 + slot) * MT + r2) * 128);
    u32x4 o;
#pragma unroll
    for (int j = 0; j < 4; ++j) o[j] = pk2(w0 * bflo(a[j]) + w1 * bflo(bq[j]) + w2 * bflo(c[j]), w0 * bfhi(a[j]) + w1 * bfhi(bq[j]) + w2 * bfhi(c[j]));
    *(u32x4*)((bf16_t*)(ws + WS_YAIN) + row * 1536 + slot * 128 + 8 * ck) = o;
}

DI void attn_prompt_item(const Ctx& C, int it) {
    const int bs = it / 96, rem = it % 96, g = rem >> 5, q = rem & 31;
    const int res = g == 0 ? 0 : (g == 1 ? q >> 3 : q >> 1), blk = g == 0 ? q : (g == 1 ? q & 7 : q & 1);
    attn_prompt_wave(C, bs >> 2, bs & 3, g, res, 256 * blk + 32 * C.wave, lane_id_here());
}

DI float half_sum(float v) {
    v += dpp_f<0xB1, 0xf>(v); v += dpp_f<0x4E, 0xf>(v); v += dpp_f<0x141, 0xf>(v); v += dpp_f<0x140, 0xf>(v); v += dpp_f<0x142, 0xa>(v);
    return v;
}
DI void attn_sample_item(const Ctx& C, int b, int slot, int g) {
    const int lane = lane_id_here(), t = C.wave;
    const int hh = lane >> 5, l4 = 4 * (lane & 31);
    unsigned char* ws = C.ws;
    const int dil = 1 << (2 * g), wb = 128 << (2 * g), hd = 4 * g + slot;
    const LAS float* BT = (const LAS float*)(C.lds + AT_BT) + hd * 129;
    const float* cache = C.in[2 + g] + (size_t)b * wb * 1024 + slot * 128 + l4;
    const float* neww = C.out + (g == 0 ? O_W1S : (g == 1 ? O_W2S : O_W3S)) + (size_t)b * 8 * 1024 + slot * 128 + l4;
    const size_t row = (size_t)MP + b * 8 + t;
    const u32x2 qraw = *(const u32x2*)((const bf16_t*)(ws + WS_QA) + ((size_t)hd * MT + row) * 128 + l4);
    const float q0 = bflo(qraw.x), q1 = bfhi(qraw.x), q2 = bflo(qraw.y), q3 = bfhi(qraw.y);
    const f32x4 kt = __builtin_nontemporal_load((const f32x4*)(cache + (size_t)t * 1024));
    const f32x4 vt = __builtin_nontemporal_load((const f32x4*)(cache + (size_t)t * 1024 + 512));
    float m = -1e30f, l = 0.f;
    f32x4 o = {0.f, 0.f, 0.f, 0.f};
#pragma unroll 1
    for (int jb = 0; jb < 128; jb += 32) {
        f32x4 kk[16], vv[16];
#pragma unroll
        for (int u = 0; u < 16; ++u) {
            const int j = jb + 2 * u + hh; const int id = wb + t - j * dil;
            const float* kr = id >= wb ? neww + (size_t)(id - wb) * 1024 : cache + (size_t)id * 1024;
            kk[u] = *(const f32x4*)kr;
            vv[u] = *(const f32x4*)(kr + 512);
        }
        unsigned sbits = __float_as_uint(-1e30f);
#pragma unroll
        for (int u = 0; u < 16; ++u) {
            const float d = half_sum(q0 * kk[u].x + q1 * kk[u].y + q2 * kk[u].z + q3 * kk[u].w);
            const unsigned se = __builtin_amdgcn_readlane(__float_as_uint(d), 31), so = __builtin_amdgcn_readlane(__float_as_uint(d), 63);
            sbits = lane == 2 * u ? se : sbits;
            sbits = lane == 2 * u + 1 ? so : sbits;
        }
        const float sb = lane < 32 ? __uint_as_float(sbits) + BT[jb + (lane & 31)] : -1e30f;
        const float mn = fmaxf(m, wave_max(sb));
        const float alpha = __builtin_amdgcn_exp2f(m - mn);
        const float pb = lane < 32 ? __builtin_amdgcn_exp2f(sb - mn) : 0.f;
        l = l * alpha + wave_sum(pb); m = mn;
        o.x *= alpha; o.y *= alpha; o.z *= alpha; o.w *= alpha;
#pragma unroll
        for (int u = 0; u < 16; ++u) {
            const float pe = __uint_as_float(__builtin_amdgcn_readlane(__float_as_uint(pb), 2 * u));
            const float po = __uint_as_float(__builtin_amdgcn_readlane(__float_as_uint(pb), 2 * u + 1));
            const float p = hh ? po : pe;
            o.x += p * vv[u].x; o.y += p * vv[u].y; o.z += p * vv[u].z; o.w += p * vv[u].w;
        }
    }
    {
        const float d = half_sum(q0 * kt.x + q1 * kt.y + q2 * kt.z + q3 * kt.w);
        const float sT = __uint_as_float(__builtin_amdgcn_readlane(__float_as_uint(d), 31)) + BT[128];
        const float mn = fmaxf(m, sT);
        const float alpha = __builtin_amdgcn_exp2f(m - mn), pT = __builtin_amdgcn_exp2f(sT - mn);
        l = l * alpha + pT; m = mn;
        const float p = hh ? 0.f : pT;
        o.x = o.x * alpha + p * vt.x; o.y = o.y * alpha + p * vt.y; o.z = o.z * alpha + p * vt.z; o.w = o.w * alpha + p * vt.w;
    }
    o.x += __shfl_xor(o.x, 32); o.y += __shfl_xor(o.y, 32); o.z += __shfl_xor(o.z, 32); o.w += __shfl_xor(o.w, 32);
    const float inv = 1.f / l;
    if (lane < 32) { u32x2 w2; w2.x = pk2(o.x * inv, o.y * inv); w2.y = pk2(o.z * inv, o.w * inv); *(u32x2*)((bf16_t*)(ws + WS_OAG) + ((size_t)hd * MT + row) * 128 + l4) = w2; }
    if (lane == 0) ((float*)(ws + WS_LSE))[((size_t)g * MT + row) * 4 + slot] = m + __builtin_amdgcn_logf(l);
}

DI float rs_from4(const float* ssq4, int row) { const f32x4 p = *(const f32x4*)(ssq4 + (size_t)row * 4); return rsqrtf(((p[0] + p[1]) + (p[2] + p[3])) * (1.f / 1024.f) + EPS); }

DI void ld_bf16x8(const bf16_t* p, f32x4& a, f32x4& b) {
    const u32x4 w = *(const u32x4*)p;
    a = (f32x4){bflo(w.x), bfhi(w.x), bflo(w.y), bfhi(w.y)}; b = (f32x4){bflo(w.z), bfhi(w.z), bflo(w.w), bfhi(w.w)};
}
template <int MODE> struct EpiGate {
    static constexpr bool PERM = true, AFTER_DRAIN = false, HAS_MID = false;
    const bf16_t* G; const bf16_t* T; bf16_t* D;
    DI void operator()(const f32x4 (&acc)[2][2][4][2], const pg8::Unit& u, int wr, int wc, int fr, int fq) const {
        const int rbase = u.pm * 256 + wr * 64 + fr, c0 = u.pn * 256 + wc * 32 + 8 * fq;
#pragma unroll
        for (int ai = 0; ai < 2; ++ai)
#pragma unroll
            for (int m = 0; m < 4; ++m) {
                const size_t off = (size_t)(rbase + ai * 128 + m * 16) * 1024 + c0;
#pragma unroll
                for (int bj = 0; bj < 2; ++bj) {
                    f32x4 g0, g1; ld_bf16x8(G + off + bj * 128, g0, g1);
                    f32x4 v0 = acc[ai][bj][m][0] * g0, v1 = acc[ai][bj][m][1] * g1;
                    if (MODE == 1) { f32x4 t0, t1; ld_bf16x8(T + off + bj * 128, t0, t1); v0 += t0; v1 += t1; }
                    st_bf16x8(D + off + bj * 128, v0, v1);
                }
            }
    }
};
struct EpiGate2 {
    static constexpr bool PERM = true, AFTER_DRAIN = false, HAS_MID = true;
    const bf16_t* GA; const bf16_t* GB; bf16_t* D; int mid_t;
    DI void mid(f32x4 (&acc)[2][2][4][2], const pg8::Unit& u, int wr, int wc, int fr_, int fq_) const {
        const int lane = lane_id_here(), fr = lane & 15, fq = lane >> 4;
        const int rbase = u.pm * 256 + wr * 64 + fr, c0 = u.pn * 256 + wc * 32 + 8 * fq;
#pragma unroll
        for (int ai = 0; ai < 2; ++ai) {
            u32x4 ga[4][2], gb[4][2];
#pragma unroll
            for (int m = 0; m < 4; ++m)
#pragma unroll
                for (int bj = 0; bj < 2; ++bj) {
                    const size_t off = (size_t)(rbase + ai * 128 + m * 16) * 1024 + c0 + bj * 128;
                    ga[m][bj] = *(const u32x4*)(GA + off); gb[m][bj] = *(const u32x4*)(GB + off);
                }
            __builtin_amdgcn_sched_barrier(0);
#pragma unroll
            for (int m = 0; m < 4; ++m)
#pragma unroll
                for (int bj = 0; bj < 2; ++bj) {
                    const u32x4 wa = ga[m][bj], wb = gb[m][bj];
                    const f32x4 a0 = (f32x4){bflo(wa.x), bfhi(wa.x), bflo(wa.y), bfhi(wa.y)}, a1 = (f32x4){bflo(wa.z), bfhi(wa.z), bflo(wa.w), bfhi(wa.w)};
                    const f32x4 b0 = (f32x4){bflo(wb.x), bfhi(wb.x), bflo(wb.y), bfhi(wb.y)}, b1 = (f32x4){bflo(wb.z), bfhi(wb.z), bflo(wb.w), bfhi(wb.w)};
#pragma unroll
                    for (int i = 0; i < 4; ++i) { acc[ai][bj][m][0][i] *= a0[i] * __builtin_amdgcn_rcpf(fmaxf(b0[i], 1e-30f)); acc[ai][bj][m][1][i] *= a1[i] * __builtin_amdgcn_rcpf(fmaxf(b1[i], 1e-30f)); }
                }
            __builtin_amdgcn_sched_barrier(0);
        }
    }
    DI void operator()(const f32x4 (&acc)[2][2][4][2], const pg8::Unit& u, int wr, int wc, int fr, int fq) const {
        const int rbase = u.pm * 256 + wr * 64 + fr, c0 = u.pn * 256 + wc * 32 + 8 * fq;
#pragma unroll
        for (int ai = 0; ai < 2; ++ai) {
            u32x4 gw[4][2];
#pragma unroll
            for (int m = 0; m < 4; ++m)
#pragma unroll
                for (int bj = 0; bj < 2; ++bj) gw[m][bj] = *(const u32x4*)(GB + (size_t)(rbase + ai * 128 + m * 16) * 1024 + c0 + bj * 128);
#pragma unroll
            for (int m = 0; m < 4; ++m) {
                const size_t off = (size_t)(rbase + ai * 128 + m * 16) * 1024 + c0;
#pragma unroll
                for (int bj = 0; bj < 2; ++bj) {
                    const u32x4 w = gw[m][bj];
                    const f32x4 b0 = (f32x4){bflo(w.x), bfhi(w.x), bflo(w.y), bfhi(w.y)}, b1 = (f32x4){bflo(w.z), bfhi(w.z), bflo(w.w), bfhi(w.w)};
                    st_bf16x8(D + off + bj * 128, acc[ai][bj][m][0] * b0, acc[ai][bj][m][1] * b1);
                }
            }
        }
    }
};
struct EpiBranch {
    static constexpr bool PERM = true, AFTER_DRAIN = false, HAS_MID = false;
    bf16_t* D; float* ssq;
    DI void operator()(const f32x4 (&acc)[2][2][4][2], const pg8::Unit& u, int wr, int wc, int fr, int fq) const {
        const int rbase = u.pm * 256 + wr * 64 + fr, c0 = u.pn * 256 + wc * 32 + 8 * fq;
#pragma unroll
        for (int ai = 0; ai < 2; ++ai)
#pragma unroll
            for (int m = 0; m < 4; ++m) {
                const int row = rbase + ai * 128 + m * 16; const size_t off = (size_t)row * 1024 + c0;
                float s = 0.f;
#pragma unroll
                for (int bj = 0; bj < 2; ++bj) {
                    const f32x4 v0 = acc[ai][bj][m][0], v1 = acc[ai][bj][m][1];
                    s += (v0[0] * v0[0] + v0[1] * v0[1]) + (v0[2] * v0[2] + v0[3] * v0[3]) + (v1[0] * v1[0] + v1[1] * v1[1]) + (v1[2] * v1[2] + v1[3] * v1[3]);
                    st_bf16x8(D + off + bj * 128, v0, v1);
                }
                s += __shfl_xor(s, 16); s += __shfl_xor(s, 32);
                if (fq == 0) ssq[(size_t)row * 16 + 4 * u.pn + wc] = s;
            }
    }
};
struct EpiRowScale {
    static constexpr bool PERM = true, AFTER_DRAIN = false, HAS_MID = false;
    const float* rs; bf16_t* D; float scale;
    DI void operator()(const f32x4 (&acc)[2][2][4][2], const pg8::Unit& u, int wr, int wc, int fr, int fq) const {
        const int rbase = u.pm * 256 + wr * 64 + fr, c0 = u.pn * 256 + wc * 32 + 8 * fq;
        float rsv[2][4];
#pragma unroll
        for (int ai = 0; ai < 2; ++ai)
#pragma unroll
            for (int m = 0; m < 4; ++m) rsv[ai][m] = rs[rbase + ai * 128 + m * 16];
#pragma unroll
        for (int ai = 0; ai < 2; ++ai)
#pragma unroll
            for (int m = 0; m < 4; ++m) {
                const int row = rbase + ai * 128 + m * 16; const float r = rsv[ai][m] * scale; const size_t off = (size_t)row * 1024 + c0;
#pragma unroll
                for (int bj = 0; bj < 2; ++bj) st_bf16x8(D + off + bj * 128, acc[ai][bj][m][0] * r, acc[ai][bj][m][1] * r);
            }
    }
};
struct EpiGateUp {
    static constexpr bool PERM = true, AFTER_DRAIN = false, HAS_MID = false;
    const float* rs; bf16_t* H;
    DI void operator()(const f32x4 (&acc)[2][2][4][2], const pg8::Unit& u, int wr, int wc, int fr, int fq) const {
        const int rbase = u.pm * 256 + wr * 64 + fr, c0 = u.pn * 128 + wc * 32 + 8 * fq;
        float rsv[2][4];
#pragma unroll
        for (int ai = 0; ai < 2; ++ai)
#pragma unroll
            for (int m = 0; m < 4; ++m) rsv[ai][m] = rs[rbase + ai * 128 + m * 16];
#pragma unroll
        for (int ai = 0; ai < 2; ++ai)
#pragma unroll
            for (int m = 0; m < 4; ++m) {
                const int row = rbase + ai * 128 + m * 16; const float r = rsv[ai][m];
                f32x4 g0 = acc[ai][0][m][0] * r, g1 = acc[ai][0][m][1] * r; const f32x4 u0 = acc[ai][1][m][0] * r, u1 = acc[ai][1][m][1] * r;
#pragma unroll
                for (int i = 0; i < 4; ++i) { g0[i] = g0[i] * fsigmoid(g0[i]) * u0[i]; g1[i] = g1[i] * fsigmoid(g1[i]) * u1[i]; }
                st_bf16x8(H + (size_t)row * DFF + c0, g0, g1);
            }
    }
};

template <bool FIRST, bool LAST> DI void resid_pass(const Ctx& C, const float* gain) {
    const int lane = lane_id_here(); const int gw = C.bid * 8 + C.wave, NGW = C.G * 8;
    unsigned char* ws = C.ws;
    const bf16_t* BR = (const bf16_t*)(ws + WS_MIX); const float* SSQ = (const float*)(ws + WS_SSQ);
    bf16_t* XB = (bf16_t*)(ws + WS_XB); float* RS = (float*)(ws + WS_RS);
    f32x4 gv[4];
#pragma unroll
    for (int j = 0; j < 4; ++j) gv[j] = ((const f32x4*)gain)[lane + 64 * j];
    u32x2 bw[4]; f32x4 xv[4]; u32x2 xbv[4]; float sq = 0.f;
#define RESID_LOAD(m_) do { const int mm_ = (m_); \
        sq = mm_ < MP ? (lane < 16 ? SSQ[(size_t)mm_ * 16 + lane] : 0.f) : (lane < 32 ? ((const float*)(ws + WS_SSQ + 2560 * 1024))[(size_t)(mm_ - MP) * 32 + lane] : 0.f); \
        _Pragma("unroll") for (int j = 0; j < 4; ++j) { bw[j] = ((const u32x2*)(BR + (size_t)mm_ * 1024))[lane + 64 * j]; \
            if (FIRST) { const float* xo_ = mm_ < MP ? C.in[0] + (size_t)mm_ * 1024 : C.in[1] + (size_t)(mm_ - MP) * 1024; xv[j] = __builtin_nontemporal_load((const f32x4*)xo_ + lane + 64 * j); } \
            else xbv[j] = ((const u32x2*)(XB + (size_t)mm_ * 1024))[lane + 64 * j]; } } while (0)
    if (gw < MT) RESID_LOAD(gw);
    for (int m = gw; m < MT; m += NGW) {
        u32x2 cb[4]; f32x4 cx[4]; const float csq = sq;
#pragma unroll
        for (int j = 0; j < 4; ++j) { cb[j] = bw[j]; cx[j] = FIRST ? xv[j] : (f32x4){bflo(xbv[j].x), bfhi(xbv[j].x), bflo(xbv[j].y), bfhi(xbv[j].y)}; }
        if (m + NGW < MT) RESID_LOAD(m + NGW);
        const float rb = rsqrtf(wave_sum(csq) * (1.f / 1024.f) + EPS);
        f32x4 v[4]; float s = 0.f;
#pragma unroll
        for (int j = 0; j < 4; ++j) {
            const f32x4 bv = (f32x4){bflo(cb[j].x), bfhi(cb[j].x), bflo(cb[j].y), bfhi(cb[j].y)};
            v[j] = cx[j] + bv * rb * gv[j];
            s += (v[j].x * v[j].x + v[j].y * v[j].y) + (v[j].z * v[j].z + v[j].w * v[j].w);
        }
        if (LAST) {
#pragma unroll
            for (int j = 0; j < 4; ++j) __builtin_nontemporal_store(v[j], (f32x4*)(C.out + (size_t)m * 1024) + lane + 64 * j);
        } else {
            s = wave_sum(s);
#pragma unroll
            for (int j = 0; j < 4; ++j) { u32x2 w; w.x = pk2(v[j].x, v[j].y); w.y = pk2(v[j].z, v[j].w); ((u32x2*)(XB + (size_t)m * 1024))[lane + 64 * j] = w; }
            if (lane == 0) RS[m] = rsqrtf(s * (1.f / 1024.f) + EPS);
        }
    }
#undef RESID_LOAD
}

constexpr int XA_PITCH = 528, XA_BUF = 128 * XA_PITCH;
#ifndef XREP_S
#define XREP_S 1
#endif
#ifndef XREP_PV
#define XREP_PV 1
#endif
static_assert(2 * XA_BUF <= LDS_BYTES - 64, "xattn lds");
DI void xattn_prompt_item(const Ctx& C, int item) {
    const int lane = lane_id_here(), w = C.wave, tid = w * 64 + lane, r = lane & 31, hh = lane >> 5;
    const int bh = item >> 5, tb = item & 31, b = bh >> 2, h = bh & 3;
    unsigned char* ws = C.ws; LAS unsigned char* lds = C.lds;
    const size_t row0 = (size_t)b * SEQ + (size_t)tb * 256 + 32 * w;
    const bf16_t* Kg = (const bf16_t*)(ws + WS_MK) + (size_t)b * 256 * 1024 + h * 256;
    const bf16_t* Vg = (const bf16_t*)(ws + WS_MVT) + ((size_t)b * 1024 + h * 256) * 256;
    u32x4 st[16];
    const bf16_t* kld = Kg + (size_t)(tid >> 5) * 1024 + 8 * (tid & 31);
    const bf16_t* vld = Vg + (size_t)(tid >> 5) * 256 + 8 * (tid & 31);
    LAS unsigned char* wst = lds + (tid >> 5) * XA_PITCH + 16 * (tid & 31);
#define XA_WRITE_ALL() do { _Pragma("unroll") for (int i = 0; i < 16; ++i) *(LAS u32x4*)(wst + (i >> 3) * XA_BUF + 16 * (i & 7) * XA_PITCH) = st[i]; } while (0)
#pragma unroll
    for (int i = 0; i < 16; ++i) st[i] = *(const u32x4*)(kld + (size_t)(16 * i) * 1024);
    bf16x8 qf[16];
    {
        const bf16_t* Q = (const bf16_t*)(ws + WS_Q2) + (row0 + r) * 1024 + h * 256 + 8 * hh;
#pragma unroll
        for (int s = 0; s < 16; ++s) qf[s] = *(const bf16x8*)(Q + 16 * s);
    }
    LDS_BARRIER();
    XA_WRITE_ALL();
    LDS_BARRIER();
    f32x16 P[8];
#pragma unroll
    for (int kh = 0; kh < 2; ++kh) {
        f32x16 acc[4];
#pragma unroll
        for (int kt = 0; kt < 4; ++kt)
#pragma unroll
            for (int j = 0; j < 16; ++j) acc[kt][j] = 0.f;
        const LAS unsigned char* kb_ = lds + kh * XA_BUF + r * XA_PITCH + 16 * hh;
        bf16x8 fa[4], fb[4];
#pragma unroll
        for (int kt = 0; kt < 4; ++kt) fa[kt] = *(const LAS bf16x8*)(kb_ + 32 * kt * XA_PITCH);
#pragma unroll
        for (int s = 0; s < 16; s += 2) {
#pragma unroll
            for (int kt = 0; kt < 4; ++kt) fb[kt] = *(const LAS bf16x8*)(kb_ + 32 * kt * XA_PITCH + 32 * (s + 1));
#pragma unroll
            for (int kt = 0; kt < 4; ++kt) acc[kt] = MFMA32(fa[kt], qf[s], acc[kt]);
            if (s + 2 < 16) {
#pragma unroll
                for (int kt = 0; kt < 4; ++kt) fa[kt] = *(const LAS bf16x8*)(kb_ + 32 * kt * XA_PITCH + 32 * (s + 2));
            }
#pragma unroll
            for (int kt = 0; kt < 4; ++kt) acc[kt] = MFMA32(fb[kt], qf[s + 1], acc[kt]);
        }
#pragma unroll
        for (int kt = 0; kt < 4; ++kt) P[4 * kh + kt] = acc[kt];
    }
    float mx = -1e30f;
#pragma unroll
    for (int kt = 0; kt < 8; ++kt)
#pragma unroll
        for (int j = 0; j < 16; ++j) mx = fmaxf(mx, P[kt][j]);
    mx = fmaxf(mx, __shfl_xor(mx, 32));
    float den = 0.f;
    bf16x8 pb[8][2];
#pragma unroll
    for (int kt = 0; kt < 8; ++kt) {
#pragma unroll
        for (int j = 0; j < 16; ++j) { const float p = __builtin_amdgcn_exp2f(P[kt][j] - mx); P[kt][j] = p; den += p; }
        pb[kt][0] = pack_step(P[kt], 0); pb[kt][1] = pack_step(P[kt], 1);
    }
    den += __shfl_xor(den, 32);
    const float inv = __builtin_amdgcn_rcpf(den);
    bf16_t* op = (bf16_t*)(ws + WS_O2) + (row0 + r) * 1024 + h * 256;
#pragma unroll
    for (int i = 0; i < 16; ++i) st[i] = *(const u32x4*)(vld + (size_t)(16 * i) * 256);
    LDS_BARRIER();
    XA_WRITE_ALL();
    LDS_BARRIER();
#pragma unroll
    for (int dh = 0; dh < 2; ++dh) {
        f32x16 O[4];
#pragma unroll
        for (int i = 0; i < 4; ++i)
#pragma unroll
            for (int j = 0; j < 16; ++j) O[i][j] = 0.f;
        {
            const LAS unsigned char* vb_ = lds + dh * XA_BUF + r * XA_PITCH + 8 * hh;
            u32x2 va[4][2], vb2[4][2];
#define XA_VREAD(dst, st_) do { _Pragma("unroll") for (int dt = 0; dt < 4; ++dt) { const LAS unsigned char* p_ = vb_ + 32 * dt * XA_PITCH + 32 * (st_); \
                dst[dt][0] = *(const LAS u32x2*)p_; dst[dt][1] = *(const LAS u32x2*)(p_ + 16); } } while (0)
            XA_VREAD(va, 0);
#pragma unroll
            for (int st2 = 0; st2 < 16; st2 += 2) {
                XA_VREAD(vb2, st2 + 1);
#pragma unroll
                for (int dt = 0; dt < 4; ++dt) O[dt] = MFMA32(cat8(va[dt][0], va[dt][1]), pb[st2 >> 1][0], O[dt]);
                if (st2 + 2 < 16) XA_VREAD(va, st2 + 2);
#pragma unroll
                for (int dt = 0; dt < 4; ++dt) O[dt] = MFMA32(cat8(vb2[dt][0], vb2[dt][1]), pb[st2 >> 1][1], O[dt]);
            }
#undef XA_VREAD
        }
#pragma unroll
        for (int dt = 0; dt < 4; ++dt)
#pragma unroll
            for (int g4 = 0; g4 < 4; g4 += 2) {
                u32x2 wa, wb;
                wa.x = pk2(O[dt][4 * g4] * inv, O[dt][4 * g4 + 1] * inv); wa.y = pk2(O[dt][4 * g4 + 2] * inv, O[dt][4 * g4 + 3] * inv);
                wb.x = pk2(O[dt][4 * g4 + 4] * inv, O[dt][4 * g4 + 5] * inv); wb.y = pk2(O[dt][4 * g4 + 6] * inv, O[dt][4 * g4 + 7] * inv);
                st_rowpair(op + 128 * dh, 4 * dt + g4, wa, wb, hh);
            }
    }
#undef XA_WRITE_ALL
}
constexpr int XS_Q = 0, XS_SC = 4096, XS_PART = 8192, XS_END = 8192 + 32768;
DI void xattn_sample_item(const Ctx& C, int b, int h, int th) {
    const int lane = lane_id_here(), w = C.wave, tid = w * 64 + lane;
    unsigned char* ws = C.ws;
    LAS float* QS = (LAS float*)(C.lds + XS_Q); LAS float* SC = (LAS float*)(C.lds + XS_SC); LAS float* PART = (LAS float*)(C.lds + XS_PART);
    const float* cache = C.in[6] + (size_t)b * 256 * 2048 + h * 256;
    const size_t row0 = (size_t)MP + b * 8 + 4 * th;
    LDS_BARRIER();
    for (int i = tid; i < 4 * 256; i += NTHREADS) QS[i] = bf1(((const bf16_t*)(ws + WS_Q2))[(row0 + (i >> 8)) * 1024 + h * 256 + (i & 255)]);
    LDS_BARRIER();
    {
        f32x4 q[4];
#pragma unroll
        for (int t = 0; t < 4; ++t) q[t] = *(const LAS f32x4*)(QS + t * 256 + 4 * lane);
        for (int mb = 0; mb < 32; mb += 16) {
            f32x4 kk[16];
#pragma unroll
            for (int u = 0; u < 16; ++u) kk[u] = __builtin_nontemporal_load((const f32x4*)(cache + (size_t)(32 * w + mb + u) * 2048 + 4 * lane));
#pragma unroll
            for (int u = 0; u < 16; ++u) {
#pragma unroll
                for (int t = 0; t < 4; ++t) {
                    const float s = wave_sum(q[t].x * kk[u].x + q[t].y * kk[u].y + q[t].z * kk[u].z + q[t].w * kk[u].w);
                    if (lane == 0) SC[t * 256 + 32 * w + mb + u] = s;
                }
            }
        }
    }
    LDS_BARRIER();
    if (w < 4) {
        float v[4]; float mx = -1e30f;
#pragma unroll
        for (int i = 0; i < 4; ++i) { v[i] = SC[w * 256 + lane + 64 * i]; mx = fmaxf(mx, v[i]); }
        mx = wave_max(mx);
        float den = 0.f;
#pragma unroll
        for (int i = 0; i < 4; ++i) { v[i] = __builtin_amdgcn_exp2f(v[i] - mx); den += v[i]; }
        den = wave_sum(den);
        const float inv = 1.f / den;
#pragma unroll
        for (int i = 0; i < 4; ++i) SC[w * 256 + lane + 64 * i] = v[i] * inv;
    }
    LDS_BARRIER();
    {
        f32x4 o[4];
#pragma unroll
        for (int t = 0; t < 4; ++t) o[t] = f32x4{0.f, 0.f, 0.f, 0.f};
        for (int mb = 0; mb < 32; mb += 16) {
            f32x4 vv[16];
#pragma unroll
            for (int u = 0; u < 16; ++u) vv[u] = __builtin_nontemporal_load((const f32x4*)(cache + (size_t)(32 * w + mb + u) * 2048 + 1024 + 4 * lane));
#pragma unroll
            for (int u4 = 0; u4 < 4; ++u4) {
#pragma unroll
                for (int t = 0; t < 4; ++t) {
                    const f32x4 pv = *(const LAS f32x4*)(SC + t * 256 + 32 * w + mb + 4 * u4);
#pragma unroll
                    for (int i = 0; i < 4; ++i) o[t] += pv[i] * vv[4 * u4 + i];
                }
            }
        }
#pragma unroll
        for (int t = 0; t < 4; ++t) *(LAS f32x4*)(PART + (w * 4 + t) * 256 + 4 * lane) = o[t];
    }
    LDS_BARRIER();
    {
        const int t = tid >> 7, d2 = 2 * (tid & 127);
        float a0 = 0.f, a1 = 0.f;
#pragma unroll
        for (int g = 0; g < 8; ++g) { const f32x2 pp = *(const LAS f32x2*)(PART + (g * 4 + t) * 256 + d2); a0 += pp.x; a1 += pp.y; }
        *(unsigned*)((bf16_t*)(ws + WS_O2) + (row0 + t) * 1024 + h * 256 + d2) = pk2(a0, a1);
    }
    LDS_BARRIER();
}

template <int NACC, class F> DI void sgemm_unit(const Ctx& C, const bf16_t* __restrict__ A, const bf16_t* __restrict__ B0, const bf16_t* __restrict__ B1, int K, int tm, const F& fin, int lda = 0, int ldb = 0) {
    if (lda == 0) lda = K;
    if (ldb == 0) ldb = K;
    const int lane = lane_id_here(), w = C.wave, r = lane & 31, hh = lane >> 5;
    LAS float* PT = (LAS float*)C.lds;
    f32x16 acc[NACC];
#pragma unroll
    for (int i = 0; i < NACC; ++i)
#pragma unroll
        for (int j = 0; j < 16; ++j) acc[i][j] = 0.f;
    const int ksl = K / 8;
    const bf16_t* ap = A + (size_t)(32 * tm + r) * lda + w * ksl + 8 * hh;
    const bf16_t* bp0 = B0 + (size_t)r * ldb + w * ksl + 8 * hh;
    const bf16_t* bp1 = B1 + (size_t)r * ldb + w * ksl + 8 * hh;
#pragma unroll 4
    for (int k = 0; k < ksl; k += 16) {
        const bf16x8 a = *(const bf16x8*)(ap + k);
        acc[0] = MFMA32(a, *(const bf16x8*)(bp0 + k), acc[0]);
        if (NACC == 2) acc[1] = MFMA32(a, *(const bf16x8*)(bp1 + k), acc[1]);
    }
    LDS_BARRIER();
#pragma unroll
    for (int i = 0; i < NACC; ++i)
#pragma unroll
        for (int j = 0; j < 16; ++j) PT[((i * 8 + w) * 32 + crow(j, hh)) * 33 + r] = acc[i][j];
    LDS_BARRIER();
    const int tid = w * 64 + lane, row = tid >> 4, c2 = 2 * (tid & 15);
    float v[NACC][2];
#pragma unroll
    for (int i = 0; i < NACC; ++i) {
        float s0 = 0.f, s1 = 0.f;
#pragma unroll
        for (int ww = 0; ww < 8; ++ww) { s0 += PT[((i * 8 + ww) * 32 + row) * 33 + c2]; s1 += PT[((i * 8 + ww) * 32 + row) * 33 + c2 + 1]; }
        v[i][0] = s0; v[i][1] = s1;
    }
    fin(32 * tm + row, c2, v);
}

constexpr size_t WS_SSQS = WS_SSQ + 2560 * 1024;
static_assert(WS_SSQ + (size_t)MT * 16 * 4 <= WS_SSQS && WS_SSQS + 256 * 32 * 4 <= WS_FB, "ssqs map");
DI void sgemm_branch(const Ctx& C, const bf16_t* A, const bf16_t* Bt, int K, int tm, int tn) {
    unsigned char* ws = C.ws; bf16_t* MIX = (bf16_t*)(ws + WS_MIX); float* SSQS = (float*)(ws + WS_SSQS);
    sgemm_unit<1>(C, A, Bt + (size_t)32 * tn * K, nullptr, K, tm,
        [&](int row, int c2, const float (&v)[1][2]) {
            *(unsigned*)(MIX + ((size_t)MP + row) * 1024 + 32 * tn + c2) = pk2(v[0][0], v[0][1]);
            float s = v[0][0] * v[0][0] + v[0][1] * v[0][1];
            s += __shfl_xor(s, 1); s += __shfl_xor(s, 2); s += __shfl_xor(s, 4); s += __shfl_xor(s, 8);
            if ((c2 >> 1) == 0) SSQS[row * 32 + tn] = s; });
}

#ifndef MK_N_LAUNCHES
#define MK_N_LAUNCHES 1
#endif
constexpr int N_PHASES = 16;
#define REP_A 1
#define STAGGER_US 0
#define REP_X 1
#define REP_XS 1
#define EXTRA_BARS 0
#define PROBE_NULLGEMM 0
#define REP_B 1
#define REP_C 1
#define REP_PA 1
#ifndef REP_MASK
#define REP_MASK 0
#endif
#define NREP(k) (((REP_MASK) >> (k)) & 1 ? 2 : 1)

__global__ void __launch_bounds__(NTHREADS, 2) fwd_megakernel(Args args) {
    extern __shared__ __attribute__((aligned(16))) unsigned char lds_raw[];
    cg::grid_group grid = cg::this_grid();
    Ctx C;
    C.in = args.in; C.out = args.out; C.ws = args.ws;
    C.lds = (LAS unsigned char*)lds_raw;
    C.wave = __builtin_amdgcn_readfirstlane(threadIdx.x >> 6);
    C.G = gridDim.x; C.bid = blockIdx.x;
    const int lo = args.ph_lo, hi = args.ph_hi;
    unsigned char* ws = args.ws;
#define IN(k) (lo <= (k) && (k) < hi)
    volatile LAS unsigned* MISC = (volatile LAS unsigned*)(C.lds + LDS_BYTES - 64);
    const bool leader = (C.wave == 0) && (lane_id() == 0);
    if (leader) { MISC[0] = 0u; MISC[1] = 0u; }
    __syncthreads();
    XcdBarrier xbar; xbar.bar = (unsigned*)(ws + WS_CTL); xbar.x = xb_xcc_id(); xbar.st = MISC;
    if (C.bid == 0) { unsigned* cw = (unsigned*)(ws + WS_CTL); for (int i = C.wave * 64 + lane_id_here(); i < XCD_BAR_WORDS; i += NTHREADS) __hip_atomic_store(cw + i, 0u, __ATOMIC_RELAXED, __HIP_MEMORY_SCOPE_AGENT); }
#define SEAM(k) do { if (IN(k) && IN((k) + 1)) { if ((k) == 0) { grid.sync(); if ((C.wave == 0) && (lane_id() == 0)) (void)xb_add(&xbar.bar[XB_XCNT(xbar.x)], 1u); } else xcd_barrier(xbar, (C.wave == 0) && (lane_id() == 0)); } } while (0)

    if (IN(0)) for (int rep_ = 0; rep_ < NREP(0); ++rep_) { p0_prologue(C); }
    SEAM(0);
    if (IN(1)) for (int rep_ = 0; rep_ < NREP(1); ++rep_) {
        {
            if (STAGGER_US > 0 && ((C.bid >> 3) & 1)) { const unsigned long long t0 = __builtin_amdgcn_s_memrealtime(); while (__builtin_amdgcn_s_memrealtime() - t0 < (unsigned long long)(STAGGER_US * 100)) __builtin_amdgcn_s_sleep(32); }
            pg8::Gemm g{(const bf16_t*)(ws + WS_XB), (const bf16_t*)(ws + WS_WIN), MT, NIN, 1024};
            pg8::StaticOrder S; S.init(MT, NIN, C.G, C.bid);
            EpiIn E{(const float*)(ws + WS_RS), ws, args.out};
            pg8::gemm_phase<EpiIn, pg8::StaticOrder, true, true>(C.lds, g, S, E, C.wave);
        }
        {
            pg8::Gemm g{(const bf16_t*)(ws + WS_MEMB), (const bf16_t*)(ws + WS_WMKV), 1024, 2048, 1024};
            pg8::StaticOrder S; S.init(1024, 2048, C.G, C.G - 1 - C.bid);
            EpiMemKV E{(const float*)(ws + WS_RSMEM), ws, args.out};
            pg8::gemm_phase<EpiMemKV, pg8::StaticOrder, true, true>(C.lds, g, S, E, C.wave);
        }
    }
#if PROBE_NULLGEMM
    {
        pg8::Gemm g{(const bf16_t*)(ws + WS_XB), (const bf16_t*)(ws + WS_WIN), MT, NIN, 1024};
        pg8::StaticOrder S; S.init(MT, NIN, C.G, C.bid);
        EpiNull E{(float*)(ws + WS_SSQ)};
        pg8::gemm_phase<EpiNull, pg8::StaticOrder, true, true>(C.lds, g, S, E, C.wave);
    }
#endif
    SEAM(1);
#if EXTRA_BARS
    for (int q_ = 0; q_ < EXTRA_BARS; ++q_) xcd_barrier(xbar, (C.wave == 0) && (lane_id() == 0));
#endif
    if (IN(2)) for (int rep_ = 0; rep_ < NREP(2); ++rep_) {
        LDS_BARRIER();
        attn_bias_tables(C, C.wave * 64 + lane_id_here());
        LDS_BARRIER();
        const bool rev = ((C.bid >> 3) & 1) != 0;
        for (int ord = 0; ord < 4; ++ord) {
            const int kind = rev ? 3 - ord : ord;
            if (kind == 0) {
                const int per = (1536 + C.G - 1) / C.G, i0 = C.bid * per, i1 = (i0 + per) < 1536 ? (i0 + per) : 1536;
                for (int q_ = 0; q_ < REP_A; ++q_) for (int it = i0; it < i1; ++it) attn_prompt_item(C, it);
            } else if (kind == 1) {
                for (int q_ = 0; q_ < REP_B; ++q_) for (int it = C.bid; it < 384; it += C.G) attn_sample_item(C, it / 12, (it % 12) & 3, (it % 12) >> 2);
            } else if (kind == 2) {
                for (int it = C.G - 1 - C.bid; it < 128; it += C.G) { for (int q_ = 0; q_ < REP_C; ++q_) gla_sample_item(C, it >> 2, it & 3); }
            } else {
                LDS_BARRIER();
                for (int q_ = 0; q_ < REP_PA; ++q_) for (int u = C.bid; u < NUNIT; u += C.G) gla_pass_a_unit(C, u);
                LDS_BARRIER();
                attn_bias_tables(C, C.wave * 64 + lane_id_here());
                LDS_BARRIER();
            }
        }
    }
    SEAM(2);
    if (IN(3)) for (int rep_ = 0; rep_ < NREP(3); ++rep_) {
        gla_pass_b(C);
        const int gid = C.bid * NTHREADS + C.wave * 64 + lane_id_here();
        for (int id = gid; id < MT * 64; id += C.G * NTHREADS) attn_combine_chunk(ws, (size_t)(id >> 6), (id >> 4) & 3, id & 15);
    }
    SEAM(3);
    if (IN(4)) for (int rep_ = 0; rep_ < NREP(4); ++rep_) { gla_pass_c(C); }
    if (IN(5)) { }
    SEAM(5);
    if (IN(6)) for (int rep_ = 0; rep_ < NREP(6); ++rep_) {
        for (int u = C.bid; u < 256; u += C.G) {
            const int tm = u >> 5, tn = u & 31;
            const bf16_t* SGA = (const bf16_t*)(ws + WS_SGA); const bf16_t* SGBT = (const bf16_t*)(ws + WS_SGBT);
            bf16_t* TMP = (bf16_t*)(ws + WS_TMP); bf16_t* MIXIN = (bf16_t*)(ws + WS_MIXIN);
            sgemm_unit<1>(C, (const bf16_t*)(ws + WS_YAIN) + (size_t)MP * 1536, (const bf16_t*)(ws + WS_WPA) + (size_t)32 * tn * 1536, nullptr, 512, tm,
                [&](int row, int c2, const float (&v)[1][2]) { const size_t o = ((size_t)MP + row) * 1024 + 32 * tn + c2; const unsigned g = *(const unsigned*)(SGA + o);
                    *(unsigned*)(TMP + o) = pk2(bflo(g) * v[0][0], bfhi(g) * v[0][1]); }, 1536, 1536);
            sgemm_unit<1>(C, (const bf16_t*)(ws + WS_YAIN) + (size_t)MP * 1536 + 512, (const bf16_t*)(ws + WS_WPA) + (size_t)32 * tn * 1536 + 512, nullptr, 1024, tm,
                [&](int row, int c2, const float (&v)[1][2]) { const size_t o = ((size_t)MP + row) * 1024 + 32 * tn + c2; const unsigned g = *(const unsigned*)(SGBT + o), t = *(const unsigned*)(TMP + o);
                    *(unsigned*)(MIXIN + o) = pk2(bflo(t) + bflo(g) * v[0][0], bfhi(t) + bfhi(g) * v[0][1]); }, 1536, 1536);
        }
        LDS_BARRIER();
        {
            pg8::Gemm g{(const bf16_t*)(ws + WS_YAIN), (const bf16_t*)(ws + WS_WPA), MP, 1024, 1536};
            pg8::StaticOrder S; S.init(MP, 1024, C.G, C.bid);
            EpiGate2 E{(const bf16_t*)(ws + WS_SGA), (const bf16_t*)(ws + WS_SGBT), (bf16_t*)(ws + WS_MIXIN), 8};
            pg8::gemm_phase<EpiGate2, pg8::StaticOrder, true, true>(C.lds, g, S, E, C.wave);
        }
    }
    SEAM(6);
    if (IN(7)) for (int rep_ = 0; rep_ < NREP(7); ++rep_) {
        for (int u = C.bid; u < 256; u += C.G) sgemm_branch(C, (const bf16_t*)(ws + WS_MIXIN) + (size_t)MP * 1024, (const bf16_t*)(ws + WS_WOUT), 1024, u >> 5, u & 31);
        LDS_BARRIER();
        pg8::Gemm g{(const bf16_t*)(ws + WS_MIXIN), (const bf16_t*)(ws + WS_WOUT), MP, 1024, 1024};
        pg8::StaticOrder S; S.init(MP, 1024, C.G, C.bid);
        EpiBranch E{(bf16_t*)(ws + WS_MIX), (float*)(ws + WS_SSQ)};
        pg8::gemm_phase<EpiBranch, pg8::StaticOrder, true, true>(C.lds, g, S, E, C.wave);
    }
    SEAM(7);
    if (IN(8)) for (int rep_ = 0; rep_ < NREP(8); ++rep_) resid_pass<true, false>(C, args.in[10]);
    SEAM(8);
    if (IN(9)) for (int rep_ = 0; rep_ < NREP(9); ++rep_) {
        for (int u = C.bid; u < 256; u += C.G) {
            const int tm = u >> 5, tn = u & 31; const float* RS = (const float*)(ws + WS_RS); bf16_t* Q2 = (bf16_t*)(ws + WS_Q2);
            sgemm_unit<1>(C, (const bf16_t*)(ws + WS_XB) + (size_t)MP * 1024, (const bf16_t*)(ws + WS_WMQ) + (size_t)32 * tn * 1024, nullptr, 1024, tm,
                [&](int row, int c2, const float (&v)[1][2]) { const float r = RS[MP + row] * Q2_SCALE; *(unsigned*)(Q2 + ((size_t)MP + row) * 1024 + 32 * tn + c2) = pk2(v[0][0] * r, v[0][1] * r); });
        }
        LDS_BARRIER();
        pg8::Gemm g{(const bf16_t*)(ws + WS_XB), (const bf16_t*)(ws + WS_WMQ), MP, 1024, 1024};
        pg8::StaticOrder S; S.init(MP, 1024, C.G, C.bid);
        EpiRowScale E{(const float*)(ws + WS_RS), (bf16_t*)(ws + WS_Q2), Q2_SCALE};
        pg8::gemm_phase<EpiRowScale, pg8::StaticOrder, true, true>(C.lds, g, S, E, C.wave);
    }
    SEAM(9);
    if (IN(10)) for (int rep_ = 0; rep_ < NREP(10); ++rep_) {
        const bool rev10 = ((C.bid >> 3) & 1) != 0;
        const bool xs = C.G == 256;
#define XS_IT(i) (xs ? 2 * (((i) & 7) * 16 + (((i) >> 3) & 15)) + ((i) >> 7) : (i))
#define XP_IT(i) (xs ? ((((i) & 7) + 8 * ((i) >> 8)) << 5) | (((i) >> 3) & 31) : (i))
        if (!rev10) { for (int q_ = 0; q_ < REP_XS; ++q_) for (int i = C.bid; i < 256; i += C.G) { const int it = XS_IT(i); xattn_sample_item(C, it >> 3, (it >> 1) & 3, it & 1); } }
        for (int q_ = 0; q_ < REP_X; ++q_) for (int i = C.bid; i < 512; i += C.G) xattn_prompt_item(C, XP_IT(i));
        if (rev10) { for (int q_ = 0; q_ < REP_XS; ++q_) for (int i = C.bid; i < 256; i += C.G) { const int it = XS_IT(i); xattn_sample_item(C, it >> 3, (it >> 1) & 3, it & 1); } }
#undef XS_IT
#undef XP_IT
    }
    SEAM(10);
    if (IN(11)) for (int rep_ = 0; rep_ < NREP(11); ++rep_) {
        for (int u = C.bid; u < 256; u += C.G) sgemm_branch(C, (const bf16_t*)(ws + WS_O2) + (size_t)MP * 1024, (const bf16_t*)(ws + WS_WMO), 1024, u >> 5, u & 31);
        LDS_BARRIER();
        pg8::Gemm g{(const bf16_t*)(ws + WS_O2), (const bf16_t*)(ws + WS_WMO), MP, 1024, 1024};
        pg8::StaticOrder S; S.init(MP, 1024, C.G, C.bid);
        EpiBranch E{(bf16_t*)(ws + WS_MIX), (float*)(ws + WS_SSQ)};
        pg8::gemm_phase<EpiBranch, pg8::StaticOrder, true, true>(C.lds, g, S, E, C.wave);
    }
    SEAM(11);
    if (IN(12)) resid_pass<false, false>(C, args.in[22]);
    SEAM(12);
    if (IN(13)) for (int rep_ = 0; rep_ < NREP(13); ++rep_) {
        for (int u = C.bid; u < 704; u += C.G) {
            const int tm = u / 88, tg = u % 88, jj = (32 * tg) >> 7, off = (32 * tg) & 127; const float* RS = (const float*)(ws + WS_RS); bf16_t* H = (bf16_t*)(ws + WS_H);
            const bf16_t* WG = (const bf16_t*)(ws + WS_WGU) + (size_t)(256 * jj + off) * 1024;
            sgemm_unit<2>(C, (const bf16_t*)(ws + WS_XB) + (size_t)MP * 1024, WG, WG + (size_t)128 * 1024, 1024, tm,
                [&](int row, int c2, const float (&v)[2][2]) { const float r = RS[MP + row]; const float g0 = v[0][0] * r, g1 = v[0][1] * r;
                    *(unsigned*)(H + ((size_t)MP + row) * DFF + 32 * tg + c2) = pk2(g0 * fsigmoid(g0) * (v[1][0] * r), g1 * fsigmoid(g1) * (v[1][1] * r)); });
        }
        LDS_BARRIER();
        pg8::Gemm g{(const bf16_t*)(ws + WS_XB), (const bf16_t*)(ws + WS_WGU), MP, 2 * DFF, 1024};
        pg8::StaticOrder S; S.init(MP, 2 * DFF, C.G, C.bid);
        EpiGateUp E{(const float*)(ws + WS_RS), (bf16_t*)(ws + WS_H)};
        pg8::gemm_phase<EpiGateUp, pg8::StaticOrder, true, true>(C.lds, g, S, E, C.wave);
    }
    SEAM(13);
    if (IN(14)) for (int rep_ = 0; rep_ < NREP(14); ++rep_) {
        for (int u = C.bid; u < 256; u += C.G) sgemm_branch(C, (const bf16_t*)(ws + WS_H) + (size_t)MP * DFF, (const bf16_t*)(ws + WS_WDN), DFF, u >> 5, u & 31);
        LDS_BARRIER();
        pg8::Gemm g{(const bf16_t*)(ws + WS_H), (const bf16_t*)(ws + WS_WDN), MP, 1024, DFF};
        pg8::StaticOrder S; S.init(MP, 1024, C.G, C.bid);
        EpiBranch E{(bf16_t*)(ws + WS_MIX), (float*)(ws + WS_SSQ)};
        pg8::gemm_phase<EpiBranch, pg8::StaticOrder, true, true>(C.lds, g, S, E, C.wave);
    }
    SEAM(14);
    if (IN(15)) resid_pass<false, true>(C, args.in[26]);
#undef IN
#undef SEAM
}

extern "C" void kernel_launch(void* const* d_in, const int* in_sizes, int n_in, void* d_out, int out_size, void* d_ws, size_t ws_size, hipStream_t stream) {
    static int grid = 0;
    if (grid == 0) {
        if (n_in != 30 || out_size != (int)O_TOTAL || ws_size < WS_END2) {
            fprintf(stderr, "kernel_launch: unexpected problem (n_in %d, out %d, ws %zu; need ws >= %zu); nothing launched\n", n_in, out_size, ws_size, (size_t)WS_END2);
            grid = -1; return;
        }
        int dev = 0, cus = 0, per_cu = 0;
        (void)hipGetDevice(&dev);
        (void)hipDeviceGetAttribute(&cus, hipDeviceAttributeMultiprocessorCount, dev);
        (void)hipFuncSetAttribute((const void*)fwd_megakernel, hipFuncAttributeMaxDynamicSharedMemorySize, LDS_BYTES);
        (void)hipOccupancyMaxActiveBlocksPerMultiprocessor(&per_cu, (const void*)fwd_megakernel, NTHREADS, LDS_BYTES);
        if (per_cu < 1) { fprintf(stderr, "kernel_launch: occupancy query says %d blocks per CU\n", per_cu); per_cu = 1; }
        (void)hipGetLastError();
        grid = cus;
        if (grid > 256) grid = 256;
    }
    if (grid < 0) return;
    Args a{};
    for (int i = 0; i < 30; ++i) a.in[i] = (const float*)d_in[i];
    a.out = (float*)d_out; a.ws = (unsigned char*)d_ws;
#if MK_N_LAUNCHES == 1
    a.ph_lo = 0; a.ph_hi = N_PHASES;
    void* kargs[] = {&a};
    hipError_t e = hipLaunchCooperativeKernel((const void*)fwd_megakernel, dim3(grid), dim3(NTHREADS), kargs, LDS_BYTES, stream);
    if (e != hipSuccess) fprintf(stderr, "cooperative launch failed: %s (grid %d)\n", hipGetErrorString(e), grid);
#else
    for (int p = 0; p < N_PHASES; ++p) {
        a.ph_lo = p; a.ph_hi = p + 1;
        hipLaunchKernelGGL(fwd_megakernel, dim3(grid), dim3(NTHREADS), LDS_BYTES, stream, a);
    }
#endif
}
```

```cpp
#include <hip/hip_runtime.h>
#include <hip/hip_cooperative_groups.h>
#include <cstdio>
#include <cstdint>
namespace cg = cooperative_groups;
#define LAS __attribute__((address_space(3)))
namespace pg8 {
#define PG8_LAS __attribute__((address_space(3)))
typedef unsigned short bf16_t;
typedef short bf16x8 __attribute__((ext_vector_type(8)));
typedef float f32x4 __attribute__((ext_vector_type(4)));
typedef unsigned u32x4 __attribute__((ext_vector_type(4)));
constexpr int BM = 256, BK = 64, HALF = 128, HTB = HALF * BK * 2  , STAGE_BYTES = 8 * HTB, NXCD = 8, WGM = 8;

__host__ __device__ __forceinline__ int lds_byte(int r, int c) { const int st = (r >> 4) * 2 + (c >> 5), rr = r & 15, cc = c & 31, ob = rr * 64 + cc * 2; return st * 1024 + (ob ^ (((ob >> 9) & 1) << 5)); }
__host__ __device__ __forceinline__ void stage_rc(int b, int& R, int& C) { const int st = b / 1024, sb = b % 1024, swz = sb ^ (((sb >> 9) & 1) << 5); R = (st >> 1) * 16 + swz / 64; C = (st & 1) * 32 + (swz % 64) / 2; }
__host__ __device__ __forceinline__ int perm32(int rho) { const int n = rho >> 4, i = rho & 15; return 8 * (i >> 2) + 4 * n + (i & 3); }

struct Unit { int pm, pn; };
struct Gemm { const bf16_t* A; const bf16_t* Bt; int M, N, K; };

struct StaticOrder {
    int nM, nN, nwg, G, c;
    __host__ __device__ void init(int M, int N, int G_, int c_) { nM = M / BM; nN = N / BM; nwg = nM * nN; G = G_; c = c_; }
    __host__ __device__ bool next(int i, Unit& u) const {
        const long L = (long)i * G + c; if (L >= nwg) return false;
        int wgid = (int)L; { const int q = nwg / NXCD, r = nwg % NXCD, xcd = wgid % NXCD, off = wgid / NXCD; wgid = (xcd < r ? xcd * (q + 1) : r * (q + 1) + (xcd - r) * q) + off; }
        const int nig = WGM * nN, gid = wgid / nig, fm = gid * WGM, gsz = (nM - fm) < WGM ? (nM - fm) : WGM;
        u.pm = fm + ((wgid % nig) % gsz); u.pn = (wgid % nig) / gsz; return true;
    }
    __device__ __forceinline__ void a_ready(const Unit&) const {}
    __device__ __forceinline__ void done(const Unit&) const {}
};

__device__ __forceinline__ unsigned cvt_pk_bf16(float lo, float hi) { unsigned r; asm volatile("v_cvt_pk_bf16_f32 %0, %1, %2" : "=v"(r) : "v"(lo), "v"(hi)); return r; }
typedef float f32x2 __attribute__((ext_vector_type(2)));
__device__ __forceinline__ f32x2 gelu_pk(f32x2 v) {
    const f32x2 av = __builtin_elementwise_abs(v), d = av * 0.2316418882f + 1.0f;
    f32x2 t; t.x = __builtin_amdgcn_rcpf(d.x); t.y = __builtin_amdgcn_rcpf(d.y);
    f32x2 q = t * 0.5307027145f + (-0.7265760135f); q = q * t + 0.7107068705f; q = q * t + (-0.142248368f); q = q * t + 0.127414796f; q = q * t;
    const f32x2 s = (v * v) * (-0.72134752044f);
    f32x2 e; e.x = __builtin_amdgcn_exp2f(s.x); e.y = __builtin_amdgcn_exp2f(s.y);
    const f32x2 m = v * (q * e), r = v - m;
    f32x2 o; o.x = v.x < 0.f ? m.x : r.x; o.y = v.y < 0.f ? m.y : r.y; return o;
}

template <int ACT  > struct EpiBf16 {
    static constexpr bool PERM = true, AFTER_DRAIN = false, HAS_MID = false; static_assert(ACT == 0 || ACT == 1, "EpiBf16: ACT is 0 (none) or 1 (gelu_pk)");
    bf16_t* O; int ldc; const float* bias; int split_cols; size_t split_stride; float scale0;
    __device__ __forceinline__ void operator()(const f32x4 (&acc)[2][2][4][2], const Unit& u, int wr, int wc, int fr, int fq) const {
        const int row0 = u.pm * BM + wr * 64 + fr; int colt = u.pn * BM; bf16_t* base = O;
        float sc = 1.f; if (split_cols) { const int t = colt / split_cols; base += (size_t)t * split_stride; colt -= t * split_cols; if (t == 0) sc = scale0; }
        const int col0 = colt + wc * 32 + 8 * fq, bcol0 = u.pn * BM + wc * 32 + 8 * fq;
        f32x4 bv[2][2];
#pragma unroll
        for (int bj = 0; bj < 2; ++bj)
#pragma unroll
            for (int n = 0; n < 2; ++n) bv[bj][n] = bias ? *(const f32x4*)(bias + bcol0 + bj * HALF + 4 * n) : (f32x4){0.f, 0.f, 0.f, 0.f};
#pragma unroll
        for (int ai = 0; ai < 2; ++ai)
#pragma unroll
            for (int m = 0; m < 4; ++m) { bf16_t* rowp = base + (size_t)(row0 + ai * HALF + m * 16) * ldc + col0;
#pragma unroll
                for (int bj = 0; bj < 2; ++bj) { f32x4 v0 = acc[ai][bj][m][0] + bv[bj][0], v1 = acc[ai][bj][m][1] + bv[bj][1];
                    if (ACT == 1) { f32x2 a = gelu_pk((f32x2){v0[0], v0[1]}), b = gelu_pk((f32x2){v0[2], v0[3]}), c = gelu_pk((f32x2){v1[0], v1[1]}), d = gelu_pk((f32x2){v1[2], v1[3]});
                        v0 = (f32x4){a.x, a.y, b.x, b.y}; v1 = (f32x4){c.x, c.y, d.x, d.y}; }
                    v0 = v0 * sc; v1 = v1 * sc; u32x4 w; w.x = cvt_pk_bf16(v0[0], v0[1]); w.y = cvt_pk_bf16(v0[2], v0[3]); w.z = cvt_pk_bf16(v1[0], v1[1]); w.w = cvt_pk_bf16(v1[2], v1[3]);
                    *(u32x4*)(rowp + bj * HALF) = w; } }
    }
};

struct PanelStats {
    unsigned* xbuf;
    unsigned* cnt;
    unsigned* tmo;
    int ntn; float eps;
    unsigned code;
    __device__ __forceinline__ bool run(const f32x4 (&v)[2][2][4][2], const Unit& u, int wr, int wc, int fr, int fq, PG8_LAS unsigned char* lds, int wid, int lane) const {
        typedef float f32x2v __attribute__((ext_vector_type(2)));
        PG8_LAS f32x2v* P = (PG8_LAS f32x2v*)lds;
        PG8_LAS f32x2v* S = (PG8_LAS f32x2v*)(lds + 8192);
        PG8_LAS unsigned* flag = (PG8_LAS unsigned*)(lds + 8192 + 2048);
#pragma unroll
        for (int ai = 0; ai < 2; ++ai)
#pragma unroll
            for (int m = 0; m < 4; ++m) {
                float s = 0.f;
#pragma unroll
                for (int bj = 0; bj < 2; ++bj)
#pragma unroll
                    for (int n = 0; n < 2; ++n) { const f32x4 x = v[ai][bj][m][n]; s += (x[0] + x[1]) + (x[2] + x[3]); }
                s += __shfl_xor(s, 16); s += __shfl_xor(s, 32);
                const float mw = s * (1.0f / 64.0f); float q = 0.f;
#pragma unroll
                for (int bj = 0; bj < 2; ++bj)
#pragma unroll
                    for (int n = 0; n < 2; ++n) { const f32x4 d = v[ai][bj][m][n] - mw; q += (d[0] * d[0] + d[1] * d[1]) + (d[2] * d[2] + d[3] * d[3]); }
                q += __shfl_xor(q, 16); q += __shfl_xor(q, 32);
                if (fq == 0) P[(ai * HALF + wr * 64 + m * 16 + fr) * 4 + wc] = (f32x2v){mw, q};
            }
        asm volatile("s_waitcnt lgkmcnt(0)" ::: "memory"); __builtin_amdgcn_s_barrier(); asm volatile("" ::: "memory");
#if defined(BROKEN_EXCHANGE_NO_WAIT)
#warning BROKEN CONTROL BUILD: the row-statistics exchange does not wait; results are wrong by design
        if (blockIdx.x >= 64) { const long long t0_ = clock64(); while (clock64() - t0_ < 60000) __builtin_amdgcn_s_sleep(8); }
#endif
        const int row = wid * 32 + (lane & 31);
        if (lane < 32) {
            const f32x2v a = P[row * 4 + 0], b = P[row * 4 + 1], c = P[row * 4 + 2], d = P[row * 4 + 3];
            const float mt = (a.x + b.x + c.x + d.x) * 0.25f;
            const float da = a.x - mt, db = b.x - mt, dc = c.x - mt, dd = d.x - mt;
            const float m2 = (a.y + b.y) + (c.y + d.y) + 64.0f * ((da * da + db * db) + (dc * dc + dd * dd));
            unsigned long long* slot = (unsigned long long*)xbuf + ((size_t)(u.pm * BM + row) * 4 + u.pn);
            __hip_atomic_store(slot, ((unsigned long long)__float_as_uint(m2) << 32) | __float_as_uint(mt), __ATOMIC_RELAXED, __HIP_MEMORY_SCOPE_AGENT);
        }
        asm volatile("s_waitcnt vmcnt(0)" ::: "memory");
        if (lane == 0) __hip_atomic_fetch_add(cnt + 64 * u.pm, 1u, __ATOMIC_RELAXED, __HIP_MEMORY_SCOPE_AGENT);
        if (wid == 0) {
            bool dead = false; const unsigned long long t0 = __builtin_amdgcn_s_memrealtime(); const unsigned want = 8u * (unsigned)ntn;
            for (;;) {
#if defined(BROKEN_EXCHANGE_NO_WAIT)
                break;
#endif
                if ((unsigned)__builtin_amdgcn_readfirstlane(__hip_atomic_load(cnt + 64 * u.pm, __ATOMIC_RELAXED, __HIP_MEMORY_SCOPE_AGENT)) >= want) break;
                if (__builtin_amdgcn_s_memrealtime() - t0 > 2000000ull) {
                    if (lane == 0) { unsigned expect = 0u; __hip_atomic_compare_exchange_strong(tmo + 1, &expect, code | (unsigned)(u.pm & 0xff), __ATOMIC_RELAXED, __ATOMIC_RELAXED, __HIP_MEMORY_SCOPE_AGENT);
                                     __hip_atomic_store(tmo, 1u, __ATOMIC_RELAXED, __HIP_MEMORY_SCOPE_AGENT); }
                    dead = true; break; }
                __builtin_amdgcn_s_sleep(2);
            }
            __builtin_amdgcn_fence(__ATOMIC_ACQUIRE, "agent");
            if (lane == 0) flag[0] = dead ? 1u : 0u;
        }
        asm volatile("s_waitcnt vmcnt(0) lgkmcnt(0)" ::: "memory"); __builtin_amdgcn_s_barrier(); asm volatile("" ::: "memory");
        const bool bad = flag[0] != 0u;
        if (lane < 32) {
            const unsigned long long* slot = (const unsigned long long*)xbuf + (size_t)(u.pm * BM + row) * 4; float mt[4], m2[4]; float ms = 0.f;
#pragma unroll
            for (int t = 0; t < 4; ++t) { if (t < ntn) { const unsigned long long w = __hip_atomic_load(slot + t, __ATOMIC_RELAXED, __HIP_MEMORY_SCOPE_AGENT); mt[t] = __uint_as_float((unsigned)w); m2[t] = __uint_as_float((unsigned)(w >> 32)); } else { mt[t] = 0.f; m2[t] = 0.f; } ms += mt[t]; }
            const float mean = ms / (float)ntn; float q = 0.f;
#pragma unroll
            for (int t = 0; t < 4; ++t) if (t < ntn) { const float dm = mt[t] - mean; q += m2[t] + 256.0f * dm * dm; }
            S[row] = (f32x2v){mean, 1.0f / sqrtf(q / (256.0f * (float)ntn) + eps)};
        }
        asm volatile("s_waitcnt lgkmcnt(0)" ::: "memory"); __builtin_amdgcn_s_barrier(); asm volatile("" ::: "memory");
        return bad;
    }
};
struct EpiLnRes {
    static constexpr bool PERM = false, AFTER_DRAIN = true, HAS_MID = false;
    const float* base; float* out; int ldc; const float* bias; PanelStats st; unsigned poison;
    __device__ __forceinline__ void fused(f32x4 (&acc)[2][2][4][2], const Unit& u, int wr, int wc, int fr, int fq, PG8_LAS unsigned char* lds, int wid, int lane) const {
        typedef float f32x2v __attribute__((ext_vector_type(2)));
        const PG8_LAS f32x2v* S = (const PG8_LAS f32x2v*)(lds + 8192);
        const int col0 = u.pn * BM + wc * 32 + 4 * fq;
#pragma unroll
        for (int bj = 0; bj < 2; ++bj)
#pragma unroll
            for (int n = 0; n < 2; ++n) { const f32x4 bv = bias ? *(const f32x4*)(bias + col0 + bj * HALF + n * 16) : (f32x4){0.f, 0.f, 0.f, 0.f};
#pragma unroll
                for (int ai = 0; ai < 2; ++ai)
#pragma unroll
                    for (int m = 0; m < 4; ++m) acc[ai][bj][m][n] += bv; }
        f32x4 pre[4][2][2];
#pragma unroll
        for (int m = 0; m < 4; ++m) { const size_t off = (size_t)(u.pm * BM + wr * 64 + m * 16 + fr) * ldc + col0;
#pragma unroll
            for (int bj = 0; bj < 2; ++bj)
#pragma unroll
                for (int n = 0; n < 2; ++n) pre[m][bj][n] = *(const f32x4*)(base + off + bj * HALF + n * 16); }
        const bool bad = st.run(acc, u, wr, wc, fr, fq, lds, wid, lane) || poison != 0u;
        const float qnan = __builtin_nanf("");
#pragma unroll
        for (int ai = 0; ai < 2; ++ai)
#pragma unroll
            for (int m = 0; m < 4; ++m) { const int r = ai * HALF + wr * 64 + m * 16 + fr; const f32x2v sr = S[r]; const size_t off = (size_t)(u.pm * BM + r) * ldc + col0;
#pragma unroll
                for (int bj = 0; bj < 2; ++bj)
#pragma unroll
                    for (int n = 0; n < 2; ++n) { const f32x4 bs = ai == 0 ? pre[m][bj][n] : *(const f32x4*)(base + off + bj * HALF + n * 16); f32x4 o = bs + (acc[ai][bj][m][n] - sr.x) * sr.y;
                        if (bad) o = (f32x4){qnan, qnan, qnan, qnan}; *(f32x4*)(out + off + bj * HALF + n * 16) = o; }
                if (m & 1) asm volatile("" ::: "memory"); }
    }
};
struct EpiLnResLn {
    static constexpr bool PERM = false, AFTER_DRAIN = true, HAS_MID = false;
    const float* base; float* out; bf16_t* xn; int ldc; const float* bias; PanelStats st1, st2; unsigned poison;
    __device__ __forceinline__ void fused(f32x4 (&acc)[2][2][4][2], const Unit& u, int wr, int wc, int fr, int fq, PG8_LAS unsigned char* lds, int wid, int lane) const {
        typedef float f32x2v __attribute__((ext_vector_type(2))); typedef unsigned u32x2v __attribute__((ext_vector_type(2)));
        const PG8_LAS f32x2v* S = (const PG8_LAS f32x2v*)(lds + 8192);
        const int col0 = u.pn * BM + wc * 32 + 4 * fq;
#pragma unroll
        for (int bj = 0; bj < 2; ++bj)
#pragma unroll
            for (int n = 0; n < 2; ++n) { const f32x4 bv = bias ? *(const f32x4*)(bias + col0 + bj * HALF + n * 16) : (f32x4){0.f, 0.f, 0.f, 0.f};
#pragma unroll
                for (int ai = 0; ai < 2; ++ai)
#pragma unroll
                    for (int m = 0; m < 4; ++m) acc[ai][bj][m][n] += bv; }
        bool bad = st1.run(acc, u, wr, wc, fr, fq, lds, wid, lane) || poison != 0u;
        const float qnan = __builtin_nanf("");
#pragma unroll
        for (int ai = 0; ai < 2; ++ai)
#pragma unroll
            for (int m = 0; m < 4; ++m) { const int r = ai * HALF + wr * 64 + m * 16 + fr; const f32x2v sr = S[r]; const size_t off = (size_t)(u.pm * BM + r) * ldc + col0;
#pragma unroll
                for (int bj = 0; bj < 2; ++bj)
#pragma unroll
                    for (int n = 0; n < 2; ++n) { const f32x4 bs = *(const f32x4*)(base + off + bj * HALF + n * 16); acc[ai][bj][m][n] = bs + (acc[ai][bj][m][n] - sr.x) * sr.y; }
                asm volatile("" : "+v"(acc[ai][0][m][0]), "+v"(acc[ai][0][m][1]), "+v"(acc[ai][1][m][0]), "+v"(acc[ai][1][m][1]));
                if (m & 1) asm volatile("" ::: "memory"); }
        const bool bad1 = bad;
        bad = st2.run(acc, u, wr, wc, fr, fq, lds, wid, lane) || bad;
#pragma unroll
        for (int ai = 0; ai < 2; ++ai)
#pragma unroll
            for (int m = 0; m < 4; ++m) { const int r = ai * HALF + wr * 64 + m * 16 + fr; const f32x2v sr = S[r]; const size_t off = (size_t)(u.pm * BM + r) * ldc + col0;
#pragma unroll
                for (int bj = 0; bj < 2; ++bj)
#pragma unroll
                    for (int n = 0; n < 2; ++n) { const f32x4 x1 = acc[ai][bj][m][n]; *(f32x4*)(out + off + bj * HALF + n * 16) = bad1 ? (f32x4){qnan, qnan, qnan, qnan} : x1;
                        const f32x4 o = (x1 - sr.x) * sr.y; u32x2v w; w.x = cvt_pk_bf16(o[0], o[1]); w.y = cvt_pk_bf16(o[2], o[3]);
                        if (bad) { w.x = 0x7fc07fc0u; w.y = 0x7fc07fc0u; } *(u32x2v*)(xn + off + bj * HALF + n * 16) = w; }
                asm volatile("" ::: "memory"); }
    }
};

template <class Epi, class Sched, bool ALIGN_EPI = false, bool SP2 = false>
__device__ __forceinline__ void gemm_phase(PG8_LAS unsigned char* lds, const Gemm g, const Sched& S, const Epi& E, const int wave_id) {
    const int lane = __builtin_amdgcn_mbcnt_hi(~0u, __builtin_amdgcn_mbcnt_lo(~0u, 0u)), wid = wave_id, tid = wid * 64 + lane, wr = wid >> 2, wc = wid & 3, fr = lane & 15, fq = lane >> 4;
    const int K = g.K, nt = K / BK;
    unsigned voffA[2], voffB[2];
#pragma unroll
    for (int i = 0; i < 2; ++i) { int R, C; stage_rc(tid * 16 + i * 8192, R, C); const int Rb = Epi::PERM ? ((R & ~31) + perm32(R & 31)) : R;
        voffA[i] = (unsigned)(R * K + C) * 2u; voffB[i] = (unsigned)(Rb * K + C) * 2u; }
    const size_t kstep = (size_t)(BK * 2);
    const size_t hstep = (size_t)HALF * K * 2;
    const size_t tstep = 2 * hstep;
    const unsigned ldsw = (unsigned)wid * 1024u;
    const int aoff = lds_byte(wr * 64 + fr, fq * 8), boff = lds_byte(wc * 32 + fr, fq * 8);
#define PG8_SA(b, h) (((b) * 2 + (h)) * HTB)
#define PG8_SB(b, h) ((4 + (b) * 2 + (h)) * HTB)
#define PG8_STAGE(bufoff, gbase, voff) do { _Pragma("unroll") for (int _i = 0; _i < 2; ++_i) \
        __builtin_amdgcn_global_load_lds((const unsigned*)((const char*)(gbase) + (voff)[_i]), (PG8_LAS unsigned*)(lds + (bufoff) + ldsw + _i * 8192), 16, 0, 0); } while (0)
#define PG8_LDA(dst, b, h) do { _Pragma("unroll") for (int m = 0; m < 4; ++m) _Pragma("unroll") for (int k = 0; k < 2; ++k) dst[m][k] = *(const PG8_LAS bf16x8*)(lds + PG8_SA(b, h) + aoff + m * 2048 + k * 1024); } while (0)
#define PG8_LDB(dst, b, h) do { _Pragma("unroll") for (int n = 0; n < 2; ++n) _Pragma("unroll") for (int k = 0; k < 2; ++k) dst[n][k] = *(const PG8_LAS bf16x8*)(lds + PG8_SB(b, h) + boff + n * 2048 + k * 1024); } while (0)
#define PG8_MMA(ai, bj, At, Bt) do { __builtin_amdgcn_s_setprio(1); _Pragma("unroll") for (int m = 0; m < 4; ++m) _Pragma("unroll") for (int n = 0; n < 2; ++n) _Pragma("unroll") for (int k = 0; k < 2; ++k) \
        acc[ai][bj][m][n] = __builtin_amdgcn_mfma_f32_16x16x32_bf16(Bt[n][k], At[m][k], acc[ai][bj][m][n], 0, 0, 0); __builtin_amdgcn_s_setprio(0); } while (0)
#define PG8_WAIT_V(n) asm volatile("s_waitcnt vmcnt(" #n ")" ::: "memory")
#define PG8_WAIT_L(n) asm volatile("s_waitcnt lgkmcnt(" #n ")" ::: "memory")
#define PG8_BAR __builtin_amdgcn_s_barrier()
#define PG8_SCHED __builtin_amdgcn_sched_barrier(0)
    Unit cur, nxt; int ui = 0;
    if (!S.next(0, cur)) return;
    f32x4 acc[2][2][4][2];
#pragma unroll
    for (int a = 0; a < 2; ++a)
#pragma unroll
        for (int b = 0; b < 2; ++b)
#pragma unroll
            for (int m = 0; m < 4; ++m)
#pragma unroll
                for (int n = 0; n < 2; ++n) acc[a][b][m][n] = (f32x4){0.f, 0.f, 0.f, 0.f};
    bf16x8 At[4][2], B0[2][2], B1[2][2];
    const char* cA = (const char*)g.A + (size_t)cur.pm * tstep; const char* cB = (const char*)g.Bt + (size_t)cur.pn * tstep;
    S.a_ready(cur);
    if constexpr (SP2) {
        PG8_STAGE(PG8_SB(0, 0), cB, voffB); PG8_STAGE(PG8_SB(0, 1), cB + hstep, voffB); PG8_STAGE(PG8_SA(0, 0), cA, voffA); PG8_STAGE(PG8_SA(0, 1), cA + hstep, voffA);
        if (wr == 1) PG8_BAR;
        PG8_WAIT_V(2); PG8_BAR;
        PG8_STAGE(PG8_SB(1, 0), cB + kstep, voffB); PG8_STAGE(PG8_SA(1, 0), cA + kstep, voffA); PG8_STAGE(PG8_SB(1, 1), cB + hstep + kstep, voffB);
        PG8_WAIT_V(6); PG8_BAR;
    } else {
        PG8_STAGE(PG8_SB(0, 0), cB, voffB); PG8_STAGE(PG8_SA(0, 0), cA, voffA); PG8_STAGE(PG8_SB(0, 1), cB + hstep, voffB); PG8_STAGE(PG8_SA(0, 1), cA + hstep, voffA);
        if (wr == 1) PG8_BAR;
        PG8_WAIT_V(4); PG8_BAR;
        PG8_STAGE(PG8_SB(1, 0), cB + kstep, voffB); PG8_STAGE(PG8_SA(1, 0), cA + kstep, voffA); PG8_STAGE(PG8_SB(1, 1), cB + hstep + kstep, voffB);
        PG8_WAIT_V(6); PG8_BAR;
    }
    for (;;) {
        const bool has_next = S.next(ui + 1, nxt);
        const char* nA = has_next ? (const char*)g.A + (size_t)nxt.pm * tstep : cA; const char* nB = has_next ? (const char*)g.Bt + (size_t)nxt.pn * tstep : cB;
        for (int t = 0; t < nt; t += 2) {
            if constexpr (Epi::HAS_MID) { if (t == E.mid_t) E.mid(acc, cur, wr, wc, fr, fq); }
            const bool last = (t == nt - 2);
            const char* a1 = cA + (size_t)(t + 1) * kstep;
            const char* a2 = last ? nA : cA + (size_t)(t + 2) * kstep; const char* b2 = last ? nB : cB + (size_t)(t + 2) * kstep;
            const char* a3 = a2 + kstep; const char* b3 = b2 + kstep;
            if (last && has_next) S.a_ready(nxt);
            if constexpr (SP2) {
            PG8_LDB(B0, 0, 0); PG8_LDB(B1, 0, 1); PG8_SCHED; PG8_LDA(At, 0, 0); PG8_STAGE(PG8_SA(1, 1), a1 + hstep, voffA);
            PG8_WAIT_V(8); PG8_WAIT_L(0); PG8_BAR; PG8_MMA(0, 0, At, B0); PG8_MMA(0, 1, At, B1); PG8_BAR; PG8_SCHED;
            PG8_LDA(At, 0, 1); PG8_STAGE(PG8_SB(0, 0), b2, voffB); PG8_STAGE(PG8_SB(0, 1), b2 + hstep, voffB); PG8_STAGE(PG8_SA(0, 0), a2, voffA);
            PG8_WAIT_V(8); PG8_WAIT_L(0); PG8_BAR; PG8_MMA(1, 0, At, B0); PG8_MMA(1, 1, At, B1); PG8_BAR; PG8_SCHED;
            PG8_LDB(B0, 1, 0); PG8_LDB(B1, 1, 1); PG8_SCHED; PG8_LDA(At, 1, 0); PG8_STAGE(PG8_SA(0, 1), a2 + hstep, voffA);
            PG8_WAIT_V(8); PG8_WAIT_L(0); PG8_BAR; PG8_MMA(0, 0, At, B0); PG8_MMA(0, 1, At, B1); PG8_BAR; PG8_SCHED;
            PG8_LDA(At, 1, 1); PG8_STAGE(PG8_SB(1, 0), b3, voffB); PG8_STAGE(PG8_SB(1, 1), b3 + hstep, voffB); PG8_STAGE(PG8_SA(1, 0), a3, voffA);
            PG8_WAIT_V(8); PG8_WAIT_L(0); PG8_BAR; PG8_MMA(1, 0, At, B0); PG8_MMA(1, 1, At, B1); PG8_BAR; PG8_SCHED;
            } else {
            PG8_LDB(B0, 0, 0); PG8_SCHED; PG8_LDA(At, 0, 0); PG8_STAGE(PG8_SA(1, 1), a1 + hstep, voffA);
            PG8_WAIT_L(8); PG8_BAR; PG8_WAIT_L(0); PG8_MMA(0, 0, At, B0); PG8_BAR; PG8_SCHED;
            PG8_LDB(B1, 0, 1); PG8_STAGE(PG8_SB(0, 0), b2, voffB);
            PG8_BAR; PG8_WAIT_L(0); PG8_MMA(0, 1, At, B1); PG8_BAR;
            PG8_LDA(At, 0, 1); PG8_STAGE(PG8_SA(0, 0), a2, voffA);
            PG8_BAR; PG8_WAIT_L(0); PG8_MMA(1, 0, At, B0); PG8_BAR; PG8_SCHED;
            PG8_STAGE(PG8_SB(0, 1), b2 + hstep, voffB);
            PG8_WAIT_V(6); PG8_BAR; PG8_MMA(1, 1, At, B1); PG8_BAR;
            PG8_LDB(B0, 1, 0); PG8_SCHED; PG8_LDA(At, 1, 0); PG8_STAGE(PG8_SA(0, 1), a2 + hstep, voffA);
            PG8_WAIT_L(8); PG8_BAR; PG8_WAIT_L(0); PG8_MMA(0, 0, At, B0); PG8_BAR; PG8_SCHED;
            PG8_LDB(B1, 1, 1); PG8_STAGE(PG8_SB(1, 0), b3, voffB);
            PG8_BAR; PG8_WAIT_L(0); PG8_MMA(0, 1, At, B1); PG8_BAR;
            PG8_LDA(At, 1, 1); PG8_STAGE(PG8_SA(1, 0), a3, voffA);
            PG8_BAR; PG8_WAIT_L(0); PG8_MMA(1, 0, At, B0); PG8_BAR; PG8_SCHED;
            PG8_STAGE(PG8_SB(1, 1), b3 + hstep, voffB);
            PG8_WAIT_V(6); PG8_BAR; PG8_MMA(1, 1, At, B1); PG8_BAR;
            }
        }
        if constexpr (ALIGN_EPI) { if (wr == 0) PG8_BAR; }
        if constexpr (!Epi::AFTER_DRAIN) { E(acc, cur, wr, wc, fr, fq); S.done(cur); }
        if (!has_next) break;
#pragma unroll
        for (int a = 0; a < 2; ++a)
#pragma unroll
            for (int b = 0; b < 2; ++b)
#pragma unroll
                for (int m = 0; m < 4; ++m)
#pragma unroll
                    for (int n = 0; n < 2; ++n) acc[a][b][m][n] = (f32x4){0.f, 0.f, 0.f, 0.f};
        cur = nxt; cA = nA; cB = nB; ++ui;
        if constexpr (ALIGN_EPI) { if (wr == 1) PG8_BAR; }
    }
    PG8_WAIT_V(0);
    if constexpr (!ALIGN_EPI) { if (wr == 0) PG8_BAR; }
    PG8_BAR;
    if constexpr (Epi::AFTER_DRAIN) { E.fused(acc, cur, wr, wc, fr, fq, lds, wid, lane); S.done(cur); }
#undef PG8_SA
#undef PG8_SB
#undef PG8_STAGE
#undef PG8_LDA
#undef PG8_LDB
#undef PG8_MMA
#undef PG8_WAIT_V
#undef PG8_WAIT_L
#undef PG8_BAR
#undef PG8_SCHED
}
}

typedef __attribute__((address_space(1))) unsigned gu32;
#define RLX_AGENT __ATOMIC_RELAXED, __HIP_MEMORY_SCOPE_AGENT
#define XB_TMO      128
#define XB_XCNT(j)  (256  + 64 * (j))
#define XB_XSUB(j)  (1280 + 64 * (j))
#define XB_XGEN(j)  (2304 + 64 * (j))
#define XB_TOP      3328
#define XB_TOPGEN   3392
#define XCD_BAR_WORDS 3456
#define XB_SPIN_CAP (1u << 18)

__device__ __forceinline__ unsigned xb_ld(unsigned* p)              { return __hip_atomic_load(p, __ATOMIC_RELAXED, __HIP_MEMORY_SCOPE_AGENT); }
__device__ __forceinline__ unsigned xb_add(unsigned* p, unsigned v) { return __hip_atomic_fetch_add(p, v, __ATOMIC_RELAXED, __HIP_MEMORY_SCOPE_AGENT); }
__device__ __forceinline__ unsigned xb_xcc_id() { return (unsigned)__builtin_amdgcn_s_getreg((3 << 11) | 20) & 0xFu; }
#define XB_SPIN(cond, bar) do { unsigned _sp = 0; while (cond) { __builtin_amdgcn_s_sleep(1); \
    if ((++_sp & 255u) == 0u) { if (xb_ld(&(bar)[XB_TMO])) break; if (_sp > XB_SPIN_CAP) { atomicAdd(&(bar)[XB_TMO], 1u); break; } } } } while (0)

struct XcdBarrier {
    unsigned* bar; unsigned x;
    volatile LAS unsigned* st;
};

__device__ __forceinline__ XcdBarrier xcd_barrier_post(unsigned* bar, volatile LAS unsigned* st, bool leader) {
    XcdBarrier b; b.bar = bar; b.x = xb_xcc_id(); b.st = st;
    if (leader) (void)xb_add(&bar[XB_XCNT(b.x)], 1u);
    return b;
}
__device__ __forceinline__ void xcd_barrier_complete(unsigned* bar, unsigned x, unsigned& nloc, unsigned& nx) {
    const unsigned G = gridDim.x * gridDim.y * gridDim.z;
    unsigned sum, cnt, mine, sp = 0u;
    for (;;) {
        sum = 0u; cnt = 0u; mine = 0u;
#pragma unroll
        for (unsigned j = 0; j < 16; ++j) { const unsigned c = xb_ld(&bar[XB_XCNT(j)]); sum += c; cnt += (c > 0u) ? 1u : 0u; mine = (j == x) ? c : mine; }
        if (sum == G) break;
        __builtin_amdgcn_s_sleep(1);
        if ((++sp & 255u) == 0u) { if (xb_ld(&bar[XB_TMO])) break; if (sp > XB_SPIN_CAP) { atomicAdd(&bar[XB_TMO], 1u); break; } }
    }
    nloc = mine > 0u ? mine : 1u; nx = cnt > 0u ? cnt : 1u;
}

__device__ __forceinline__ void xcd_barrier(const XcdBarrier& b, bool leader) {
    asm volatile("s_waitcnt vmcnt(0)" ::: "memory");
    __syncthreads();
    if (leader) {
        unsigned* bar = b.bar;
        __builtin_amdgcn_s_waitcnt(0);
        unsigned nloc = b.st[0], nx = b.st[1];
        if (nloc == 0u) { xcd_barrier_complete(bar, b.x, nloc, nx); b.st[0] = nloc; b.st[1] = nx; }
        const unsigned old = xb_add(&bar[XB_XSUB(b.x)], 1u);
        const unsigned gen = old / nloc;
        if (old + 1u == (gen + 1u) * nloc) {
            __builtin_amdgcn_fence(__ATOMIC_RELEASE, "agent");
            asm volatile("s_waitcnt vmcnt(0)" ::: "memory");
            const unsigned og = xb_add(&bar[XB_TOP], 1u);
            const unsigned tg = og / nx;
            if (og + 1u == (tg + 1u) * nx) xb_add(&bar[XB_TOPGEN], 1u);
            else XB_SPIN(xb_ld(&bar[XB_TOPGEN]) == tg, bar);
            __builtin_amdgcn_fence(__ATOMIC_ACQUIRE, "agent");
            xb_add(&bar[XB_XGEN(b.x)], 1u);
            asm volatile("s_waitcnt vmcnt(0)" ::: "memory");
        } else {
            XB_SPIN(xb_ld(&bar[XB_XGEN(b.x)]) == gen, bar);
            __builtin_amdgcn_fence(__ATOMIC_ACQUIRE, "agent");
            asm volatile("s_waitcnt vmcnt(0)" ::: "memory");
        }
    }
    __syncthreads();
}

#define DI __device__ __forceinline__

typedef unsigned short bf16_t;
typedef short bf16x8 __attribute__((ext_vector_type(8)));
typedef short bf16x4 __attribute__((ext_vector_type(4)));
typedef float f32x2 __attribute__((ext_vector_type(2)));
typedef float f32x4 __attribute__((ext_vector_type(4)));
typedef float f32x16 __attribute__((ext_vector_type(16)));
typedef unsigned u32x2 __attribute__((ext_vector_type(2)));
typedef unsigned u32x4 __attribute__((ext_vector_type(4)));
typedef __bf16 hwbf16x2 __attribute__((ext_vector_type(2)));

constexpr int DM = 1024, NB = 4, SEQ = 8192, DB = 32, DS = 8;
constexpr int MP = NB * SEQ;
constexpr int MS = DB * DS;
constexpr int MT = MP + MS;
constexpr int NIN_SRC = 9744, NIN = 9984;
constexpr int DFF = 2816;
constexpr float EPS = 1e-6f;
constexpr float LOG2E = 1.4426950408889634f;
constexpr float QA_SCALE = 0.08838834764831845f * LOG2E;
constexpr float QB_SCALE = 0.08838834764831845f;
constexpr float Q2_SCALE = 0.0625f * LOG2E;

constexpr size_t O_Y = 0, O_W1P = 33816576, O_W2P = 34340864, O_W3P = 36438016, O_GLAP = 44826624, O_MEMP = 45350912,
                 O_W1S = 47448064, O_W2S = 47710208, O_W3S = 47972352, O_GLAS = 48234496, O_TOTAL = 52428800;

constexpr size_t MiB = 1u << 20;
constexpr size_t WS_CTL = 0, WS_WIN = 1 * MiB, WS_WMKV = 21 * MiB, WS_WPA = 25 * MiB, WS_WPB = 26 * MiB, WS_WOUT = 28 * MiB, WS_WMQ = 30 * MiB,
                 WS_WMO = 32 * MiB, WS_WGU = 34 * MiB, WS_WDN = 45 * MiB, WS_XB = 51 * MiB, WS_MEMB = 116 * MiB, WS_RS = 118 * MiB, WS_SSQ = 119 * MiB,
                 WS_FB = 122 * MiB, WS_MK = 125 * MiB, WS_MVT = 127 * MiB, WS_LSE = 129 * MiB, WS_QA = 131 * MiB, WS_KA = 228 * MiB, WS_VA = 325 * MiB,
                 WS_QB = 422 * MiB, WS_KB = 455 * MiB, WS_VB = 488 * MiB, WS_SGB = 553 * MiB, WS_SGA = 618 * MiB, WS_SGBT = 683 * MiB, WS_OAG = 748 * MiB,
                 WS_YAIN = 845 * MiB, WS_OBN = 878 * MiB, WS_END = 943 * MiB;
constexpr size_t WS_TMP = 131 * MiB, WS_MIXIN = 196 * MiB, WS_MIX = 261 * MiB, WS_Q2 = 326 * MiB, WS_O2 = 391 * MiB, WS_H = 488 * MiB;
constexpr size_t WS_RSMEM = WS_RS + 512 * 1024;
static_assert(WS_WIN + (size_t)NIN * 1024 * 2 <= WS_WMKV && WS_WDN + (size_t)1024 * DFF * 2 <= WS_XB && WS_XB + (size_t)MT * 1024 * 2 <= WS_MEMB, "ws map 1");
static_assert(WS_QA + (size_t)MT * 1536 * 2 <= WS_KA && WS_QB + (size_t)MT * 512 * 2 <= WS_KB && WS_VB + (size_t)MT * 1024 * 2 <= WS_SGB, "ws map 2");
static_assert(WS_OAG + (size_t)3 * MT * 512 * 2 <= WS_YAIN && WS_YAIN + (size_t)MT * 512 * 2 <= WS_OBN && WS_OBN + (size_t)MT * 1024 * 2 <= WS_END, "ws map 3");
static_assert(WS_H + (size_t)MT * DFF * 2 <= WS_OAG && WS_O2 + (size_t)MT * 1024 * 2 <= WS_VB && WS_SSQ + (size_t)MT * 16 * 4 <= WS_FB && WS_LSE + (size_t)MT * 12 * 4 <= WS_QA, "ws map 4");

constexpr int LDS_BYTES = 147456;
constexpr int NTHREADS = 512;

DI unsigned pk2(float lo, float hi) { f32x2 v = {lo, hi}; hwbf16x2 b = __builtin_convertvector(v, hwbf16x2); return __builtin_bit_cast(unsigned, b); }
DI float bflo(unsigned w) { return __uint_as_float(w << 16); }
DI float bfhi(unsigned w) { return __uint_as_float(w & 0xffff0000u); }
DI float bf1(bf16_t h) { return __uint_as_float((unsigned)h << 16); }
DI bf16_t f2bf(float f) { return (bf16_t)(pk2(f, 0.f) & 0xffffu); }
template <int CTRL, int ROW_MASK> DI float dpp_f(float v) {
    return __builtin_bit_cast(float, __builtin_amdgcn_update_dpp(0, __builtin_bit_cast(int, v), CTRL, ROW_MASK, 0xf, false));
}
DI float wave_sum(float v) {
    v += dpp_f<0xB1, 0xf>(v);
    v += dpp_f<0x4E, 0xf>(v);
    v += dpp_f<0x141, 0xf>(v);
    v += dpp_f<0x140, 0xf>(v);
    v += dpp_f<0x142, 0xa>(v);
    v += dpp_f<0x143, 0xc>(v);
    return __builtin_bit_cast(float, __builtin_amdgcn_ds_bpermute(63 * 4, __builtin_bit_cast(int, v)));
}
template <int CTRL, int ROW_MASK> DI float dpp_keep(float v) {
    return __builtin_bit_cast(float, __builtin_amdgcn_update_dpp(__builtin_bit_cast(int, v), __builtin_bit_cast(int, v), CTRL, ROW_MASK, 0xf, false));
}
DI float wave_max(float v) {
    v = fmaxf(v, dpp_keep<0xB1, 0xf>(v));
    v = fmaxf(v, dpp_keep<0x4E, 0xf>(v));
    v = fmaxf(v, dpp_keep<0x141, 0xf>(v));
    v = fmaxf(v, dpp_keep<0x140, 0xf>(v));
    v = fmaxf(v, dpp_keep<0x142, 0xa>(v));
    v = fmaxf(v, dpp_keep<0x143, 0xc>(v));
    return __builtin_bit_cast(float, __builtin_amdgcn_readlane(__builtin_bit_cast(int, v), 63));
}
DI float fsigmoid(float x) { return __builtin_amdgcn_rcpf(1.f + __expf(-x)); }
#define LDS_WAIT() asm volatile("s_waitcnt lgkmcnt(0)" ::: "memory")
#define LDS_BARRIER() do { asm volatile("s_waitcnt lgkmcnt(0)" ::: "memory"); __builtin_amdgcn_s_barrier(); asm volatile("" ::: "memory"); } while (0)
#define MFMA32(a, b, c) __builtin_amdgcn_mfma_f32_32x32x16_bf16((a), (b), (c), 0, 0, 0)
DI int crow(int reg, int h) { return (reg & 3) + 8 * (reg >> 2) + 4 * h; }
DI bf16x8 pack_step(const f32x16& x, int s) {
    u32x4 p;
    p[0] = pk2(x[8 * s + 0], x[8 * s + 1]); p[1] = pk2(x[8 * s + 2], x[8 * s + 3]); p[2] = pk2(x[8 * s + 4], x[8 * s + 5]); p[3] = pk2(x[8 * s + 6], x[8 * s + 7]);
    return __builtin_bit_cast(bf16x8, p);
}
DI bf16x8 cat8(u32x2 lo, u32x2 hi) { u32x4 p; p[0] = lo[0]; p[1] = lo[1]; p[2] = hi[0]; p[3] = hi[1]; return __builtin_bit_cast(bf16x8, p); }

struct Args {
    const float* in[30];
    float* out;
    unsigned char* ws;
    int ph_lo, ph_hi;
};

struct Ctx {
    const float* const* in;
    float* out; unsigned char* ws;
    LAS unsigned char* lds;
    int wave, G, bid;
};
DI int lane_id() { return __builtin_amdgcn_mbcnt_hi(~0u, __builtin_amdgcn_mbcnt_lo(~0u, 0u)); }
DI int lane_id_here() { int l = lane_id(); asm volatile("" : "+v"(l)); return l; }

DI void p0_transpose_item(const float* __restrict__ W, int ldw, int src_col0, int nvalid, const float* __restrict__ gain,
                          bf16_t* __restrict__ WT, int K, int dst_row0, int kb, LAS float* scr, int lane, int kofs = 0) {
    const int k0 = 64 * kb;
    {
        const int kr = lane >> 3, n4 = 4 * (lane & 7);
        f32x4 v[8];
        if (nvalid > 0) {
            const float* wp = W + (size_t)(k0 + kr) * ldw + src_col0 + (n4 < nvalid ? n4 : 0);
#pragma unroll
            for (int i = 0; i < 8; ++i) v[i] = __builtin_nontemporal_load((const f32x4*)(wp + (size_t)(8 * i) * ldw));
        }
#pragma unroll
        for (int i = 0; i < 8; ++i) {
            const int kk = kr + 8 * i;
            f32x4 t = (nvalid > 0 && n4 < nvalid) ? v[i] : (f32x4){0.f, 0.f, 0.f, 0.f};
            if (gain) t = t * gain[k0 + kk];
            LAS float* d = scr + kk * 33 + n4;
            d[0] = t[0]; d[1] = t[1]; d[2] = t[2]; d[3] = t[3];
        }
    }
    LDS_WAIT(); asm volatile("" ::: "memory");
    const int c = lane & 7;
#pragma unroll
    for (int j = 0; j < 4; ++j) {
        const int n = (lane >> 3) + 8 * j; const LAS float* s = scr + (8 * c) * 33 + n;
        u32x4 o; o.x = pk2(s[0 * 33], s[1 * 33]); o.y = pk2(s[2 * 33], s[3 * 33]); o.z = pk2(s[4 * 33], s[5 * 33]); o.w = pk2(s[6 * 33], s[7 * 33]);
        *(u32x4*)(WT + (size_t)(dst_row0 + n) * K + kofs + k0 + 8 * c) = o;
    }
    LDS_WAIT(); asm volatile("" ::: "memory");
}
template <int NR> DI void p0_rows(const float* const (&xrow)[NR], bf16_t* const (&orow)[NR], float* const (&rs_out)[NR], int lane) {
    f32x4 v[NR][4];
#pragma unroll
    for (int q = 0; q < NR; ++q)
#pragma unroll
        for (int j = 0; j < 4; ++j) v[q][j] = __builtin_nontemporal_load((const f32x4*)xrow[q] + lane + 64 * j);
#pragma unroll
    for (int q = 0; q < NR; ++q) {
        float s = 0.f;
#pragma unroll
        for (int j = 0; j < 4; ++j) s += (v[q][j].x * v[q][j].x + v[q][j].y * v[q][j].y) + (v[q][j].z * v[q][j].z + v[q][j].w * v[q][j].w);
        s = wave_sum(s);
        const float r = rsqrtf(s * (1.f / 1024.f) + EPS);
        u32x2* o8 = (u32x2*)orow[q] + lane;
#pragma unroll
        for (int j = 0; j < 4; ++j) { u32x2 w; w.x = pk2(v[q][j].x * r, v[q][j].y * r); w.y = pk2(v[q][j].z * r, v[q][j].w * r); o8[64 * j] = w; }
        if (lane == 0) *rs_out[q] = r;
    }
}
DI void p0_prologue(const Ctx& C) {
    const int lane = lane_id();
    LAS float* scr = (LAS float*)(C.lds + C.wave * 16384);
    const int gw = C.bid * 8 + C.wave, NGW = C.G * 8;
    const float* const* in = C.in;
    unsigned char* ws = C.ws;
    constexpr int I_IN = 16 * 312, I_MK = 16 * 32, I_PA = 8 * 32, I_SQ = 16 * 32, I_GU = 16 * 176, I_DN = 44 * 32;
    constexpr int NITEMS = I_IN + 2 * I_MK + I_PA + 4 * I_SQ + I_GU + I_DN;
    for (int it = gw; it < NITEMS; it += NGW) {
        int r = it;
        if (r < I_IN) {
            const int G = r % 312, kb = r / 312; int src, nv;
            if (G < 240) { src = 32 * G; nv = 32; } else if (G < 304) { src = 7696 + 32 * (G - 240); nv = 32; } else if (G == 304) { src = 7680; nv = 16; } else { src = 0; nv = 0; }
            p0_transpose_item(in[11], NIN_SRC, src, nv, in[9], (bf16_t*)(ws + WS_WIN), 1024, 32 * G, kb, scr, lane); continue; }
        r -= I_IN;
        if (r < I_MK) { p0_transpose_item(in[19], 1024, 32 * (r % 32), 32, in[18], (bf16_t*)(ws + WS_WMKV), 1024, 32 * (r % 32), r / 32, scr, lane); continue; } r -= I_MK;
        if (r < I_MK) { p0_transpose_item(in[20], 1024, 32 * (r % 32), 32, in[18], (bf16_t*)(ws + WS_WMKV), 1024, 1024 + 32 * (r % 32), r / 32, scr, lane); continue; } r -= I_MK;
        if (r < I_PA) { p0_transpose_item(in[15], 1024, 32 * (r % 32), 32, nullptr, (bf16_t*)(ws + WS_WPA), 1536, 32 * (r % 32), r / 32, scr, lane, 0); continue; } r -= I_PA;
        if (r < I_SQ) { p0_transpose_item(in[16], 1024, 32 * (r % 32), 32, nullptr, (bf16_t*)(ws + WS_WPA), 1536, 32 * (r % 32), r / 32, scr, lane, 512); continue; } r -= I_SQ;
        if (r < I_SQ) { p0_transpose_item(in[17], 1024, 32 * (r % 32), 32, nullptr, (bf16_t*)(ws + WS_WOUT), 1024, 32 * (r % 32), r / 32, scr, lane); continue; } r -= I_SQ;
        if (r < I_SQ) { p0_transpose_item(in[23], 1024, 32 * (r % 32), 32, in[21], (bf16_t*)(ws + WS_WMQ), 1024, 32 * (r % 32), r / 32, scr, lane); continue; } r -= I_SQ;
        if (r < I_SQ) { p0_transpose_item(in[24], 1024, 32 * (r % 32), 32, nullptr, (bf16_t*)(ws + WS_WMO), 1024, 32 * (r % 32), r / 32, scr, lane); continue; } r -= I_SQ;
        if (r < I_GU) {
            const int G = r % 176, kb = r / 176, j = G >> 3, sub = G & 7;
            const float* W = sub < 4 ? in[27] : in[28];
            p0_transpose_item(W, DFF, 128 * j + 32 * (sub & 3), 32, in[25], (bf16_t*)(ws + WS_WGU), 1024, 32 * G, kb, scr, lane); continue; }
        r -= I_GU;
        p0_transpose_item(in[29], 1024, 32 * (r % 32), 32, nullptr, (bf16_t*)(ws + WS_WDN), DFF, 32 * (r % 32), r / 32, scr, lane);
    }
    bf16_t* XB = (bf16_t*)(ws + WS_XB); float* RS = (float*)(ws + WS_RS);
    for (int m = gw; m < MT; m += 4 * NGW) {
        if (m + 3 * NGW < MT) {
            const float* src[4]; bf16_t* dst[4]; float* rsp[4];
#pragma unroll
            for (int q = 0; q < 4; ++q) { const int mm = m + q * NGW; src[q] = mm < MP ? in[0] + (size_t)mm * 1024 : in[1] + (size_t)(mm - MP) * 1024; dst[q] = XB + (size_t)mm * 1024; rsp[q] = RS + mm; }
            p0_rows<4>(src, dst, rsp, lane);
        } else {
            for (int mm = m; mm < MT; mm += NGW) {
                const float* src[1] = {mm < MP ? in[0] + (size_t)mm * 1024 : in[1] + (size_t)(mm - MP) * 1024}; bf16_t* dst[1] = {XB + (size_t)mm * 1024}; float* rsp[1] = {RS + mm};
                p0_rows<1>(src, dst, rsp, lane);
            }
        }
    }
    bf16_t* MEMB = (bf16_t*)(ws + WS_MEMB); float* RSM = (float*)(ws + WS_RSMEM);
    for (int m = gw; m < 1024; m += NGW) { const float* src[1] = {in[7] + (size_t)m * 1024}; bf16_t* dst[1] = {MEMB + (size_t)m * 1024}; float* rsp[1] = {RSM + m}; p0_rows<1>(src, dst, rsp, lane); }
}

DI void st_bf16x8(bf16_t* p, f32x4 v0, f32x4 v1) {
    u32x4 w; w.x = pk2(v0[0], v0[1]); w.y = pk2(v0[2], v0[3]); w.z = pk2(v1[0], v1[1]); w.w = pk2(v1[2], v1[3]);
    *(u32x4*)p = w;
}
DI void st_rowpair(bf16_t* row_base, int k, u32x2 a, u32x2 b, int hh) {
    const auto r0 = __builtin_amdgcn_permlane32_swap(a.x, b.x, false, false);
    const auto r1 = __builtin_amdgcn_permlane32_swap(a.y, b.y, false, false);
    u32x4 w; w.x = r0[0]; w.y = r1[0]; w.z = r0[1]; w.w = r1[1];
    *(u32x4*)(row_base + 8 * k + 8 * hh) = w;
}
DI void st_bf16x8_nt(bf16_t* p, f32x4 v0, f32x4 v1) {
    u32x4 w; w.x = pk2(v0[0], v0[1]); w.y = pk2(v0[2], v0[3]); w.z = pk2(v1[0], v1[1]); w.w = pk2(v1[2], v1[3]);
    __builtin_nontemporal_store(w, (u32x4*)p);
}
DI int attn_prow(int row, int g) {
    if (row >= MP) return row;
    const int t = row & 8191, sh = 2 * g;
    return (row & ~8191) + ((t & ((1 << sh) - 1)) << (13 - sh)) + (t >> sh);
}
struct EpiIn {
    static constexpr bool PERM = true, AFTER_DRAIN = false, HAS_MID = false;
    const float* rs; unsigned char* ws; float* out;
    DI void operator()(const f32x4 (&acc)[2][2][4][2], const pg8::Unit& u, int wr, int wc, int fr, int fq) const {
        const int pn = u.pn, rbase = u.pm * 256 + wr * 64 + fr, cl = wc * 32 + 8 * fq;
        if (pn == 38) {
            if (wc == 0 && fq < 2) {
                float* FB = (float*)(ws + WS_FB);
#pragma unroll
                for (int ai = 0; ai < 2; ++ai)
#pragma unroll
                    for (int m = 0; m < 4; ++m) { const int row = rbase + ai * 128 + m * 16;
                        *(f32x4*)(FB + (size_t)row * 16 + 8 * fq) = acc[ai][0][m][0]; *(f32x4*)(FB + (size_t)row * 16 + 8 * fq + 4) = acc[ai][0][m][1]; }
            }
            return;
        }
        bf16_t* dst; int ldc, cbase; float sc = 1.f; int act = 0;
        int perm_g = -1;
        if (pn < 6)       { perm_g = pn >> 1; dst = (bf16_t*)(ws + WS_QA) + (size_t)(4 * perm_g + 2 * (pn & 1)) * MT * 128; ldc = 128; cbase = 0; sc = QA_SCALE; }
        else if (pn < 12) { perm_g = (pn - 6) >> 1; dst = (bf16_t*)(ws + WS_KA) + (size_t)(4 * perm_g + 2 * (pn & 1)) * MT * 128; ldc = 128; cbase = 0; }
        else if (pn < 18) { perm_g = (pn - 12) >> 1; dst = (bf16_t*)(ws + WS_VA) + (size_t)(4 * perm_g + 2 * (pn & 1)) * MT * 128; ldc = 128; cbase = 0; }
        else if (pn < 20) { dst = (bf16_t*)(ws + WS_QB); ldc = 512; cbase = (pn - 18) * 256; sc = QB_SCALE; }
        else if (pn < 22) { dst = (bf16_t*)(ws + WS_KB); ldc = 512; cbase = (pn - 20) * 256; }
        else if (pn < 26) { dst = (bf16_t*)(ws + WS_VB); ldc = 1024; cbase = (pn - 22) * 256; }
        else if (pn < 30) { dst = (bf16_t*)(ws + WS_SGB); ldc = 1024; cbase = (pn - 26) * 256; act = 1; }
        else if (pn < 34) { dst = (bf16_t*)(ws + WS_SGA); ldc = 1024; cbase = (pn - 30) * 256; act = 2; }
        else              { dst = (bf16_t*)(ws + WS_SGBT); ldc = 1024; cbase = (pn - 34) * 256; act = 2; }
        const bool iskv = (pn >= 6 && pn < 18);
        const bool maywin = iskv && (u.pm == 128 || (u.pm & 31) >= 24);
        const int kv = pn >= 12 ? 1 : 0, pc = (pn - 6) % 6, g = pc >> 1, cg0 = (pc & 1) * 256, keep = 128 << (2 * g);
        const size_t offp = g == 0 ? O_W1P : (g == 1 ? O_W2P : O_W3P), offs = g == 0 ? O_W1S : (g == 1 ? O_W2S : O_W3S);
#pragma unroll
        for (int ai = 0; ai < 2; ++ai)
#pragma unroll
            for (int m = 0; m < 4; ++m) {
                const int row = rbase + ai * 128 + m * 16;
                bf16_t* rowp = dst + (size_t)(perm_g >= 0 ? attn_prow(row, perm_g) : row) * ldc + cbase + cl;
                float* wp = nullptr;
                if (maywin) {
                    if (row >= MP) wp = out + offs + ((size_t)(row - MP) * 2 + kv) * 512 + cg0 + cl;
                    else { const int b = row >> 13, t = row & 8191; if (t >= SEQ - keep) wp = out + offp + ((size_t)(b * keep + t - (SEQ - keep)) * 2 + kv) * 512 + cg0 + cl; }
                }
#pragma unroll
                for (int bj = 0; bj < 2; ++bj) {
                    f32x4 v0 = acc[ai][bj][m][0], v1 = acc[ai][bj][m][1];
                    if (wp) { *(f32x4*)(wp + bj * 128) = v0; *(f32x4*)(wp + bj * 128 + 4) = v1; }
                    if (act) {
#pragma unroll
                        for (int i = 0; i < 4; ++i) { const float s0 = fsigmoid(v0[i]), s1 = fsigmoid(v1[i]); v0[i] = act == 1 ? v0[i] * s0 : s0; v1[i] = act == 1 ? v1[i] * s1 : s1; }
                    }
                    st_bf16x8_nt(rowp + (perm_g >= 0 ? (size_t)bj * MT * 128 : (size_t)bj * 128), v0 * sc, v1 * sc);
                }
            }
    }
};
struct EpiMemKV {
    static constexpr bool PERM = true, AFTER_DRAIN = false, HAS_MID = false;
    const float* rs; unsigned char* ws; float* out;
    DI void operator()(const f32x4 (&acc)[2][2][4][2], const pg8::Unit& u, int wr, int wc, int fr, int fq) const {
        const int pn = u.pn, rbase = u.pm * 256 + wr * 64 + fr, cl = wc * 32 + 8 * fq, kv = pn >> 2, c0 = (pn & 3) * 256 + cl;
        bf16_t* MK = (bf16_t*)(ws + WS_MK); bf16_t* MVT = (bf16_t*)(ws + WS_MVT);
#pragma unroll
        for (int ai = 0; ai < 2; ++ai)
#pragma unroll
            for (int m = 0; m < 4; ++m) {
                const int row = rbase + ai * 128 + m * 16;
                float* op = out + O_MEMP + ((size_t)row * 2 + kv) * 1024 + c0;
#pragma unroll
                for (int bj = 0; bj < 2; ++bj) {
                    const f32x4 v0 = acc[ai][bj][m][0], v1 = acc[ai][bj][m][1];
                    *(f32x4*)(op + bj * 128) = v0; *(f32x4*)(op + bj * 128 + 4) = v1;
                    if (kv == 0) st_bf16x8(MK + (size_t)row * 1024 + c0 + bj * 128, v0, v1);
                    else {
                        bf16_t* vp = MVT + ((size_t)(row >> 8) * 1024 + c0 + bj * 128) * 256 + (row & 255);
#pragma unroll
                        for (int i = 0; i < 4; ++i) { vp[(size_t)i * 256] = f2bf(v0[i]); vp[(size_t)(i + 4) * 256] = f2bf(v1[i]); }
                    }
                }
            }
    }
};

struct EpiNull {
    static constexpr bool PERM = true, AFTER_DRAIN = false, HAS_MID = false;
    float* sink;
    DI void operator()(const f32x4 (&acc)[2][2][4][2], const pg8::Unit& u, int wr, int wc, int fr, int fq) const {
        float s = 0.f;
#pragma unroll
        for (int ai = 0; ai < 2; ++ai)
#pragma unroll
            for (int bj = 0; bj < 2; ++bj)
#pragma unroll
                for (int m = 0; m < 4; ++m)
#pragma unroll
                    for (int n = 0; n < 2; ++n) s += acc[ai][bj][m][n][0] + acc[ai][bj][m][n][1] + acc[ai][bj][m][n][2] + acc[ai][bj][m][n][3];
        if (fr == 0 && fq == 0) sink[(u.pm * 64 + u.pn) * 8 + wr * 4 + wc] = s;
    }
};

constexpr int GL_QP = 0, GL_KP = 17408, GL_KPT = 34816, GL_VT = 53248, GL_OT = 90112, GL_FB = 123904, GL_PFX = 128000, GL_EBL = 136192,
              GL_WF2 = 136704, GL_BF2 = 144896, GL_GN = 145408, GL_END = 146432;
constexpr int QP_PITCH = 272, KT_PITCH = 144, OT_PITCH = 528;
static_assert(GL_END <= LDS_BYTES, "gla lds");

DI float logsig16(float z) {
    const float a = fabsf(z);
    return (fminf(z, 0.f) - __logf(1.f + __expf(-a))) * 0.0625f;
}

constexpr int GL_XF = GL_OT;
constexpr size_t WS_OIG = WS_XB, WS_DSG = 943 * MiB, WS_QPG = 959 * MiB, WS_EBLG = 991 * MiB, WS_END2 = 992 * MiB;
static_assert(WS_OIG + (size_t)2048 * 32768 <= WS_MEMB && WS_DSG >= WS_END && WS_DSG + (size_t)256 * 65536 <= WS_QPG && WS_QPG + (size_t)2048 * 16384 <= WS_EBLG && WS_EBLG + MiB <= WS_END2, "gla ws map");

DI void gla_load_consts(const Ctx& C, int h, int tid) {
    LAS unsigned char* lds = C.lds;
    const float* wf2 = C.in[12]; const float* bf2 = C.in[13]; const float* gn = C.in[14];
    LAS float* WF = (LAS float*)(lds + GL_WF2);
    for (int i = tid; i < 16 * 128; i += NTHREADS) WF[i] = wf2[(size_t)(i >> 7) * 512 + h * 128 + (i & 127)];
    if (tid < 128) ((LAS float*)(lds + GL_BF2))[tid] = bf2[h * 128 + tid];
    if (tid < 256) ((LAS float*)(lds + GL_GN))[tid] = gn[tid];
}

constexpr int NSUB = 8, NUNIT = 16 * (128 / NSUB);
constexpr int GL_CUM = GL_GN;
DI void gla_pass_a_unit(const Ctx& C, int unit) {
    LAS unsigned char* lds = C.lds;
    const int lane = lane_id_here(), w = C.wave, tid = w * 64 + lane, r = lane & 31, hh = lane >> 5;
    const int bh = unit / (128 / NSUB), sc = unit % (128 / NSUB), b = bh >> 2, h = bh & 3;
    unsigned char* ws = C.ws;
    const bf16_t* QB = (const bf16_t*)(ws + WS_QB); const bf16_t* KB = (const bf16_t*)(ws + WS_KB); const bf16_t* VB = (const bf16_t*)(ws + WS_VB);
    const float* FB = (const float*)(ws + WS_FB);
    const size_t tok0 = (size_t)b * SEQ + (size_t)sc * NSUB * 64;
    const int cg = tid & 31, rg = tid >> 5;
    u32x2 q4[4], k4[4]; u32x4 vreg[4]; f32x4 fbreg = {0.f, 0.f, 0.f, 0.f};
#define GLA_ISSUE_LOADS(jn) do { const size_t t0_ = tok0 + (size_t)(jn) * 64; \
        _Pragma("unroll") for (int i = 0; i < 4; ++i) { \
            q4[i] = *(const u32x2*)(QB + (t0_ + 4 * rg + i) * 512 + h * 128 + 4 * cg); \
            k4[i] = *(const u32x2*)(KB + (t0_ + 4 * rg + i) * 512 + h * 128 + 4 * cg); \
            vreg[i] = *(const u32x4*)(VB + (t0_ + lane) * 1024 + h * 256 + 32 * w + 8 * i); } \
        if (tid < 256) fbreg = *(const f32x4*)(FB + t0_ * 16 + tid * 4); } while (0)
    GLA_ISSUE_LOADS(0);
    LDS_BARRIER();
    gla_load_consts(C, h, tid);
    if (tid < 128) ((LAS float*)(lds + GL_CUM))[tid] = 1.f;
    f32x16 S[4];
#pragma unroll
    for (int i = 0; i < 4; ++i)
#pragma unroll
        for (int j = 0; j < 16; ++j) S[i][j] = 0.f;
    for (int jc = 0; jc < NSUB; ++jc) {
        const size_t cunit = (size_t)bh * 128 + sc * NSUB + jc;
        if (tid < 256) *(LAS f32x4*)(lds + GL_FB + tid * 16) = fbreg;
        {
            LAS bf16_t* VT = (LAS bf16_t*)(lds + GL_VT);
#pragma unroll
            for (int i = 0; i < 4; ++i)
#pragma unroll
                for (int j = 0; j < 4; ++j) {
                    const unsigned wv = vreg[i][j]; const int e = 32 * w + 8 * i + 2 * j;
                    VT[e * (KT_PITCH / 2) + lane] = (bf16_t)(wv & 0xffffu); VT[(e + 1) * (KT_PITCH / 2) + lane] = (bf16_t)(wv >> 16);
                }
        }
        LDS_BARRIER();
        float bl[4][4];
        {
            const LAS float* WF = (const LAS float*)(lds + GL_WF2); const LAS float* FBs = (const LAS float*)(lds + GL_FB);
            const f32x4 bb = *(const LAS f32x4*)(lds + GL_BF2 + 16 * cg);
            f32x4 z[4] = {bb, bb, bb, bb};
#pragma unroll
            for (int j4 = 0; j4 < 4; ++j4) {
                f32x4 f[4];
#pragma unroll
                for (int i = 0; i < 4; ++i) f[i] = *(const LAS f32x4*)(FBs + (4 * rg + i) * 16 + 4 * j4);
#pragma unroll
                for (int jj = 0; jj < 4; ++jj) {
                    const f32x4 wv = *(const LAS f32x4*)(WF + (4 * j4 + jj) * 128 + 4 * cg);
#pragma unroll
                    for (int i = 0; i < 4; ++i) z[i] += wv * f[i][jj];
                }
            }
#pragma unroll
            for (int c = 0; c < 4; ++c) {
                float run = 0.f;
#pragma unroll
                for (int i = 0; i < 4; ++i) { run += logsig16(z[i][c]); bl[i][c] = run; }
            }
            *(LAS f32x4*)(lds + GL_PFX + (rg * 128 + 4 * cg) * 4) = (f32x4){bl[3][0], bl[3][1], bl[3][2], bl[3][3]};
        }
        LDS_BARRIER();
        f32x4 ebnew = {1.f, 1.f, 1.f, 1.f};
        {
            f32x4 pre = {0.f, 0.f, 0.f, 0.f}, tot = {0.f, 0.f, 0.f, 0.f};
#pragma unroll
            for (int g = 0; g < 16; ++g) { const f32x4 p = *(const LAS f32x4*)(lds + GL_PFX + (g * 128 + 4 * cg) * 4); tot += p; if (g < rg) pre += p; }
            const f32x4 cum = *(const LAS f32x4*)(lds + GL_CUM + 16 * cg);
            ebnew = (f32x4){__expf(tot[0]), __expf(tot[1]), __expf(tot[2]), __expf(tot[3])};
            if (rg == 0) *(LAS f32x4*)(lds + GL_EBL + 16 * cg) = ebnew;
            float kq[4][4];
            bf16_t* QPG = (bf16_t*)(ws + WS_QPG) + cunit * 8192;
#pragma unroll
            for (int i = 0; i < 4; ++i) {
                float qv[4] = {bflo(q4[i][0]), bfhi(q4[i][0]), bflo(q4[i][1]), bfhi(q4[i][1])};
                float kv[4] = {bflo(k4[i][0]), bfhi(k4[i][0]), bflo(k4[i][1]), bfhi(k4[i][1])};
                float qo[4];
#pragma unroll
                for (int c = 0; c < 4; ++c) { const float bv = pre[c] + bl[i][c]; const float e = __expf(bv); qo[c] = qv[c] * e; kq[i][c] = kv[c] * __builtin_amdgcn_rcpf(e); }
                u32x2 wq; wq.x = pk2(qo[0], qo[1]); wq.y = pk2(qo[2], qo[3]);
                u32x2 wk; wk.x = pk2(kq[i][0], kq[i][1]); wk.y = pk2(kq[i][2], kq[i][3]);
                u32x2 wg; wg.x = pk2(qo[0] * cum[0], qo[1] * cum[1]); wg.y = pk2(qo[2] * cum[2], qo[3] * cum[3]);
                *(LAS u32x2*)(lds + GL_QP + (4 * rg + i) * QP_PITCH + 8 * cg) = wq;
                *(LAS u32x2*)(lds + GL_KP + (4 * rg + i) * QP_PITCH + 8 * cg) = wk;
                *(u32x2*)(QPG + (4 * rg + i) * 128 + 4 * cg) = wg;
            }
#pragma unroll
            for (int c = 0; c < 4; ++c) { u32x2 wt; wt.x = pk2(kq[0][c], kq[1][c]); wt.y = pk2(kq[2][c], kq[3][c]);
                *(LAS u32x2*)(lds + GL_KPT + (4 * cg + c) * KT_PITCH + 8 * rg) = wt; }
        }
        LDS_BARRIER();
        if (rg == 0) { const f32x4 cum = *(const LAS f32x4*)(lds + GL_CUM + 16 * cg); *(LAS f32x4*)(lds + GL_CUM + 16 * cg) = cum * ebnew; }
        f32x16 O[2];
#pragma unroll
        for (int i = 0; i < 2; ++i)
#pragma unroll
            for (int j = 0; j < 16; ++j) O[i][j] = 0.f;
        if (jc > 0) {
#pragma unroll
            for (int dt = 0; dt < 4; ++dt)
#pragma unroll
                for (int s = 0; s < 2; ++s) {
                    const bf16x8 sb = pack_step(S[dt], s);
#pragma unroll
                    for (int ct = 0; ct < 2; ++ct) {
                        const LAS unsigned char* p = lds + GL_QP + (32 * ct + r) * QP_PITCH + (32 * dt + 16 * s + 4 * hh) * 2;
                        const bf16x8 a = cat8(*(const LAS u32x2*)p, *(const LAS u32x2*)(p + 16));
                        O[ct] = MFMA32(a, sb, O[ct]);
                    }
                    __builtin_amdgcn_sched_barrier(0);
                }
        }
        if (w < 3) {
            const int jt = w == 2 ? 1 : 0, ct = w == 0 ? 0 : 1;
            f32x16 X;
#pragma unroll
            for (int j = 0; j < 16; ++j) X[j] = 0.f;
#pragma unroll
            for (int s8 = 0; s8 < 8; ++s8) {
                const bf16x8 a = *(const LAS bf16x8*)(lds + GL_KP + (32 * jt + r) * QP_PITCH + (16 * s8 + 8 * hh) * 2);
                const bf16x8 bq = *(const LAS bf16x8*)(lds + GL_QP + (32 * ct + r) * QP_PITCH + (16 * s8 + 8 * hh) * 2);
                X = MFMA32(a, bq, X);
            }
            if (jt == ct) {
#pragma unroll
                for (int j = 0; j < 16; ++j) if (crow(j, hh) > r) X[j] = 0.f;
            }
            *(LAS u32x4*)(lds + GL_XF + ((w * 2 + 0) * 64 + lane) * 16) = __builtin_bit_cast(u32x4, pack_step(X, 0));
            *(LAS u32x4*)(lds + GL_XF + ((w * 2 + 1) * 64 + lane) * 16) = __builtin_bit_cast(u32x4, pack_step(X, 1));
        }
        __builtin_amdgcn_sched_barrier(0);
        if (jc + 1 < NSUB) GLA_ISSUE_LOADS(jc + 1);
        __builtin_amdgcn_sched_barrier(0);
        {
#pragma unroll
            for (int dt = 0; dt < 4; ++dt) {
#pragma unroll
                for (int s = 0; s < 4; ++s) {
                    const bf16x8 a = *(const LAS bf16x8*)(lds + GL_KPT + (32 * dt + r) * KT_PITCH + (16 * s + 8 * hh) * 2);
                    const bf16x8 vb = *(const LAS bf16x8*)(lds + GL_VT + (32 * w + r) * KT_PITCH + (16 * s + 8 * hh) * 2);
                    S[dt] = MFMA32(a, vb, S[dt]);
                }
#pragma unroll
                for (int g4 = 0; g4 < 4; ++g4) {
                    const f32x4 e = *(const LAS f32x4*)(lds + GL_EBL + (32 * dt + 8 * g4 + 4 * hh) * 4);
#pragma unroll
                    for (int i = 0; i < 4; ++i) S[dt][4 * g4 + i] *= e[i];
                }
                __builtin_amdgcn_sched_barrier(0);
            }
        }
        LDS_BARRIER();
        {
#pragma unroll
            for (int ct = 0; ct < 2; ++ct)
#pragma unroll
                for (int jt = 0; jt <= ct; ++jt) {
                    const int tile = ct == 0 ? 0 : (jt == 0 ? 1 : 2);
#pragma unroll
                    for (int s = 0; s < 2; ++s) {
                        const bf16x8 xa = *(const LAS bf16x8*)(lds + GL_XF + ((tile * 2 + s) * 64 + lane) * 16);
                        const LAS unsigned char* p = lds + GL_VT + (32 * w + r) * KT_PITCH + (32 * jt + 16 * s + 4 * hh) * 2;
                        const bf16x8 vb = cat8(*(const LAS u32x2*)p, *(const LAS u32x2*)(p + 16));
                        O[ct] = MFMA32(xa, vb, O[ct]);
                    }
                }
            u32x2* OIG = (u32x2*)(ws + WS_OIG) + cunit * 4096 + w * 64 + lane;
#pragma unroll
            for (int ct = 0; ct < 2; ++ct)
#pragma unroll
                for (int g4 = 0; g4 < 4; ++g4) { u32x2 o; o.x = pk2(O[ct][4 * g4], O[ct][4 * g4 + 1]); o.y = pk2(O[ct][4 * g4 + 2], O[ct][4 * g4 + 3]); OIG[(ct * 4 + g4) * 512] = o; }
        }
    }
#undef GLA_ISSUE_LOADS
    {
        int l2 = lane_id_here(); const int w2 = w;
        u32x4* DSG = (u32x4*)(ws + WS_DSG) + (size_t)unit * 4096 + w2 * 64 + l2;
#pragma unroll
        for (int dt = 0; dt < 4; ++dt) { DSG[(dt * 2 + 0) * 512] = __builtin_bit_cast(u32x4, pack_step(S[dt], 0)); DSG[(dt * 2 + 1) * 512] = __builtin_bit_cast(u32x4, pack_step(S[dt], 1)); }
        const int t2 = w2 * 64 + l2;
        if (t2 < 128) ((float*)(ws + WS_EBLG))[(size_t)unit * 128 + t2] = ((const LAS float*)(lds + GL_CUM))[t2];
    }
}

DI void gla_pass_b(const Ctx& C) {
    const int lane = lane_id_here(), tid = C.wave * 64 + lane, gid = C.bid * NTHREADS + tid;
    unsigned char* ws = C.ws;
    constexpr int UPB = 128 / NSUB;
    for (int id = gid; id < 16 * 8192; id += C.G * NTHREADS) {
        const int bh = id >> 13, f = (id >> 1) & 4095, half = id & 1;
        const int fl = f & 63, fw = (f >> 6) & 7, fs = (f >> 9) & 1, fdt = f >> 10;
        const int d0 = 32 * fdt + 16 * fs + 8 * half + 4 * (fl >> 5), e = 32 * fw + (fl & 31);
        u32x2* p = (u32x2*)(ws + WS_DSG) + ((size_t)bh * UPB * 4096 + f) * 2 + half;
        const float* eb = (const float*)(ws + WS_EBLG) + (size_t)bh * UPB * 128 + d0;
        float s0 = 0.f, s1 = 0.f, s2 = 0.f, s3 = 0.f;
#pragma unroll
        for (int u = 0; u < UPB; ++u) {
            const u32x2 ds = p[(size_t)u * 8192];
            const f32x4 ev = *(const f32x4*)(eb + u * 128);
            u32x2 st; st.x = pk2(s0, s1); st.y = pk2(s2, s3);
            p[(size_t)u * 8192] = st;
            s0 = ev[0] * s0 + bflo(ds.x); s1 = ev[1] * s1 + bfhi(ds.x); s2 = ev[2] * s2 + bflo(ds.y); s3 = ev[3] * s3 + bfhi(ds.y);
        }
        float* gp = C.out + O_GLAP + ((size_t)bh * 128 + d0) * 256 + e;
        gp[0] = s0; gp[256] = s1; gp[512] = s2; gp[768] = s3;
    }
}

DI void gla_pass_c(const Ctx& C) {
    LAS unsigned char* lds = C.lds;
    const int lane = lane_id_here(), w = C.wave, tid = w * 64 + lane, r = lane & 31, hh = lane >> 5;
    unsigned char* ws = C.ws;
    const int orow = tid >> 3, occ = tid & 7;
#define GLC_QLOAD(un) do { const u32x4* q_ = (const u32x4*)((const bf16_t*)(ws + WS_QPG) + (size_t)(un) * 8192); qst0 = q_[tid]; qst1 = q_[tid + 512]; } while (0)
#define GLC_QWRITE() do { *(LAS u32x4*)(lds + GL_QP + (tid >> 4) * QP_PITCH + 16 * (tid & 15)) = qst0; *(LAS u32x4*)(lds + GL_QP + (32 + (tid >> 4)) * QP_PITCH + 16 * (tid & 15)) = qst1; } while (0)
    const bool xs = C.G == 256;
#define GLC_UNIT(li) (xs ? (((li) & ~255) | (((li) & 7) << 5) | (((li) >> 3) & 31)) : (li))
    int li = C.bid;
    int unit = GLC_UNIT(li);
    u32x4 qst0 = {0u, 0u, 0u, 0u}, qst1 = {0u, 0u, 0u, 0u};
    if (li < 2048) GLC_QLOAD(unit);
    LDS_BARRIER();
    GLC_QWRITE();
    if (tid < 256) ((LAS float*)(lds + GL_GN))[tid] = C.in[14][tid];
    LDS_BARRIER();
    for (; li < 2048; li += C.G, unit = GLC_UNIT(li)) {
        const int bh = unit >> 7, ch = unit & 127, b = bh >> 2, h = bh & 3;
        const size_t t0 = (size_t)b * SEQ + (size_t)ch * 64;
        const int nli = li + C.G, nxt = nli < 2048 ? GLC_UNIT(nli) : 2048;
        u32x4 sgb[4];
#pragma unroll
        for (int i = 0; i < 4; ++i) sgb[i] = *(const u32x4*)((const bf16_t*)(ws + WS_SGB) + (t0 + orow) * 1024 + h * 256 + 32 * occ + 8 * i);
        f32x16 O[2];
        {
            const u32x2* OIG = (const u32x2*)(ws + WS_OIG) + (size_t)unit * 4096 + w * 64 + lane;
#pragma unroll
            for (int ct = 0; ct < 2; ++ct)
#pragma unroll
                for (int g4 = 0; g4 < 4; ++g4) { const u32x2 o = OIG[(ct * 4 + g4) * 512]; O[ct][4 * g4] = bflo(o.x); O[ct][4 * g4 + 1] = bfhi(o.x); O[ct][4 * g4 + 2] = bflo(o.y); O[ct][4 * g4 + 3] = bfhi(o.y); }
        }
        {
            const u32x4* SCG = (const u32x4*)(ws + WS_DSG) + (size_t)(bh * (128 / NSUB) + ch / NSUB) * 4096 + w * 64 + lane;
            u32x4 scg[8];
#pragma unroll
            for (int i = 0; i < 8; ++i) scg[i] = SCG[i * 512];
            if (nxt < 2048) GLC_QLOAD(nxt);
#pragma unroll
            for (int dt = 0; dt < 4; ++dt)
#pragma unroll
                for (int s = 0; s < 2; ++s) {
                    const bf16x8 sb = __builtin_bit_cast(bf16x8, scg[dt * 2 + s]);
#pragma unroll
                    for (int ct = 0; ct < 2; ++ct) {
                        const LAS unsigned char* p = lds + GL_QP + (32 * ct + r) * QP_PITCH + (32 * dt + 16 * s + 4 * hh) * 2;
                        const bf16x8 a = cat8(*(const LAS u32x2*)p, *(const LAS u32x2*)(p + 16));
                        O[ct] = MFMA32(a, sb, O[ct]);
                    }
                }
        }
        LDS_BARRIER();
        if (nxt < 2048) GLC_QWRITE();
        {
            LAS bf16_t* OT = (LAS bf16_t*)(lds + GL_OT);
#pragma unroll
            for (int ct = 0; ct < 2; ++ct)
#pragma unroll
                for (int j = 0; j < 16; ++j) OT[(32 * ct + crow(j, hh)) * (OT_PITCH / 2) + 32 * w + r] = f2bf(O[ct][j]);
        }
        LDS_BARRIER();
        {
            float v[32]; float ss = 0.f;
#pragma unroll
            for (int i = 0; i < 4; ++i) {
                const u32x4 wv = *(const LAS u32x4*)(lds + GL_OT + orow * OT_PITCH + 64 * occ + 16 * i);
#pragma unroll
                for (int j = 0; j < 4; ++j) { v[8 * i + 2 * j] = bflo(wv[j]); v[8 * i + 2 * j + 1] = bfhi(wv[j]); }
            }
#pragma unroll
            for (int i = 0; i < 32; ++i) ss += v[i] * v[i];
            ss += __shfl_xor(ss, 1); ss += __shfl_xor(ss, 2); ss += __shfl_xor(ss, 4);
            const float rinv = rsqrtf(ss * (1.f / 256.f) + EPS);
            bf16_t* op = (bf16_t*)(ws + WS_YAIN) + (t0 + orow) * 1536 + 512 + h * 256 + 32 * occ;
#pragma unroll
            for (int i = 0; i < 4; ++i) {
                const f32x4 g0 = *(const LAS f32x4*)(lds + GL_GN + (32 * occ + 8 * i) * 4), g1 = *(const LAS f32x4*)(lds + GL_GN + (32 * occ + 8 * i + 4) * 4);
                const u32x4 sg = sgb[i];
                u32x4 o;
                o[0] = pk2(v[8 * i + 0] * rinv * g0[0] * bflo(sg[0]), v[8 * i + 1] * rinv * g0[1] * bfhi(sg[0]));
                o[1] = pk2(v[8 * i + 2] * rinv * g0[2] * bflo(sg[1]), v[8 * i + 3] * rinv * g0[3] * bfhi(sg[1]));
                o[2] = pk2(v[8 * i + 4] * rinv * g1[0] * bflo(sg[2]), v[8 * i + 5] * rinv * g1[1] * bfhi(sg[2]));
                o[3] = pk2(v[8 * i + 6] * rinv * g1[2] * bflo(sg[3]), v[8 * i + 7] * rinv * g1[3] * bfhi(sg[3]));
                *(u32x4*)(op + 8 * i) = o;
            }
        }
    }
#undef GLC_QLOAD
#undef GLC_QWRITE
#undef GLC_UNIT
}

constexpr int GS_QP = 0, GS_KM = 4096, GS_EBL = 8192, GS_AM = 8704, GS_VS = 8960, GS_OS = 34304, GS_RED = 33536, GS_FB = 33792, GS_OS2 = 85248, GS_END = GS_OS2 + 32768;
static_assert(GS_OS + 32768 <= 69632 && GS_END <= LDS_BYTES - 64, "gla sample lds");
DI void gla_sample_item(const Ctx& C, int b, int h) {
    LAS unsigned char* lds = C.lds; const int tid = C.wave * 64 + lane_id_here(); unsigned char* ws = C.ws;
    const bf16_t* QB = (const bf16_t*)(ws + WS_QB); const bf16_t* KB = (const bf16_t*)(ws + WS_KB); const bf16_t* VB = (const bf16_t*)(ws + WS_VB);
    const bf16_t* SGB = (const bf16_t*)(ws + WS_SGB); const float* FB = (const float*)(ws + WS_FB); bf16_t* OBN = (bf16_t*)(ws + WS_YAIN) + 512;
    const size_t row0 = (size_t)MP + (size_t)b * 8;
    LAS float* QPt = (LAS float*)(lds + GS_QP); LAS float* KMt = (LAS float*)(lds + GS_KM); LAS float* EBLs = (LAS float*)(lds + GS_EBL);
    LAS float* AM = (LAS float*)(lds + GS_AM); LAS float* VS = (LAS float*)(lds + GS_VS); LAS float* OS = (LAS float*)(lds + GS_OS);
    LAS float* RED = (LAS float*)(lds + GS_RED); LAS float* FBs = (LAS float*)(lds + GS_FB);
    const int e4 = 4 * (tid & 63), grp = C.wave;
    const float* S0 = C.in[5] + ((size_t)(b * 4 + h) * 128) * 256; float* S1 = C.out + O_GLAS + ((size_t)(b * 4 + h) * 128) * 256;
    f32x4 st[16];
#pragma unroll
    for (int i = 0; i < 16; ++i) st[i] = __builtin_nontemporal_load((const f32x4*)(S0 + (size_t)(grp * 16 + i) * 256 + e4));
    LDS_BARRIER();
    if (tid < 128) FBs[tid] = FB[row0 * 16 + tid];
    for (int i = tid; i < 8 * 256; i += NTHREADS) VS[i] = bf1(VB[(row0 + (i >> 8)) * 1024 + h * 256 + (i & 255)]);
    LDS_BARRIER();
    if (tid < 128) {
        const int d = tid; const float* wf2 = C.in[12]; const float* bf2 = C.in[13];
        float wcol[16];
#pragma unroll
        for (int j = 0; j < 16; ++j) wcol[j] = wf2[(size_t)j * 512 + h * 128 + d];
        const float bb = bf2[h * 128 + d];
        float run = 0.f;
#pragma unroll
        for (int c = 0; c < 8; ++c) {
            float z = bb;
#pragma unroll
            for (int j = 0; j < 16; ++j) z += FBs[c * 16 + j] * wcol[j];
            run += logsig16(z);
            const float e = __expf(run);
            QPt[d * 8 + c] = bf1(QB[(row0 + c) * 512 + h * 128 + d]) * e;
            KMt[d * 8 + c] = bf1(KB[(row0 + c) * 512 + h * 128 + d]) / e;
        }
        EBLs[d] = __expf(run);
    }
    LDS_BARRIER();
    if (tid < 64) {
        const int c = tid >> 3, j = tid & 7; float a = 0.f;
        for (int d = 0; d < 128; ++d) a += QPt[d * 8 + c] * KMt[d * 8 + j];
        AM[c * 8 + j] = j <= c ? a : 0.f;
    }
    f32x4 vv[8], oo[8];
#pragma unroll
    for (int c = 0; c < 8; ++c) { vv[c] = *(const LAS f32x4*)(VS + c * 256 + e4); oo[c] = f32x4{0.f, 0.f, 0.f, 0.f}; }
#pragma unroll
    for (int i = 0; i < 16; ++i) {
        const int d = grp * 16 + i;
        const f32x4 s4 = st[i];
        const f32x4 qa = *(const LAS f32x4*)(QPt + d * 8), qb = *(const LAS f32x4*)(QPt + d * 8 + 4);
        const f32x4 ka = *(const LAS f32x4*)(KMt + d * 8), kb = *(const LAS f32x4*)(KMt + d * 8 + 4);
        f32x4 acc = s4;
#pragma unroll
        for (int c = 0; c < 4; ++c) { oo[c] += qa[c] * s4; oo[c + 4] += qb[c] * s4; acc += ka[c] * vv[c]; acc += kb[c] * vv[c + 4]; }
        const float eb = EBLs[d];
        __builtin_nontemporal_store(acc * eb, (f32x4*)(S1 + (size_t)d * 256 + e4));
    }
    {
        LAS float* OSg = (LAS float*)(lds + (grp < 4 ? GS_OS + grp * 8192 : GS_OS2 + (grp - 4) * 8192));
#pragma unroll
        for (int c = 0; c < 8; ++c) *(LAS f32x4*)(OSg + c * 256 + e4) = oo[c];
    }
    LDS_BARRIER();
    {
        const int c = tid >> 6, l = tid & 63;
        float o[4]; float ss = 0.f;
#pragma unroll
        for (int i = 0; i < 4; ++i) {
            const int ee = 4 * l + i; float a = 0.f;
#pragma unroll
            for (int g2 = 0; g2 < 8; ++g2) a += ((const LAS float*)(lds + (g2 < 4 ? GS_OS + g2 * 8192 : GS_OS2 + (g2 - 4) * 8192)))[c * 256 + ee];
#pragma unroll
            for (int j = 0; j < 8; ++j) a += AM[c * 8 + j] * VS[j * 256 + ee];
            o[i] = a; ss += a * a;
        }
        ss = wave_sum(ss);
        const float rinv = rsqrtf(ss * (1.f / 256.f) + EPS);
        const float* gn = C.in[14];
        u32x2 wv;
        const bf16_t* sg = SGB + (row0 + c) * 1024 + h * 256 + 4 * l;
        wv.x = pk2(o[0] * rinv * gn[4 * l] * bf1(sg[0]), o[1] * rinv * gn[4 * l + 1] * bf1(sg[1]));
        wv.y = pk2(o[2] * rinv * gn[4 * l + 2] * bf1(sg[2]), o[3] * rinv * gn[4 * l + 3] * bf1(sg[3]));
        *(u32x2*)(OBN + (row0 + c) * 1536 + h * 256 + 4 * l) = wv;
    }
    LDS_BARRIER();
}

__device__ const unsigned char T5_BUCKET[387] = {0,1,2,3,4,5,6,7,8,9,10,11,12,13,14,15,16,16,16,16,16,16,17,17,17,17,17,17,17,17,18,18,18,18,18,18,18,18,18,18,19,19,19,19,19,19,19,19,19,19,19,19,19,19,20,20,20,20,20,20,20,20,20,20,20,20,20,20,20,20,20,20,20,21,21,21,21,21,21,21,21,21,21,21,21,21,21,21,21,21,21,21,21,21,21,21,21,21,21,22,22,22,22,22,22,22,22,22,22,22,22,22,22,22,22,22,22,22,22,22,22,22,22,22,22,22,22,22,22,0,4,8,12,16,16,17,17,18,18,19,19,19,19,20,20,20,20,20,21,21,21,21,21,21,22,22,22,22,22,22,22,22,22,23,23,23,23,23,23,23,23,23,23,23,23,24,24,24,24,24,24,24,24,24,24,24,24,24,24,24,24,25,25,25,25,25,25,25,25,25,25,25,25,25,25,25,25,25,25,25,25,25,26,26,26,26,26,26,26,26,26,26,26,26,26,26,26,26,26,26,26,26,26,26,26,26,26,26,26,26,26,26,27,27,27,27,27,27,27,27,27,27,27,27,27,27,27,27,0,16,18,19,20,21,21,22,22,23,23,23,24,24,24,24,25,25,25,25,25,26,26,26,26,26,26,26,26,27,27,27,27,27,27,27,27,27,27,28,28,28,28,28,28,28,28,28,28,28,28,28,29,29,29,29,29,29,29,29,29,29,29,29,29,29,29,29,29,29,30,30,30,30,30,30,30,30,30,30,30,30,30,30,30,30,30,30,30,30,30,30,30,30,30,31,31,31,31,31,31,31,31,31,31,31,31,31,31,31,31,31,31,31,31,31,31,31,31,31,31,31,31,31,31,31,31,31,31};

constexpr int AT_V = 0, AT_VP = 272, AT_VW = 32 * AT_VP, AT_BT = 8 * AT_VW, AT_RT = AT_BT + 12 * 129 * 4, AT_END = AT_RT + 12 * 192 * 4;
static_assert(AT_END <= LDS_BYTES, "attn lds");

DI void attn_bias_tables(const Ctx& C, int tid) {
    LAS float* BT = (LAS float*)(C.lds + AT_BT); LAS float* RT = (LAS float*)(C.lds + AT_RT);
    for (int i = tid; i < 12 * 129; i += NTHREADS) { const int hd = i / 129, ds = i % 129; BT[i] = C.in[8][(int)T5_BUCKET[(hd >> 2) * 129 + ds] * 12 + hd] * LOG2E; }
    for (int i = tid; i < 12 * 192; i += NTHREADS) {
        const int hd = i / 192, k = i % 192, dsub = 159 - k;
        RT[i] = (dsub >= 0 && dsub <= 128) ? C.in[8][(int)T5_BUCKET[(hd >> 2) * 129 + dsub] * 12 + hd] * LOG2E : -1e30f;
    }
}

DI void attn_prompt_wave(const Ctx& C, int b, int slot, int g, int res, int m0, int lane) {
    const int r = lane & 31, hh = lane >> 5, dil = 1 << (2 * g), hd = 4 * g + slot;
    unsigned char* ws = C.ws;
    const bf16_t* QA = (const bf16_t*)(ws + WS_QA) + (size_t)hd * MT * 128; const bf16_t* KA = (const bf16_t*)(ws + WS_KA) + (size_t)hd * MT * 128;
    const bf16_t* VA = (const bf16_t*)(ws + WS_VA) + (size_t)hd * MT * 128;
    LAS unsigned char* VL = C.lds + AT_V + C.wave * AT_VW;
    const size_t rowb = (size_t)b * SEQ + (size_t)res * (SEQ >> (2 * g));
    bf16x8 qf[8];
    {
        const bf16_t* qp = QA + (rowb + (size_t)(m0 + r)) * 128 + 8 * hh;
#pragma unroll
        for (int s = 0; s < 8; ++s) qf[s] = *(const bf16x8*)(qp + 16 * s);
    }
    f32x16 P[5];
    u32x4 ka[8], kb[8];
    const size_t lane_off = (size_t)(lane >> 4) * 128 + 8 * (lane & 15);
#define ATT_LOADROWS(dst, base, kt_) do { const int mkb_ = (m0 - 128 + 32 * (kt_)) < 0 ? 0 : (m0 - 128 + 32 * (kt_)); \
        const bf16_t* tp_ = base + (rowb + (size_t)mkb_) * 128 + lane_off; \
        _Pragma("unroll") for (int i = 0; i < 8; ++i) dst[i] = *(const u32x4*)(tp_ + (size_t)i * 512); } while (0)
#define ATT_STAGE(src) do { LDS_WAIT(); asm volatile("" ::: "memory"); \
        _Pragma("unroll") for (int i = 0; i < 8; ++i) *(LAS u32x4*)(VL + (4 * i + (lane >> 4)) * AT_VP + 16 * (lane & 15)) = src[i]; \
        LDS_WAIT(); asm volatile("" ::: "memory"); } while (0)
#define ATT_QK(kt_) do { f32x16 acc_; _Pragma("unroll") for (int j = 0; j < 16; ++j) acc_[j] = 0.f; \
        _Pragma("unroll") for (int s = 0; s < 8; ++s) { const bf16x8 kf_ = *(const LAS bf16x8*)(VL + r * AT_VP + (16 * s + 8 * hh) * 2); acc_ = MFMA32(kf_, qf[s], acc_); } P[kt_] = acc_; } while (0)
    ATT_LOADROWS(ka, KA, 0); ATT_LOADROWS(kb, KA, 1); __builtin_amdgcn_sched_barrier(0);
    ATT_STAGE(ka); ATT_LOADROWS(ka, KA, 2); __builtin_amdgcn_sched_barrier(0); ATT_QK(0); __builtin_amdgcn_sched_barrier(0);
    ATT_STAGE(kb); ATT_LOADROWS(kb, KA, 3); __builtin_amdgcn_sched_barrier(0); ATT_QK(1); __builtin_amdgcn_sched_barrier(0);
    ATT_STAGE(ka); ATT_LOADROWS(ka, KA, 4); __builtin_amdgcn_sched_barrier(0); ATT_QK(2); __builtin_amdgcn_sched_barrier(0);
    ATT_STAGE(kb); __builtin_amdgcn_sched_barrier(0); ATT_QK(3); __builtin_amdgcn_sched_barrier(0);
    ATT_STAGE(ka); __builtin_amdgcn_sched_barrier(0); ATT_QK(4); __builtin_amdgcn_sched_barrier(0);
#undef ATT_QK
    u32x4 vv[8], vw[8];
#define ATT_LOADV(dst, kt_) ATT_LOADROWS(dst, VA, kt_)
    ATT_LOADV(vv, 0); ATT_LOADV(vw, 1);
    __builtin_amdgcn_sched_barrier(0);
    float mx = -1e30f;
    {
        const LAS float* rt = (const LAS float*)(C.lds + AT_RT) + hd * 192 + (31 - r + 4 * hh);
#pragma unroll
        for (int kt = 0; kt < 5; ++kt)
#pragma unroll
            for (int j = 0; j < 16; ++j) { const float sv = P[kt][j] + rt[32 * kt + (j & 3) + 8 * (j >> 2)]; P[kt][j] = sv; }
        if (m0 < 128) {
#pragma unroll
            for (int kt = 0; kt < 5; ++kt)
#pragma unroll
                for (int j = 0; j < 16; ++j) if (m0 - 128 + 32 * kt + crow(j, hh) < 0) P[kt][j] = -1e30f;
        }
#pragma unroll
        for (int kt = 0; kt < 5; ++kt)
#pragma unroll
            for (int j = 0; j < 16; ++j) mx = fmaxf(mx, P[kt][j]);
    }
    mx = fmaxf(mx, __shfl_xor(mx, 32));
    float den = 0.f;
#pragma unroll
    for (int kt = 0; kt < 5; ++kt)
#pragma unroll
        for (int j = 0; j < 16; ++j) { const float p = __builtin_amdgcn_exp2f(P[kt][j] - mx); P[kt][j] = p; den += p; }
    den += __shfl_xor(den, 32);
    f32x16 O[4];
#pragma unroll
    for (int i = 0; i < 4; ++i)
#pragma unroll
        for (int j = 0; j < 16; ++j) O[i][j] = 0.f;
#pragma unroll
    for (int kt = 0; kt < 5; ++kt) {
        __builtin_amdgcn_sched_barrier(0);
        LDS_WAIT(); asm volatile("" ::: "memory");
        if ((kt & 1) == 0) {
#pragma unroll
            for (int i = 0; i < 8; ++i) *(LAS u32x4*)(VL + (4 * i + (lane >> 4)) * AT_VP + 16 * (lane & 15)) = vv[i];
            LDS_WAIT(); asm volatile("" ::: "memory");
            if (kt + 2 < 5) ATT_LOADV(vv, kt + 2);
        } else {
#pragma unroll
            for (int i = 0; i < 8; ++i) *(LAS u32x4*)(VL + (4 * i + (lane >> 4)) * AT_VP + 16 * (lane & 15)) = vw[i];
            LDS_WAIT(); asm volatile("" ::: "memory");
            if (kt + 2 < 5) ATT_LOADV(vw, kt + 2);
        }
        __builtin_amdgcn_sched_barrier(0);
        {
            u32x2 tl[2][4], th[2][4];
            const unsigned va = (unsigned)(size_t)VL + (unsigned)((4 * hh + ((lane & 15) >> 2)) * AT_VP + (16 * ((lane >> 4) & 1) + 4 * (lane & 3)) * 2);
            asm volatile(
                "ds_read_b64_tr_b16 %0, %16\n\tds_read_b64_tr_b16 %1, %16 offset:64\n\tds_read_b64_tr_b16 %2, %16 offset:128\n\tds_read_b64_tr_b16 %3, %16 offset:192\n\t"
                "ds_read_b64_tr_b16 %4, %16 offset:2176\n\tds_read_b64_tr_b16 %5, %16 offset:2240\n\tds_read_b64_tr_b16 %6, %16 offset:2304\n\tds_read_b64_tr_b16 %7, %16 offset:2368\n\t"
                "ds_read_b64_tr_b16 %8, %16 offset:4352\n\tds_read_b64_tr_b16 %9, %16 offset:4416\n\tds_read_b64_tr_b16 %10, %16 offset:4480\n\tds_read_b64_tr_b16 %11, %16 offset:4544\n\t"
                "ds_read_b64_tr_b16 %12, %16 offset:6528\n\tds_read_b64_tr_b16 %13, %16 offset:6592\n\tds_read_b64_tr_b16 %14, %16 offset:6656\n\tds_read_b64_tr_b16 %15, %16 offset:6720\n\t"
                "s_waitcnt lgkmcnt(0)"
                : "=&v"(tl[0][0]), "=&v"(tl[0][1]), "=&v"(tl[0][2]), "=&v"(tl[0][3]), "=&v"(th[0][0]), "=&v"(th[0][1]), "=&v"(th[0][2]), "=&v"(th[0][3]),
                  "=&v"(tl[1][0]), "=&v"(tl[1][1]), "=&v"(tl[1][2]), "=&v"(tl[1][3]), "=&v"(th[1][0]), "=&v"(th[1][1]), "=&v"(th[1][2]), "=&v"(th[1][3])
                : "v"(va) : "memory");
            __builtin_amdgcn_sched_barrier(0);
#pragma unroll
            for (int s = 0; s < 2; ++s) {
                const bf16x8 pb = pack_step(P[kt], s);
#pragma unroll
                for (int dt = 0; dt < 4; ++dt) O[dt] = MFMA32(cat8(tl[s][dt], th[s][dt]), pb, O[dt]);
            }
            __builtin_amdgcn_sched_barrier(0);
        }
    }
#undef ATT_LOADV
#undef ATT_LOADROWS
#undef ATT_STAGE
    const float inv = __builtin_amdgcn_rcpf(den);
    const size_t qrow = rowb + (size_t)(m0 + r);
    bf16_t* op = (bf16_t*)(ws + WS_OAG) + ((size_t)hd * MT + qrow) * 128;
#pragma unroll
    for (int dt = 0; dt < 4; ++dt)
#pragma unroll
        for (int g4 = 0; g4 < 4; g4 += 2) {
            u32x2 wa, wb;
            wa.x = pk2(O[dt][4 * g4] * inv, O[dt][4 * g4 + 1] * inv); wa.y = pk2(O[dt][4 * g4 + 2] * inv, O[dt][4 * g4 + 3] * inv);
            wb.x = pk2(O[dt][4 * g4 + 4] * inv, O[dt][4 * g4 + 5] * inv); wb.y = pk2(O[dt][4 * g4 + 6] * inv, O[dt][4 * g4 + 7] * inv);
            st_rowpair(op, 4 * dt + g4, wa, wb, hh);
        }
    if (hh == 0) ((float*)(ws + WS_LSE))[((size_t)g * MT + qrow) * 4 + slot] = mx + __builtin_amdgcn_logf(den);
}

DI void attn_combine_chunk(unsigned char* ws, size_t row, int slot, int ck) {
    const size_t r0 = row, r1 = (size_t)attn_prow((int)row, 1), r2 = (size_t)attn_prow((int)row, 2);
    const float* lse = (const float*)(ws + WS_LSE) + slot;
    const float l0 = lse[r0 * 4], l1 = lse[((size_t)MT + r1) * 4], l2 = lse[((size_t)2 * MT + r2) * 4];
    const float lm = fmaxf(l0, fmaxf(l1, l2));
    float w0 = __builtin_amdgcn_exp2f(l0 - lm), w1 = __builtin_amdgcn_exp2f(l1 - lm), w2 = __builtin_amdgcn_exp2f(l2 - lm);
    const float ws_ = __builtin_amdgcn_rcpf(w0 + w1 + w2); w0 *= ws_; w1 *= ws_; w2 *= ws_;
    const bf16_t* ob = (const bf16_t*)(ws + WS_OAG) + 8 * ck;
    const u32x4 a = *(const u32x4*)(ob + ((size_t)slot * MT + r0) * 128), bq = *(const u32x4*)(ob + ((size_t)(4 + slot) * MT + r1) * 128), c = *(const u32x4*)(ob + ((size_t)(8 + slot) * MT + r2) * 128);
    u32x4 o;
#pragma unroll
    for (int j = 0; j < 4; ++j) o[j] = pk2(w0 * bflo(a[j]) + w1 * bflo(bq[j]) + w2 * bflo(c[j]), w0 * bfhi(a[j]) + w1 * bfhi(bq[j]) + w2 * bfhi(c[j]));
    *(u32x4*)((bf16_t*)(ws + WS_YAIN) + row * 1536 + slot * 128 + 8 * ck) = o;
}

DI void attn_prompt_item(const Ctx& C, int it) {
    const int bs = it / 96, rem = it % 96, g = rem >> 5, q = rem & 31;
    const int res = g == 0 ? 0 : (g == 1 ? q >> 3 : q >> 1), blk = g == 0 ? q : (g == 1 ? q & 7 : q & 1);
    attn_prompt_wave(C, bs >> 2, bs & 3, g, res, 256 * blk + 32 * C.wave, lane_id_here());
}

DI float half_sum(float v) {
    v += dpp_f<0xB1, 0xf>(v); v += dpp_f<0x4E, 0xf>(v); v += dpp_f<0x141, 0xf>(v); v += dpp_f<0x140, 0xf>(v); v += dpp_f<0x142, 0xa>(v);
    return v;
}
DI void attn_sample_item(const Ctx& C, int b, int slot, int g) {
    const int lane = lane_id_here(), t = C.wave;
    const int hh = lane >> 5, l4 = 4 * (lane & 31);
    unsigned char* ws = C.ws;
    const int dil = 1 << (2 * g), wb = 128 << (2 * g), hd = 4 * g + slot;
    const LAS float* BT = (const LAS float*)(C.lds + AT_BT) + hd * 129;
    const float* cache = C.in[2 + g] + (size_t)b * wb * 1024 + slot * 128 + l4;
    const float* neww = C.out + (g == 0 ? O_W1S : (g == 1 ? O_W2S : O_W3S)) + (size_t)b * 8 * 1024 + slot * 128 + l4;
    const size_t row = (size_t)MP + b * 8 + t;
    const u32x2 qraw = *(const u32x2*)((const bf16_t*)(ws + WS_QA) + ((size_t)hd * MT + row) * 128 + l4);
    const float q0 = bflo(qraw.x), q1 = bfhi(qraw.x), q2 = bflo(qraw.y), q3 = bfhi(qraw.y);
    const f32x4 kt = __builtin_nontemporal_load((const f32x4*)(cache + (size_t)t * 1024));
    const f32x4 vt = __builtin_nontemporal_load((const f32x4*)(cache + (size_t)t * 1024 + 512));
    float m = -1e30f, l = 0.f;
    f32x4 o = {0.f, 0.f, 0.f, 0.f};
#pragma unroll 1
    for (int jb = 0; jb < 128; jb += 32) {
        f32x4 kk[16], vv[16];
#pragma unroll
        for (int u = 0; u < 16; ++u) {
            const int j = jb + 2 * u + hh; const int id = wb + t - j * dil;
            const float* kr = id >= wb ? neww + (size_t)(id - wb) * 1024 : cache + (size_t)id * 1024;
            kk[u] = *(const f32x4*)kr;
            vv[u] = *(const f32x4*)(kr + 512);
        }
        unsigned sbits = __float_as_uint(-1e30f);
#pragma unroll
        for (int u = 0; u < 16; ++u) {
            const float d = half_sum(q0 * kk[u].x + q1 * kk[u].y + q2 * kk[u].z + q3 * kk[u].w);
            const unsigned se = __builtin_amdgcn_readlane(__float_as_uint(d), 31), so = __builtin_amdgcn_readlane(__float_as_uint(d), 63);
            sbits = lane == 2 * u ? se : sbits;
            sbits = lane == 2 * u + 1 ? so : sbits;
        }
        const float sb = lane < 32 ? __uint_as_float(sbits) + BT[jb + (lane & 31)] : -1e30f;
        const float mn = fmaxf(m, wave_max(sb));
        const float alpha = __builtin_amdgcn_exp2f(m - mn);
        const float pb = lane < 32 ? __builtin_amdgcn_exp2f(sb - mn) : 0.f;
        l = l * alpha + wave_sum(pb); m = mn;
        o.x *= alpha; o.y *= alpha; o.z *= alpha; o.w *= alpha;
#pragma unroll
        for (int u = 0; u < 16; ++u) {
            const float pe = __uint_as_float(__builtin_amdgcn_readlane(__float_as_uint(pb), 2 * u));
            const float po = __uint_as_float(__builtin_amdgcn_readlane(__float_as_uint(pb), 2 * u + 1));
            const float p = hh ? po : pe;
            o.x += p * vv[u].x; o.y += p * vv[u].y; o.z += p * vv[u].z; o.w += p * vv[u].w;
        }
    }
    {
        const float d = half_sum(q0 * kt.x + q1 * kt.y + q2 * kt.z + q3 * kt.w);
        const float sT = __uint_as_float(__builtin_amdgcn_readlane(__float_as_uint(d), 31)) + BT[128];
        const float mn = fmaxf(m, sT);
        const float alpha = __builtin_amdgcn_exp2f(m - mn), pT = __builtin_amdgcn_exp2f(sT - mn);
        l = l * alpha + pT; m = mn;
        const float p = hh ? 0.f : pT;
        o.x = o.x * alpha + p * vt.x; o.y = o.y * alpha + p * vt.y; o.z = o.z * alpha + p * vt.z; o.w = o.w * alpha + p * vt.w;
    }
    o.x += __shfl_xor(o.x, 32); o.y += __shfl_xor(o.y, 32); o.z += __shfl_xor(o.z, 32); o.w += __shfl_xor(o.w, 32);
    const float inv = 1.f / l;
    if (lane < 32) { u32x2 w2; w2.x = pk2(o.x * inv, o.y * inv); w2.y = pk2(o.z * inv, o.w * inv); *(u32x2*)((bf16_t*)(ws + WS_OAG) + ((size_t)hd * MT + row) * 128 + l4) = w2; }
    if (lane == 0) ((float*)(ws + WS_LSE))[((size_t)g * MT + row) * 4 + slot] = m + __builtin_amdgcn_logf(l);
}

DI float rs_from4(const float* ssq4, int row) { const f32x4 p = *(const f32x4*)(ssq4 + (size_t)row * 4); return rsqrtf(((p[0] + p[1]) + (p[2] + p[3])) * (1.f / 1024.f) + EPS); }

DI void ld_bf16x8(const bf16_t* p, f32x4& a, f32x4& b) {
    const u32x4 w = *(const u32x4*)p;
    a = (f32x4){bflo(w.x), bfhi(w.x), bflo(w.y), bfhi(w.y)}; b = (f32x4){bflo(w.z), bfhi(w.z), bflo(w.w), bfhi(w.w)};
}
template <int MODE> struct EpiGate {
    static constexpr bool PERM = true, AFTER_DRAIN = false, HAS_MID = false;
    const bf16_t* G; const bf16_t* T; bf16_t* D;
    DI void operator()(const f32x4 (&acc)[2][2][4][2], const pg8::Unit& u, int wr, int wc, int fr, int fq) const {
        const int rbase = u.pm * 256 + wr * 64 + fr, c0 = u.pn * 256 + wc * 32 + 8 * fq;
#pragma unroll
        for (int ai = 0; ai < 2; ++ai)
#pragma unroll
            for (int m = 0; m < 4; ++m) {
                const size_t off = (size_t)(rbase + ai * 128 + m * 16) * 1024 + c0;
#pragma unroll
                for (int bj = 0; bj < 2; ++bj) {
                    f32x4 g0, g1; ld_bf16x8(G + off + bj * 128, g0, g1);
                    f32x4 v0 = acc[ai][bj][m][0] * g0, v1 = acc[ai][bj][m][1] * g1;
                    if (MODE == 1) { f32x4 t0, t1; ld_bf16x8(T + off + bj * 128, t0, t1); v0 += t0; v1 += t1; }
                    st_bf16x8(D + off + bj * 128, v0, v1);
                }
            }
    }
};
struct EpiGate2 {
    static constexpr bool PERM = true, AFTER_DRAIN = false, HAS_MID = true;
    const bf16_t* GA; const bf16_t* GB; bf16_t* D; int mid_t;
    DI void mid(f32x4 (&acc)[2][2][4][2], const pg8::Unit& u, int wr, int wc, int fr_, int fq_) const {
        const int lane = lane_id_here(), fr = lane & 15, fq = lane >> 4;
        const int rbase = u.pm * 256 + wr * 64 + fr, c0 = u.pn * 256 + wc * 32 + 8 * fq;
#pragma unroll
        for (int ai = 0; ai < 2; ++ai) {
            u32x4 ga[4][2], gb[4][2];
#pragma unroll
            for (int m = 0; m < 4; ++m)
#pragma unroll
                for (int bj = 0; bj < 2; ++bj) {
                    const size_t off = (size_t)(rbase + ai * 128 + m * 16) * 1024 + c0 + bj * 128;
                    ga[m][bj] = *(const u32x4*)(GA + off); gb[m][bj] = *(const u32x4*)(GB + off);
                }
            __builtin_amdgcn_sched_barrier(0);
#pragma unroll
            for (int m = 0; m < 4; ++m)
#pragma unroll
                for (int bj = 0; bj < 2; ++bj) {
                    const u32x4 wa = ga[m][bj], wb = gb[m][bj];
                    const f32x4 a0 = (f32x4){bflo(wa.x), bfhi(wa.x), bflo(wa.y), bfhi(wa.y)}, a1 = (f32x4){bflo(wa.z), bfhi(wa.z), bflo(wa.w), bfhi(wa.w)};
                    const f32x4 b0 = (f32x4){bflo(wb.x), bfhi(wb.x), bflo(wb.y), bfhi(wb.y)}, b1 = (f32x4){bflo(wb.z), bfhi(wb.z), bflo(wb.w), bfhi(wb.w)};
#pragma unroll
                    for (int i = 0; i < 4; ++i) { acc[ai][bj][m][0][i] *= a0[i] * __builtin_amdgcn_rcpf(fmaxf(b0[i], 1e-30f)); acc[ai][bj][m][1][i] *= a1[i] * __builtin_amdgcn_rcpf(fmaxf(b1[i], 1e-30f)); }
                }
            __builtin_amdgcn_sched_barrier(0);
        }
    }
    DI void operator()(const f32x4 (&acc)[2][2][4][2], const pg8::Unit& u, int wr, int wc, int fr, int fq) const {
        const int rbase = u.pm * 256 + wr * 64 + fr, c0 = u.pn * 256 + wc * 32 + 8 * fq;
#pragma unroll
        for (int ai = 0; ai < 2; ++ai) {
            u32x4 gw[4][2];
#pragma unroll
            for (int m = 0; m < 4; ++m)
#pragma unroll
                for (int bj = 0; bj < 2; ++bj) gw[m][bj] = *(const u32x4*)(GB + (size_t)(rbase + ai * 128 + m * 16) * 1024 + c0 + bj * 128);
#pragma unroll
            for (int m = 0; m < 4; ++m) {
                const size_t off = (size_t)(rbase + ai * 128 + m * 16) * 1024 + c0;
#pragma unroll
                for (int bj = 0; bj < 2; ++bj) {
                    const u32x4 w = gw[m][bj];
                    const f32x4 b0 = (f32x4){bflo(w.x), bfhi(w.x), bflo(w.y), bfhi(w.y)}, b1 = (f32x4){bflo(w.z), bfhi(w.z), bflo(w.w), bfhi(w.w)};
                    st_bf16x8(D + off + bj * 128, acc[ai][bj][m][0] * b0, acc[ai][bj][m][1] * b1);
                }
            }
        }
    }
};
struct EpiBranch {
    static constexpr bool PERM = true, AFTER_DRAIN = false, HAS_MID = false;
    bf16_t* D; float* ssq;
    DI void operator()(const f32x4 (&acc)[2][2][4][2], const pg8::Unit& u, int wr, int wc, int fr, int fq) const {
        const int rbase = u.pm * 256 + wr * 64 + fr, c0 = u.pn * 256 + wc * 32 + 8 * fq;
#pragma unroll
        for (int ai = 0; ai < 2; ++ai)
#pragma unroll
            for (int m = 0; m < 4; ++m) {
                const int row = rbase + ai * 128 + m * 16; const size_t off = (size_t)row * 1024 + c0;
                float s = 0.f;
#pragma unroll
                for (int bj = 0; bj < 2; ++bj) {
                    const f32x4 v0 = acc[ai][bj][m][0], v1 = acc[ai][bj][m][1];
                    s += (v0[0] * v0[0] + v0[1] * v0[1]) + (v0[2] * v0[2] + v0[3] * v0[3]) + (v1[0] * v1[0] + v1[1] * v1[1]) + (v1[2] * v1[2] + v1[3] * v1[3]);
                    st_bf16x8(D + off + bj * 128, v0, v1);
                }
                s += __shfl_xor(s, 16); s += __shfl_xor(s, 32);
                if (fq == 0) ssq[(size_t)row * 16 + 4 * u.pn + wc] = s;
            }
    }
};
struct EpiRowScale {
    static constexpr bool PERM = true, AFTER_DRAIN = false, HAS_MID = false;
    const float* rs; bf16_t* D; float scale;
    DI void operator()(const f32x4 (&acc)[2][2][4][2], const pg8::Unit& u, int wr, int wc, int fr, int fq) const {
        const int rbase = u.pm * 256 + wr * 64 + fr, c0 = u.pn * 256 + wc * 32 + 8 * fq;
        float rsv[2][4];
#pragma unroll
        for (int ai = 0; ai < 2; ++ai)
#pragma unroll
            for (int m = 0; m < 4; ++m) rsv[ai][m] = rs[rbase + ai * 128 + m * 16];
#pragma unroll
        for (int ai = 0; ai < 2; ++ai)
#pragma unroll
            for (int m = 0; m < 4; ++m) {
                const int row = rbase + ai * 128 + m * 16; const float r = rsv[ai][m] * scale; const size_t off = (size_t)row * 1024 + c0;
#pragma unroll
                for (int bj = 0; bj < 2; ++bj) st_bf16x8(D + off + bj * 128, acc[ai][bj][m][0] * r, acc[ai][bj][m][1] * r);
            }
    }
};
struct EpiGateUp {
    static constexpr bool PERM = true, AFTER_DRAIN = false, HAS_MID = false;
    const float* rs; bf16_t* H;
    DI void operator()(const f32x4 (&acc)[2][2][4][2], const pg8::Unit& u, int wr, int wc, int fr, int fq) const {
        const int rbase = u.pm * 256 + wr * 64 + fr, c0 = u.pn * 128 + wc * 32 + 8 * fq;
        float rsv[2][4];
#pragma unroll
        for (int ai = 0; ai < 2; ++ai)
#pragma unroll
            for (int m = 0; m < 4; ++m) rsv[ai][m] = rs[rbase + ai * 128 + m * 16];
#pragma unroll
        for (int ai = 0; ai < 2; ++ai)
#pragma unroll
            for (int m = 0; m < 4; ++m) {
                const int row = rbase + ai * 128 + m * 16; const float r = rsv[ai][m];
                f32x4 g0 = acc[ai][0][m][0] * r, g1 = acc[ai][0][m][1] * r; const f32x4 u0 = acc[ai][1][m][0] * r, u1 = acc[ai][1][m][1] * r;
#pragma unroll
                for (int i = 0; i < 4; ++i) { g0[i] = g0[i] * fsigmoid(g0[i]) * u0[i]; g1[i] = g1[i] * fsigmoid(g1[i]) * u1[i]; }
                st_bf16x8(H + (size_t)row * DFF + c0, g0, g1);
            }
    }
};

template <bool FIRST, bool LAST> DI void resid_pass(const Ctx& C, const float* gain) {
    const int lane = lane_id_here(); const int gw = C.bid * 8 + C.wave, NGW = C.G * 8;
    unsigned char* ws = C.ws;
    const bf16_t* BR = (const bf16_t*)(ws + WS_MIX); const float* SSQ = (const float*)(ws + WS_SSQ);
    bf16_t* XB = (bf16_t*)(ws + WS_XB); float* RS = (float*)(ws + WS_RS);
    f32x4 gv[4];
#pragma unroll
    for (int j = 0; j < 4; ++j) gv[j] = ((const f32x4*)gain)[lane + 64 * j];
    u32x2 bw[4]; f32x4 xv[4]; u32x2 xbv[4]; float sq = 0.f;
#define RESID_LOAD(m_) do { const int mm_ = (m_); \
        sq = mm_ < MP ? (lane < 16 ? SSQ[(size_t)mm_ * 16 + lane] : 0.f) : (lane < 32 ? ((const float*)(ws + WS_SSQ + 2560 * 1024))[(size_t)(mm_ - MP) * 32 + lane] : 0.f); \
        _Pragma("unroll") for (int j = 0; j < 4; ++j) { bw[j] = ((const u32x2*)(BR + (size_t)mm_ * 1024))[lane + 64 * j]; \
            if (FIRST) { const float* xo_ = mm_ < MP ? C.in[0] + (size_t)mm_ * 1024 : C.in[1] + (size_t)(mm_ - MP) * 1024; xv[j] = __builtin_nontemporal_load((const f32x4*)xo_ + lane + 64 * j); } \
            else xbv[j] = ((const u32x2*)(XB + (size_t)mm_ * 1024))[lane + 64 * j]; } } while (0)
    if (gw < MT) RESID_LOAD(gw);
    for (int m = gw; m < MT; m += NGW) {
        u32x2 cb[4]; f32x4 cx[4]; const float csq = sq;
#pragma unroll
        for (int j = 0; j < 4; ++j) { cb[j] = bw[j]; cx[j] = FIRST ? xv[j] : (f32x4){bflo(xbv[j].x), bfhi(xbv[j].x), bflo(xbv[j].y), bfhi(xbv[j].y)}; }
        if (m + NGW < MT) RESID_LOAD(m + NGW);
        const float rb = rsqrtf(wave_sum(csq) * (1.f / 1024.f) + EPS);
        f32x4 v[4]; float s = 0.f;
#pragma unroll
        for (int j = 0; j < 4; ++j) {
            const f32x4 bv = (f32x4){bflo(cb[j].x), bfhi(cb[j].x), bflo(cb[j].y), bfhi(cb[j].y)};
            v[j] = cx[j] + bv * rb * gv[j];
            s += (v[j].x * v[j].x + v[j].y * v[j].y) + (v[j].z * v[j].z + v[j].w * v[j].w);
        }
        if (LAST) {
#pragma unroll
            for (int j = 0; j < 4; ++j) __builtin_nontemporal_store(v[j], (f32x4*)(C.out + (size_t)m * 1024) + lane + 64 * j);
        } else {
            s = wave_sum(s);
#pragma unroll
            for (int j = 0; j < 4; ++j) { u32x2 w; w.x = pk2(v[j].x, v[j].y); w.y = pk2(v[j].z, v[j].w); ((u32x2*)(XB + (size_t)m * 1024))[lane + 64 * j] = w; }
            if (lane == 0) RS[m] = rsqrtf(s * (1.f / 1024.f) + EPS);
        }
    }
#undef RESID_LOAD
}

constexpr int XA_PITCH = 528, XA_BUF = 128 * XA_PITCH;
#ifndef XREP_S
#define XREP_S 1
#endif
#ifndef XREP_PV
#define XREP_PV 1
#endif
static_assert(2 * XA_BUF <= LDS_BYTES - 64, "xattn lds");
DI void xattn_prompt_item(const Ctx& C, int item) {
    const int lane = lane_id_here(), w = C.wave, tid = w * 64 + lane, r = lane & 31, hh = lane >> 5;
    const int bh = item >> 5, tb = item & 31, b = bh >> 2, h = bh & 3;
    unsigned char* ws = C.ws; LAS unsigned char* lds = C.lds;
    const size_t row0 = (size_t)b * SEQ + (size_t)tb * 256 + 32 * w;
    const bf16_t* Kg = (const bf16_t*)(ws + WS_MK) + (size_t)b * 256 * 1024 + h * 256;
    const bf16_t* Vg = (const bf16_t*)(ws + WS_MVT) + ((size_t)b * 1024 + h * 256) * 256;
    u32x4 st[16];
    const bf16_t* kld = Kg + (size_t)(tid >> 5) * 1024 + 8 * (tid & 31);
    const bf16_t* vld = Vg + (size_t)(tid >> 5) * 256 + 8 * (tid & 31);
    LAS unsigned char* wst = lds + (tid >> 5) * XA_PITCH + 16 * (tid & 31);
#define XA_WRITE_ALL() do { _Pragma("unroll") for (int i = 0; i < 16; ++i) *(LAS u32x4*)(wst + (i >> 3) * XA_BUF + 16 * (i & 7) * XA_PITCH) = st[i]; } while (0)
#pragma unroll
    for (int i = 0; i < 16; ++i) st[i] = *(const u32x4*)(kld + (size_t)(16 * i) * 1024);
    bf16x8 qf[16];
    {
        const bf16_t* Q = (const bf16_t*)(ws + WS_Q2) + (row0 + r) * 1024 + h * 256 + 8 * hh;
#pragma unroll
        for (int s = 0; s < 16; ++s) qf[s] = *(const bf16x8*)(Q + 16 * s);
    }
    LDS_BARRIER();
    XA_WRITE_ALL();
    LDS_BARRIER();
    f32x16 P[8];
#pragma unroll
    for (int kh = 0; kh < 2; ++kh) {
        f32x16 acc[4];
#pragma unroll
        for (int kt = 0; kt < 4; ++kt)
#pragma unroll
            for (int j = 0; j < 16; ++j) acc[kt][j] = 0.f;
        const LAS unsigned char* kb_ = lds + kh * XA_BUF + r * XA_PITCH + 16 * hh;
        bf16x8 fa[4], fb[4];
#pragma unroll
        for (int kt = 0; kt < 4; ++kt) fa[kt] = *(const LAS bf16x8*)(kb_ + 32 * kt * XA_PITCH);
#pragma unroll
        for (int s = 0; s < 16; s += 2) {
#pragma unroll
            for (int kt = 0; kt < 4; ++kt) fb[kt] = *(const LAS bf16x8*)(kb_ + 32 * kt * XA_PITCH + 32 * (s + 1));
#pragma unroll
            for (int kt = 0; kt < 4; ++kt) acc[kt] = MFMA32(fa[kt], qf[s], acc[kt]);
            if (s + 2 < 16) {
#pragma unroll
                for (int kt = 0; kt < 4; ++kt) fa[kt] = *(const LAS bf16x8*)(kb_ + 32 * kt * XA_PITCH + 32 * (s + 2));
            }
#pragma unroll
            for (int kt = 0; kt < 4; ++kt) acc[kt] = MFMA32(fb[kt], qf[s + 1], acc[kt]);
        }
#pragma unroll
        for (int kt = 0; kt < 4; ++kt) P[4 * kh + kt] = acc[kt];
    }
    float mx = -1e30f;
#pragma unroll
    for (int kt = 0; kt < 8; ++kt)
#pragma unroll
        for (int j = 0; j < 16; ++j) mx = fmaxf(mx, P[kt][j]);
    mx = fmaxf(mx, __shfl_xor(mx, 32));
    float den = 0.f;
    bf16x8 pb[8][2];
#pragma unroll
    for (int kt = 0; kt < 8; ++kt) {
#pragma unroll
        for (int j = 0; j < 16; ++j) { const float p = __builtin_amdgcn_exp2f(P[kt][j] - mx); P[kt][j] = p; den += p; }
        pb[kt][0] = pack_step(P[kt], 0); pb[kt][1] = pack_step(P[kt], 1);
    }
    den += __shfl_xor(den, 32);
    const float inv = __builtin_amdgcn_rcpf(den);
    bf16_t* op = (bf16_t*)(ws + WS_O2) + (row0 + r) * 1024 + h * 256;
#pragma unroll
    for (int i = 0; i < 16; ++i) st[i] = *(const u32x4*)(vld + (size_t)(16 * i) * 256);
    LDS_BARRIER();
    XA_WRITE_ALL();
    LDS_BARRIER();
#pragma unroll
    for (int dh = 0; dh < 2; ++dh) {
        f32x16 O[4];
#pragma unroll
        for (int i = 0; i < 4; ++i)
#pragma unroll
            for (int j = 0; j < 16; ++j) O[i][j] = 0.f;
        {
            const LAS unsigned char* vb_ = lds + dh * XA_BUF + r * XA_PITCH + 8 * hh;
            u32x2 va[4][2], vb2[4][2];
#define XA_VREAD(dst, st_) do { _Pragma("unroll") for (int dt = 0; dt < 4; ++dt) { const LAS unsigned char* p_ = vb_ + 32 * dt * XA_PITCH + 32 * (st_); \
                dst[dt][0] = *(const LAS u32x2*)p_; dst[dt][1] = *(const LAS u32x2*)(p_ + 16); } } while (0)
            XA_VREAD(va, 0);
#pragma unroll
            for (int st2 = 0; st2 < 16; st2 += 2) {
                XA_VREAD(vb2, st2 + 1);
#pragma unroll
                for (int dt = 0; dt < 4; ++dt) O[dt] = MFMA32(cat8(va[dt][0], va[dt][1]), pb[st2 >> 1][0], O[dt]);
                if (st2 + 2 < 16) XA_VREAD(va, st2 + 2);
#pragma unroll
                for (int dt = 0; dt < 4; ++dt) O[dt] = MFMA32(cat8(vb2[dt][0], vb2[dt][1]), pb[st2 >> 1][1], O[dt]);
            }
#undef XA_VREAD
        }
#pragma unroll
        for (int dt = 0; dt < 4; ++dt)
#pragma unroll
            for (int g4 = 0; g4 < 4; g4 += 2) {
                u32x2 wa, wb;
                wa.x = pk2(O[dt][4 * g4] * inv, O[dt][4 * g4 + 1] * inv); wa.y = pk2(O[dt][4 * g4 + 2] * inv, O[dt][4 * g4 + 3] * inv);
                wb.x = pk2(O[dt][4 * g4 + 4] * inv, O[dt][4 * g4 + 5] * inv); wb.y = pk2(O[dt][4 * g4 + 6] * inv, O[dt][4 * g4 + 7] * inv);
                st_rowpair(op + 128 * dh, 4 * dt + g4, wa, wb, hh);
            }
    }
#undef XA_WRITE_ALL
}
constexpr int XS_Q = 0, XS_SC = 4096, XS_PART = 8192, XS_END = 8192 + 32768;
DI void xattn_sample_item(const Ctx& C, int b, int h, int th) {
    const int lane = lane_id_here(), w = C.wave, tid = w * 64 + lane;
    unsigned char* ws = C.ws;
    LAS float* QS = (LAS float*)(C.lds + XS_Q); LAS float* SC = (LAS float*)(C.lds + XS_SC); LAS float* PART = (LAS float*)(C.lds + XS_PART);
    const float* cache = C.in[6] + (size_t)b * 256 * 2048 + h * 256;
    const size_t row0 = (size_t)MP + b * 8 + 4 * th;
    LDS_BARRIER();
    for (int i = tid; i < 4 * 256; i += NTHREADS) QS[i] = bf1(((const bf16_t*)(ws + WS_Q2))[(row0 + (i >> 8)) * 1024 + h * 256 + (i & 255)]);
    LDS_BARRIER();
    {
        f32x4 q[4];
#pragma unroll
        for (int t = 0; t < 4; ++t) q[t] = *(const LAS f32x4*)(QS + t * 256 + 4 * lane);
        for (int mb = 0; mb < 32; mb += 16) {
            f32x4 kk[16];
#pragma unroll
            for (int u = 0; u < 16; ++u) kk[u] = __builtin_nontemporal_load((const f32x4*)(cache + (size_t)(32 * w + mb + u) * 2048 + 4 * lane));
#pragma unroll
            for (int u = 0; u < 16; ++u) {
#pragma unroll
                for (int t = 0; t < 4; ++t) {
                    const float s = wave_sum(q[t].x * kk[u].x + q[t].y * kk[u].y + q[t].z * kk[u].z + q[t].w * kk[u].w);
                    if (lane == 0) SC[t * 256 + 32 * w + mb + u] = s;
                }
            }
        }
    }
    LDS_BARRIER();
    if (w < 4) {
        float v[4]; float mx = -1e30f;
#pragma unroll
        for (int i = 0; i < 4; ++i) { v[i] = SC[w * 256 + lane + 64 * i]; mx = fmaxf(mx, v[i]); }
        mx = wave_max(mx);
        float den = 0.f;
#pragma unroll
        for (int i = 0; i < 4; ++i) { v[i] = __builtin_amdgcn_exp2f(v[i] - mx); den += v[i]; }
        den = wave_sum(den);
        const float inv = 1.f / den;
#pragma unroll
        for (int i = 0; i < 4; ++i) SC[w * 256 + lane + 64 * i] = v[i] * inv;
    }
    LDS_BARRIER();
    {
        f32x4 o[4];
#pragma unroll
        for (int t = 0; t < 4; ++t) o[t] = f32x4{0.f, 0.f, 0.f, 0.f};
        for (int mb = 0; mb < 32; mb += 16) {
            f32x4 vv[16];
#pragma unroll
            for (int u = 0; u < 16; ++u) vv[u] = __builtin_nontemporal_load((const f32x4*)(cache + (size_t)(32 * w + mb + u) * 2048 + 1024 + 4 * lane));
#pragma unroll
            for (int u4 = 0; u4 < 4; ++u4) {
#pragma unroll
                for (int t = 0; t < 4; ++t) {
                    const f32x4 pv = *(const LAS f32x4*)(SC + t * 256 + 32 * w + mb + 4 * u4);
#pragma unroll
                    for (int i = 0; i < 4; ++i) o[t] += pv[i] * vv[4 * u4 + i];
                }
            }
        }
#pragma unroll
        for (int t = 0; t < 4; ++t) *(LAS f32x4*)(PART + (w * 4 + t) * 256 + 4 * lane) = o[t];
    }
    LDS_BARRIER();
    {
        const int t = tid >> 7, d2 = 2 * (tid & 127);
        float a0 = 0.f, a1 = 0.f;
#pragma unroll
        for (int g = 0; g < 8; ++g) { const f32x2 pp = *(const LAS f32x2*)(PART + (g * 4 + t) * 256 + d2); a0 += pp.x; a1 += pp.y; }
        *(unsigned*)((bf16_t*)(ws + WS_O2) + (row0 + t) * 1024 + h * 256 + d2) = pk2(a0, a1);
    }
    LDS_BARRIER();
}

template <int NACC, class F> DI void sgemm_unit(const Ctx& C, const bf16_t* __restrict__ A, const bf16_t* __restrict__ B0, const bf16_t* __restrict__ B1, int K, int tm, const F& fin, int lda = 0, int ldb = 0) {
    if (lda == 0) lda = K;
    if (ldb == 0) ldb = K;
    const int lane = lane_id_here(), w = C.wave, r = lane & 31, hh = lane >> 5;
    LAS float* PT = (LAS float*)C.lds;
    f32x16 acc[NACC];
#pragma unroll
    for (int i = 0; i < NACC; ++i)
#pragma unroll
        for (int j = 0; j < 16; ++j) acc[i][j] = 0.f;
    const int ksl = K / 8;
    const bf16_t* ap = A + (size_t)(32 * tm + r) * lda + w * ksl + 8 * hh;
    const bf16_t* bp0 = B0 + (size_t)r * ldb + w * ksl + 8 * hh;
    const bf16_t* bp1 = B1 + (size_t)r * ldb + w * ksl + 8 * hh;
#pragma unroll 4
    for (int k = 0; k < ksl; k += 16) {
        const bf16x8 a = *(const bf16x8*)(ap + k);
        acc[0] = MFMA32(a, *(const bf16x8*)(bp0 + k), acc[0]);
        if (NACC == 2) acc[1] = MFMA32(a, *(const bf16x8*)(bp1 + k), acc[1]);
    }
    LDS_BARRIER();
#pragma unroll
    for (int i = 0; i < NACC; ++i)
#pragma unroll
        for (int j = 0; j < 16; ++j) PT[((i * 8 + w) * 32 + crow(j, hh)) * 33 + r] = acc[i][j];
    LDS_BARRIER();
    const int tid = w * 64 + lane, row = tid >> 4, c2 = 2 * (tid & 15);
    float v[NACC][2];
#pragma unroll
    for (int i = 0; i < NACC; ++i) {
        float s0 = 0.f, s1 = 0.f;
#pragma unroll
        for (int ww = 0; ww < 8; ++ww) { s0 += PT[((i * 8 + ww) * 32 + row) * 33 + c2]; s1 += PT[((i * 8 + ww) * 32 + row) * 33 + c2 + 1]; }
        v[i][0] = s0; v[i][1] = s1;
    }
    fin(32 * tm + row, c2, v);
}

constexpr size_t WS_SSQS = WS_SSQ + 2560 * 1024;
static_assert(WS_SSQ + (size_t)MT * 16 * 4 <= WS_SSQS && WS_SSQS + 256 * 32 * 4 <= WS_FB, "ssqs map");
DI void sgemm_branch(const Ctx& C, const bf16_t* A, const bf16_t* Bt, int K, int tm, int tn) {
    unsigned char* ws = C.ws; bf16_t* MIX = (bf16_t*)(ws + WS_MIX); float* SSQS = (float*)(ws + WS_SSQS);
    sgemm_unit<1>(C, A, Bt + (size_t)32 * tn * K, nullptr, K, tm,
        [&](int row, int c2, const float (&v)[1][2]) {
            *(unsigned*)(MIX + ((size_t)MP + row) * 1024 + 32 * tn + c2) = pk2(v[0][0], v[0][1]);
            float s = v[0][0] * v[0][0] + v[0][1] * v[0][1];
            s += __shfl_xor(s, 1); s += __shfl_xor(s, 2); s += __shfl_xor(s, 4); s += __shfl_xor(s, 8);
            if ((c2 >> 1) == 0) SSQS[row * 32 + tn] = s; });
}

#ifndef MK_N_LAUNCHES
#define MK_N_LAUNCHES 1
#endif
constexpr int N_PHASES = 16;
#define REP_A 1
#define STAGGER_US 0
#define REP_X 1
#define REP_XS 1
#define EXTRA_BARS 0
#define PROBE_NULLGEMM 0
#define REP_B 1
#define REP_C 1
#define REP_PA 1
#ifndef REP_MASK
#define REP_MASK 0
#endif
#define NREP(k) (((REP_MASK) >> (k)) & 1 ? 2 : 1)

__global__ void __launch_bounds__(NTHREADS, 2) fwd_megakernel(Args args) {
    extern __shared__ __attribute__((aligned(16))) unsigned char lds_raw[];
    cg::grid_group grid = cg::this_grid();
    Ctx C;
    C.in = args.in; C.out = args.out; C.ws = args.ws;
    C.lds = (LAS unsigned char*)lds_raw;
    C.wave = __builtin_amdgcn_readfirstlane(threadIdx.x >> 6);
    C.G = gridDim.x; C.bid = blockIdx.x;
    const int lo = args.ph_lo, hi = args.ph_hi;
    unsigned char* ws = args.ws;
#define IN(k) (lo <= (k) && (k) < hi)
    volatile LAS unsigned* MISC = (volatile LAS unsigned*)(C.lds + LDS_BYTES - 64);
    const bool leader = (C.wave == 0) && (lane_id() == 0);
    if (leader) { MISC[0] = 0u; MISC[1] = 0u; }
    __syncthreads();
    XcdBarrier xbar = xcd_barrier_post((unsigned*)(ws + WS_CTL), MISC, leader);
#define SEAM(k) do { if (IN(k) && IN((k) + 1)) { if ((k) == 0 && lo < 0) grid.sync(); else xcd_barrier(xbar, (C.wave == 0) && (lane_id() == 0)); } } while (0)

    if (IN(0)) for (int rep_ = 0; rep_ < NREP(0); ++rep_) { p0_prologue(C); }
    SEAM(0);
    if (IN(1)) for (int rep_ = 0; rep_ < NREP(1); ++rep_) {
        {
            if (STAGGER_US > 0 && ((C.bid >> 3) & 1)) { const unsigned long long t0 = __builtin_amdgcn_s_memrealtime(); while (__builtin_amdgcn_s_memrealtime() - t0 < (unsigned long long)(STAGGER_US * 100)) __builtin_amdgcn_s_sleep(32); }
            pg8::Gemm g{(const bf16_t*)(ws + WS_XB), (const bf16_t*)(ws + WS_WIN), MT, NIN, 1024};
            pg8::StaticOrder S; S.init(MT, NIN, C.G, C.bid);
            EpiIn E{(const float*)(ws + WS_RS), ws, args.out};
            pg8::gemm_phase<EpiIn, pg8::StaticOrder, true, true>(C.lds, g, S, E, C.wave);
        }
        {
            pg8::Gemm g{(const bf16_t*)(ws + WS_MEMB), (const bf16_t*)(ws + WS_WMKV), 1024, 2048, 1024};
            pg8::StaticOrder S; S.init(1024, 2048, C.G, C.G - 1 - C.bid);
            EpiMemKV E{(const float*)(ws + WS_RSMEM), ws, args.out};
            pg8::gemm_phase<EpiMemKV, pg8::StaticOrder, true, true>(C.lds, g, S, E, C.wave);
        }
    }
#if PROBE_NULLGEMM
    {
        pg8::Gemm g{(const bf16_t*)(ws + WS_XB), (const bf16_t*)(ws + WS_WIN), MT, NIN, 1024};
        pg8::StaticOrder S; S.init(MT, NIN, C.G, C.bid);
        EpiNull E{(float*)(ws + WS_SSQ)};
        pg8::gemm_phase<EpiNull, pg8::StaticOrder, true, true>(C.lds, g, S, E, C.wave);
    }
#endif
    SEAM(1);
#if EXTRA_BARS
    for (int q_ = 0; q_ < EXTRA_BARS; ++q_) xcd_barrier(xbar, (C.wave == 0) && (lane_id() == 0));
#endif
    if (IN(2)) for (int rep_ = 0; rep_ < NREP(2); ++rep_) {
        LDS_BARRIER();
        attn_bias_tables(C, C.wave * 64 + lane_id_here());
        LDS_BARRIER();
        const bool rev = ((C.bid >> 3) & 1) != 0;
        for (int ord = 0; ord < 4; ++ord) {
            const int kind = rev ? 3 - ord : ord;
            if (kind == 0) {
                const bool split57 = C.G == 256;
                const int per = (1536 + C.G - 1) / C.G;
                const int i0 = split57 ? (C.bid < 128 ? C.bid * 5 : 640 + (C.bid - 128) * 7) : C.bid * per;
                const int i1e = split57 ? i0 + (C.bid < 128 ? 5 : 7) : i0 + per, i1 = i1e < 1536 ? i1e : 1536;
                for (int q_ = 0; q_ < REP_A; ++q_) for (int it = i0; it < i1; ++it) attn_prompt_item(C, it);
            } else if (kind == 1) {
                for (int q_ = 0; q_ < REP_B; ++q_) for (int it = C.bid; it < 384; it += C.G) attn_sample_item(C, it / 12, (it % 12) & 3, (it % 12) >> 2);
            } else if (kind == 2) {
                for (int it = C.G - 1 - C.bid; it < 128; it += C.G) { for (int q_ = 0; q_ < REP_C; ++q_) gla_sample_item(C, it >> 2, it & 3); }
            } else {
                LDS_BARRIER();
                for (int q_ = 0; q_ < REP_PA; ++q_) for (int u = C.bid; u < NUNIT; u += C.G) gla_pass_a_unit(C, u);
                LDS_BARRIER();
                attn_bias_tables(C, C.wave * 64 + lane_id_here());
                LDS_BARRIER();
            }
        }
    }
    SEAM(2);
    if (IN(3)) for (int rep_ = 0; rep_ < NREP(3); ++rep_) {
        gla_pass_b(C);
        const int gid = C.bid * NTHREADS + C.wave * 64 + lane_id_here();
        for (int id = gid; id < MT * 64; id += C.G * NTHREADS) attn_combine_chunk(ws, (size_t)(id >> 6), (id >> 4) & 3, id & 15);
    }
    SEAM(3);
    if (IN(4)) for (int rep_ = 0; rep_ < NREP(4); ++rep_) { gla_pass_c(C); }
    if (IN(5)) { }
    SEAM(5);
    if (IN(6)) for (int rep_ = 0; rep_ < NREP(6); ++rep_) {
        for (int u = C.bid; u < 256; u += C.G) {
            const int tm = u >> 5, tn = u & 31;
            const bf16_t* SGA = (const bf16_t*)(ws + WS_SGA); const bf16_t* SGBT = (const bf16_t*)(ws + WS_SGBT);
            bf16_t* TMP = (bf16_t*)(ws + WS_TMP); bf16_t* MIXIN = (bf16_t*)(ws + WS_MIXIN);
            sgemm_unit<1>(C, (const bf16_t*)(ws + WS_YAIN) + (size_t)MP * 1536, (const bf16_t*)(ws + WS_WPA) + (size_t)32 * tn * 1536, nullptr, 512, tm,
                [&](int row, int c2, const float (&v)[1][2]) { const size_t o = ((size_t)MP + row) * 1024 + 32 * tn + c2; const unsigned g = *(const unsigned*)(SGA + o);
                    *(unsigned*)(TMP + o) = pk2(bflo(g) * v[0][0], bfhi(g) * v[0][1]); }, 1536, 1536);
            sgemm_unit<1>(C, (const bf16_t*)(ws + WS_YAIN) + (size_t)MP * 1536 + 512, (const bf16_t*)(ws + WS_WPA) + (size_t)32 * tn * 1536 + 512, nullptr, 1024, tm,
                [&](int row, int c2, const float (&v)[1][2]) { const size_t o = ((size_t)MP + row) * 1024 + 32 * tn + c2; const unsigned g = *(const unsigned*)(SGBT + o), t = *(const unsigned*)(TMP + o);
                    *(unsigned*)(MIXIN + o) = pk2(bflo(t) + bflo(g) * v[0][0], bfhi(t) + bfhi(g) * v[0][1]); }, 1536, 1536);
        }
        LDS_BARRIER();
        {
            pg8::Gemm g{(const bf16_t*)(ws + WS_YAIN), (const bf16_t*)(ws + WS_WPA), MP, 1024, 1536};
            pg8::StaticOrder S; S.init(MP, 1024, C.G, C.bid);
            EpiGate2 E{(const bf16_t*)(ws + WS_SGA), (const bf16_t*)(ws + WS_SGBT), (bf16_t*)(ws + WS_MIXIN), 8};
            pg8::gemm_phase<EpiGate2, pg8::StaticOrder, true, true>(C.lds, g, S, E, C.wave);
        }
    }
    SEAM(6);
    if (IN(7)) for (int rep_ = 0; rep_ < NREP(7); ++rep_) {
        for (int u = C.bid; u < 256; u += C.G) sgemm_branch(C, (const bf16_t*)(ws + WS_MIXIN) + (size_t)MP * 1024, (const bf16_t*)(ws + WS_WOUT), 1024, u >> 5, u & 31);
        LDS_BARRIER();
        pg8::Gemm g{(const bf16_t*)(ws + WS_MIXIN), (const bf16_t*)(ws + WS_WOUT), MP, 1024, 1024};
        pg8::StaticOrder S; S.init(MP, 1024, C.G, C.bid);
        EpiBranch E{(bf16_t*)(ws + WS_MIX), (float*)(ws + WS_SSQ)};
        pg8::gemm_phase<EpiBranch, pg8::StaticOrder, true, true>(C.lds, g, S, E, C.wave);
    }
    SEAM(7);
    if (IN(8)) for (int rep_ = 0; rep_ < NREP(8); ++rep_) resid_pass<true, false>(C, args.in[10]);
    SEAM(8);
    if (IN(9)) for (int rep_ = 0; rep_ < NREP(9); ++rep_) {
        for (int u = C.bid; u < 256; u += C.G) {
            const int tm = u >> 5, tn = u & 31; const float* RS = (const float*)(ws + WS_RS); bf16_t* Q2 = (bf16_t*)(ws + WS_Q2);
            sgemm_unit<1>(C, (const bf16_t*)(ws + WS_XB) + (size_t)MP * 1024, (const bf16_t*)(ws + WS_WMQ) + (size_t)32 * tn * 1024, nullptr, 1024, tm,
                [&](int row, int c2, const float (&v)[1][2]) { const float r = RS[MP + row] * Q2_SCALE; *(unsigned*)(Q2 + ((size_t)MP + row) * 1024 + 32 * tn + c2) = pk2(v[0][0] * r, v[0][1] * r); });
        }
        LDS_BARRIER();
        pg8::Gemm g{(const bf16_t*)(ws + WS_XB), (const bf16_t*)(ws + WS_WMQ), MP, 1024, 1024};
        pg8::StaticOrder S; S.init(MP, 1024, C.G, C.bid);
        EpiRowScale E{(const float*)(ws + WS_RS), (bf16_t*)(ws + WS_Q2), Q2_SCALE};
        pg8::gemm_phase<EpiRowScale, pg8::StaticOrder, true, true>(C.lds, g, S, E, C.wave);
    }
    SEAM(9);
    if (IN(10)) for (int rep_ = 0; rep_ < NREP(10); ++rep_) {
        const bool rev10 = ((C.bid >> 3) & 1) != 0;
        const bool xs = C.G == 256;
#define XS_IT(i) (xs ? 2 * (((i) & 7) * 16 + (((i) >> 3) & 15)) + ((i) >> 7) : (i))
#define XP_IT(i) (xs ? ((((i) & 7) + 8 * ((i) >> 8)) << 5) | (((i) >> 3) & 31) : (i))
        if (!rev10) { for (int q_ = 0; q_ < REP_XS; ++q_) for (int i = C.bid; i < 256; i += C.G) { const int it = XS_IT(i); xattn_sample_item(C, it >> 3, (it >> 1) & 3, it & 1); } }
        for (int q_ = 0; q_ < REP_X; ++q_) for (int i = C.bid; i < 512; i += C.G) xattn_prompt_item(C, XP_IT(i));
        if (rev10) { for (int q_ = 0; q_ < REP_XS; ++q_) for (int i = C.bid; i < 256; i += C.G) { const int it = XS_IT(i); xattn_sample_item(C, it >> 3, (it >> 1) & 3, it & 1); } }
#undef XS_IT
#undef XP_IT
    }
    SEAM(10);
    if (IN(11)) for (int rep_ = 0; rep_ < NREP(11); ++rep_) {
        for (int u = C.bid; u < 256; u += C.G) sgemm_branch(C, (const bf16_t*)(ws + WS_O2) + (size_t)MP * 1024, (const bf16_t*)(ws + WS_WMO), 1024, u >> 5, u & 31);
        LDS_BARRIER();
        pg8::Gemm g{(const bf16_t*)(ws + WS_O2), (const bf16_t*)(ws + WS_WMO), MP, 1024, 1024};
        pg8::StaticOrder S; S.init(MP, 1024, C.G, C.bid);
        EpiBranch E{(bf16_t*)(ws + WS_MIX), (float*)(ws + WS_SSQ)};
        pg8::gemm_phase<EpiBranch, pg8::StaticOrder, true, true>(C.lds, g, S, E, C.wave);
    }
    SEAM(11);
    if (IN(12)) resid_pass<false, false>(C, args.in[22]);
    SEAM(12);
    if (IN(13)) for (int rep_ = 0; rep_ < NREP(13); ++rep_) {
        for (int u = C.bid; u < 704; u += C.G) {
            const int tm = u / 88, tg = u % 88, jj = (32 * tg) >> 7, off = (32 * tg) & 127; const float* RS = (const float*)(ws + WS_RS); bf16_t* H = (bf16_t*)(ws + WS_H);
            const bf16_t* WG = (const bf16_t*)(ws + WS_WGU) + (size_t)(256 * jj + off) * 1024;
            sgemm_unit<2>(C, (const bf16_t*)(ws + WS_XB) + (size_t)MP * 1024, WG, WG + (size_t)128 * 1024, 1024, tm,
                [&](int row, int c2, const float (&v)[2][2]) { const float r = RS[MP + row]; const float g0 = v[0][0] * r, g1 = v[0][1] * r;
                    *(unsigned*)(H + ((size_t)MP + row) * DFF + 32 * tg + c2) = pk2(g0 * fsigmoid(g0) * (v[1][0] * r), g1 * fsigmoid(g1) * (v[1][1] * r)); });
        }
        LDS_BARRIER();
        pg8::Gemm g{(const bf16_t*)(ws + WS_XB), (const bf16_t*)(ws + WS_WGU), MP, 2 * DFF, 1024};
        pg8::StaticOrder S; S.init(MP, 2 * DFF, C.G, C.bid);
        EpiGateUp E{(const float*)(ws + WS_RS), (bf16_t*)(ws + WS_H)};
        pg8::gemm_phase<EpiGateUp, pg8::StaticOrder, true, true>(C.lds, g, S, E, C.wave);
    }
    SEAM(13);
    if (IN(14)) for (int rep_ = 0; rep_ < NREP(14); ++rep_) {
        for (int u = C.bid; u < 256; u += C.G) sgemm_branch(C, (const bf16_t*)(ws + WS_H) + (size_t)MP * DFF, (const bf16_t*)(ws + WS_WDN), DFF, u >> 5, u & 31);
        LDS_BARRIER();
        pg8::Gemm g{(const bf16_t*)(ws + WS_H), (const bf16_t*)(ws + WS_WDN), MP, 1024, DFF};
        pg8::StaticOrder S; S.init(MP, 1024, C.G, C.bid);
        EpiBranch E{(bf16_t*)(ws + WS_MIX), (float*)(ws + WS_SSQ)};
        pg8::gemm_phase<EpiBranch, pg8::StaticOrder, true, true>(C.lds, g, S, E, C.wave);
    }
    SEAM(14);
    if (IN(15)) resid_pass<false, true>(C, args.in[26]);
#undef IN
#undef SEAM
}

extern "C" void kernel_launch(void* const* d_in, const int* in_sizes, int n_in, void* d_out, int out_size, void* d_ws, size_t ws_size, hipStream_t stream) {
    static int grid = 0;
    if (grid == 0) {
        if (n_in != 30 || out_size != (int)O_TOTAL || ws_size < WS_END2) {
            fprintf(stderr, "kernel_launch: unexpected problem (n_in %d, out %d, ws %zu; need ws >= %zu); nothing launched\n", n_in, out_size, ws_size, (size_t)WS_END2);
            grid = -1; return;
        }
        int dev = 0, cus = 0, per_cu = 0;
        (void)hipGetDevice(&dev);
        (void)hipDeviceGetAttribute(&cus, hipDeviceAttributeMultiprocessorCount, dev);
        (void)hipFuncSetAttribute((const void*)fwd_megakernel, hipFuncAttributeMaxDynamicSharedMemorySize, LDS_BYTES);
        (void)hipOccupancyMaxActiveBlocksPerMultiprocessor(&per_cu, (const void*)fwd_megakernel, NTHREADS, LDS_BYTES);
        if (per_cu < 1) { fprintf(stderr, "kernel_launch: occupancy query says %d blocks per CU\n", per_cu); per_cu = 1; }
        (void)hipGetLastError();
        grid = cus;
        if (grid > 256) grid = 256;
    }
    if (grid < 0) return;
    (void)hipMemsetAsync((char*)d_ws + WS_CTL, 0, 65536, stream);
    Args a{};
    for (int i = 0; i < 30; ++i) a.in[i] = (const float*)d_in[i];
    a.out = (float*)d_out; a.ws = (unsigned char*)d_ws;
#if MK_N_LAUNCHES == 1
    a.ph_lo = 0; a.ph_hi = N_PHASES;
    void* kargs[] = {&a};
    hipError_t e = hipLaunchCooperativeKernel((const void*)fwd_megakernel, dim3(grid), dim3(NTHREADS), kargs, LDS_BYTES, stream);
    if (e != hipSuccess) fprintf(stderr, "cooperative launch failed: %s (grid %d)\n", hipGetErrorString(e), grid);
#else
    for (int p = 0; p < N_PHASES; ++p) {
        a.ph_lo = p; a.ph_hi = p + 1;
        hipLaunchKernelGGL(fwd_megakernel, dim3(grid), dim3(NTHREADS), LDS_BYTES, stream, a);
    }
#endif
}
```

```cpp
#include <hip/hip_runtime.h>
#include <hip/hip_cooperative_groups.h>
#include <cstdio>
#include <cstdint>
namespace cg = cooperative_groups;
#define LAS __attribute__((address_space(3)))
namespace pg8 {
#define PG8_LAS __attribute__((address_space(3)))
typedef unsigned short bf16_t;
typedef short bf16x8 __attribute__((ext_vector_type(8)));
typedef float f32x4 __attribute__((ext_vector_type(4)));
typedef unsigned u32x4 __attribute__((ext_vector_type(4)));
constexpr int BM = 256, BK = 64, HALF = 128, HTB = HALF * BK * 2  , STAGE_BYTES = 8 * HTB, NXCD = 8, WGM = 8;

__host__ __device__ __forceinline__ int lds_byte(int r, int c) { const int st = (r >> 4) * 2 + (c >> 5), rr = r & 15, cc = c & 31, ob = rr * 64 + cc * 2; return st * 1024 + (ob ^ (((ob >> 9) & 1) << 5)); }
__host__ __device__ __forceinline__ void stage_rc(int b, int& R, int& C) { const int st = b / 1024, sb = b % 1024, swz = sb ^ (((sb >> 9) & 1) << 5); R = (st >> 1) * 16 + swz / 64; C = (st & 1) * 32 + (swz % 64) / 2; }
__host__ __device__ __forceinline__ int perm32(int rho) { const int n = rho >> 4, i = rho & 15; return 8 * (i >> 2) + 4 * n + (i & 3); }

struct Unit { int pm, pn; };
struct Gemm { const bf16_t* A; const bf16_t* Bt; int M, N, K; };

struct StaticOrder {
    int nM, nN, nwg, G, c;
    __host__ __device__ void init(int M, int N, int G_, int c_) { nM = M / BM; nN = N / BM; nwg = nM * nN; G = G_; c = c_; }
    __host__ __device__ bool next(int i, Unit& u) const {
        const long L = (long)i * G + c; if (L >= nwg) return false;
        int wgid = (int)L; { const int q = nwg / NXCD, r = nwg % NXCD, xcd = wgid % NXCD, off = wgid / NXCD; wgid = (xcd < r ? xcd * (q + 1) : r * (q + 1) + (xcd - r) * q) + off; }
        const int nig = WGM * nN, gid = wgid / nig, fm = gid * WGM, gsz = (nM - fm) < WGM ? (nM - fm) : WGM;
        u.pm = fm + ((wgid % nig) % gsz); u.pn = (wgid % nig) / gsz; return true;
    }
    __device__ __forceinline__ void a_ready(const Unit&) const {}
    __device__ __forceinline__ void done(const Unit&) const {}
};

__device__ __forceinline__ unsigned cvt_pk_bf16(float lo, float hi) { unsigned r; asm volatile("v_cvt_pk_bf16_f32 %0, %1, %2" : "=v"(r) : "v"(lo), "v"(hi)); return r; }
typedef float f32x2 __attribute__((ext_vector_type(2)));
__device__ __forceinline__ f32x2 gelu_pk(f32x2 v) {
    const f32x2 av = __builtin_elementwise_abs(v), d = av * 0.2316418882f + 1.0f;
    f32x2 t; t.x = __builtin_amdgcn_rcpf(d.x); t.y = __builtin_amdgcn_rcpf(d.y);
    f32x2 q = t * 0.5307027145f + (-0.7265760135f); q = q * t + 0.7107068705f; q = q * t + (-0.142248368f); q = q * t + 0.127414796f; q = q * t;
    const f32x2 s = (v * v) * (-0.72134752044f);
    f32x2 e; e.x = __builtin_amdgcn_exp2f(s.x); e.y = __builtin_amdgcn_exp2f(s.y);
    const f32x2 m = v * (q * e), r = v - m;
    f32x2 o; o.x = v.x < 0.f ? m.x : r.x; o.y = v.y < 0.f ? m.y : r.y; return o;
}

template <int ACT  > struct EpiBf16 {
    static constexpr bool PERM = true, AFTER_DRAIN = false, HAS_MID = false; static_assert(ACT == 0 || ACT == 1, "EpiBf16: ACT is 0 (none) or 1 (gelu_pk)");
    bf16_t* O; int ldc; const float* bias; int split_cols; size_t split_stride; float scale0;
    __device__ __forceinline__ void operator()(const f32x4 (&acc)[2][2][4][2], const Unit& u, int wr, int wc, int fr, int fq) const {
        const int row0 = u.pm * BM + wr * 64 + fr; int colt = u.pn * BM; bf16_t* base = O;
        float sc = 1.f; if (split_cols) { const int t = colt / split_cols; base += (size_t)t * split_stride; colt -= t * split_cols; if (t == 0) sc = scale0; }
        const int col0 = colt + wc * 32 + 8 * fq, bcol0 = u.pn * BM + wc * 32 + 8 * fq;
        f32x4 bv[2][2];
#pragma unroll
        for (int bj = 0; bj < 2; ++bj)
#pragma unroll
            for (int n = 0; n < 2; ++n) bv[bj][n] = bias ? *(const f32x4*)(bias + bcol0 + bj * HALF + 4 * n) : (f32x4){0.f, 0.f, 0.f, 0.f};
#pragma unroll
        for (int ai = 0; ai < 2; ++ai)
#pragma unroll
            for (int m = 0; m < 4; ++m) { bf16_t* rowp = base + (size_t)(row0 + ai * HALF + m * 16) * ldc + col0;
#pragma unroll
                for (int bj = 0; bj < 2; ++bj) { f32x4 v0 = acc[ai][bj][m][0] + bv[bj][0], v1 = acc[ai][bj][m][1] + bv[bj][1];
                    if (ACT == 1) { f32x2 a = gelu_pk((f32x2){v0[0], v0[1]}), b = gelu_pk((f32x2){v0[2], v0[3]}), c = gelu_pk((f32x2){v1[0], v1[1]}), d = gelu_pk((f32x2){v1[2], v1[3]});
                        v0 = (f32x4){a.x, a.y, b.x, b.y}; v1 = (f32x4){c.x, c.y, d.x, d.y}; }
                    v0 = v0 * sc; v1 = v1 * sc; u32x4 w; w.x = cvt_pk_bf16(v0[0], v0[1]); w.y = cvt_pk_bf16(v0[2], v0[3]); w.z = cvt_pk_bf16(v1[0], v1[1]); w.w = cvt_pk_bf16(v1[2], v1[3]);
                    *(u32x4*)(rowp + bj * HALF) = w; } }
    }
};

struct PanelStats {
    unsigned* xbuf;
    unsigned* cnt;
    unsigned* tmo;
    int ntn; float eps;
    unsigned code;
    __device__ __forceinline__ bool run(const f32x4 (&v)[2][2][4][2], const Unit& u, int wr, int wc, int fr, int fq, PG8_LAS unsigned char* lds, int wid, int lane) const {
        typedef float f32x2v __attribute__((ext_vector_type(2)));
        PG8_LAS f32x2v* P = (PG8_LAS f32x2v*)lds;
        PG8_LAS f32x2v* S = (PG8_LAS f32x2v*)(lds + 8192);
        PG8_LAS unsigned* flag = (PG8_LAS unsigned*)(lds + 8192 + 2048);
#pragma unroll
        for (int ai = 0; ai < 2; ++ai)
#pragma unroll
            for (int m = 0; m < 4; ++m) {
                float s = 0.f;
#pragma unroll
                for (int bj = 0; bj < 2; ++bj)
#pragma unroll
                    for (int n = 0; n < 2; ++n) { const f32x4 x = v[ai][bj][m][n]; s += (x[0] + x[1]) + (x[2] + x[3]); }
                s += __shfl_xor(s, 16); s += __shfl_xor(s, 32);
                const float mw = s * (1.0f / 64.0f); float q = 0.f;
#pragma unroll
                for (int bj = 0; bj < 2; ++bj)
#pragma unroll
                    for (int n = 0; n < 2; ++n) { const f32x4 d = v[ai][bj][m][n] - mw; q += (d[0] * d[0] + d[1] * d[1]) + (d[2] * d[2] + d[3] * d[3]); }
                q += __shfl_xor(q, 16); q += __shfl_xor(q, 32);
                if (fq == 0) P[(ai * HALF + wr * 64 + m * 16 + fr) * 4 + wc] = (f32x2v){mw, q};
            }
        asm volatile("s_waitcnt lgkmcnt(0)" ::: "memory"); __builtin_amdgcn_s_barrier(); asm volatile("" ::: "memory");
#if defined(BROKEN_EXCHANGE_NO_WAIT)
#warning BROKEN CONTROL BUILD: the row-statistics exchange does not wait; results are wrong by design
        if (blockIdx.x >= 64) { const long long t0_ = clock64(); while (clock64() - t0_ < 60000) __builtin_amdgcn_s_sleep(8); }
#endif
        const int row = wid * 32 + (lane & 31);
        if (lane < 32) {
            const f32x2v a = P[row * 4 + 0], b = P[row * 4 + 1], c = P[row * 4 + 2], d = P[row * 4 + 3];
            const float mt = (a.x + b.x + c.x + d.x) * 0.25f;
            const float da = a.x - mt, db = b.x - mt, dc = c.x - mt, dd = d.x - mt;
            const float m2 = (a.y + b.y) + (c.y + d.y) + 64.0f * ((da * da + db * db) + (dc * dc + dd * dd));
            unsigned long long* slot = (unsigned long long*)xbuf + ((size_t)(u.pm * BM + row) * 4 + u.pn);
            __hip_atomic_store(slot, ((unsigned long long)__float_as_uint(m2) << 32) | __float_as_uint(mt), __ATOMIC_RELAXED, __HIP_MEMORY_SCOPE_AGENT);
        }
        asm volatile("s_waitcnt vmcnt(0)" ::: "memory");
        if (lane == 0) __hip_atomic_fetch_add(cnt + 64 * u.pm, 1u, __ATOMIC_RELAXED, __HIP_MEMORY_SCOPE_AGENT);
        if (wid == 0) {
            bool dead = false; const unsigned long long t0 = __builtin_amdgcn_s_memrealtime(); const unsigned want = 8u * (unsigned)ntn;
            for (;;) {
#if defined(BROKEN_EXCHANGE_NO_WAIT)
                break;
#endif
                if ((unsigned)__builtin_amdgcn_readfirstlane(__hip_atomic_load(cnt + 64 * u.pm, __ATOMIC_RELAXED, __HIP_MEMORY_SCOPE_AGENT)) >= want) break;
                if (__builtin_amdgcn_s_memrealtime() - t0 > 2000000ull) {
                    if (lane == 0) { unsigned expect = 0u; __hip_atomic_compare_exchange_strong(tmo + 1, &expect, code | (unsigned)(u.pm & 0xff), __ATOMIC_RELAXED, __ATOMIC_RELAXED, __HIP_MEMORY_SCOPE_AGENT);
                                     __hip_atomic_store(tmo, 1u, __ATOMIC_RELAXED, __HIP_MEMORY_SCOPE_AGENT); }
                    dead = true; break; }
                __builtin_amdgcn_s_sleep(2);
            }
            __builtin_amdgcn_fence(__ATOMIC_ACQUIRE, "agent");
            if (lane == 0) flag[0] = dead ? 1u : 0u;
        }
        asm volatile("s_waitcnt vmcnt(0) lgkmcnt(0)" ::: "memory"); __builtin_amdgcn_s_barrier(); asm volatile("" ::: "memory");
        const bool bad = flag[0] != 0u;
        if (lane < 32) {
            const unsigned long long* slot = (const unsigned long long*)xbuf + (size_t)(u.pm * BM + row) * 4; float mt[4], m2[4]; float ms = 0.f;
#pragma unroll
            for (int t = 0; t < 4; ++t) { if (t < ntn) { const unsigned long long w = __hip_atomic_load(slot + t, __ATOMIC_RELAXED, __HIP_MEMORY_SCOPE_AGENT); mt[t] = __uint_as_float((unsigned)w); m2[t] = __uint_as_float((unsigned)(w >> 32)); } else { mt[t] = 0.f; m2[t] = 0.f; } ms += mt[t]; }
            const float mean = ms / (float)ntn; float q = 0.f;
#pragma unroll
            for (int t = 0; t < 4; ++t) if (t < ntn) { const float dm = mt[t] - mean; q += m2[t] + 256.0f * dm * dm; }
            S[row] = (f32x2v){mean, 1.0f / sqrtf(q / (256.0f * (float)ntn) + eps)};
        }
        asm volatile("s_waitcnt lgkmcnt(0)" ::: "memory"); __builtin_amdgcn_s_barrier(); asm volatile("" ::: "memory");
        return bad;
    }
};
struct EpiLnRes {
    static constexpr bool PERM = false, AFTER_DRAIN = true, HAS_MID = false;
    const float* base; float* out; int ldc; const float* bias; PanelStats st; unsigned poison;
    __device__ __forceinline__ void fused(f32x4 (&acc)[2][2][4][2], const Unit& u, int wr, int wc, int fr, int fq, PG8_LAS unsigned char* lds, int wid, int lane) const {
        typedef float f32x2v __attribute__((ext_vector_type(2)));
        const PG8_LAS f32x2v* S = (const PG8_LAS f32x2v*)(lds + 8192);
        const int col0 = u.pn * BM + wc * 32 + 4 * fq;
#pragma unroll
        for (int bj = 0; bj < 2; ++bj)
#pragma unroll
            for (int n = 0; n < 2; ++n) { const f32x4 bv = bias ? *(const f32x4*)(bias + col0 + bj * HALF + n * 16) : (f32x4){0.f, 0.f, 0.f, 0.f};
#pragma unroll
                for (int ai = 0; ai < 2; ++ai)
#pragma unroll
                    for (int m = 0; m < 4; ++m) acc[ai][bj][m][n] += bv; }
        f32x4 pre[4][2][2];
#pragma unroll
        for (int m = 0; m < 4; ++m) { const size_t off = (size_t)(u.pm * BM + wr * 64 + m * 16 + fr) * ldc + col0;
#pragma unroll
            for (int bj = 0; bj < 2; ++bj)
#pragma unroll
                for (int n = 0; n < 2; ++n) pre[m][bj][n] = *(const f32x4*)(base + off + bj * HALF + n * 16); }
        const bool bad = st.run(acc, u, wr, wc, fr, fq, lds, wid, lane) || poison != 0u;
        const float qnan = __builtin_nanf("");
#pragma unroll
        for (int ai = 0; ai < 2; ++ai)
#pragma unroll
            for (int m = 0; m < 4; ++m) { const int r = ai * HALF + wr * 64 + m * 16 + fr; const f32x2v sr = S[r]; const size_t off = (size_t)(u.pm * BM + r) * ldc + col0;
#pragma unroll
                for (int bj = 0; bj < 2; ++bj)
#pragma unroll
                    for (int n = 0; n < 2; ++n) { const f32x4 bs = ai == 0 ? pre[m][bj][n] : *(const f32x4*)(base + off + bj * HALF + n * 16); f32x4 o = bs + (acc[ai][bj][m][n] - sr.x) * sr.y;
                        if (bad) o = (f32x4){qnan, qnan, qnan, qnan}; *(f32x4*)(out + off + bj * HALF + n * 16) = o; }
                if (m & 1) asm volatile("" ::: "memory"); }
    }
};
struct EpiLnResLn {
    static constexpr bool PERM = false, AFTER_DRAIN = true, HAS_MID = false;
    const float* base; float* out; bf16_t* xn; int ldc; const float* bias; PanelStats st1, st2; unsigned poison;
    __device__ __forceinline__ void fused(f32x4 (&acc)[2][2][4][2], const Unit& u, int wr, int wc, int fr, int fq, PG8_LAS unsigned char* lds, int wid, int lane) const {
        typedef float f32x2v __attribute__((ext_vector_type(2))); typedef unsigned u32x2v __attribute__((ext_vector_type(2)));
        const PG8_LAS f32x2v* S = (const PG8_LAS f32x2v*)(lds + 8192);
        const int col0 = u.pn * BM + wc * 32 + 4 * fq;
#pragma unroll
        for (int bj = 0; bj < 2; ++bj)
#pragma unroll
            for (int n = 0; n < 2; ++n) { const f32x4 bv = bias ? *(const f32x4*)(bias + col0 + bj * HALF + n * 16) : (f32x4){0.f, 0.f, 0.f, 0.f};
#pragma unroll
                for (int ai = 0; ai < 2; ++ai)
#pragma unroll
                    for (int m = 0; m < 4; ++m) acc[ai][bj][m][n] += bv; }
        bool bad = st1.run(acc, u, wr, wc, fr, fq, lds, wid, lane) || poison != 0u;
        const float qnan = __builtin_nanf("");
#pragma unroll
        for (int ai = 0; ai < 2; ++ai)
#pragma unroll
            for (int m = 0; m < 4; ++m) { const int r = ai * HALF + wr * 64 + m * 16 + fr; const f32x2v sr = S[r]; const size_t off = (size_t)(u.pm * BM + r) * ldc + col0;
#pragma unroll
                for (int bj = 0; bj < 2; ++bj)
#pragma unroll
                    for (int n = 0; n < 2; ++n) { const f32x4 bs = *(const f32x4*)(base + off + bj * HALF + n * 16); acc[ai][bj][m][n] = bs + (acc[ai][bj][m][n] - sr.x) * sr.y; }
                asm volatile("" : "+v"(acc[ai][0][m][0]), "+v"(acc[ai][0][m][1]), "+v"(acc[ai][1][m][0]), "+v"(acc[ai][1][m][1]));
                if (m & 1) asm volatile("" ::: "memory"); }
        const bool bad1 = bad;
        bad = st2.run(acc, u, wr, wc, fr, fq, lds, wid, lane) || bad;
#pragma unroll
        for (int ai = 0; ai < 2; ++ai)
#pragma unroll
            for (int m = 0; m < 4; ++m) { const int r = ai * HALF + wr * 64 + m * 16 + fr; const f32x2v sr = S[r]; const size_t off = (size_t)(u.pm * BM + r) * ldc + col0;
#pragma unroll
                for (int bj = 0; bj < 2; ++bj)
#pragma unroll
                    for (int n = 0; n < 2; ++n) { const f32x4 x1 = acc[ai][bj][m][n]; *(f32x4*)(out + off + bj * HALF + n * 16) = bad1 ? (f32x4){qnan, qnan, qnan, qnan} : x1;
                        const f32x4 o = (x1 - sr.x) * sr.y; u32x2v w; w.x = cvt_pk_bf16(o[0], o[1]); w.y = cvt_pk_bf16(o[2], o[3]);
                        if (bad) { w.x = 0x7fc07fc0u; w.y = 0x7fc07fc0u; } *(u32x2v*)(xn + off + bj * HALF + n * 16) = w; }
                asm volatile("" ::: "memory"); }
    }
};

template <class Epi, class Sched, bool ALIGN_EPI = false, bool SP2 = false>
__device__ __forceinline__ void gemm_phase(PG8_LAS unsigned char* lds, const Gemm g, const Sched& S, const Epi& E, const int wave_id) {
    const int lane = __builtin_amdgcn_mbcnt_hi(~0u, __builtin_amdgcn_mbcnt_lo(~0u, 0u)), wid = wave_id, tid = wid * 64 + lane, wr = wid >> 2, wc = wid & 3, fr = lane & 15, fq = lane >> 4;
    const int K = g.K, nt = K / BK;
    unsigned voffA[2], voffB[2];
#pragma unroll
    for (int i = 0; i < 2; ++i) { int R, C; stage_rc(tid * 16 + i * 8192, R, C); const int Rb = Epi::PERM ? ((R & ~31) + perm32(R & 31)) : R;
        voffA[i] = (unsigned)(R * K + C) * 2u; voffB[i] = (unsigned)(Rb * K + C) * 2u; }
    const size_t kstep = (size_t)(BK * 2);
    const size_t hstep = (size_t)HALF * K * 2;
    const size_t tstep = 2 * hstep;
    const unsigned ldsw = (unsigned)wid * 1024u;
    const int aoff = lds_byte(wr * 64 + fr, fq * 8), boff = lds_byte(wc * 32 + fr, fq * 8);
#define PG8_SA(b, h) (((b) * 2 + (h)) * HTB)
#define PG8_SB(b, h) ((4 + (b) * 2 + (h)) * HTB)
#define PG8_STAGE(bufoff, gbase, voff) do { _Pragma("unroll") for (int _i = 0; _i < 2; ++_i) \
        __builtin_amdgcn_global_load_lds((const unsigned*)((const char*)(gbase) + (voff)[_i]), (PG8_LAS unsigned*)(lds + (bufoff) + ldsw + _i * 8192), 16, 0, 0); } while (0)
#define PG8_LDA(dst, b, h) do { _Pragma("unroll") for (int m = 0; m < 4; ++m) _Pragma("unroll") for (int k = 0; k < 2; ++k) dst[m][k] = *(const PG8_LAS bf16x8*)(lds + PG8_SA(b, h) + aoff + m * 2048 + k * 1024); } while (0)
#define PG8_LDB(dst, b, h) do { _Pragma("unroll") for (int n = 0; n < 2; ++n) _Pragma("unroll") for (int k = 0; k < 2; ++k) dst[n][k] = *(const PG8_LAS bf16x8*)(lds + PG8_SB(b, h) + boff + n * 2048 + k * 1024); } while (0)
#define PG8_MMA(ai, bj, At, Bt) do { __builtin_amdgcn_s_setprio(1); _Pragma("unroll") for (int m = 0; m < 4; ++m) _Pragma("unroll") for (int n = 0; n < 2; ++n) _Pragma("unroll") for (int k = 0; k < 2; ++k) \
        acc[ai][bj][m][n] = __builtin_amdgcn_mfma_f32_16x16x32_bf16(Bt[n][k], At[m][k], acc[ai][bj][m][n], 0, 0, 0); __builtin_amdgcn_s_setprio(0); } while (0)
#define PG8_WAIT_V(n) asm volatile("s_waitcnt vmcnt(" #n ")" ::: "memory")
#define PG8_WAIT_L(n) asm volatile("s_waitcnt lgkmcnt(" #n ")" ::: "memory")
#define PG8_BAR __builtin_amdgcn_s_barrier()
#define PG8_SCHED __builtin_amdgcn_sched_barrier(0)
    Unit cur, nxt; int ui = 0;
    if (!S.next(0, cur)) return;
    f32x4 acc[2][2][4][2];
#pragma unroll
    for (int a = 0; a < 2; ++a)
#pragma unroll
        for (int b = 0; b < 2; ++b)
#pragma unroll
            for (int m = 0; m < 4; ++m)
#pragma unroll
                for (int n = 0; n < 2; ++n) acc[a][b][m][n] = (f32x4){0.f, 0.f, 0.f, 0.f};
    bf16x8 At[4][2], B0[2][2], B1[2][2];
    const char* cA = (const char*)g.A + (size_t)cur.pm * tstep; const char* cB = (const char*)g.Bt + (size_t)cur.pn * tstep;
    S.a_ready(cur);
    if constexpr (SP2) {
        PG8_STAGE(PG8_SB(0, 0), cB, voffB); PG8_STAGE(PG8_SB(0, 1), cB + hstep, voffB); PG8_STAGE(PG8_SA(0, 0), cA, voffA); PG8_STAGE(PG8_SA(0, 1), cA + hstep, voffA);
        if (wr == 1) PG8_BAR;
        PG8_WAIT_V(2); PG8_BAR;
        PG8_STAGE(PG8_SB(1, 0), cB + kstep, voffB); PG8_STAGE(PG8_SA(1, 0), cA + kstep, voffA); PG8_STAGE(PG8_SB(1, 1), cB + hstep + kstep, voffB);
        PG8_WAIT_V(6); PG8_BAR;
    } else {
        PG8_STAGE(PG8_SB(0, 0), cB, voffB); PG8_STAGE(PG8_SA(0, 0), cA, voffA); PG8_STAGE(PG8_SB(0, 1), cB + hstep, voffB); PG8_STAGE(PG8_SA(0, 1), cA + hstep, voffA);
        if (wr == 1) PG8_BAR;
        PG8_WAIT_V(4); PG8_BAR;
        PG8_STAGE(PG8_SB(1, 0), cB + kstep, voffB); PG8_STAGE(PG8_SA(1, 0), cA + kstep, voffA); PG8_STAGE(PG8_SB(1, 1), cB + hstep + kstep, voffB);
        PG8_WAIT_V(6); PG8_BAR;
    }
    for (;;) {
        const bool has_next = S.next(ui + 1, nxt);
        const char* nA = has_next ? (const char*)g.A + (size_t)nxt.pm * tstep : cA; const char* nB = has_next ? (const char*)g.Bt + (size_t)nxt.pn * tstep : cB;
        for (int t = 0; t < nt; t += 2) {
            if constexpr (Epi::HAS_MID) { if (t == E.mid_t) E.mid(acc, cur, wr, wc, fr, fq); }
            const bool last = (t == nt - 2);
            const char* a1 = cA + (size_t)(t + 1) * kstep;
            const char* a2 = last ? nA : cA + (size_t)(t + 2) * kstep; const char* b2 = last ? nB : cB + (size_t)(t + 2) * kstep;
            const char* a3 = a2 + kstep; const char* b3 = b2 + kstep;
            if (last && has_next) S.a_ready(nxt);
            if constexpr (SP2) {
            PG8_LDB(B0, 0, 0); PG8_LDB(B1, 0, 1); PG8_SCHED; PG8_LDA(At, 0, 0); PG8_STAGE(PG8_SA(1, 1), a1 + hstep, voffA);
            PG8_WAIT_V(8); PG8_WAIT_L(0); PG8_BAR; PG8_MMA(0, 0, At, B0); PG8_MMA(0, 1, At, B1); PG8_BAR; PG8_SCHED;
            PG8_LDA(At, 0, 1); PG8_STAGE(PG8_SB(0, 0), b2, voffB); PG8_STAGE(PG8_SB(0, 1), b2 + hstep, voffB); PG8_STAGE(PG8_SA(0, 0), a2, voffA);
            PG8_WAIT_V(8); PG8_WAIT_L(0); PG8_BAR; PG8_MMA(1, 0, At, B0); PG8_MMA(1, 1, At, B1); PG8_BAR; PG8_SCHED;
            PG8_LDB(B0, 1, 0); PG8_LDB(B1, 1, 1); PG8_SCHED; PG8_LDA(At, 1, 0); PG8_STAGE(PG8_SA(0, 1), a2 + hstep, voffA);
            PG8_WAIT_V(8); PG8_WAIT_L(0); PG8_BAR; PG8_MMA(0, 0, At, B0); PG8_MMA(0, 1, At, B1); PG8_BAR; PG8_SCHED;
            PG8_LDA(At, 1, 1); PG8_STAGE(PG8_SB(1, 0), b3, voffB); PG8_STAGE(PG8_SB(1, 1), b3 + hstep, voffB); PG8_STAGE(PG8_SA(1, 0), a3, voffA);
            PG8_WAIT_V(8); PG8_WAIT_L(0); PG8_BAR; PG8_MMA(1, 0, At, B0); PG8_MMA(1, 1, At, B1); PG8_BAR; PG8_SCHED;
            } else {
            PG8_LDB(B0, 0, 0); PG8_SCHED; PG8_LDA(At, 0, 0); PG8_STAGE(PG8_SA(1, 1), a1 + hstep, voffA);
            PG8_WAIT_L(8); PG8_BAR; PG8_WAIT_L(0); PG8_MMA(0, 0, At, B0); PG8_BAR; PG8_SCHED;
            PG8_LDB(B1, 0, 1); PG8_STAGE(PG8_SB(0, 0), b2, voffB);
            PG8_BAR; PG8_WAIT_L(0); PG8_MMA(0, 1, At, B1); PG8_BAR;
            PG8_LDA(At, 0, 1); PG8_STAGE(PG8_SA(0, 0), a2, voffA);
            PG8_BAR; PG8_WAIT_L(0); PG8_MMA(1, 0, At, B0); PG8_BAR; PG8_SCHED;
            PG8_STAGE(PG8_SB(0, 1), b2 + hstep, voffB);
            PG8_WAIT_V(6); PG8_BAR; PG8_MMA(1, 1, At, B1); PG8_BAR;
            PG8_LDB(B0, 1, 0); PG8_SCHED; PG8_LDA(At, 1, 0); PG8_STAGE(PG8_SA(0, 1), a2 + hstep, voffA);
            PG8_WAIT_L(8); PG8_BAR; PG8_WAIT_L(0); PG8_MMA(0, 0, At, B0); PG8_BAR; PG8_SCHED;
            PG8_LDB(B1, 1, 1); PG8_STAGE(PG8_SB(1, 0), b3, voffB);
            PG8_BAR; PG8_WAIT_L(0); PG8_MMA(0, 1, At, B1); PG8_BAR;
            PG8_LDA(At, 1, 1); PG8_STAGE(PG8_SA(1, 0), a3, voffA);
            PG8_BAR; PG8_WAIT_L(0); PG8_MMA(1, 0, At, B0); PG8_BAR; PG8_SCHED;
            PG8_STAGE(PG8_SB(1, 1), b3 + hstep, voffB);
            PG8_WAIT_V(6); PG8_BAR; PG8_MMA(1, 1, At, B1); PG8_BAR;
            }
        }
        if constexpr (ALIGN_EPI) { if (wr == 0) PG8_BAR; }
        if constexpr (!Epi::AFTER_DRAIN) { E(acc, cur, wr, wc, fr, fq); S.done(cur); }
        if (!has_next) break;
#pragma unroll
        for (int a = 0; a < 2; ++a)
#pragma unroll
            for (int b = 0; b < 2; ++b)
#pragma unroll
                for (int m = 0; m < 4; ++m)
#pragma unroll
                    for (int n = 0; n < 2; ++n) acc[a][b][m][n] = (f32x4){0.f, 0.f, 0.f, 0.f};
        cur = nxt; cA = nA; cB = nB; ++ui;
        if constexpr (ALIGN_EPI) { if (wr == 1) PG8_BAR; }
    }
    PG8_WAIT_V(0);
    if constexpr (!ALIGN_EPI) { if (wr == 0) PG8_BAR; }
    PG8_BAR;
    if constexpr (Epi::AFTER_DRAIN) { E.fused(acc, cur, wr, wc, fr, fq, lds, wid, lane); S.done(cur); }
#undef PG8_SA
#undef PG8_SB
#undef PG8_STAGE
#undef PG8_LDA
#undef PG8_LDB
#undef PG8_MMA
#undef PG8_WAIT_V
#undef PG8_WAIT_L
#undef PG8_BAR
#undef PG8_SCHED
}
}

typedef __attribute__((address_space(1))) unsigned gu32;
#define RLX_AGENT __ATOMIC_RELAXED, __HIP_MEMORY_SCOPE_AGENT
#define XB_TMO      128
#define XB_XCNT(j)  (256  + 64 * (j))
#define XB_XSUB(j)  (1280 + 64 * (j))
#define XB_XGEN(j)  (2304 + 64 * (j))
#define XB_TOP      3328
#define XB_TOPGEN   3392
#define XCD_BAR_WORDS 3456
#define XB_SPIN_CAP (1u << 18)

__device__ __forceinline__ unsigned xb_ld(unsigned* p)              { return __hip_atomic_load(p, __ATOMIC_RELAXED, __HIP_MEMORY_SCOPE_AGENT); }
__device__ __forceinline__ unsigned xb_add(unsigned* p, unsigned v) { return __hip_atomic_fetch_add(p, v, __ATOMIC_RELAXED, __HIP_MEMORY_SCOPE_AGENT); }
__device__ __forceinline__ unsigned xb_xcc_id() { return (unsigned)__builtin_amdgcn_s_getreg((3 << 11) | 20) & 0xFu; }
#define XB_SPIN(cond, bar) do { unsigned _sp = 0; while (cond) { __builtin_amdgcn_s_sleep(1); \
    if ((++_sp & 255u) == 0u) { if (xb_ld(&(bar)[XB_TMO])) break; if (_sp > XB_SPIN_CAP) { atomicAdd(&(bar)[XB_TMO], 1u); break; } } } } while (0)

struct XcdBarrier {
    unsigned* bar; unsigned x;
    volatile LAS unsigned* st;
};

__device__ __forceinline__ XcdBarrier xcd_barrier_post(unsigned* bar, volatile LAS unsigned* st, bool leader) {
    XcdBarrier b; b.bar = bar; b.x = xb_xcc_id(); b.st = st;
    if (leader) (void)xb_add(&bar[XB_XCNT(b.x)], 1u);
    return b;
}
__device__ __forceinline__ void xcd_barrier_complete(unsigned* bar, unsigned x, unsigned& nloc, unsigned& nx) {
    const unsigned G = gridDim.x * gridDim.y * gridDim.z;
    unsigned sum, cnt, mine, sp = 0u;
    for (;;) {
        sum = 0u; cnt = 0u; mine = 0u;
#pragma unroll
        for (unsigned j = 0; j < 16; ++j) { const unsigned c = xb_ld(&bar[XB_XCNT(j)]); sum += c; cnt += (c > 0u) ? 1u : 0u; mine = (j == x) ? c : mine; }
        if (sum == G) break;
        __builtin_amdgcn_s_sleep(1);
        if ((++sp & 255u) == 0u) { if (xb_ld(&bar[XB_TMO])) break; if (sp > XB_SPIN_CAP) { atomicAdd(&bar[XB_TMO], 1u); break; } }
    }
    nloc = mine > 0u ? mine : 1u; nx = cnt > 0u ? cnt : 1u;
}

__device__ __forceinline__ void xcd_barrier(const XcdBarrier& b, bool leader) {
    asm volatile("s_waitcnt vmcnt(0)" ::: "memory");
    __syncthreads();
    if (leader) {
        unsigned* bar = b.bar;
        __builtin_amdgcn_s_waitcnt(0);
        unsigned nloc = b.st[0], nx = b.st[1];
        if (nloc == 0u) { xcd_barrier_complete(bar, b.x, nloc, nx); b.st[0] = nloc; b.st[1] = nx; }
        const unsigned old = xb_add(&bar[XB_XSUB(b.x)], 1u);
        const unsigned gen = old / nloc;
        if (old + 1u == (gen + 1u) * nloc) {
            __builtin_amdgcn_fence(__ATOMIC_RELEASE, "agent");
            asm volatile("s_waitcnt vmcnt(0)" ::: "memory");
            const unsigned og = xb_add(&bar[XB_TOP], 1u);
            const unsigned tg = og / nx;
            if (og + 1u == (tg + 1u) * nx) xb_add(&bar[XB_TOPGEN], 1u);
            else XB_SPIN(xb_ld(&bar[XB_TOPGEN]) == tg, bar);
            __builtin_amdgcn_fence(__ATOMIC_ACQUIRE, "agent");
            xb_add(&bar[XB_XGEN(b.x)], 1u);
            asm volatile("s_waitcnt vmcnt(0)" ::: "memory");
        } else {
            XB_SPIN(xb_ld(&bar[XB_XGEN(b.x)]) == gen, bar);
            __builtin_amdgcn_fence(__ATOMIC_ACQUIRE, "agent");
            asm volatile("s_waitcnt vmcnt(0)" ::: "memory");
        }
    }
    __syncthreads();
}

#define DI __device__ __forceinline__

typedef unsigned short bf16_t;
typedef short bf16x8 __attribute__((ext_vector_type(8)));
typedef short bf16x4 __attribute__((ext_vector_type(4)));
typedef float f32x2 __attribute__((ext_vector_type(2)));
typedef float f32x4 __attribute__((ext_vector_type(4)));
typedef float f32x16 __attribute__((ext_vector_type(16)));
typedef unsigned u32x2 __attribute__((ext_vector_type(2)));
typedef unsigned u32x4 __attribute__((ext_vector_type(4)));
typedef __bf16 hwbf16x2 __attribute__((ext_vector_type(2)));

constexpr int DM = 1024, NB = 4, SEQ = 8192, DB = 32, DS = 8;
constexpr int MP = NB * SEQ;
constexpr int MS = DB * DS;
constexpr int MT = MP + MS;
constexpr int NIN_SRC = 9744, NIN = 9984;
constexpr int DFF = 2816;
constexpr float EPS = 1e-6f;
constexpr float LOG2E = 1.4426950408889634f;
constexpr float QA_SCALE = 0.08838834764831845f * LOG2E;
constexpr float QB_SCALE = 0.08838834764831845f;
constexpr float Q2_SCALE = 0.0625f * LOG2E;

constexpr size_t O_Y = 0, O_W1P = 33816576, O_W2P = 34340864, O_W3P = 36438016, O_GLAP = 44826624, O_MEMP = 45350912,
                 O_W1S = 47448064, O_W2S = 47710208, O_W3S = 47972352, O_GLAS = 48234496, O_TOTAL = 52428800;

constexpr size_t MiB = 1u << 20;
constexpr size_t WS_CTL = 0, WS_WIN = 1 * MiB, WS_WMKV = 21 * MiB, WS_WPA = 25 * MiB, WS_WPB = 26 * MiB, WS_WOUT = 28 * MiB, WS_WMQ = 30 * MiB,
                 WS_WMO = 32 * MiB, WS_WGU = 34 * MiB, WS_WDN = 45 * MiB, WS_XB = 51 * MiB, WS_MEMB = 116 * MiB, WS_RS = 118 * MiB, WS_SSQ = 119 * MiB,
                 WS_FB = 122 * MiB, WS_MK = 125 * MiB, WS_MVT = 127 * MiB, WS_LSE = 129 * MiB, WS_QA = 131 * MiB, WS_KA = 228 * MiB, WS_VA = 325 * MiB,
                 WS_QB = 422 * MiB, WS_KB = 455 * MiB, WS_VB = 488 * MiB, WS_SGB = 553 * MiB, WS_SGA = 618 * MiB, WS_SGBT = 683 * MiB, WS_OAG = 748 * MiB,
                 WS_YAIN = 845 * MiB, WS_OBN = 878 * MiB, WS_END = 943 * MiB;
constexpr size_t WS_TMP = 131 * MiB, WS_MIXIN = 196 * MiB, WS_MIX = 261 * MiB, WS_Q2 = 326 * MiB, WS_O2 = 391 * MiB, WS_H = 488 * MiB;
constexpr size_t WS_RSMEM = WS_RS + 512 * 1024;
static_assert(WS_WIN + (size_t)NIN * 1024 * 2 <= WS_WMKV && WS_WDN + (size_t)1024 * DFF * 2 <= WS_XB && WS_XB + (size_t)MT * 1024 * 2 <= WS_MEMB, "ws map 1");
static_assert(WS_QA + (size_t)MT * 1536 * 2 <= WS_KA && WS_QB + (size_t)MT * 512 * 2 <= WS_KB && WS_VB + (size_t)MT * 1024 * 2 <= WS_SGB, "ws map 2");
static_assert(WS_OAG + (size_t)3 * MT * 512 * 2 <= WS_YAIN && WS_YAIN + (size_t)MT * 512 * 2 <= WS_OBN && WS_OBN + (size_t)MT * 1024 * 2 <= WS_END, "ws map 3");
static_assert(WS_H + (size_t)MT * DFF * 2 <= WS_OAG && WS_O2 + (size_t)MT * 1024 * 2 <= WS_VB && WS_SSQ + (size_t)MT * 16 * 4 <= WS_FB && WS_LSE + (size_t)MT * 12 * 4 <= WS_QA, "ws map 4");

constexpr int LDS_BYTES = 147456;
constexpr int NTHREADS = 512;

DI unsigned pk2(float lo, float hi) { f32x2 v = {lo, hi}; hwbf16x2 b = __builtin_convertvector(v, hwbf16x2); return __builtin_bit_cast(unsigned, b); }
DI float bflo(unsigned w) { return __uint_as_float(w << 16); }
DI float bfhi(unsigned w) { return __uint_as_float(w & 0xffff0000u); }
DI float bf1(bf16_t h) { return __uint_as_float((unsigned)h << 16); }
DI bf16_t f2bf(float f) { return (bf16_t)(pk2(f, 0.f) & 0xffffu); }
template <int CTRL, int ROW_MASK> DI float dpp_f(float v) {
    return __builtin_bit_cast(float, __builtin_amdgcn_update_dpp(0, __builtin_bit_cast(int, v), CTRL, ROW_MASK, 0xf, false));
}
DI float wave_sum(float v) {
    v += dpp_f<0xB1, 0xf>(v);
    v += dpp_f<0x4E, 0xf>(v);
    v += dpp_f<0x141, 0xf>(v);
    v += dpp_f<0x140, 0xf>(v);
    v += dpp_f<0x142, 0xa>(v);
    v += dpp_f<0x143, 0xc>(v);
    return __builtin_bit_cast(float, __builtin_amdgcn_ds_bpermute(63 * 4, __builtin_bit_cast(int, v)));
}
template <int CTRL, int ROW_MASK> DI float dpp_keep(float v) {
    return __builtin_bit_cast(float, __builtin_amdgcn_update_dpp(__builtin_bit_cast(int, v), __builtin_bit_cast(int, v), CTRL, ROW_MASK, 0xf, false));
}
DI float wave_max(float v) {
    v = fmaxf(v, dpp_keep<0xB1, 0xf>(v));
    v = fmaxf(v, dpp_keep<0x4E, 0xf>(v));
    v = fmaxf(v, dpp_keep<0x141, 0xf>(v));
    v = fmaxf(v, dpp_keep<0x140, 0xf>(v));
    v = fmaxf(v, dpp_keep<0x142, 0xa>(v));
    v = fmaxf(v, dpp_keep<0x143, 0xc>(v));
    return __builtin_bit_cast(float, __builtin_amdgcn_readlane(__builtin_bit_cast(int, v), 63));
}
DI float fsigmoid(float x) { return __builtin_amdgcn_rcpf(1.f + __expf(-x)); }
#define LDS_WAIT() asm volatile("s_waitcnt lgkmcnt(0)" ::: "memory")
#define LDS_BARRIER() do { asm volatile("s_waitcnt lgkmcnt(0)" ::: "memory"); __builtin_amdgcn_s_barrier(); asm volatile("" ::: "memory"); } while (0)
#define MFMA32(a, b, c) __builtin_amdgcn_mfma_f32_32x32x16_bf16((a), (b), (c), 0, 0, 0)
DI int crow(int reg, int h) { return (reg & 3) + 8 * (reg >> 2) + 4 * h; }
DI bf16x8 pack_step(const f32x16& x, int s) {
    u32x4 p;
    p[0] = pk2(x[8 * s + 0], x[8 * s + 1]); p[1] = pk2(x[8 * s + 2], x[8 * s + 3]); p[2] = pk2(x[8 * s + 4], x[8 * s + 5]); p[3] = pk2(x[8 * s + 6], x[8 * s + 7]);
    return __builtin_bit_cast(bf16x8, p);
}
DI bf16x8 cat8(u32x2 lo, u32x2 hi) { u32x4 p; p[0] = lo[0]; p[1] = lo[1]; p[2] = hi[0]; p[3] = hi[1]; return __builtin_bit_cast(bf16x8, p); }

struct Args {
    const float* in[30];
    float* out;
    unsigned char* ws;
    int ph_lo, ph_hi;
};

struct Ctx {
    const float* const* in;
    float* out; unsigned char* ws;
    LAS unsigned char* lds;
    int wave, G, bid;
};
DI int lane_id() { return __builtin_amdgcn_mbcnt_hi(~0u, __builtin_amdgcn_mbcnt_lo(~0u, 0u)); }
DI int lane_id_here() { int l = lane_id(); asm volatile("" : "+v"(l)); return l; }

DI void p0_transpose_item(const float* __restrict__ W, int ldw, int src_col0, int nvalid, const float* __restrict__ gain,
                          bf16_t* __restrict__ WT, int K, int dst_row0, int kb, LAS float* scr, int lane, int kofs = 0) {
    const int k0 = 64 * kb;
    {
        const int kr = lane >> 3, n4 = 4 * (lane & 7);
        f32x4 v[8];
        if (nvalid > 0) {
            const float* wp = W + (size_t)(k0 + kr) * ldw + src_col0 + (n4 < nvalid ? n4 : 0);
#pragma unroll
            for (int i = 0; i < 8; ++i) v[i] = __builtin_nontemporal_load((const f32x4*)(wp + (size_t)(8 * i) * ldw));
        }
#pragma unroll
        for (int i = 0; i < 8; ++i) {
            const int kk = kr + 8 * i;
            f32x4 t = (nvalid > 0 && n4 < nvalid) ? v[i] : (f32x4){0.f, 0.f, 0.f, 0.f};
            if (gain) t = t * gain[k0 + kk];
            LAS float* d = scr + kk * 33 + n4;
            d[0] = t[0]; d[1] = t[1]; d[2] = t[2]; d[3] = t[3];
        }
    }
    LDS_WAIT(); asm volatile("" ::: "memory");
    const int c = lane & 7;
#pragma unroll
    for (int j = 0; j < 4; ++j) {
        const int n = (lane >> 3) + 8 * j; const LAS float* s = scr + (8 * c) * 33 + n;
        u32x4 o; o.x = pk2(s[0 * 33], s[1 * 33]); o.y = pk2(s[2 * 33], s[3 * 33]); o.z = pk2(s[4 * 33], s[5 * 33]); o.w = pk2(s[6 * 33], s[7 * 33]);
        *(u32x4*)(WT + (size_t)(dst_row0 + n) * K + kofs + k0 + 8 * c) = o;
    }
    LDS_WAIT(); asm volatile("" ::: "memory");
}
template <int NR> DI void p0_rows(const float* const (&xrow)[NR], bf16_t* const (&orow)[NR], float* const (&rs_out)[NR], int lane) {
    f32x4 v[NR][4];
#pragma unroll
    for (int q = 0; q < NR; ++q)
#pragma unroll
        for (int j = 0; j < 4; ++j) v[q][j] = __builtin_nontemporal_load((const f32x4*)xrow[q] + lane + 64 * j);
#pragma unroll
    for (int q = 0; q < NR; ++q) {
        float s = 0.f;
#pragma unroll
        for (int j = 0; j < 4; ++j) s += (v[q][j].x * v[q][j].x + v[q][j].y * v[q][j].y) + (v[q][j].z * v[q][j].z + v[q][j].w * v[q][j].w);
        s = wave_sum(s);
        const float r = rsqrtf(s * (1.f / 1024.f) + EPS);
        u32x2* o8 = (u32x2*)orow[q] + lane;
#pragma unroll
        for (int j = 0; j < 4; ++j) { u32x2 w; w.x = pk2(v[q][j].x * r, v[q][j].y * r); w.y = pk2(v[q][j].z * r, v[q][j].w * r); o8[64 * j] = w; }
        if (lane == 0) *rs_out[q] = r;
    }
}
DI void p0_prologue(const Ctx& C) {
    const int lane = lane_id();
    LAS float* scr = (LAS float*)(C.lds + C.wave * 16384);
    const int gw = C.bid * 8 + C.wave, NGW = C.G * 8;
    const float* const* in = C.in;
    unsigned char* ws = C.ws;
    constexpr int I_IN = 16 * 312, I_MK = 16 * 32, I_PA = 8 * 32, I_SQ = 16 * 32, I_GU = 16 * 176, I_DN = 44 * 32;
    constexpr int NITEMS = I_IN + 2 * I_MK + I_PA + 4 * I_SQ + I_GU + I_DN;
    for (int it = gw; it < NITEMS; it += NGW) {
        int r = it;
        if (r < I_IN) {
            const int G = r % 312, kb = r / 312; int src, nv;
            if (G < 240) { src = 32 * G; nv = 32; } else if (G < 304) { src = 7696 + 32 * (G - 240); nv = 32; } else if (G == 304) { src = 7680; nv = 16; } else { src = 0; nv = 0; }
            p0_transpose_item(in[11], NIN_SRC, src, nv, in[9], (bf16_t*)(ws + WS_WIN), 1024, 32 * G, kb, scr, lane); continue; }
        r -= I_IN;
        if (r < I_MK) { p0_transpose_item(in[19], 1024, 32 * (r % 32), 32, in[18], (bf16_t*)(ws + WS_WMKV), 1024, 32 * (r % 32), r / 32, scr, lane); continue; } r -= I_MK;
        if (r < I_MK) { p0_transpose_item(in[20], 1024, 32 * (r % 32), 32, in[18], (bf16_t*)(ws + WS_WMKV), 1024, 1024 + 32 * (r % 32), r / 32, scr, lane); continue; } r -= I_MK;
        if (r < I_PA) { p0_transpose_item(in[15], 1024, 32 * (r % 32), 32, nullptr, (bf16_t*)(ws + WS_WPA), 1536, 32 * (r % 32), r / 32, scr, lane, 0); continue; } r -= I_PA;
        if (r < I_SQ) { p0_transpose_item(in[16], 1024, 32 * (r % 32), 32, nullptr, (bf16_t*)(ws + WS_WPA), 1536, 32 * (r % 32), r / 32, scr, lane, 512); continue; } r -= I_SQ;
        if (r < I_SQ) { p0_transpose_item(in[17], 1024, 32 * (r % 32), 32, nullptr, (bf16_t*)(ws + WS_WOUT), 1024, 32 * (r % 32), r / 32, scr, lane); continue; } r -= I_SQ;
        if (r < I_SQ) { p0_transpose_item(in[23], 1024, 32 * (r % 32), 32, in[21], (bf16_t*)(ws + WS_WMQ), 1024, 32 * (r % 32), r / 32, scr, lane); continue; } r -= I_SQ;
        if (r < I_SQ) { p0_transpose_item(in[24], 1024, 32 * (r % 32), 32, nullptr, (bf16_t*)(ws + WS_WMO), 1024, 32 * (r % 32), r / 32, scr, lane); continue; } r -= I_SQ;
        if (r < I_GU) {
            const int G = r % 176, kb = r / 176, j = G >> 3, sub = G & 7;
            const float* W = sub < 4 ? in[27] : in[28];
            p0_transpose_item(W, DFF, 128 * j + 32 * (sub & 3), 32, in[25], (bf16_t*)(ws + WS_WGU), 1024, 32 * G, kb, scr, lane); continue; }
        r -= I_GU;
        p0_transpose_item(in[29], 1024, 32 * (r % 32), 32, nullptr, (bf16_t*)(ws + WS_WDN), DFF, 32 * (r % 32), r / 32, scr, lane);
    }
    bf16_t* XB = (bf16_t*)(ws + WS_XB); float* RS = (float*)(ws + WS_RS);
    for (int m = gw; m < MT; m += 4 * NGW) {
        if (m + 3 * NGW < MT) {
            const float* src[4]; bf16_t* dst[4]; float* rsp[4];
#pragma unroll
            for (int q = 0; q < 4; ++q) { const int mm = m + q * NGW; src[q] = mm < MP ? in[0] + (size_t)mm * 1024 : in[1] + (size_t)(mm - MP) * 1024; dst[q] = XB + (size_t)mm * 1024; rsp[q] = RS + mm; }
            p0_rows<4>(src, dst, rsp, lane);
        } else {
            for (int mm = m; mm < MT; mm += NGW) {
                const float* src[1] = {mm < MP ? in[0] + (size_t)mm * 1024 : in[1] + (size_t)(mm - MP) * 1024}; bf16_t* dst[1] = {XB + (size_t)mm * 1024}; float* rsp[1] = {RS + mm};
                p0_rows<1>(src, dst, rsp, lane);
            }
        }
    }
    bf16_t* MEMB = (bf16_t*)(ws + WS_MEMB); float* RSM = (float*)(ws + WS_RSMEM);
    for (int m = gw; m < 1024; m += NGW) { const float* src[1] = {in[7] + (size_t)m * 1024}; bf16_t* dst[1] = {MEMB + (size_t)m * 1024}; float* rsp[1] = {RSM + m}; p0_rows<1>(src, dst, rsp, lane); }
}

DI void st_bf16x8(bf16_t* p, f32x4 v0, f32x4 v1) {
    u32x4 w; w.x = pk2(v0[0], v0[1]); w.y = pk2(v0[2], v0[3]); w.z = pk2(v1[0], v1[1]); w.w = pk2(v1[2], v1[3]);
    *(u32x4*)p = w;
}
DI void st_rowpair(bf16_t* row_base, int k, u32x2 a, u32x2 b, int hh) {
    const auto r0 = __builtin_amdgcn_permlane32_swap(a.x, b.x, false, false);
    const auto r1 = __builtin_amdgcn_permlane32_swap(a.y, b.y, false, false);
    u32x4 w; w.x = r0[0]; w.y = r1[0]; w.z = r0[1]; w.w = r1[1];
    *(u32x4*)(row_base + 8 * k + 8 * hh) = w;
}
DI void st_bf16x8_nt(bf16_t* p, f32x4 v0, f32x4 v1) {
    u32x4 w; w.x = pk2(v0[0], v0[1]); w.y = pk2(v0[2], v0[3]); w.z = pk2(v1[0], v1[1]); w.w = pk2(v1[2], v1[3]);
    __builtin_nontemporal_store(w, (u32x4*)p);
}
DI int attn_prow(int row, int g) {
    if (row >= MP) return row;
    const int t = row & 8191, sh = 2 * g;
    return (row & ~8191) + ((t & ((1 << sh) - 1)) << (13 - sh)) + (t >> sh);
}
struct EpiIn {
    static constexpr bool PERM = true, AFTER_DRAIN = false, HAS_MID = false;
    const float* rs; unsigned char* ws; float* out;
    DI void operator()(const f32x4 (&acc)[2][2][4][2], const pg8::Unit& u, int wr, int wc, int fr, int fq) const {
        const int pn = u.pn, rbase = u.pm * 256 + wr * 64 + fr, cl = wc * 32 + 8 * fq;
        if (pn == 38) {
            if (wc == 0 && fq < 2) {
                float* FB = (float*)(ws + WS_FB);
#pragma unroll
                for (int ai = 0; ai < 2; ++ai)
#pragma unroll
                    for (int m = 0; m < 4; ++m) { const int row = rbase + ai * 128 + m * 16;
                        *(f32x4*)(FB + (size_t)row * 16 + 8 * fq) = acc[ai][0][m][0]; *(f32x4*)(FB + (size_t)row * 16 + 8 * fq + 4) = acc[ai][0][m][1]; }
            }
            return;
        }
        bf16_t* dst; int ldc, cbase; float sc = 1.f; int act = 0;
        int perm_g = -1;
        if (pn < 6)       { perm_g = pn >> 1; dst = (bf16_t*)(ws + WS_QA) + (size_t)(4 * perm_g + 2 * (pn & 1)) * MT * 128; ldc = 128; cbase = 0; sc = QA_SCALE; }
        else if (pn < 12) { perm_g = (pn - 6) >> 1; dst = (bf16_t*)(ws + WS_KA) + (size_t)(4 * perm_g + 2 * (pn & 1)) * MT * 128; ldc = 128; cbase = 0; }
        else if (pn < 18) { perm_g = (pn - 12) >> 1; dst = (bf16_t*)(ws + WS_VA) + (size_t)(4 * perm_g + 2 * (pn & 1)) * MT * 128; ldc = 128; cbase = 0; }
        else if (pn < 20) { dst = (bf16_t*)(ws + WS_QB); ldc = 512; cbase = (pn - 18) * 256; sc = QB_SCALE; }
        else if (pn < 22) { dst = (bf16_t*)(ws + WS_KB); ldc = 512; cbase = (pn - 20) * 256; }
        else if (pn < 26) { dst = (bf16_t*)(ws + WS_VB); ldc = 1024; cbase = (pn - 22) * 256; }
        else if (pn < 30) { dst = (bf16_t*)(ws + WS_SGB); ldc = 1024; cbase = (pn - 26) * 256; act = 1; }
        else if (pn < 34) { dst = (bf16_t*)(ws + WS_SGA); ldc = 1024; cbase = (pn - 30) * 256; act = 2; }
        else              { dst = (bf16_t*)(ws + WS_SGBT); ldc = 1024; cbase = (pn - 34) * 256; act = 2; }
        const bool iskv = (pn >= 6 && pn < 18);
        const bool maywin = iskv && (u.pm == 128 || (u.pm & 31) >= 24);
        const int kv = pn >= 12 ? 1 : 0, pc = (pn - 6) % 6, g = pc >> 1, cg0 = (pc & 1) * 256, keep = 128 << (2 * g);
        const size_t offp = g == 0 ? O_W1P : (g == 1 ? O_W2P : O_W3P), offs = g == 0 ? O_W1S : (g == 1 ? O_W2S : O_W3S);
#pragma unroll
        for (int ai = 0; ai < 2; ++ai)
#pragma unroll
            for (int m = 0; m < 4; ++m) {
                const int row = rbase + ai * 128 + m * 16;
                bf16_t* rowp = dst + (size_t)(perm_g >= 0 ? attn_prow(row, perm_g) : row) * ldc + cbase + cl;
                float* wp = nullptr;
                if (maywin) {
                    if (row >= MP) wp = out + offs + ((size_t)(row - MP) * 2 + kv) * 512 + cg0 + cl;
                    else { const int b = row >> 13, t = row & 8191; if (t >= SEQ - keep) wp = out + offp + ((size_t)(b * keep + t - (SEQ - keep)) * 2 + kv) * 512 + cg0 + cl; }
                }
#pragma unroll
                for (int bj = 0; bj < 2; ++bj) {
                    f32x4 v0 = acc[ai][bj][m][0], v1 = acc[ai][bj][m][1];
                    if (wp) { *(f32x4*)(wp + bj * 128) = v0; *(f32x4*)(wp + bj * 128 + 4) = v1; }
                    if (act) {
#pragma unroll
                        for (int i = 0; i < 4; ++i) { const float s0 = fsigmoid(v0[i]), s1 = fsigmoid(v1[i]); v0[i] = act == 1 ? v0[i] * s0 : s0; v1[i] = act == 1 ? v1[i] * s1 : s1; }
                    }
                    st_bf16x8_nt(rowp + (perm_g >= 0 ? (size_t)bj * MT * 128 : (size_t)bj * 128), v0 * sc, v1 * sc);
                }
            }
    }
};
struct EpiMemKV {
    static constexpr bool PERM = true, AFTER_DRAIN = false, HAS_MID = false;
    const float* rs; unsigned char* ws; float* out;
    DI void operator()(const f32x4 (&acc)[2][2][4][2], const pg8::Unit& u, int wr, int wc, int fr, int fq) const {
        const int pn = u.pn, rbase = u.pm * 256 + wr * 64 + fr, cl = wc * 32 + 8 * fq, kv = pn >> 2, c0 = (pn & 3) * 256 + cl;
        bf16_t* MK = (bf16_t*)(ws + WS_MK); bf16_t* MVT = (bf16_t*)(ws + WS_MVT);
#pragma unroll
        for (int ai = 0; ai < 2; ++ai)
#pragma unroll
            for (int m = 0; m < 4; ++m) {
                const int row = rbase + ai * 128 + m * 16;
                float* op = out + O_MEMP + ((size_t)row * 2 + kv) * 1024 + c0;
#pragma unroll
                for (int bj = 0; bj < 2; ++bj) {
                    const f32x4 v0 = acc[ai][bj][m][0], v1 = acc[ai][bj][m][1];
                    *(f32x4*)(op + bj * 128) = v0; *(f32x4*)(op + bj * 128 + 4) = v1;
                    if (kv == 0) st_bf16x8(MK + (size_t)row * 1024 + c0 + bj * 128, v0, v1);
                    else {
                        bf16_t* vp = MVT + ((size_t)(row >> 8) * 1024 + c0 + bj * 128) * 256 + (row & 255);
#pragma unroll
                        for (int i = 0; i < 4; ++i) { vp[(size_t)i * 256] = f2bf(v0[i]); vp[(size_t)(i + 4) * 256] = f2bf(v1[i]); }
                    }
                }
            }
    }
};

struct EpiNull {
    static constexpr bool PERM = true, AFTER_DRAIN = false, HAS_MID = false;
    float* sink;
    DI void operator()(const f32x4 (&acc)[2][2][4][2], const pg8::Unit& u, int wr, int wc, int fr, int fq) const {
        float s = 0.f;
#pragma unroll
        for (int ai = 0; ai < 2; ++ai)
#pragma unroll
            for (int bj = 0; bj < 2; ++bj)
#pragma unroll
                for (int m = 0; m < 4; ++m)
#pragma unroll
                    for (int n = 0; n < 2; ++n) s += acc[ai][bj][m][n][0] + acc[ai][bj][m][n][1] + acc[ai][bj][m][n][2] + acc[ai][bj][m][n][3];
        if (fr == 0 && fq == 0) sink[(u.pm * 64 + u.pn) * 8 + wr * 4 + wc] = s;
    }
};

constexpr int GL_QP = 0, GL_KP = 17408, GL_KPT = 34816, GL_VT = 53248, GL_OT = 90112, GL_FB = 123904, GL_PFX = 128000, GL_EBL = 136192,
              GL_WF2 = 136704, GL_BF2 = 144896, GL_GN = 145408, GL_END = 146432;
constexpr int QP_PITCH = 272, KT_PITCH = 144, OT_PITCH = 528;
static_assert(GL_END <= LDS_BYTES, "gla lds");

DI float logsig16(float z) {
    const float a = fabsf(z);
    return (fminf(z, 0.f) - __logf(1.f + __expf(-a))) * 0.0625f;
}

constexpr int GL_XF = GL_OT;
constexpr size_t WS_OIG = WS_XB, WS_DSG = 943 * MiB, WS_QPG = 959 * MiB, WS_EBLG = 991 * MiB, WS_END2 = 992 * MiB;
static_assert(WS_OIG + (size_t)2048 * 32768 <= WS_MEMB && WS_DSG >= WS_END && WS_DSG + (size_t)256 * 65536 <= WS_QPG && WS_QPG + (size_t)2048 * 16384 <= WS_EBLG && WS_EBLG + MiB <= WS_END2, "gla ws map");

DI void gla_load_consts(const Ctx& C, int h, int tid) {
    LAS unsigned char* lds = C.lds;
    const float* wf2 = C.in[12]; const float* bf2 = C.in[13]; const float* gn = C.in[14];
    LAS float* WF = (LAS float*)(lds + GL_WF2);
    for (int i = tid; i < 16 * 128; i += NTHREADS) WF[i] = wf2[(size_t)(i >> 7) * 512 + h * 128 + (i & 127)];
    if (tid < 128) ((LAS float*)(lds + GL_BF2))[tid] = bf2[h * 128 + tid];
    if (tid < 256) ((LAS float*)(lds + GL_GN))[tid] = gn[tid];
}

constexpr int NSUB = 8, NUNIT = 16 * (128 / NSUB);
constexpr int GL_CUM = GL_GN;
DI void gla_pass_a_unit(const Ctx& C, int unit) {
    LAS unsigned char* lds = C.lds;
    const int lane = lane_id_here(), w = C.wave, tid = w * 64 + lane, r = lane & 31, hh = lane >> 5;
    const int bh = unit / (128 / NSUB), sc = unit % (128 / NSUB), b = bh >> 2, h = bh & 3;
    unsigned char* ws = C.ws;
    const bf16_t* QB = (const bf16_t*)(ws + WS_QB); const bf16_t* KB = (const bf16_t*)(ws + WS_KB); const bf16_t* VB = (const bf16_t*)(ws + WS_VB);
    const float* FB = (const float*)(ws + WS_FB);
    const size_t tok0 = (size_t)b * SEQ + (size_t)sc * NSUB * 64;
    const int cg = tid & 31, rg = tid >> 5;
    u32x2 q4[4], k4[4]; u32x4 vreg[4]; f32x4 fbreg = {0.f, 0.f, 0.f, 0.f};
#define GLA_ISSUE_LOADS(jn) do { const size_t t0_ = tok0 + (size_t)(jn) * 64; \
        _Pragma("unroll") for (int i = 0; i < 4; ++i) { \
            q4[i] = *(const u32x2*)(QB + (t0_ + 4 * rg + i) * 512 + h * 128 + 4 * cg); \
            k4[i] = *(const u32x2*)(KB + (t0_ + 4 * rg + i) * 512 + h * 128 + 4 * cg); \
            vreg[i] = *(const u32x4*)(VB + (t0_ + lane) * 1024 + h * 256 + 32 * w + 8 * i); } \
        if (tid < 256) fbreg = *(const f32x4*)(FB + t0_ * 16 + tid * 4); } while (0)
    GLA_ISSUE_LOADS(0);
    LDS_BARRIER();
    gla_load_consts(C, h, tid);
    if (tid < 128) ((LAS float*)(lds + GL_CUM))[tid] = 1.f;
    f32x16 S[4];
#pragma unroll
    for (int i = 0; i < 4; ++i)
#pragma unroll
        for (int j = 0; j < 16; ++j) S[i][j] = 0.f;
    for (int jc = 0; jc < NSUB; ++jc) {
        const size_t cunit = (size_t)bh * 128 + sc * NSUB + jc;
        if (tid < 256) *(LAS f32x4*)(lds + GL_FB + tid * 16) = fbreg;
        {
            LAS bf16_t* VT = (LAS bf16_t*)(lds + GL_VT);
#pragma unroll
            for (int i = 0; i < 4; ++i)
#pragma unroll
                for (int j = 0; j < 4; ++j) {
                    const unsigned wv = vreg[i][j]; const int e = 32 * w + 8 * i + 2 * j;
                    VT[e * (KT_PITCH / 2) + lane] = (bf16_t)(wv & 0xffffu); VT[(e + 1) * (KT_PITCH / 2) + lane] = (bf16_t)(wv >> 16);
                }
        }
        LDS_BARRIER();
        float bl[4][4];
        {
            const LAS float* WF = (const LAS float*)(lds + GL_WF2); const LAS float* FBs = (const LAS float*)(lds + GL_FB);
            const f32x4 bb = *(const LAS f32x4*)(lds + GL_BF2 + 16 * cg);
            f32x4 z[4] = {bb, bb, bb, bb};
#pragma unroll
            for (int j4 = 0; j4 < 4; ++j4) {
                f32x4 f[4];
#pragma unroll
                for (int i = 0; i < 4; ++i) f[i] = *(const LAS f32x4*)(FBs + (4 * rg + i) * 16 + 4 * j4);
#pragma unroll
                for (int jj = 0; jj < 4; ++jj) {
                    const f32x4 wv = *(const LAS f32x4*)(WF + (4 * j4 + jj) * 128 + 4 * cg);
#pragma unroll
                    for (int i = 0; i < 4; ++i) z[i] += wv * f[i][jj];
                }
            }
#pragma unroll
            for (int c = 0; c < 4; ++c) {
                float run = 0.f;
#pragma unroll
                for (int i = 0; i < 4; ++i) { run += logsig16(z[i][c]); bl[i][c] = run; }
            }
            *(LAS f32x4*)(lds + GL_PFX + (rg * 128 + 4 * cg) * 4) = (f32x4){bl[3][0], bl[3][1], bl[3][2], bl[3][3]};
        }
        LDS_BARRIER();
        f32x4 ebnew = {1.f, 1.f, 1.f, 1.f};
        {
            f32x4 pre = {0.f, 0.f, 0.f, 0.f}, tot = {0.f, 0.f, 0.f, 0.f};
#pragma unroll
            for (int g = 0; g < 16; ++g) { const f32x4 p = *(const LAS f32x4*)(lds + GL_PFX + (g * 128 + 4 * cg) * 4); tot += p; if (g < rg) pre += p; }
            const f32x4 cum = *(const LAS f32x4*)(lds + GL_CUM + 16 * cg);
            ebnew = (f32x4){__expf(tot[0]), __expf(tot[1]), __expf(tot[2]), __expf(tot[3])};
            if (rg == 0) *(LAS f32x4*)(lds + GL_EBL + 16 * cg) = ebnew;
            float kq[4][4];
            bf16_t* QPG = (bf16_t*)(ws + WS_QPG) + cunit * 8192;
#pragma unroll
            for (int i = 0; i < 4; ++i) {
                float qv[4] = {bflo(q4[i][0]), bfhi(q4[i][0]), bflo(q4[i][1]), bfhi(q4[i][1])};
                float kv[4] = {bflo(k4[i][0]), bfhi(k4[i][0]), bflo(k4[i][1]), bfhi(k4[i][1])};
                float qo[4];
#pragma unroll
                for (int c = 0; c < 4; ++c) { const float bv = pre[c] + bl[i][c]; const float e = __expf(bv); qo[c] = qv[c] * e; kq[i][c] = kv[c] * __builtin_amdgcn_rcpf(e); }
                u32x2 wq; wq.x = pk2(qo[0], qo[1]); wq.y = pk2(qo[2], qo[3]);
                u32x2 wk; wk.x = pk2(kq[i][0], kq[i][1]); wk.y = pk2(kq[i][2], kq[i][3]);
                u32x2 wg; wg.x = pk2(qo[0] * cum[0], qo[1] * cum[1]); wg.y = pk2(qo[2] * cum[2], qo[3] * cum[3]);
                *(LAS u32x2*)(lds + GL_QP + (4 * rg + i) * QP_PITCH + 8 * cg) = wq;
                *(LAS u32x2*)(lds + GL_KP + (4 * rg + i) * QP_PITCH + 8 * cg) = wk;
                *(u32x2*)(QPG + (4 * rg + i) * 128 + 4 * cg) = wg;
            }
#pragma unroll
            for (int c = 0; c < 4; ++c) { u32x2 wt; wt.x = pk2(kq[0][c], kq[1][c]); wt.y = pk2(kq[2][c], kq[3][c]);
                *(LAS u32x2*)(lds + GL_KPT + (4 * cg + c) * KT_PITCH + 8 * rg) = wt; }
        }
        LDS_BARRIER();
        if (rg == 0) { const f32x4 cum = *(const LAS f32x4*)(lds + GL_CUM + 16 * cg); *(LAS f32x4*)(lds + GL_CUM + 16 * cg) = cum * ebnew; }
        f32x16 O[2];
#pragma unroll
        for (int i = 0; i < 2; ++i)
#pragma unroll
            for (int j = 0; j < 16; ++j) O[i][j] = 0.f;
        if (jc > 0) {
#pragma unroll
            for (int dt = 0; dt < 4; ++dt)
#pragma unroll
                for (int s = 0; s < 2; ++s) {
                    const bf16x8 sb = pack_step(S[dt], s);
#pragma unroll
                    for (int ct = 0; ct < 2; ++ct) {
                        const LAS unsigned char* p = lds + GL_QP + (32 * ct + r) * QP_PITCH + (32 * dt + 16 * s + 4 * hh) * 2;
                        const bf16x8 a = cat8(*(const LAS u32x2*)p, *(const LAS u32x2*)(p + 16));
                        O[ct] = MFMA32(a, sb, O[ct]);
                    }
                    __builtin_amdgcn_sched_barrier(0);
                }
        }
        if (w < 3) {
            const int jt = w == 2 ? 1 : 0, ct = w == 0 ? 0 : 1;
            f32x16 X;
#pragma unroll
            for (int j = 0; j < 16; ++j) X[j] = 0.f;
#pragma unroll
            for (int s8 = 0; s8 < 8; ++s8) {
                const bf16x8 a = *(const LAS bf16x8*)(lds + GL_KP + (32 * jt + r) * QP_PITCH + (16 * s8 + 8 * hh) * 2);
                const bf16x8 bq = *(const LAS bf16x8*)(lds + GL_QP + (32 * ct + r) * QP_PITCH + (16 * s8 + 8 * hh) * 2);
                X = MFMA32(a, bq, X);
            }
            if (jt == ct) {
#pragma unroll
                for (int j = 0; j < 16; ++j) if (crow(j, hh) > r) X[j] = 0.f;
            }
            *(LAS u32x4*)(lds + GL_XF + ((w * 2 + 0) * 64 + lane) * 16) = __builtin_bit_cast(u32x4, pack_step(X, 0));
            *(LAS u32x4*)(lds + GL_XF + ((w * 2 + 1) * 64 + lane) * 16) = __builtin_bit_cast(u32x4, pack_step(X, 1));
        }
        __builtin_amdgcn_sched_barrier(0);
        if (jc + 1 < NSUB) GLA_ISSUE_LOADS(jc + 1);
        __builtin_amdgcn_sched_barrier(0);
        {
#pragma unroll
            for (int dt = 0; dt < 4; ++dt) {
#pragma unroll
                for (int s = 0; s < 4; ++s) {
                    const bf16x8 a = *(const LAS bf16x8*)(lds + GL_KPT + (32 * dt + r) * KT_PITCH + (16 * s + 8 * hh) * 2);
                    const bf16x8 vb = *(const LAS bf16x8*)(lds + GL_VT + (32 * w + r) * KT_PITCH + (16 * s + 8 * hh) * 2);
                    S[dt] = MFMA32(a, vb, S[dt]);
                }
#pragma unroll
                for (int g4 = 0; g4 < 4; ++g4) {
                    const f32x4 e = *(const LAS f32x4*)(lds + GL_EBL + (32 * dt + 8 * g4 + 4 * hh) * 4);
#pragma unroll
                    for (int i = 0; i < 4; ++i) S[dt][4 * g4 + i] *= e[i];
                }
                __builtin_amdgcn_sched_barrier(0);
            }
        }
        LDS_BARRIER();
        {
#pragma unroll
            for (int ct = 0; ct < 2; ++ct)
#pragma unroll
                for (int jt = 0; jt <= ct; ++jt) {
                    const int tile = ct == 0 ? 0 : (jt == 0 ? 1 : 2);
#pragma unroll
                    for (int s = 0; s < 2; ++s) {
                        const bf16x8 xa = *(const LAS bf16x8*)(lds + GL_XF + ((tile * 2 + s) * 64 + lane) * 16);
                        const LAS unsigned char* p = lds + GL_VT + (32 * w + r) * KT_PITCH + (32 * jt + 16 * s + 4 * hh) * 2;
                        const bf16x8 vb = cat8(*(const LAS u32x2*)p, *(const LAS u32x2*)(p + 16));
                        O[ct] = MFMA32(xa, vb, O[ct]);
                    }
                }
            u32x2* OIG = (u32x2*)(ws + WS_OIG) + cunit * 4096 + w * 64 + lane;
#pragma unroll
            for (int ct = 0; ct < 2; ++ct)
#pragma unroll
                for (int g4 = 0; g4 < 4; ++g4) { u32x2 o; o.x = pk2(O[ct][4 * g4], O[ct][4 * g4 + 1]); o.y = pk2(O[ct][4 * g4 + 2], O[ct][4 * g4 + 3]); OIG[(ct * 4 + g4) * 512] = o; }
        }
    }
#undef GLA_ISSUE_LOADS
    {
        int l2 = lane_id_here(); const int w2 = w;
        u32x4* DSG = (u32x4*)(ws + WS_DSG) + (size_t)unit * 4096 + w2 * 64 + l2;
#pragma unroll
        for (int dt = 0; dt < 4; ++dt) { DSG[(dt * 2 + 0) * 512] = __builtin_bit_cast(u32x4, pack_step(S[dt], 0)); DSG[(dt * 2 + 1) * 512] = __builtin_bit_cast(u32x4, pack_step(S[dt], 1)); }
        const int t2 = w2 * 64 + l2;
        if (t2 < 128) ((float*)(ws + WS_EBLG))[(size_t)unit * 128 + t2] = ((const LAS float*)(lds + GL_CUM))[t2];
    }
}

DI void gla_pass_b(const Ctx& C) {
    const int lane = lane_id_here(), tid = C.wave * 64 + lane, gid = C.bid * NTHREADS + tid;
    unsigned char* ws = C.ws;
    constexpr int UPB = 128 / NSUB;
    for (int id = gid; id < 16 * 8192; id += C.G * NTHREADS) {
        const int bh = id >> 13, f = (id >> 1) & 4095, half = id & 1;
        const int fl = f & 63, fw = (f >> 6) & 7, fs = (f >> 9) & 1, fdt = f >> 10;
        const int d0 = 32 * fdt + 16 * fs + 8 * half + 4 * (fl >> 5), e = 32 * fw + (fl & 31);
        u32x2* p = (u32x2*)(ws + WS_DSG) + ((size_t)bh * UPB * 4096 + f) * 2 + half;
        const float* eb = (const float*)(ws + WS_EBLG) + (size_t)bh * UPB * 128 + d0;
        float s0 = 0.f, s1 = 0.f, s2 = 0.f, s3 = 0.f;
#pragma unroll
        for (int u = 0; u < UPB; ++u) {
            const u32x2 ds = p[(size_t)u * 8192];
            const f32x4 ev = *(const f32x4*)(eb + u * 128);
            u32x2 st; st.x = pk2(s0, s1); st.y = pk2(s2, s3);
            p[(size_t)u * 8192] = st;
            s0 = ev[0] * s0 + bflo(ds.x); s1 = ev[1] * s1 + bfhi(ds.x); s2 = ev[2] * s2 + bflo(ds.y); s3 = ev[3] * s3 + bfhi(ds.y);
        }
        float* gp = C.out + O_GLAP + ((size_t)bh * 128 + d0) * 256 + e;
        gp[0] = s0; gp[256] = s1; gp[512] = s2; gp[768] = s3;
    }
}

DI void gla_pass_c(const Ctx& C) {
    LAS unsigned char* lds = C.lds;
    const int lane = lane_id_here(), w = C.wave, tid = w * 64 + lane, r = lane & 31, hh = lane >> 5;
    unsigned char* ws = C.ws;
    const int orow = tid >> 3, occ = tid & 7;
#define GLC_QLOAD(un) do { const u32x4* q_ = (const u32x4*)((const bf16_t*)(ws + WS_QPG) + (size_t)(un) * 8192); qst0 = q_[tid]; qst1 = q_[tid + 512]; } while (0)
#define GLC_QWRITE() do { *(LAS u32x4*)(lds + GL_QP + (tid >> 4) * QP_PITCH + 16 * (tid & 15)) = qst0; *(LAS u32x4*)(lds + GL_QP + (32 + (tid >> 4)) * QP_PITCH + 16 * (tid & 15)) = qst1; } while (0)
    const bool xs = C.G == 256;
#define GLC_UNIT(li) (xs ? (((li) & ~255) | (((li) & 7) << 5) | (((li) >> 3) & 31)) : (li))
    int li = C.bid;
    int unit = GLC_UNIT(li);
    u32x4 qst0 = {0u, 0u, 0u, 0u}, qst1 = {0u, 0u, 0u, 0u};
    if (li < 2048) GLC_QLOAD(unit);
    LDS_BARRIER();
    GLC_QWRITE();
    if (tid < 256) ((LAS float*)(lds + GL_GN))[tid] = C.in[14][tid];
    LDS_BARRIER();
    for (; li < 2048; li += C.G, unit = GLC_UNIT(li)) {
        const int bh = unit >> 7, ch = unit & 127, b = bh >> 2, h = bh & 3;
        const size_t t0 = (size_t)b * SEQ + (size_t)ch * 64;
        const int nli = li + C.G, nxt = nli < 2048 ? GLC_UNIT(nli) : 2048;
        u32x4 sgb[4];
#pragma unroll
        for (int i = 0; i < 4; ++i) sgb[i] = *(const u32x4*)((const bf16_t*)(ws + WS_SGB) + (t0 + orow) * 1024 + h * 256 + 32 * occ + 8 * i);
        f32x16 O[2];
        {
            const u32x2* OIG = (const u32x2*)(ws + WS_OIG) + (size_t)unit * 4096 + w * 64 + lane;
#pragma unroll
            for (int ct = 0; ct < 2; ++ct)
#pragma unroll
                for (int g4 = 0; g4 < 4; ++g4) { const u32x2 o = OIG[(ct * 4 + g4) * 512]; O[ct][4 * g4] = bflo(o.x); O[ct][4 * g4 + 1] = bfhi(o.x); O[ct][4 * g4 + 2] = bflo(o.y); O[ct][4 * g4 + 3] = bfhi(o.y); }
        }
        {
            const u32x4* SCG = (const u32x4*)(ws + WS_DSG) + (size_t)(bh * (128 / NSUB) + ch / NSUB) * 4096 + w * 64 + lane;
            u32x4 scg[8];
#pragma unroll
            for (int i = 0; i < 8; ++i) scg[i] = SCG[i * 512];
            if (nxt < 2048) GLC_QLOAD(nxt);
#pragma unroll
            for (int dt = 0; dt < 4; ++dt)
#pragma unroll
                for (int s = 0; s < 2; ++s) {
                    const bf16x8 sb = __builtin_bit_cast(bf16x8, scg[dt * 2 + s]);
#pragma unroll
                    for (int ct = 0; ct < 2; ++ct) {
                        const LAS unsigned char* p = lds + GL_QP + (32 * ct + r) * QP_PITCH + (32 * dt + 16 * s + 4 * hh) * 2;
                        const bf16x8 a = cat8(*(const LAS u32x2*)p, *(const LAS u32x2*)(p + 16));
                        O[ct] = MFMA32(a, sb, O[ct]);
                    }
                }
        }
        LDS_BARRIER();
        if (nxt < 2048) GLC_QWRITE();
        {
            LAS bf16_t* OT = (LAS bf16_t*)(lds + GL_OT);
#pragma unroll
            for (int ct = 0; ct < 2; ++ct)
#pragma unroll
                for (int j = 0; j < 16; ++j) OT[(32 * ct + crow(j, hh)) * (OT_PITCH / 2) + 32 * w + r] = f2bf(O[ct][j]);
        }
        LDS_BARRIER();
        {
            float v[32]; float ss = 0.f;
#pragma unroll
            for (int i = 0; i < 4; ++i) {
                const u32x4 wv = *(const LAS u32x4*)(lds + GL_OT + orow * OT_PITCH + 64 * occ + 16 * i);
#pragma unroll
                for (int j = 0; j < 4; ++j) { v[8 * i + 2 * j] = bflo(wv[j]); v[8 * i + 2 * j + 1] = bfhi(wv[j]); }
            }
#pragma unroll
            for (int i = 0; i < 32; ++i) ss += v[i] * v[i];
            ss += __shfl_xor(ss, 1); ss += __shfl_xor(ss, 2); ss += __shfl_xor(ss, 4);
            const float rinv = rsqrtf(ss * (1.f / 256.f) + EPS);
            bf16_t* op = (bf16_t*)(ws + WS_YAIN) + (t0 + orow) * 1536 + 512 + h * 256 + 32 * occ;
#pragma unroll
            for (int i = 0; i < 4; ++i) {
                const f32x4 g0 = *(const LAS f32x4*)(lds + GL_GN + (32 * occ + 8 * i) * 4), g1 = *(const LAS f32x4*)(lds + GL_GN + (32 * occ + 8 * i + 4) * 4);
                const u32x4 sg = sgb[i];
                u32x4 o;
                o[0] = pk2(v[8 * i + 0] * rinv * g0[0] * bflo(sg[0]), v[8 * i + 1] * rinv * g0[1] * bfhi(sg[0]));
                o[1] = pk2(v[8 * i + 2] * rinv * g0[2] * bflo(sg[1]), v[8 * i + 3] * rinv * g0[3] * bfhi(sg[1]));
                o[2] = pk2(v[8 * i + 4] * rinv * g1[0] * bflo(sg[2]), v[8 * i + 5] * rinv * g1[1] * bfhi(sg[2]));
                o[3] = pk2(v[8 * i + 6] * rinv * g1[2] * bflo(sg[3]), v[8 * i + 7] * rinv * g1[3] * bfhi(sg[3]));
                *(u32x4*)(op + 8 * i) = o;
            }
        }
    }
#undef GLC_QLOAD
#undef GLC_QWRITE
#undef GLC_UNIT
}

constexpr int GS_QP = 0, GS_KM = 4096, GS_EBL = 8192, GS_AM = 8704, GS_VS = 8960, GS_OS = 34304, GS_RED = 33536, GS_FB = 33792, GS_OS2 = 85248, GS_END = GS_OS2 + 32768;
static_assert(GS_OS + 32768 <= 69632 && GS_END <= LDS_BYTES - 64, "gla sample lds");
DI void gla_sample_item(const Ctx& C, int b, int h) {
    LAS unsigned char* lds = C.lds; const int tid = C.wave * 64 + lane_id_here(); unsigned char* ws = C.ws;
    const bf16_t* QB = (const bf16_t*)(ws + WS_QB); const bf16_t* KB = (const bf16_t*)(ws + WS_KB); const bf16_t* VB = (const bf16_t*)(ws + WS_VB);
    const bf16_t* SGB = (const bf16_t*)(ws + WS_SGB); const float* FB = (const float*)(ws + WS_FB); bf16_t* OBN = (bf16_t*)(ws + WS_YAIN) + 512;
    const size_t row0 = (size_t)MP + (size_t)b * 8;
    LAS float* QPt = (LAS float*)(lds + GS_QP); LAS float* KMt = (LAS float*)(lds + GS_KM); LAS float* EBLs = (LAS float*)(lds + GS_EBL);
    LAS float* AM = (LAS float*)(lds + GS_AM); LAS float* VS = (LAS float*)(lds + GS_VS); LAS float* OS = (LAS float*)(lds + GS_OS);
    LAS float* RED = (LAS float*)(lds + GS_RED); LAS float* FBs = (LAS float*)(lds + GS_FB);
    const int e4 = 4 * (tid & 63), grp = C.wave;
    const float* S0 = C.in[5] + ((size_t)(b * 4 + h) * 128) * 256; float* S1 = C.out + O_GLAS + ((size_t)(b * 4 + h) * 128) * 256;
    f32x4 st[16];
#pragma unroll
    for (int i = 0; i < 16; ++i) st[i] = __builtin_nontemporal_load((const f32x4*)(S0 + (size_t)(grp * 16 + i) * 256 + e4));
    float fbv = 0.f, bb = 0.f, wcol[16]; bf16_t vsv[4], qv[8], kv[8];
#pragma unroll
    for (int k = 0; k < 4; ++k) { const int i = tid + NTHREADS * k; vsv[k] = VB[(row0 + (i >> 8)) * 1024 + h * 256 + (i & 255)]; }
#pragma unroll
    for (int j = 0; j < 16; ++j) wcol[j] = 0.f;
#pragma unroll
    for (int c = 0; c < 8; ++c) { qv[c] = 0; kv[c] = 0; }
    if (tid < 128) {
        const float* wf2 = C.in[12]; const float* bf2 = C.in[13];
        fbv = FB[row0 * 16 + tid];
#pragma unroll
        for (int j = 0; j < 16; ++j) wcol[j] = wf2[(size_t)j * 512 + h * 128 + tid];
        bb = bf2[h * 128 + tid];
#pragma unroll
        for (int c = 0; c < 8; ++c) { qv[c] = QB[(row0 + c) * 512 + h * 128 + tid]; kv[c] = KB[(row0 + c) * 512 + h * 128 + tid]; }
    }
    LDS_BARRIER();
    if (tid < 128) FBs[tid] = fbv;
#pragma unroll
    for (int k = 0; k < 4; ++k) VS[tid + NTHREADS * k] = bf1(vsv[k]);
    LDS_BARRIER();
    if (tid < 128) {
        const int d = tid;
        float run = 0.f;
#pragma unroll
        for (int c = 0; c < 8; ++c) {
            float z = bb;
#pragma unroll
            for (int j = 0; j < 16; ++j) z += FBs[c * 16 + j] * wcol[j];
            run += logsig16(z);
            const float e = __expf(run);
            QPt[d * 8 + c] = bf1(qv[c]) * e;
            KMt[d * 8 + c] = bf1(kv[c]) / e;
        }
        EBLs[d] = __expf(run);
    }
    LDS_BARRIER();
    if (tid < 64) {
        const int c = tid >> 3, j = tid & 7; float a = 0.f;
        for (int d = 0; d < 128; ++d) a += QPt[d * 8 + c] * KMt[d * 8 + j];
        AM[c * 8 + j] = j <= c ? a : 0.f;
    }
    f32x4 vv[8], oo[8];
#pragma unroll
    for (int c = 0; c < 8; ++c) { vv[c] = *(const LAS f32x4*)(VS + c * 256 + e4); oo[c] = f32x4{0.f, 0.f, 0.f, 0.f}; }
#pragma unroll
    for (int i = 0; i < 16; ++i) {
        const int d = grp * 16 + i;
        const f32x4 s4 = st[i];
        const f32x4 qa = *(const LAS f32x4*)(QPt + d * 8), qb = *(const LAS f32x4*)(QPt + d * 8 + 4);
        const f32x4 ka = *(const LAS f32x4*)(KMt + d * 8), kb = *(const LAS f32x4*)(KMt + d * 8 + 4);
        f32x4 acc = s4;
#pragma unroll
        for (int c = 0; c < 4; ++c) { oo[c] += qa[c] * s4; oo[c + 4] += qb[c] * s4; acc += ka[c] * vv[c]; acc += kb[c] * vv[c + 4]; }
        const float eb = EBLs[d];
        __builtin_nontemporal_store(acc * eb, (f32x4*)(S1 + (size_t)d * 256 + e4));
    }
    {
        LAS float* OSg = (LAS float*)(lds + (grp < 4 ? GS_OS + grp * 8192 : GS_OS2 + (grp - 4) * 8192));
#pragma unroll
        for (int c = 0; c < 8; ++c) *(LAS f32x4*)(OSg + c * 256 + e4) = oo[c];
    }
    LDS_BARRIER();
    {
        const int c = tid >> 6, l = tid & 63;
        float o[4]; float ss = 0.f;
#pragma unroll
        for (int i = 0; i < 4; ++i) {
            const int ee = 4 * l + i; float a = 0.f;
#pragma unroll
            for (int g2 = 0; g2 < 8; ++g2) a += ((const LAS float*)(lds + (g2 < 4 ? GS_OS + g2 * 8192 : GS_OS2 + (g2 - 4) * 8192)))[c * 256 + ee];
#pragma unroll
            for (int j = 0; j < 8; ++j) a += AM[c * 8 + j] * VS[j * 256 + ee];
            o[i] = a; ss += a * a;
        }
        ss = wave_sum(ss);
        const float rinv = rsqrtf(ss * (1.f / 256.f) + EPS);
        const float* gn = C.in[14];
        u32x2 wv;
        const bf16_t* sg = SGB + (row0 + c) * 1024 + h * 256 + 4 * l;
        wv.x = pk2(o[0] * rinv * gn[4 * l] * bf1(sg[0]), o[1] * rinv * gn[4 * l + 1] * bf1(sg[1]));
        wv.y = pk2(o[2] * rinv * gn[4 * l + 2] * bf1(sg[2]), o[3] * rinv * gn[4 * l + 3] * bf1(sg[3]));
        *(u32x2*)(OBN + (row0 + c) * 1536 + h * 256 + 4 * l) = wv;
    }
    LDS_BARRIER();
}

__device__ const unsigned char T5_BUCKET[387] = {0,1,2,3,4,5,6,7,8,9,10,11,12,13,14,15,16,16,16,16,16,16,17,17,17,17,17,17,17,17,18,18,18,18,18,18,18,18,18,18,19,19,19,19,19,19,19,19,19,19,19,19,19,19,20,20,20,20,20,20,20,20,20,20,20,20,20,20,20,20,20,20,20,21,21,21,21,21,21,21,21,21,21,21,21,21,21,21,21,21,21,21,21,21,21,21,21,21,21,22,22,22,22,22,22,22,22,22,22,22,22,22,22,22,22,22,22,22,22,22,22,22,22,22,22,22,22,22,22,0,4,8,12,16,16,17,17,18,18,19,19,19,19,20,20,20,20,20,21,21,21,21,21,21,22,22,22,22,22,22,22,22,22,23,23,23,23,23,23,23,23,23,23,23,23,24,24,24,24,24,24,24,24,24,24,24,24,24,24,24,24,25,25,25,25,25,25,25,25,25,25,25,25,25,25,25,25,25,25,25,25,25,26,26,26,26,26,26,26,26,26,26,26,26,26,26,26,26,26,26,26,26,26,26,26,26,26,26,26,26,26,26,27,27,27,27,27,27,27,27,27,27,27,27,27,27,27,27,0,16,18,19,20,21,21,22,22,23,23,23,24,24,24,24,25,25,25,25,25,26,26,26,26,26,26,26,26,27,27,27,27,27,27,27,27,27,27,28,28,28,28,28,28,28,28,28,28,28,28,28,29,29,29,29,29,29,29,29,29,29,29,29,29,29,29,29,29,29,30,30,30,30,30,30,30,30,30,30,30,30,30,30,30,30,30,30,30,30,30,30,30,30,30,31,31,31,31,31,31,31,31,31,31,31,31,31,31,31,31,31,31,31,31,31,31,31,31,31,31,31,31,31,31,31,31,31,31};

constexpr int AT_V = 0, AT_VP = 272, AT_VW = 32 * AT_VP, AT_BT = 8 * AT_VW, AT_RT = AT_BT + 12 * 129 * 4, AT_END = AT_RT + 12 * 192 * 4;
static_assert(AT_END <= LDS_BYTES, "attn lds");

DI void attn_bias_tables(const Ctx& C, int tid) {
    LAS float* BT = (LAS float*)(C.lds + AT_BT); LAS float* RT = (LAS float*)(C.lds + AT_RT);
    for (int i = tid; i < 12 * 129; i += NTHREADS) { const int hd = i / 129, ds = i % 129; BT[i] = C.in[8][(int)T5_BUCKET[(hd >> 2) * 129 + ds] * 12 + hd] * LOG2E; }
    for (int i = tid; i < 12 * 192; i += NTHREADS) {
        const int hd = i / 192, k = i % 192, dsub = 159 - k;
        RT[i] = (dsub >= 0 && dsub <= 128) ? C.in[8][(int)T5_BUCKET[(hd >> 2) * 129 + dsub] * 12 + hd] * LOG2E : -1e30f;
    }
}

DI void attn_prompt_wave(const Ctx& C, int b, int slot, int g, int res, int m0, int lane) {
    const int r = lane & 31, hh = lane >> 5, dil = 1 << (2 * g), hd = 4 * g + slot;
    unsigned char* ws = C.ws;
    const bf16_t* QA = (const bf16_t*)(ws + WS_QA) + (size_t)hd * MT * 128; const bf16_t* KA = (const bf16_t*)(ws + WS_KA) + (size_t)hd * MT * 128;
    const bf16_t* VA = (const bf16_t*)(ws + WS_VA) + (size_t)hd * MT * 128;
    LAS unsigned char* VL = C.lds + AT_V + C.wave * AT_VW;
    const size_t rowb = (size_t)b * SEQ + (size_t)res * (SEQ >> (2 * g));
    bf16x8 qf[8];
    {
        const bf16_t* qp = QA + (rowb + (size_t)(m0 + r)) * 128 + 8 * hh;
#pragma unroll
        for (int s = 0; s < 8; ++s) qf[s] = *(const bf16x8*)(qp + 16 * s);
    }
    f32x16 P[5];
    u32x4 ka[8], kb[8];
    const size_t lane_off = (size_t)(lane >> 4) * 128 + 8 * (lane & 15);
#define ATT_LOADROWS(dst, base, kt_) do { const int mkb_ = (m0 - 128 + 32 * (kt_)) < 0 ? 0 : (m0 - 128 + 32 * (kt_)); \
        const bf16_t* tp_ = base + (rowb + (size_t)mkb_) * 128 + lane_off; \
        _Pragma("unroll") for (int i = 0; i < 8; ++i) dst[i] = *(const u32x4*)(tp_ + (size_t)i * 512); } while (0)
#define ATT_STAGE(src) do { LDS_WAIT(); asm volatile("" ::: "memory"); \
        _Pragma("unroll") for (int i = 0; i < 8; ++i) *(LAS u32x4*)(VL + (4 * i + (lane >> 4)) * AT_VP + 16 * (lane & 15)) = src[i]; \
        LDS_WAIT(); asm volatile("" ::: "memory"); } while (0)
#define ATT_QK(kt_) do { f32x16 acc_; _Pragma("unroll") for (int j = 0; j < 16; ++j) acc_[j] = 0.f; \
        _Pragma("unroll") for (int s = 0; s < 8; ++s) { const bf16x8 kf_ = *(const LAS bf16x8*)(VL + r * AT_VP + (16 * s + 8 * hh) * 2); acc_ = MFMA32(kf_, qf[s], acc_); } P[kt_] = acc_; } while (0)
    ATT_LOADROWS(ka, KA, 0); ATT_LOADROWS(kb, KA, 1); __builtin_amdgcn_sched_barrier(0);
    ATT_STAGE(ka); ATT_LOADROWS(ka, KA, 2); __builtin_amdgcn_sched_barrier(0); ATT_QK(0); __builtin_amdgcn_sched_barrier(0);
    ATT_STAGE(kb); ATT_LOADROWS(kb, KA, 3); __builtin_amdgcn_sched_barrier(0); ATT_QK(1); __builtin_amdgcn_sched_barrier(0);
    ATT_STAGE(ka); ATT_LOADROWS(ka, KA, 4); __builtin_amdgcn_sched_barrier(0); ATT_QK(2); __builtin_amdgcn_sched_barrier(0);
    ATT_STAGE(kb); __builtin_amdgcn_sched_barrier(0); ATT_QK(3); __builtin_amdgcn_sched_barrier(0);
    ATT_STAGE(ka); __builtin_amdgcn_sched_barrier(0); ATT_QK(4); __builtin_amdgcn_sched_barrier(0);
#undef ATT_QK
    u32x4 vv[8], vw[8];
#define ATT_LOADV(dst, kt_) ATT_LOADROWS(dst, VA, kt_)
    ATT_LOADV(vv, 0); ATT_LOADV(vw, 1);
    __builtin_amdgcn_sched_barrier(0);
    float mx = -1e30f;
    {
        const LAS float* rt = (const LAS float*)(C.lds + AT_RT) + hd * 192 + (31 - r + 4 * hh);
#pragma unroll
        for (int kt = 0; kt < 5; ++kt)
#pragma unroll
            for (int j = 0; j < 16; ++j) { const float sv = P[kt][j] + rt[32 * kt + (j & 3) + 8 * (j >> 2)]; P[kt][j] = sv; }
        if (m0 < 128) {
#pragma unroll
            for (int kt = 0; kt < 5; ++kt)
#pragma unroll
                for (int j = 0; j < 16; ++j) if (m0 - 128 + 32 * kt + crow(j, hh) < 0) P[kt][j] = -1e30f;
        }
#pragma unroll
        for (int kt = 0; kt < 5; ++kt)
#pragma unroll
            for (int j = 0; j < 16; ++j) mx = fmaxf(mx, P[kt][j]);
    }
    mx = fmaxf(mx, __shfl_xor(mx, 32));
    float den = 0.f;
#pragma unroll
    for (int kt = 0; kt < 5; ++kt)
#pragma unroll
        for (int j = 0; j < 16; ++j) { const float p = __builtin_amdgcn_exp2f(P[kt][j] - mx); P[kt][j] = p; den += p; }
    den += __shfl_xor(den, 32);
    f32x16 O[4];
#pragma unroll
    for (int i = 0; i < 4; ++i)
#pragma unroll
        for (int j = 0; j < 16; ++j) O[i][j] = 0.f;
#pragma unroll
    for (int kt = 0; kt < 5; ++kt) {
        __builtin_amdgcn_sched_barrier(0);
        LDS_WAIT(); asm volatile("" ::: "memory");
        if ((kt & 1) == 0) {
#pragma unroll
            for (int i = 0; i < 8; ++i) *(LAS u32x4*)(VL + (4 * i + (lane >> 4)) * AT_VP + 16 * (lane & 15)) = vv[i];
            LDS_WAIT(); asm volatile("" ::: "memory");
            if (kt + 2 < 5) ATT_LOADV(vv, kt + 2);
        } else {
#pragma unroll
            for (int i = 0; i < 8; ++i) *(LAS u32x4*)(VL + (4 * i + (lane >> 4)) * AT_VP + 16 * (lane & 15)) = vw[i];
            LDS_WAIT(); asm volatile("" ::: "memory");
            if (kt + 2 < 5) ATT_LOADV(vw, kt + 2);
        }
        __builtin_amdgcn_sched_barrier(0);
        {
            u32x2 tl[2][4], th[2][4];
            const unsigned va = (unsigned)(size_t)VL + (unsigned)((4 * hh + ((lane & 15) >> 2)) * AT_VP + (16 * ((lane >> 4) & 1) + 4 * (lane & 3)) * 2);
            asm volatile(
                "ds_read_b64_tr_b16 %0, %16\n\tds_read_b64_tr_b16 %1, %16 offset:64\n\tds_read_b64_tr_b16 %2, %16 offset:128\n\tds_read_b64_tr_b16 %3, %16 offset:192\n\t"
                "ds_read_b64_tr_b16 %4, %16 offset:2176\n\tds_read_b64_tr_b16 %5, %16 offset:2240\n\tds_read_b64_tr_b16 %6, %16 offset:2304\n\tds_read_b64_tr_b16 %7, %16 offset:2368\n\t"
                "ds_read_b64_tr_b16 %8, %16 offset:4352\n\tds_read_b64_tr_b16 %9, %16 offset:4416\n\tds_read_b64_tr_b16 %10, %16 offset:4480\n\tds_read_b64_tr_b16 %11, %16 offset:4544\n\t"
                "ds_read_b64_tr_b16 %12, %16 offset:6528\n\tds_read_b64_tr_b16 %13, %16 offset:6592\n\tds_read_b64_tr_b16 %14, %16 offset:6656\n\tds_read_b64_tr_b16 %15, %16 offset:6720\n\t"
                "s_waitcnt lgkmcnt(0)"
                : "=&v"(tl[0][0]), "=&v"(tl[0][1]), "=&v"(tl[0][2]), "=&v"(tl[0][3]), "=&v"(th[0][0]), "=&v"(th[0][1]), "=&v"(th[0][2]), "=&v"(th[0][3]),
                  "=&v"(tl[1][0]), "=&v"(tl[1][1]), "=&v"(tl[1][2]), "=&v"(tl[1][3]), "=&v"(th[1][0]), "=&v"(th[1][1]), "=&v"(th[1][2]), "=&v"(th[1][3])
                : "v"(va) : "memory");
            __builtin_amdgcn_sched_barrier(0);
#pragma unroll
            for (int s = 0; s < 2; ++s) {
                const bf16x8 pb = pack_step(P[kt], s);
#pragma unroll
                for (int dt = 0; dt < 4; ++dt) O[dt] = MFMA32(cat8(tl[s][dt], th[s][dt]), pb, O[dt]);
            }
            __builtin_amdgcn_sched_barrier(0);
        }
    }
#undef ATT_LOADV
#undef ATT_LOADROWS
#undef ATT_STAGE
    const float inv = __builtin_amdgcn_rcpf(den);
    const size_t qrow = rowb + (size_t)(m0 + r);
    bf16_t* op = (bf16_t*)(ws + WS_OAG) + ((size_t)hd * MT + qrow) * 128;
#pragma unroll
    for (int dt = 0; dt < 4; ++dt)
#pragma unroll
        for (int g4 = 0; g4 < 4; g4 += 2) {
            u32x2 wa, wb;
            wa.x = pk2(O[dt][4 * g4] * inv, O[dt][4 * g4 + 1] * inv); wa.y = pk2(O[dt][4 * g4 + 2] * inv, O[dt][4 * g4 + 3] * inv);
            wb.x = pk2(O[dt][4 * g4 + 4] * inv, O[dt][4 * g4 + 5] * inv); wb.y = pk2(O[dt][4 * g4 + 6] * inv, O[dt][4 * g4 + 7] * inv);
            st_rowpair(op, 4 * dt + g4, wa, wb, hh);
        }
    if (hh == 0) ((float*)(ws + WS_LSE))[((size_t)g * MT + qrow) * 4 + slot] = mx + __builtin_amdgcn_logf(den);
}

DI void attn_combine_chunk(unsigned char* ws, size_t row, int slot, int ck) {
    const size_t r0 = row, r1 = (size_t)attn_prow((int)row, 1), r2 = (size_t)attn_prow((int)row, 2);
    const float* lse = (const float*)(ws + WS_LSE) + slot;
    const float l0 = lse[r0 * 4], l1 = lse[((size_t)MT + r1) * 4], l2 = lse[((size_t)2 * MT + r2) * 4];
    const float lm = fmaxf(l0, fmaxf(l1, l2));
    float w0 = __builtin_amdgcn_exp2f(l0 - lm), w1 = __builtin_amdgcn_exp2f(l1 - lm), w2 = __builtin_amdgcn_exp2f(l2 - lm);
    const float ws_ = __builtin_amdgcn_rcpf(w0 + w1 + w2); w0 *= ws_; w1 *= ws_; w2 *= ws_;
    const bf16_t* ob = (const bf16_t*)(ws + WS_OAG) + 8 * ck;
    const u32x4 a = *(const u32x4*)(ob + ((size_t)slot * MT + r0) * 128), bq = *(const u32x4*)(ob + ((size_t)(4 + slot) * MT + r1) * 128), c = *(const u32x4*)(ob + ((size_t)(8 + slot) * MT + r2) * 128);
    u32x4 o;
#pragma unroll
    for (int j = 0; j < 4; ++j) o[j] = pk2(w0 * bflo(a[j]) + w1 * bflo(bq[j]) + w2 * bflo(c[j]), w0 * bfhi(a[j]) + w1 * bfhi(bq[j]) + w2 * bfhi(c[j]));
    *(u32x4*)((bf16_t*)(ws + WS_YAIN) + row * 1536 + slot * 128 + 8 * ck) = o;
}

DI void attn_prompt_item(const Ctx& C, int it) {
    const int bs = it / 96, rem = it % 96, g = rem >> 5, q = rem & 31;
    const int res = g == 0 ? 0 : (g == 1 ? q >> 3 : q >> 1), blk = g == 0 ? q : (g == 1 ? q & 7 : q & 1);
    attn_prompt_wave(C, bs >> 2, bs & 3, g, res, 256 * blk + 32 * C.wave, lane_id_here());
}

DI float half_sum(float v) {
    v += dpp_f<0xB1, 0xf>(v); v += dpp_f<0x4E, 0xf>(v); v += dpp_f<0x141, 0xf>(v); v += dpp_f<0x140, 0xf>(v); v += dpp_f<0x142, 0xa>(v);
    return v;
}
DI void attn_sample_item(const Ctx& C, int b, int slot, int g) {
    const int lane = lane_id_here(), t = C.wave;
    const int hh = lane >> 5, l4 = 4 * (lane & 31);
    unsigned char* ws = C.ws;
    const int dil = 1 << (2 * g), wb = 128 << (2 * g), hd = 4 * g + slot;
    const LAS float* BT = (const LAS float*)(C.lds + AT_BT) + hd * 129;
    const float* cache = C.in[2 + g] + (size_t)b * wb * 1024 + slot * 128 + l4;
    const float* neww = C.out + (g == 0 ? O_W1S : (g == 1 ? O_W2S : O_W3S)) + (size_t)b * 8 * 1024 + slot * 128 + l4;
    const size_t row = (size_t)MP + b * 8 + t;
    const u32x2 qraw = *(const u32x2*)((const bf16_t*)(ws + WS_QA) + ((size_t)hd * MT + row) * 128 + l4);
    const float q0 = bflo(qraw.x), q1 = bfhi(qraw.x), q2 = bflo(qraw.y), q3 = bfhi(qraw.y);
    const f32x4 kt = __builtin_nontemporal_load((const f32x4*)(cache + (size_t)t * 1024));
    const f32x4 vt = __builtin_nontemporal_load((const f32x4*)(cache + (size_t)t * 1024 + 512));
    float m = -1e30f, l = 0.f;
    f32x4 o = {0.f, 0.f, 0.f, 0.f};
#pragma unroll 1
    for (int jb = 0; jb < 128; jb += 32) {
        f32x4 kk[16], vv[16];
#pragma unroll
        for (int u = 0; u < 16; ++u) {
            const int j = jb + 2 * u + hh; const int id = wb + t - j * dil;
            const float* kr = id >= wb ? neww + (size_t)(id - wb) * 1024 : cache + (size_t)id * 1024;
            kk[u] = *(const f32x4*)kr;
            vv[u] = *(const f32x4*)(kr + 512);
        }
        unsigned sbits = __float_as_uint(-1e30f);
#pragma unroll
        for (int u = 0; u < 16; ++u) {
            const float d = half_sum(q0 * kk[u].x + q1 * kk[u].y + q2 * kk[u].z + q3 * kk[u].w);
            const unsigned se = __builtin_amdgcn_readlane(__float_as_uint(d), 31), so = __builtin_amdgcn_readlane(__float_as_uint(d), 63);
            sbits = lane == 2 * u ? se : sbits;
            sbits = lane == 2 * u + 1 ? so : sbits;
        }
        const float sb = lane < 32 ? __uint_as_float(sbits) + BT[jb + (lane & 31)] : -1e30f;
        const float mn = fmaxf(m, wave_max(sb));
        const float alpha = __builtin_amdgcn_exp2f(m - mn);
        const float pb = lane < 32 ? __builtin_amdgcn_exp2f(sb - mn) : 0.f;
        l = l * alpha + wave_sum(pb); m = mn;
        o.x *= alpha; o.y *= alpha; o.z *= alpha; o.w *= alpha;
#pragma unroll
        for (int u = 0; u < 16; ++u) {
            const float pe = __uint_as_float(__builtin_amdgcn_readlane(__float_as_uint(pb), 2 * u));
            const float po = __uint_as_float(__builtin_amdgcn_readlane(__float_as_uint(pb), 2 * u + 1));
            const float p = hh ? po : pe;
            o.x += p * vv[u].x; o.y += p * vv[u].y; o.z += p * vv[u].z; o.w += p * vv[u].w;
        }
    }
    {
        const float d = half_sum(q0 * kt.x + q1 * kt.y + q2 * kt.z + q3 * kt.w);
        const float sT = __uint_as_float(__builtin_amdgcn_readlane(__float_as_uint(d), 31)) + BT[128];
        const float mn = fmaxf(m, sT);
        const float alpha = __builtin_amdgcn_exp2f(m - mn), pT = __builtin_amdgcn_exp2f(sT - mn);
        l = l * alpha + pT; m = mn;
        const float p = hh ? 0.f : pT;
        o.x = o.x * alpha + p * vt.x; o.y = o.y * alpha + p * vt.y; o.z = o.z * alpha + p * vt.z; o.w = o.w * alpha + p * vt.w;
    }
    o.x += __shfl_xor(o.x, 32); o.y += __shfl_xor(o.y, 32); o.z += __shfl_xor(o.z, 32); o.w += __shfl_xor(o.w, 32);
    const float inv = 1.f / l;
    if (lane < 32) { u32x2 w2; w2.x = pk2(o.x * inv, o.y * inv); w2.y = pk2(o.z * inv, o.w * inv); *(u32x2*)((bf16_t*)(ws + WS_OAG) + ((size_t)hd * MT + row) * 128 + l4) = w2; }
    if (lane == 0) ((float*)(ws + WS_LSE))[((size_t)g * MT + row) * 4 + slot] = m + __builtin_amdgcn_logf(l);
}

DI float rs_from4(const float* ssq4, int row) { const f32x4 p = *(const f32x4*)(ssq4 + (size_t)row * 4); return rsqrtf(((p[0] + p[1]) + (p[2] + p[3])) * (1.f / 1024.f) + EPS); }

DI void ld_bf16x8(const bf16_t* p, f32x4& a, f32x4& b) {
    const u32x4 w = *(const u32x4*)p;
    a = (f32x4){bflo(w.x), bfhi(w.x), bflo(w.y), bfhi(w.y)}; b = (f32x4){bflo(w.z), bfhi(w.z), bflo(w.w), bfhi(w.w)};
}
template <int MODE> struct EpiGate {
    static constexpr bool PERM = true, AFTER_DRAIN = false, HAS_MID = false;
    const bf16_t* G; const bf16_t* T; bf16_t* D;
    DI void operator()(const f32x4 (&acc)[2][2][4][2], const pg8::Unit& u, int wr, int wc, int fr, int fq) const {
        const int rbase = u.pm * 256 + wr * 64 + fr, c0 = u.pn * 256 + wc * 32 + 8 * fq;
#pragma unroll
        for (int ai = 0; ai < 2; ++ai)
#pragma unroll
            for (int m = 0; m < 4; ++m) {
                const size_t off = (size_t)(rbase + ai * 128 + m * 16) * 1024 + c0;
#pragma unroll
                for (int bj = 0; bj < 2; ++bj) {
                    f32x4 g0, g1; ld_bf16x8(G + off + bj * 128, g0, g1);
                    f32x4 v0 = acc[ai][bj][m][0] * g0, v1 = acc[ai][bj][m][1] * g1;
                    if (MODE == 1) { f32x4 t0, t1; ld_bf16x8(T + off + bj * 128, t0, t1); v0 += t0; v1 += t1; }
                    st_bf16x8(D + off + bj * 128, v0, v1);
                }
            }
    }
};
struct EpiGate2 {
    static constexpr bool PERM = true, AFTER_DRAIN = false, HAS_MID = true;
    const bf16_t* GA; const bf16_t* GB; bf16_t* D; int mid_t;
    DI void mid(f32x4 (&acc)[2][2][4][2], const pg8::Unit& u, int wr, int wc, int fr_, int fq_) const {
        const int lane = lane_id_here(), fr = lane & 15, fq = lane >> 4;
        const int rbase = u.pm * 256 + wr * 64 + fr, c0 = u.pn * 256 + wc * 32 + 8 * fq;
#pragma unroll
        for (int ai = 0; ai < 2; ++ai) {
            u32x4 ga[4][2], gb[4][2];
#pragma unroll
            for (int m = 0; m < 4; ++m)
#pragma unroll
                for (int bj = 0; bj < 2; ++bj) {
                    const size_t off = (size_t)(rbase + ai * 128 + m * 16) * 1024 + c0 + bj * 128;
                    ga[m][bj] = *(const u32x4*)(GA + off); gb[m][bj] = *(const u32x4*)(GB + off);
                }
            __builtin_amdgcn_sched_barrier(0);
#pragma unroll
            for (int m = 0; m < 4; ++m)
#pragma unroll
                for (int bj = 0; bj < 2; ++bj) {
                    const u32x4 wa = ga[m][bj], wb = gb[m][bj];
                    const f32x4 a0 = (f32x4){bflo(wa.x), bfhi(wa.x), bflo(wa.y), bfhi(wa.y)}, a1 = (f32x4){bflo(wa.z), bfhi(wa.z), bflo(wa.w), bfhi(wa.w)};
                    const f32x4 b0 = (f32x4){bflo(wb.x), bfhi(wb.x), bflo(wb.y), bfhi(wb.y)}, b1 = (f32x4){bflo(wb.z), bfhi(wb.z), bflo(wb.w), bfhi(wb.w)};
#pragma unroll
                    for (int i = 0; i < 4; ++i) { acc[ai][bj][m][0][i] *= a0[i] * __builtin_amdgcn_rcpf(fmaxf(b0[i], 1e-30f)); acc[ai][bj][m][1][i] *= a1[i] * __builtin_amdgcn_rcpf(fmaxf(b1[i], 1e-30f)); }
                }
            __builtin_amdgcn_sched_barrier(0);
        }
    }
    DI void operator()(const f32x4 (&acc)[2][2][4][2], const pg8::Unit& u, int wr, int wc, int fr, int fq) const {
        const int rbase = u.pm * 256 + wr * 64 + fr, c0 = u.pn * 256 + wc * 32 + 8 * fq;
#pragma unroll
        for (int ai = 0; ai < 2; ++ai) {
            u32x4 gw[4][2];
#pragma unroll
            for (int m = 0; m < 4; ++m)
#pragma unroll
                for (int bj = 0; bj < 2; ++bj) gw[m][bj] = *(const u32x4*)(GB + (size_t)(rbase + ai * 128 + m * 16) * 1024 + c0 + bj * 128);
#pragma unroll
            for (int m = 0; m < 4; ++m) {
                const size_t off = (size_t)(rbase + ai * 128 + m * 16) * 1024 + c0;
#pragma unroll
                for (int bj = 0; bj < 2; ++bj) {
                    const u32x4 w = gw[m][bj];
                    const f32x4 b0 = (f32x4){bflo(w.x), bfhi(w.x), bflo(w.y), bfhi(w.y)}, b1 = (f32x4){bflo(w.z), bfhi(w.z), bflo(w.w), bfhi(w.w)};
                    st_bf16x8(D + off + bj * 128, acc[ai][bj][m][0] * b0, acc[ai][bj][m][1] * b1);
                }
            }
        }
    }
};
struct EpiBranch {
    static constexpr bool PERM = true, AFTER_DRAIN = false, HAS_MID = false;
    bf16_t* D; float* ssq;
    DI void operator()(const f32x4 (&acc)[2][2][4][2], const pg8::Unit& u, int wr, int wc, int fr, int fq) const {
        const int rbase = u.pm * 256 + wr * 64 + fr, c0 = u.pn * 256 + wc * 32 + 8 * fq;
#pragma unroll
        for (int ai = 0; ai < 2; ++ai)
#pragma unroll
            for (int m = 0; m < 4; ++m) {
                const int row = rbase + ai * 128 + m * 16; const size_t off = (size_t)row * 1024 + c0;
                float s = 0.f;
#pragma unroll
                for (int bj = 0; bj < 2; ++bj) {
                    const f32x4 v0 = acc[ai][bj][m][0], v1 = acc[ai][bj][m][1];
                    s += (v0[0] * v0[0] + v0[1] * v0[1]) + (v0[2] * v0[2] + v0[3] * v0[3]) + (v1[0] * v1[0] + v1[1] * v1[1]) + (v1[2] * v1[2] + v1[3] * v1[3]);
                    st_bf16x8(D + off + bj * 128, v0, v1);
                }
                s += __shfl_xor(s, 16); s += __shfl_xor(s, 32);
                if (fq == 0) ssq[(size_t)row * 16 + 4 * u.pn + wc] = s;
            }
    }
};
struct EpiRowScale {
    static constexpr bool PERM = true, AFTER_DRAIN = false, HAS_MID = false;
    const float* rs; bf16_t* D; float scale;
    DI void operator()(const f32x4 (&acc)[2][2][4][2], const pg8::Unit& u, int wr, int wc, int fr, int fq) const {
        const int rbase = u.pm * 256 + wr * 64 + fr, c0 = u.pn * 256 + wc * 32 + 8 * fq;
        float rsv[2][4];
#pragma unroll
        for (int ai = 0; ai < 2; ++ai)
#pragma unroll
            for (int m = 0; m < 4; ++m) rsv[ai][m] = rs[rbase + ai * 128 + m * 16];
#pragma unroll
        for (int ai = 0; ai < 2; ++ai)
#pragma unroll
            for (int m = 0; m < 4; ++m) {
                const int row = rbase + ai * 128 + m * 16; const float r = rsv[ai][m] * scale; const size_t off = (size_t)row * 1024 + c0;
#pragma unroll
                for (int bj = 0; bj < 2; ++bj) st_bf16x8(D + off + bj * 128, acc[ai][bj][m][0] * r, acc[ai][bj][m][1] * r);
            }
    }
};
struct EpiGateUp {
    static constexpr bool PERM = true, AFTER_DRAIN = false, HAS_MID = false;
    const float* rs; bf16_t* H;
    DI void operator()(const f32x4 (&acc)[2][2][4][2], const pg8::Unit& u, int wr, int wc, int fr, int fq) const {
        const int rbase = u.pm * 256 + wr * 64 + fr, c0 = u.pn * 128 + wc * 32 + 8 * fq;
        float rsv[2][4];
#pragma unroll
        for (int ai = 0; ai < 2; ++ai)
#pragma unroll
            for (int m = 0; m < 4; ++m) rsv[ai][m] = rs[rbase + ai * 128 + m * 16];
#pragma unroll
        for (int ai = 0; ai < 2; ++ai)
#pragma unroll
            for (int m = 0; m < 4; ++m) {
                const int row = rbase + ai * 128 + m * 16; const float r = rsv[ai][m];
                f32x4 g0 = acc[ai][0][m][0] * r, g1 = acc[ai][0][m][1] * r; const f32x4 u0 = acc[ai][1][m][0] * r, u1 = acc[ai][1][m][1] * r;
#pragma unroll
                for (int i = 0; i < 4; ++i) { g0[i] = g0[i] * fsigmoid(g0[i]) * u0[i]; g1[i] = g1[i] * fsigmoid(g1[i]) * u1[i]; }
                st_bf16x8(H + (size_t)row * DFF + c0, g0, g1);
            }
    }
};

template <bool FIRST, bool LAST> DI void resid_pass(const Ctx& C, const float* gain) {
    const int lane = lane_id_here(); const int gw = C.bid * 8 + C.wave, NGW = C.G * 8;
    unsigned char* ws = C.ws;
    const bf16_t* BR = (const bf16_t*)(ws + WS_MIX); const float* SSQ = (const float*)(ws + WS_SSQ);
    bf16_t* XB = (bf16_t*)(ws + WS_XB); float* RS = (float*)(ws + WS_RS);
    f32x4 gv[4];
#pragma unroll
    for (int j = 0; j < 4; ++j) gv[j] = ((const f32x4*)gain)[lane + 64 * j];
    u32x2 bw[4]; f32x4 xv[4]; u32x2 xbv[4]; float sq = 0.f;
#define RESID_LOAD(m_) do { const int mm_ = (m_); \
        sq = mm_ < MP ? (lane < 16 ? SSQ[(size_t)mm_ * 16 + lane] : 0.f) : (lane < 32 ? ((const float*)(ws + WS_SSQ + 2560 * 1024))[(size_t)(mm_ - MP) * 32 + lane] : 0.f); \
        _Pragma("unroll") for (int j = 0; j < 4; ++j) { bw[j] = ((const u32x2*)(BR + (size_t)mm_ * 1024))[lane + 64 * j]; \
            if (FIRST) { const float* xo_ = mm_ < MP ? C.in[0] + (size_t)mm_ * 1024 : C.in[1] + (size_t)(mm_ - MP) * 1024; xv[j] = __builtin_nontemporal_load((const f32x4*)xo_ + lane + 64 * j); } \
            else xbv[j] = ((const u32x2*)(XB + (size_t)mm_ * 1024))[lane + 64 * j]; } } while (0)
    if (gw < MT) RESID_LOAD(gw);
    for (int m = gw; m < MT; m += NGW) {
        u32x2 cb[4]; f32x4 cx[4]; const float csq = sq;
#pragma unroll
        for (int j = 0; j < 4; ++j) { cb[j] = bw[j]; cx[j] = FIRST ? xv[j] : (f32x4){bflo(xbv[j].x), bfhi(xbv[j].x), bflo(xbv[j].y), bfhi(xbv[j].y)}; }
        if (m + NGW < MT) RESID_LOAD(m + NGW);
        const float rb = rsqrtf(wave_sum(csq) * (1.f / 1024.f) + EPS);
        f32x4 v[4]; float s = 0.f;
#pragma unroll
        for (int j = 0; j < 4; ++j) {
            const f32x4 bv = (f32x4){bflo(cb[j].x), bfhi(cb[j].x), bflo(cb[j].y), bfhi(cb[j].y)};
            v[j] = cx[j] + bv * rb * gv[j];
            s += (v[j].x * v[j].x + v[j].y * v[j].y) + (v[j].z * v[j].z + v[j].w * v[j].w);
        }
        if (LAST) {
#pragma unroll
            for (int j = 0; j < 4; ++j) __builtin_nontemporal_store(v[j], (f32x4*)(C.out + (size_t)m * 1024) + lane + 64 * j);
        } else {
            s = wave_sum(s);
#pragma unroll
            for (int j = 0; j < 4; ++j) { u32x2 w; w.x = pk2(v[j].x, v[j].y); w.y = pk2(v[j].z, v[j].w); ((u32x2*)(XB + (size_t)m * 1024))[lane + 64 * j] = w; }
            if (lane == 0) RS[m] = rsqrtf(s * (1.f / 1024.f) + EPS);
        }
    }
#undef RESID_LOAD
}

constexpr int XA_PITCH = 528, XA_BUF = 128 * XA_PITCH;
#ifndef XREP_S
#define XREP_S 1
#endif
#ifndef XREP_PV
#define XREP_PV 1
#endif
static_assert(2 * XA_BUF <= LDS_BYTES - 64, "xattn lds");
DI void xattn_prompt_item(const Ctx& C, int item) {
    const int lane = lane_id_here(), w = C.wave, tid = w * 64 + lane, r = lane & 31, hh = lane >> 5;
    const int bh = item >> 5, tb = item & 31, b = bh >> 2, h = bh & 3;
    unsigned char* ws = C.ws; LAS unsigned char* lds = C.lds;
    const size_t row0 = (size_t)b * SEQ + (size_t)tb * 256 + 32 * w;
    const bf16_t* Kg = (const bf16_t*)(ws + WS_MK) + (size_t)b * 256 * 1024 + h * 256;
    const bf16_t* Vg = (const bf16_t*)(ws + WS_MVT) + ((size_t)b * 1024 + h * 256) * 256;
    u32x4 st[16];
    const bf16_t* kld = Kg + (size_t)(tid >> 5) * 1024 + 8 * (tid & 31);
    const bf16_t* vld = Vg + (size_t)(tid >> 5) * 256 + 8 * (tid & 31);
    LAS unsigned char* wst = lds + (tid >> 5) * XA_PITCH + 16 * (tid & 31);
#define XA_WRITE_ALL() do { _Pragma("unroll") for (int i = 0; i < 16; ++i) *(LAS u32x4*)(wst + (i >> 3) * XA_BUF + 16 * (i & 7) * XA_PITCH) = st[i]; } while (0)
#pragma unroll
    for (int i = 0; i < 16; ++i) st[i] = *(const u32x4*)(kld + (size_t)(16 * i) * 1024);
    bf16x8 qf[16];
    {
        const bf16_t* Q = (const bf16_t*)(ws + WS_Q2) + (row0 + r) * 1024 + h * 256 + 8 * hh;
#pragma unroll
        for (int s = 0; s < 16; ++s) qf[s] = *(const bf16x8*)(Q + 16 * s);
    }
    LDS_BARRIER();
    XA_WRITE_ALL();
    LDS_BARRIER();
    f32x16 P[8];
#pragma unroll
    for (int kh = 0; kh < 2; ++kh) {
        f32x16 acc[4];
#pragma unroll
        for (int kt = 0; kt < 4; ++kt)
#pragma unroll
            for (int j = 0; j < 16; ++j) acc[kt][j] = 0.f;
        const LAS unsigned char* kb_ = lds + kh * XA_BUF + r * XA_PITCH + 16 * hh;
        bf16x8 fa[4], fb[4];
#pragma unroll
        for (int kt = 0; kt < 4; ++kt) fa[kt] = *(const LAS bf16x8*)(kb_ + 32 * kt * XA_PITCH);
#pragma unroll
        for (int s = 0; s < 16; s += 2) {
#pragma unroll
            for (int kt = 0; kt < 4; ++kt) fb[kt] = *(const LAS bf16x8*)(kb_ + 32 * kt * XA_PITCH + 32 * (s + 1));
#pragma unroll
            for (int kt = 0; kt < 4; ++kt) acc[kt] = MFMA32(fa[kt], qf[s], acc[kt]);
            if (s + 2 < 16) {
#pragma unroll
                for (int kt = 0; kt < 4; ++kt) fa[kt] = *(const LAS bf16x8*)(kb_ + 32 * kt * XA_PITCH + 32 * (s + 2));
            }
#pragma unroll
            for (int kt = 0; kt < 4; ++kt) acc[kt] = MFMA32(fb[kt], qf[s + 1], acc[kt]);
        }
#pragma unroll
        for (int kt = 0; kt < 4; ++kt) P[4 * kh + kt] = acc[kt];
    }
    float mx = -1e30f;
#pragma unroll
    for (int kt = 0; kt < 8; ++kt)
#pragma unroll
        for (int j = 0; j < 16; ++j) mx = fmaxf(mx, P[kt][j]);
    mx = fmaxf(mx, __shfl_xor(mx, 32));
    float den = 0.f;
    bf16x8 pb[8][2];
#pragma unroll
    for (int kt = 0; kt < 8; ++kt) {
#pragma unroll
        for (int j = 0; j < 16; ++j) { const float p = __builtin_amdgcn_exp2f(P[kt][j] - mx); P[kt][j] = p; den += p; }
        pb[kt][0] = pack_step(P[kt], 0); pb[kt][1] = pack_step(P[kt], 1);
    }
    den += __shfl_xor(den, 32);
    const float inv = __builtin_amdgcn_rcpf(den);
    bf16_t* op = (bf16_t*)(ws + WS_O2) + (row0 + r) * 1024 + h * 256;
#pragma unroll
    for (int i = 0; i < 16; ++i) st[i] = *(const u32x4*)(vld + (size_t)(16 * i) * 256);
    LDS_BARRIER();
    XA_WRITE_ALL();
    LDS_BARRIER();
#pragma unroll
    for (int dh = 0; dh < 2; ++dh) {
        f32x16 O[4];
#pragma unroll
        for (int i = 0; i < 4; ++i)
#pragma unroll
            for (int j = 0; j < 16; ++j) O[i][j] = 0.f;
        {
            const LAS unsigned char* vb_ = lds + dh * XA_BUF + r * XA_PITCH + 8 * hh;
            u32x2 va[4][2], vb2[4][2];
#define XA_VREAD(dst, st_) do { _Pragma("unroll") for (int dt = 0; dt < 4; ++dt) { const LAS unsigned char* p_ = vb_ + 32 * dt * XA_PITCH + 32 * (st_); \
                dst[dt][0] = *(const LAS u32x2*)p_; dst[dt][1] = *(const LAS u32x2*)(p_ + 16); } } while (0)
            XA_VREAD(va, 0);
#pragma unroll
            for (int st2 = 0; st2 < 16; st2 += 2) {
                XA_VREAD(vb2, st2 + 1);
#pragma unroll
                for (int dt = 0; dt < 4; ++dt) O[dt] = MFMA32(cat8(va[dt][0], va[dt][1]), pb[st2 >> 1][0], O[dt]);
                if (st2 + 2 < 16) XA_VREAD(va, st2 + 2);
#pragma unroll
                for (int dt = 0; dt < 4; ++dt) O[dt] = MFMA32(cat8(vb2[dt][0], vb2[dt][1]), pb[st2 >> 1][1], O[dt]);
            }
#undef XA_VREAD
        }
#pragma unroll
        for (int dt = 0; dt < 4; ++dt)
#pragma unroll
            for (int g4 = 0; g4 < 4; g4 += 2) {
                u32x2 wa, wb;
                wa.x = pk2(O[dt][4 * g4] * inv, O[dt][4 * g4 + 1] * inv); wa.y = pk2(O[dt][4 * g4 + 2] * inv, O[dt][4 * g4 + 3] * inv);
                wb.x = pk2(O[dt][4 * g4 + 4] * inv, O[dt][4 * g4 + 5] * inv); wb.y = pk2(O[dt][4 * g4 + 6] * inv, O[dt][4 * g4 + 7] * inv);
                st_rowpair(op + 128 * dh, 4 * dt + g4, wa, wb, hh);
            }
    }
#undef XA_WRITE_ALL
}
constexpr int XS_Q = 0, XS_SC = 4096, XS_PART = 8192, XS_END = 8192 + 32768;
DI void xattn_sample_item(const Ctx& C, int b, int h, int th) {
    const int lane = lane_id_here(), w = C.wave, tid = w * 64 + lane;
    unsigned char* ws = C.ws;
    LAS float* QS = (LAS float*)(C.lds + XS_Q); LAS float* SC = (LAS float*)(C.lds + XS_SC); LAS float* PART = (LAS float*)(C.lds + XS_PART);
    const float* cache = C.in[6] + (size_t)b * 256 * 2048 + h * 256;
    const size_t row0 = (size_t)MP + b * 8 + 4 * th;
    bf16_t qsv[2];
#pragma unroll
    for (int k = 0; k < 2; ++k) { const int i = tid + NTHREADS * k; qsv[k] = ((const bf16_t*)(ws + WS_Q2))[(row0 + (i >> 8)) * 1024 + h * 256 + (i & 255)]; }
    LDS_BARRIER();
#pragma unroll
    for (int k = 0; k < 2; ++k) QS[tid + NTHREADS * k] = bf1(qsv[k]);
    LDS_BARRIER();
    {
        f32x4 q[4];
#pragma unroll
        for (int t = 0; t < 4; ++t) q[t] = *(const LAS f32x4*)(QS + t * 256 + 4 * lane);
        for (int mb = 0; mb < 32; mb += 16) {
            f32x4 kk[16];
#pragma unroll
            for (int u = 0; u < 16; ++u) kk[u] = __builtin_nontemporal_load((const f32x4*)(cache + (size_t)(32 * w + mb + u) * 2048 + 4 * lane));
#pragma unroll
            for (int u = 0; u < 16; ++u) {
#pragma unroll
                for (int t = 0; t < 4; ++t) {
                    const float s = wave_sum(q[t].x * kk[u].x + q[t].y * kk[u].y + q[t].z * kk[u].z + q[t].w * kk[u].w);
                    if (lane == 0) SC[t * 256 + 32 * w + mb + u] = s;
                }
            }
        }
    }
    LDS_BARRIER();
    if (w < 4) {
        float v[4]; float mx = -1e30f;
#pragma unroll
        for (int i = 0; i < 4; ++i) { v[i] = SC[w * 256 + lane + 64 * i]; mx = fmaxf(mx, v[i]); }
        mx = wave_max(mx);
        float den = 0.f;
#pragma unroll
        for (int i = 0; i < 4; ++i) { v[i] = __builtin_amdgcn_exp2f(v[i] - mx); den += v[i]; }
        den = wave_sum(den);
        const float inv = 1.f / den;
#pragma unroll
        for (int i = 0; i < 4; ++i) SC[w * 256 + lane + 64 * i] = v[i] * inv;
    }
    LDS_BARRIER();
    {
        f32x4 o[4];
#pragma unroll
        for (int t = 0; t < 4; ++t) o[t] = f32x4{0.f, 0.f, 0.f, 0.f};
        for (int mb = 0; mb < 32; mb += 16) {
            f32x4 vv[16];
#pragma unroll
            for (int u = 0; u < 16; ++u) vv[u] = __builtin_nontemporal_load((const f32x4*)(cache + (size_t)(32 * w + mb + u) * 2048 + 1024 + 4 * lane));
#pragma unroll
            for (int u4 = 0; u4 < 4; ++u4) {
#pragma unroll
                for (int t = 0; t < 4; ++t) {
                    const f32x4 pv = *(const LAS f32x4*)(SC + t * 256 + 32 * w + mb + 4 * u4);
#pragma unroll
                    for (int i = 0; i < 4; ++i) o[t] += pv[i] * vv[4 * u4 + i];
                }
            }
        }
#pragma unroll
        for (int t = 0; t < 4; ++t) *(LAS f32x4*)(PART + (w * 4 + t) * 256 + 4 * lane) = o[t];
    }
    LDS_BARRIER();
    {
        const int t = tid >> 7, d2 = 2 * (tid & 127);
        float a0 = 0.f, a1 = 0.f;
#pragma unroll
        for (int g = 0; g < 8; ++g) { const f32x2 pp = *(const LAS f32x2*)(PART + (g * 4 + t) * 256 + d2); a0 += pp.x; a1 += pp.y; }
        *(unsigned*)((bf16_t*)(ws + WS_O2) + (row0 + t) * 1024 + h * 256 + d2) = pk2(a0, a1);
    }
    LDS_BARRIER();
}

template <int NACC, class F> DI void sgemm_unit(const Ctx& C, const bf16_t* __restrict__ A, const bf16_t* __restrict__ B0, const bf16_t* __restrict__ B1, int K, int tm, const F& fin, int lda = 0, int ldb = 0) {
    if (lda == 0) lda = K;
    if (ldb == 0) ldb = K;
    const int lane = lane_id_here(), w = C.wave, r = lane & 31, hh = lane >> 5;
    LAS float* PT = (LAS float*)C.lds;
    f32x16 acc[NACC];
#pragma unroll
    for (int i = 0; i < NACC; ++i)
#pragma unroll
        for (int j = 0; j < 16; ++j) acc[i][j] = 0.f;
    const int ksl = K / 8;
    const bf16_t* ap = A + (size_t)(32 * tm + r) * lda + w * ksl + 8 * hh;
    const bf16_t* bp0 = B0 + (size_t)r * ldb + w * ksl + 8 * hh;
    const bf16_t* bp1 = B1 + (size_t)r * ldb + w * ksl + 8 * hh;
#pragma unroll 4
    for (int k = 0; k < ksl; k += 16) {
        const bf16x8 a = *(const bf16x8*)(ap + k);
        acc[0] = MFMA32(a, *(const bf16x8*)(bp0 + k), acc[0]);
        if (NACC == 2) acc[1] = MFMA32(a, *(const bf16x8*)(bp1 + k), acc[1]);
    }
    LDS_BARRIER();
#pragma unroll
    for (int i = 0; i < NACC; ++i)
#pragma unroll
        for (int j = 0; j < 16; ++j) PT[((i * 8 + w) * 32 + crow(j, hh)) * 33 + r] = acc[i][j];
    LDS_BARRIER();
    const int tid = w * 64 + lane, row = tid >> 4, c2 = 2 * (tid & 15);
    float v[NACC][2];
#pragma unroll
    for (int i = 0; i < NACC; ++i) {
        float s0 = 0.f, s1 = 0.f;
#pragma unroll
        for (int ww = 0; ww < 8; ++ww) { s0 += PT[((i * 8 + ww) * 32 + row) * 33 + c2]; s1 += PT[((i * 8 + ww) * 32 + row) * 33 + c2 + 1]; }
        v[i][0] = s0; v[i][1] = s1;
    }
    fin(32 * tm + row, c2, v);
}

constexpr size_t WS_SSQS = WS_SSQ + 2560 * 1024;
static_assert(WS_SSQ + (size_t)MT * 16 * 4 <= WS_SSQS && WS_SSQS + 256 * 32 * 4 <= WS_FB, "ssqs map");
DI void sgemm_branch(const Ctx& C, const bf16_t* A, const bf16_t* Bt, int K, int tm, int tn) {
    unsigned char* ws = C.ws; bf16_t* MIX = (bf16_t*)(ws + WS_MIX); float* SSQS = (float*)(ws + WS_SSQS);
    sgemm_unit<1>(C, A, Bt + (size_t)32 * tn * K, nullptr, K, tm,
        [&](int row, int c2, const float (&v)[1][2]) {
            *(unsigned*)(MIX + ((size_t)MP + row) * 1024 + 32 * tn + c2) = pk2(v[0][0], v[0][1]);
            float s = v[0][0] * v[0][0] + v[0][1] * v[0][1];
            s += __shfl_xor(s, 1); s += __shfl_xor(s, 2); s += __shfl_xor(s, 4); s += __shfl_xor(s, 8);
            if ((c2 >> 1) == 0) SSQS[row * 32 + tn] = s; });
}

#ifndef MK_N_LAUNCHES
#define MK_N_LAUNCHES 1
#endif
constexpr int N_PHASES = 16;
#define REP_A 1
#define STAGGER_US 0
#define REP_X 1
#define REP_XS 1
#define EXTRA_BARS 0
#define PROBE_NULLGEMM 0
#define REP_B 1
#define REP_C 1
#define REP_PA 1
#ifndef REP_MASK
#define REP_MASK 0
#endif
#define NREP(k) (((REP_MASK) >> (k)) & 1 ? 2 : 1)

__global__ void __launch_bounds__(NTHREADS, 2) fwd_megakernel(Args args) {
    extern __shared__ __attribute__((aligned(16))) unsigned char lds_raw[];
    cg::grid_group grid = cg::this_grid();
    Ctx C;
    C.in = args.in; C.out = args.out; C.ws = args.ws;
    C.lds = (LAS unsigned char*)lds_raw;
    C.wave = __builtin_amdgcn_readfirstlane(threadIdx.x >> 6);
    C.G = gridDim.x; C.bid = blockIdx.x;
    const int lo = args.ph_lo, hi = args.ph_hi;
    unsigned char* ws = args.ws;
#define IN(k) (lo <= (k) && (k) < hi)
    volatile LAS unsigned* MISC = (volatile LAS unsigned*)(C.lds + LDS_BYTES - 64);
    const bool leader = (C.wave == 0) && (lane_id() == 0);
    if (leader) { MISC[0] = 0u; MISC[1] = 0u; }
    __syncthreads();
    XcdBarrier xbar = xcd_barrier_post((unsigned*)(ws + WS_CTL), MISC, leader);
#define SEAM(k) do { if (IN(k) && IN((k) + 1)) { if ((k) == 0 && lo < 0) grid.sync(); else xcd_barrier(xbar, (C.wave == 0) && (lane_id() == 0)); } } while (0)

    if (IN(0)) for (int rep_ = 0; rep_ < NREP(0); ++rep_) { p0_prologue(C); }
    SEAM(0);
    if (IN(1)) for (int rep_ = 0; rep_ < NREP(1); ++rep_) {
        {
            if (STAGGER_US > 0 && ((C.bid >> 3) & 1)) { const unsigned long long t0 = __builtin_amdgcn_s_memrealtime(); while (__builtin_amdgcn_s_memrealtime() - t0 < (unsigned long long)(STAGGER_US * 100)) __builtin_amdgcn_s_sleep(32); }
            pg8::Gemm g{(const bf16_t*)(ws + WS_XB), (const bf16_t*)(ws + WS_WIN), MT, NIN, 1024};
            pg8::StaticOrder S; S.init(MT, NIN, C.G, C.bid);
            EpiIn E{(const float*)(ws + WS_RS), ws, args.out};
            pg8::gemm_phase<EpiIn, pg8::StaticOrder, true, true>(C.lds, g, S, E, C.wave);
        }
        {
            pg8::Gemm g{(const bf16_t*)(ws + WS_MEMB), (const bf16_t*)(ws + WS_WMKV), 1024, 2048, 1024};
            pg8::StaticOrder S; S.init(1024, 2048, C.G, C.G - 1 - C.bid);
            EpiMemKV E{(const float*)(ws + WS_RSMEM), ws, args.out};
            pg8::gemm_phase<EpiMemKV, pg8::StaticOrder, true, true>(C.lds, g, S, E, C.wave);
        }
    }
#if PROBE_NULLGEMM
    {
        pg8::Gemm g{(const bf16_t*)(ws + WS_XB), (const bf16_t*)(ws + WS_WIN), MT, NIN, 1024};
        pg8::StaticOrder S; S.init(MT, NIN, C.G, C.bid);
        EpiNull E{(float*)(ws + WS_SSQ)};
        pg8::gemm_phase<EpiNull, pg8::StaticOrder, true, true>(C.lds, g, S, E, C.wave);
    }
#endif
    SEAM(1);
#if EXTRA_BARS
    for (int q_ = 0; q_ < EXTRA_BARS; ++q_) xcd_barrier(xbar, (C.wave == 0) && (lane_id() == 0));
#endif
    if (IN(2)) for (int rep_ = 0; rep_ < NREP(2); ++rep_) {
        LDS_BARRIER();
        attn_bias_tables(C, C.wave * 64 + lane_id_here());
        LDS_BARRIER();
        const bool rev = ((C.bid >> 3) & 1) != 0;
        for (int ord = 0; ord < 4; ++ord) {
            const int kind = rev ? 3 - ord : ord;
            if (kind == 0) {
                const bool split57 = C.G == 256;
                const int per = (1536 + C.G - 1) / C.G;
                const int i0 = split57 ? (C.bid < 128 ? C.bid * 5 : 640 + (C.bid - 128) * 7) : C.bid * per;
                const int i1e = split57 ? i0 + (C.bid < 128 ? 5 : 7) : i0 + per, i1 = i1e < 1536 ? i1e : 1536;
                for (int q_ = 0; q_ < REP_A; ++q_) for (int it = i0; it < i1; ++it) attn_prompt_item(C, it);
            } else if (kind == 1) {
                for (int q_ = 0; q_ < REP_B; ++q_) for (int it = C.bid; it < 384; it += C.G) attn_sample_item(C, it / 12, (it % 12) & 3, (it % 12) >> 2);
            } else if (kind == 2) {
                for (int it = C.G - 1 - C.bid; it < 128; it += C.G) { for (int q_ = 0; q_ < REP_C; ++q_) gla_sample_item(C, it >> 2, it & 3); }
            } else {
                LDS_BARRIER();
                for (int q_ = 0; q_ < REP_PA; ++q_) for (int u = C.bid; u < NUNIT; u += C.G) gla_pass_a_unit(C, u);
                LDS_BARRIER();
                attn_bias_tables(C, C.wave * 64 + lane_id_here());
                LDS_BARRIER();
            }
        }
    }
    SEAM(2);
    if (IN(3)) for (int rep_ = 0; rep_ < NREP(3); ++rep_) {
        gla_pass_b(C);
        const int gid = C.bid * NTHREADS + C.wave * 64 + lane_id_here();
        for (int id = gid; id < MT * 64; id += C.G * NTHREADS) attn_combine_chunk(ws, (size_t)(id >> 6), (id >> 4) & 3, id & 15);
    }
    SEAM(3);
    if (IN(4)) for (int rep_ = 0; rep_ < NREP(4); ++rep_) { gla_pass_c(C); }
    if (IN(5)) { }
    SEAM(5);
    if (IN(6)) for (int rep_ = 0; rep_ < NREP(6); ++rep_) {
        for (int u = C.bid; u < 256; u += C.G) {
            const int tm = u >> 5, tn = u & 31;
            const bf16_t* SGA = (const bf16_t*)(ws + WS_SGA); const bf16_t* SGBT = (const bf16_t*)(ws + WS_SGBT);
            bf16_t* TMP = (bf16_t*)(ws + WS_TMP); bf16_t* MIXIN = (bf16_t*)(ws + WS_MIXIN);
            sgemm_unit<1>(C, (const bf16_t*)(ws + WS_YAIN) + (size_t)MP * 1536, (const bf16_t*)(ws + WS_WPA) + (size_t)32 * tn * 1536, nullptr, 512, tm,
                [&](int row, int c2, const float (&v)[1][2]) { const size_t o = ((size_t)MP + row) * 1024 + 32 * tn + c2; const unsigned g = *(const unsigned*)(SGA + o);
                    *(unsigned*)(TMP + o) = pk2(bflo(g) * v[0][0], bfhi(g) * v[0][1]); }, 1536, 1536);
            sgemm_unit<1>(C, (const bf16_t*)(ws + WS_YAIN) + (size_t)MP * 1536 + 512, (const bf16_t*)(ws + WS_WPA) + (size_t)32 * tn * 1536 + 512, nullptr, 1024, tm,
                [&](int row, int c2, const float (&v)[1][2]) { const size_t o = ((size_t)MP + row) * 1024 + 32 * tn + c2; const unsigned g = *(const unsigned*)(SGBT + o), t = *(const unsigned*)(TMP + o);
                    *(unsigned*)(MIXIN + o) = pk2(bflo(t) + bflo(g) * v[0][0], bfhi(t) + bfhi(g) * v[0][1]); }, 1536, 1536);
        }
        LDS_BARRIER();
        {
            pg8::Gemm g{(const bf16_t*)(ws + WS_YAIN), (const bf16_t*)(ws + WS_WPA), MP, 1024, 1536};
            pg8::StaticOrder S; S.init(MP, 1024, C.G, C.bid);
            EpiGate2 E{(const bf16_t*)(ws + WS_SGA), (const bf16_t*)(ws + WS_SGBT), (bf16_t*)(ws + WS_MIXIN), 8};
            pg8::gemm_phase<EpiGate2, pg8::StaticOrder, true, true>(C.lds, g, S, E, C.wave);
        }
    }
    SEAM(6);
    if (IN(7)) for (int rep_ = 0; rep_ < NREP(7); ++rep_) {
        for (int u = C.bid; u < 256; u += C.G) sgemm_branch(C, (const bf16_t*)(ws + WS_MIXIN) + (size_t)MP * 1024, (const bf16_t*)(ws + WS_WOUT), 1024, u >> 5, u & 31);
        LDS_BARRIER();
        pg8::Gemm g{(const bf16_t*)(ws + WS_MIXIN), (const bf16_t*)(ws + WS_WOUT), MP, 1024, 1024};
        pg8::StaticOrder S; S.init(MP, 1024, C.G, C.bid);
        EpiBranch E{(bf16_t*)(ws + WS_MIX), (float*)(ws + WS_SSQ)};
        pg8::gemm_phase<EpiBranch, pg8::StaticOrder, true, true>(C.lds, g, S, E, C.wave);
    }
    SEAM(7);
    if (IN(8)) for (int rep_ = 0; rep_ < NREP(8); ++rep_) resid_pass<true, false>(C, args.in[10]);
    SEAM(8);
    if (IN(9)) for (int rep_ = 0; rep_ < NREP(9); ++rep_) {
        for (int u = C.bid; u < 256; u += C.G) {
            const int tm = u >> 5, tn = u & 31; const float* RS = (const float*)(ws + WS_RS); bf16_t* Q2 = (bf16_t*)(ws + WS_Q2);
            sgemm_unit<1>(C, (const bf16_t*)(ws + WS_XB) + (size_t)MP * 1024, (const bf16_t*)(ws + WS_WMQ) + (size_t)32 * tn * 1024, nullptr, 1024, tm,
                [&](int row, int c2, const float (&v)[1][2]) { const float r = RS[MP + row] * Q2_SCALE; *(unsigned*)(Q2 + ((size_t)MP + row) * 1024 + 32 * tn + c2) = pk2(v[0][0] * r, v[0][1] * r); });
        }
        LDS_BARRIER();
        pg8::Gemm g{(const bf16_t*)(ws + WS_XB), (const bf16_t*)(ws + WS_WMQ), MP, 1024, 1024};
        pg8::StaticOrder S; S.init(MP, 1024, C.G, C.bid);
        EpiRowScale E{(const float*)(ws + WS_RS), (bf16_t*)(ws + WS_Q2), Q2_SCALE};
        pg8::gemm_phase<EpiRowScale, pg8::StaticOrder, true, true>(C.lds, g, S, E, C.wave);
    }
    SEAM(9);
    if (IN(10)) for (int rep_ = 0; rep_ < NREP(10); ++rep_) {
        const bool rev10 = ((C.bid >> 3) & 1) != 0;
        const bool xs = C.G == 256;
#define XS_IT(i) (xs ? 2 * (((i) & 7) * 16 + (((i) >> 3) & 15)) + ((i) >> 7) : (i))
#define XP_IT(i) (xs ? ((((i) & 7) + 8 * ((i) >> 8)) << 5) | (((i) >> 3) & 31) : (i))
        if (!rev10) { for (int q_ = 0; q_ < REP_XS; ++q_) for (int i = C.bid; i < 256; i += C.G) { const int it = XS_IT(i); xattn_sample_item(C, it >> 3, (it >> 1) & 3, it & 1); } }
        for (int q_ = 0; q_ < REP_X; ++q_) for (int i = C.bid; i < 512; i += C.G) xattn_prompt_item(C, XP_IT(i));
        if (rev10) { for (int q_ = 0; q_ < REP_XS; ++q_) for (int i = C.bid; i < 256; i += C.G) { const int it = XS_IT(i); xattn_sample_item(C, it >> 3, (it >> 1) & 3, it & 1); } }
#undef XS_IT
#undef XP_IT
    }
    SEAM(10);
    if (IN(11)) for (int rep_ = 0; rep_ < NREP(11); ++rep_) {
        for (int u = C.bid; u < 256; u += C.G) sgemm_branch(C, (const bf16_t*)(ws + WS_O2) + (size_t)MP * 1024, (const bf16_t*)(ws + WS_WMO), 1024, u >> 5, u & 31);
        LDS_BARRIER();
        pg8::Gemm g{(const bf16_t*)(ws + WS_O2), (const bf16_t*)(ws + WS_WMO), MP, 1024, 1024};
        pg8::StaticOrder S; S.init(MP, 1024, C.G, C.bid);
        EpiBranch E{(bf16_t*)(ws + WS_MIX), (float*)(ws + WS_SSQ)};
        pg8::gemm_phase<EpiBranch, pg8::StaticOrder, true, true>(C.lds, g, S, E, C.wave);
    }
    SEAM(11);
    if (IN(12)) resid_pass<false, false>(C, args.in[22]);
    SEAM(12);
    if (IN(13)) for (int rep_ = 0; rep_ < NREP(13); ++rep_) {
        for (int u = C.bid; u < 704; u += C.G) {
            const int tm = u / 88, tg = u % 88, jj = (32 * tg) >> 7, off = (32 * tg) & 127; const float* RS = (const float*)(ws + WS_RS); bf16_t* H = (bf16_t*)(ws + WS_H);
            const bf16_t* WG = (const bf16_t*)(ws + WS_WGU) + (size_t)(256 * jj + off) * 1024;
            sgemm_unit<2>(C, (const bf16_t*)(ws + WS_XB) + (size_t)MP * 1024, WG, WG + (size_t)128 * 1024, 1024, tm,
                [&](int row, int c2, const float (&v)[2][2]) { const float r = RS[MP + row]; const float g0 = v[0][0] * r, g1 = v[0][1] * r;
                    *(unsigned*)(H + ((size_t)MP + row) * DFF + 32 * tg + c2) = pk2(g0 * fsigmoid(g0) * (v[1][0] * r), g1 * fsigmoid(g1) * (v[1][1] * r)); });
        }
        LDS_BARRIER();
        pg8::Gemm g{(const bf16_t*)(ws + WS_XB), (const bf16_t*)(ws + WS_WGU), MP, 2 * DFF, 1024};
        pg8::StaticOrder S; S.init(MP, 2 * DFF, C.G, C.bid);
        EpiGateUp E{(const float*)(ws + WS_RS), (bf16_t*)(ws + WS_H)};
        pg8::gemm_phase<EpiGateUp, pg8::StaticOrder, true, true>(C.lds, g, S, E, C.wave);
    }
    SEAM(13);
    if (IN(14)) for (int rep_ = 0; rep_ < NREP(14); ++rep_) {
        for (int u = C.bid; u < 256; u += C.G) sgemm_branch(C, (const bf16_t*)(ws + WS_H) + (size_t)MP * DFF, (const bf16_t*)(ws + WS_WDN), DFF, u >> 5, u & 31);
        LDS_BARRIER();
        pg8::Gemm g{(const bf16_t*)(ws + WS_H), (const bf16_t*)(ws + WS_WDN), MP, 1024, DFF};
        pg8::StaticOrder S; S.init(MP, 1024, C.G, C.bid);
        EpiBranch E{(bf16_t*)(ws + WS_MIX), (float*)(ws + WS_SSQ)};
        pg8::gemm_phase<EpiBranch, pg8::StaticOrder, true, true>(C.lds, g, S, E, C.wave);
    }
    SEAM(14);
    if (IN(15)) resid_pass<false, true>(C, args.in[26]);
#undef IN
#undef SEAM
}

extern "C" void kernel_launch(void* const* d_in, const int* in_sizes, int n_in, void* d_out, int out_size, void* d_ws, size_t ws_size, hipStream_t stream) {
    static int grid = 0;
    if (grid == 0) {
        if (n_in != 30 || out_size != (int)O_TOTAL || ws_size < WS_END2) {
            fprintf(stderr, "kernel_launch: unexpected problem (n_in %d, out %d, ws %zu; need ws >= %zu); nothing launched\n", n_in, out_size, ws_size, (size_t)WS_END2);
            grid = -1; return;
        }
        int dev = 0, cus = 0, per_cu = 0;
        (void)hipGetDevice(&dev);
        (void)hipDeviceGetAttribute(&cus, hipDeviceAttributeMultiprocessorCount, dev);
        (void)hipFuncSetAttribute((const void*)fwd_megakernel, hipFuncAttributeMaxDynamicSharedMemorySize, LDS_BYTES);
        (void)hipOccupancyMaxActiveBlocksPerMultiprocessor(&per_cu, (const void*)fwd_megakernel, NTHREADS, LDS_BYTES);
        if (per_cu < 1) { fprintf(stderr, "kernel_launch: occupancy query says %d blocks per CU\n", per_cu); per_cu = 1; }
        (void)hipGetLastError();
        grid = cus;
        if (grid > 256) grid = 256;
    }
    if (grid < 0) return;
    (void)hipMemsetAsync((char*)d_ws + WS_CTL, 0, 65536, stream);
    Args a{};
    for (int i = 0; i < 30; ++i) a.in[i] = (const float*)d_in[i];
    a.out = (float*)d_out; a.ws = (unsigned char*)d_ws;
#if MK_N_LAUNCHES == 1
    a.ph_lo = 0; a.ph_hi = N_PHASES;
    void* kargs[] = {&a};
    hipError_t e = hipLaunchCooperativeKernel((const void*)fwd_megakernel, dim3(grid), dim3(NTHREADS), kargs, LDS_BYTES, stream);
    if (e != hipSuccess) fprintf(stderr, "cooperative launch failed: %s (grid %d)\n", hipGetErrorString(e), grid);
#else
    for (int p = 0; p < N_PHASES; ++p) {
        a.ph_lo = p; a.ph_hi = p + 1;
        hipLaunchKernelGGL(fwd_megakernel, dim3(grid), dim3(NTHREADS), LDS_BYTES, stream, a);
    }
#endif
}
```

```cpp
#include <hip/hip_runtime.h>
#include <hip/hip_cooperative_groups.h>
#include <cstdio>
#include <cstdint>
namespace cg = cooperative_groups;
#define LAS __attribute__((address_space(3)))
namespace pg8 {
#define PG8_LAS __attribute__((address_space(3)))
typedef unsigned short bf16_t;
typedef short bf16x8 __attribute__((ext_vector_type(8)));
typedef float f32x4 __attribute__((ext_vector_type(4)));
typedef unsigned u32x4 __attribute__((ext_vector_type(4)));
constexpr int BM = 256, BK = 64, HALF = 128, HTB = HALF * BK * 2  , STAGE_BYTES = 8 * HTB, NXCD = 8, WGM = 8;

__host__ __device__ __forceinline__ int lds_byte(int r, int c) { const int st = (r >> 4) * 2 + (c >> 5), rr = r & 15, cc = c & 31, ob = rr * 64 + cc * 2; return st * 1024 + (ob ^ (((ob >> 9) & 1) << 5)); }
__host__ __device__ __forceinline__ void stage_rc(int b, int& R, int& C) { const int st = b / 1024, sb = b % 1024, swz = sb ^ (((sb >> 9) & 1) << 5); R = (st >> 1) * 16 + swz / 64; C = (st & 1) * 32 + (swz % 64) / 2; }
__host__ __device__ __forceinline__ int perm32(int rho) { const int n = rho >> 4, i = rho & 15; return 8 * (i >> 2) + 4 * n + (i & 3); }

struct Unit { int pm, pn; };
struct Gemm { const bf16_t* A; const bf16_t* Bt; int M, N, K; };

struct StaticOrder {
    int nM, nN, nwg, G, c;
    __host__ __device__ void init(int M, int N, int G_, int c_) { nM = M / BM; nN = N / BM; nwg = nM * nN; G = G_; c = c_; }
    __host__ __device__ bool next(int i, Unit& u) const {
        const long L = (long)i * G + c; if (L >= nwg) return false;
        int wgid = (int)L; { const int q = nwg / NXCD, r = nwg % NXCD, xcd = wgid % NXCD, off = wgid / NXCD; wgid = (xcd < r ? xcd * (q + 1) : r * (q + 1) + (xcd - r) * q) + off; }
        const int nig = WGM * nN, gid = wgid / nig, fm = gid * WGM, gsz = (nM - fm) < WGM ? (nM - fm) : WGM;
        u.pm = fm + ((wgid % nig) % gsz); u.pn = (wgid % nig) / gsz; return true;
    }
    __device__ __forceinline__ void a_ready(const Unit&) const {}
    __device__ __forceinline__ void done(const Unit&) const {}
};

__device__ __forceinline__ unsigned cvt_pk_bf16(float lo, float hi) { unsigned r; asm volatile("v_cvt_pk_bf16_f32 %0, %1, %2" : "=v"(r) : "v"(lo), "v"(hi)); return r; }
typedef float f32x2 __attribute__((ext_vector_type(2)));
__device__ __forceinline__ f32x2 gelu_pk(f32x2 v) {
    const f32x2 av = __builtin_elementwise_abs(v), d = av * 0.2316418882f + 1.0f;
    f32x2 t; t.x = __builtin_amdgcn_rcpf(d.x); t.y = __builtin_amdgcn_rcpf(d.y);
    f32x2 q = t * 0.5307027145f + (-0.7265760135f); q = q * t + 0.7107068705f; q = q * t + (-0.142248368f); q = q * t + 0.127414796f; q = q * t;
    const f32x2 s = (v * v) * (-0.72134752044f);
    f32x2 e; e.x = __builtin_amdgcn_exp2f(s.x); e.y = __builtin_amdgcn_exp2f(s.y);
    const f32x2 m = v * (q * e), r = v - m;
    f32x2 o; o.x = v.x < 0.f ? m.x : r.x; o.y = v.y < 0.f ? m.y : r.y; return o;
}

template <int ACT  > struct EpiBf16 {
    static constexpr bool PERM = true, AFTER_DRAIN = false, HAS_MID = false; static_assert(ACT == 0 || ACT == 1, "EpiBf16: ACT is 0 (none) or 1 (gelu_pk)");
    bf16_t* O; int ldc; const float* bias; int split_cols; size_t split_stride; float scale0;
    __device__ __forceinline__ void operator()(const f32x4 (&acc)[2][2][4][2], const Unit& u, int wr, int wc, int fr, int fq) const {
        const int row0 = u.pm * BM + wr * 64 + fr; int colt = u.pn * BM; bf16_t* base = O;
        float sc = 1.f; if (split_cols) { const int t = colt / split_cols; base += (size_t)t * split_stride; colt -= t * split_cols; if (t == 0) sc = scale0; }
        const int col0 = colt + wc * 32 + 8 * fq, bcol0 = u.pn * BM + wc * 32 + 8 * fq;
        f32x4 bv[2][2];
#pragma unroll
        for (int bj = 0; bj < 2; ++bj)
#pragma unroll
            for (int n = 0; n < 2; ++n) bv[bj][n] = bias ? *(const f32x4*)(bias + bcol0 + bj * HALF + 4 * n) : (f32x4){0.f, 0.f, 0.f, 0.f};
#pragma unroll
        for (int ai = 0; ai < 2; ++ai)
#pragma unroll
            for (int m = 0; m < 4; ++m) { bf16_t* rowp = base + (size_t)(row0 + ai * HALF + m * 16) * ldc + col0;
#pragma unroll
                for (int bj = 0; bj < 2; ++bj) { f32x4 v0 = acc[ai][bj][m][0] + bv[bj][0], v1 = acc[ai][bj][m][1] + bv[bj][1];
                    if (ACT == 1) { f32x2 a = gelu_pk((f32x2){v0[0], v0[1]}), b = gelu_pk((f32x2){v0[2], v0[3]}), c = gelu_pk((f32x2){v1[0], v1[1]}), d = gelu_pk((f32x2){v1[2], v1[3]});
                        v0 = (f32x4){a.x, a.y, b.x, b.y}; v1 = (f32x4){c.x, c.y, d.x, d.y}; }
                    v0 = v0 * sc; v1 = v1 * sc; u32x4 w; w.x = cvt_pk_bf16(v0[0], v0[1]); w.y = cvt_pk_bf16(v0[2], v0[3]); w.z = cvt_pk_bf16(v1[0], v1[1]); w.w = cvt_pk_bf16(v1[2], v1[3]);
                    *(u32x4*)(rowp + bj * HALF) = w; } }
    }
};

struct PanelStats {
    unsigned* xbuf;
    unsigned* cnt;
    unsigned* tmo;
    int ntn; float eps;
    unsigned code;
    __device__ __forceinline__ bool run(const f32x4 (&v)[2][2][4][2], const Unit& u, int wr, int wc, int fr, int fq, PG8_LAS unsigned char* lds, int wid, int lane) const {
        typedef float f32x2v __attribute__((ext_vector_type(2)));
        PG8_LAS f32x2v* P = (PG8_LAS f32x2v*)lds;
        PG8_LAS f32x2v* S = (PG8_LAS f32x2v*)(lds + 8192);
        PG8_LAS unsigned* flag = (PG8_LAS unsigned*)(lds + 8192 + 2048);
#pragma unroll
        for (int ai = 0; ai < 2; ++ai)
#pragma unroll
            for (int m = 0; m < 4; ++m) {
                float s = 0.f;
#pragma unroll
                for (int bj = 0; bj < 2; ++bj)
#pragma unroll
                    for (int n = 0; n < 2; ++n) { const f32x4 x = v[ai][bj][m][n]; s += (x[0] + x[1]) + (x[2] + x[3]); }
                s += __shfl_xor(s, 16); s += __shfl_xor(s, 32);
                const float mw = s * (1.0f / 64.0f); float q = 0.f;
#pragma unroll
                for (int bj = 0; bj < 2; ++bj)
#pragma unroll
                    for (int n = 0; n < 2; ++n) { const f32x4 d = v[ai][bj][m][n] - mw; q += (d[0] * d[0] + d[1] * d[1]) + (d[2] * d[2] + d[3] * d[3]); }
                q += __shfl_xor(q, 16); q += __shfl_xor(q, 32);
                if (fq == 0) P[(ai * HALF + wr * 64 + m * 16 + fr) * 4 + wc] = (f32x2v){mw, q};
            }
        asm volatile("s_waitcnt lgkmcnt(0)" ::: "memory"); __builtin_amdgcn_s_barrier(); asm volatile("" ::: "memory");
#if defined(BROKEN_EXCHANGE_NO_WAIT)
#warning BROKEN CONTROL BUILD: the row-statistics exchange does not wait; results are wrong by design
        if (blockIdx.x >= 64) { const long long t0_ = clock64(); while (clock64() - t0_ < 60000) __builtin_amdgcn_s_sleep(8); }
#endif
        const int row = wid * 32 + (lane & 31);
        if (lane < 32) {
            const f32x2v a = P[row * 4 + 0], b = P[row * 4 + 1], c = P[row * 4 + 2], d = P[row * 4 + 3];
            const float mt = (a.x + b.x + c.x + d.x) * 0.25f;
            const float da = a.x - mt, db = b.x - mt, dc = c.x - mt, dd = d.x - mt;
            const float m2 = (a.y + b.y) + (c.y + d.y) + 64.0f * ((da * da + db * db) + (dc * dc + dd * dd));
            unsigned long long* slot = (unsigned long long*)xbuf + ((size_t)(u.pm * BM + row) * 4 + u.pn);
            __hip_atomic_store(slot, ((unsigned long long)__float_as_uint(m2) << 32) | __float_as_uint(mt), __ATOMIC_RELAXED, __HIP_MEMORY_SCOPE_AGENT);
        }
        asm volatile("s_waitcnt vmcnt(0)" ::: "memory");
        if (lane == 0) __hip_atomic_fetch_add(cnt + 64 * u.pm, 1u, __ATOMIC_RELAXED, __HIP_MEMORY_SCOPE_AGENT);
        if (wid == 0) {
            bool dead = false; const unsigned long long t0 = __builtin_amdgcn_s_memrealtime(); const unsigned want = 8u * (unsigned)ntn;
            for (;;) {
#if defined(BROKEN_EXCHANGE_NO_WAIT)
                break;
#endif
                if ((unsigned)__builtin_amdgcn_readfirstlane(__hip_atomic_load(cnt + 64 * u.pm, __ATOMIC_RELAXED, __HIP_MEMORY_SCOPE_AGENT)) >= want) break;
                if (__builtin_amdgcn_s_memrealtime() - t0 > 2000000ull) {
                    if (lane == 0) { unsigned expect = 0u; __hip_atomic_compare_exchange_strong(tmo + 1, &expect, code | (unsigned)(u.pm & 0xff), __ATOMIC_RELAXED, __ATOMIC_RELAXED, __HIP_MEMORY_SCOPE_AGENT);
                                     __hip_atomic_store(tmo, 1u, __ATOMIC_RELAXED, __HIP_MEMORY_SCOPE_AGENT); }
                    dead = true; break; }
                __builtin_amdgcn_s_sleep(2);
            }
            __builtin_amdgcn_fence(__ATOMIC_ACQUIRE, "agent");
            if (lane == 0) flag[0] = dead ? 1u : 0u;
        }
        asm volatile("s_waitcnt vmcnt(0) lgkmcnt(0)" ::: "memory"); __builtin_amdgcn_s_barrier(); asm volatile("" ::: "memory");
        const bool bad = flag[0] != 0u;
        if (lane < 32) {
            const unsigned long long* slot = (const unsigned long long*)xbuf + (size_t)(u.pm * BM + row) * 4; float mt[4], m2[4]; float ms = 0.f;
#pragma unroll
            for (int t = 0; t < 4; ++t) { if (t < ntn) { const unsigned long long w = __hip_atomic_load(slot + t, __ATOMIC_RELAXED, __HIP_MEMORY_SCOPE_AGENT); mt[t] = __uint_as_float((unsigned)w); m2[t] = __uint_as_float((unsigned)(w >> 32)); } else { mt[t] = 0.f; m2[t] = 0.f; } ms += mt[t]; }
            const float mean = ms / (float)ntn; float q = 0.f;
#pragma unroll
            for (int t = 0; t < 4; ++t) if (t < ntn) { const float dm = mt[t] - mean; q += m2[t] + 256.0f * dm * dm; }
            S[row] = (f32x2v){mean, 1.0f / sqrtf(q / (256.0f * (float)ntn) + eps)};
        }
        asm volatile("s_waitcnt lgkmcnt(0)" ::: "memory"); __builtin_amdgcn_s_barrier(); asm volatile("" ::: "memory");
        return bad;
    }
};
struct EpiLnRes {
    static constexpr bool PERM = false, AFTER_DRAIN = true, HAS_MID = false;
    const float* base; float* out; int ldc; const float* bias; PanelStats st; unsigned poison;
    __device__ __forceinline__ void fused(f32x4 (&acc)[2][2][4][2], const Unit& u, int wr, int wc, int fr, int fq, PG8_LAS unsigned char* lds, int wid, int lane) const {
        typedef float f32x2v __attribute__((ext_vector_type(2)));
        const PG8_LAS f32x2v* S = (const PG8_LAS f32x2v*)(lds + 8192);
        const int col0 = u.pn * BM + wc * 32 + 4 * fq;
#pragma unroll
        for (int bj = 0; bj < 2; ++bj)
#pragma unroll
            for (int n = 0; n < 2; ++n) { const f32x4 bv = bias ? *(const f32x4*)(bias + col0 + bj * HALF + n * 16) : (f32x4){0.f, 0.f, 0.f, 0.f};
#pragma unroll
                for (int ai = 0; ai < 2; ++ai)
#pragma unroll
                    for (int m = 0; m < 4; ++m) acc[ai][bj][m][n] += bv; }
        f32x4 pre[4][2][2];
#pragma unroll
        for (int m = 0; m < 4; ++m) { const size_t off = (size_t)(u.pm * BM + wr * 64 + m * 16 + fr) * ldc + col0;
#pragma unroll
            for (int bj = 0; bj < 2; ++bj)
#pragma unroll
                for (int n = 0; n < 2; ++n) pre[m][bj][n] = *(const f32x4*)(base + off + bj * HALF + n * 16); }
        const bool bad = st.run(acc, u, wr, wc, fr, fq, lds, wid, lane) || poison != 0u;
        const float qnan = __builtin_nanf("");
#pragma unroll
        for (int ai = 0; ai < 2; ++ai)
#pragma unroll
            for (int m = 0; m < 4; ++m) { const int r = ai * HALF + wr * 64 + m * 16 + fr; const f32x2v sr = S[r]; const size_t off = (size_t)(u.pm * BM + r) * ldc + col0;
#pragma unroll
                for (int bj = 0; bj < 2; ++bj)
#pragma unroll
                    for (int n = 0; n < 2; ++n) { const f32x4 bs = ai == 0 ? pre[m][bj][n] : *(const f32x4*)(base + off + bj * HALF + n * 16); f32x4 o = bs + (acc[ai][bj][m][n] - sr.x) * sr.y;
                        if (bad) o = (f32x4){qnan, qnan, qnan, qnan}; *(f32x4*)(out + off + bj * HALF + n * 16) = o; }
                if (m & 1) asm volatile("" ::: "memory"); }
    }
};
struct EpiLnResLn {
    static constexpr bool PERM = false, AFTER_DRAIN = true, HAS_MID = false;
    const float* base; float* out; bf16_t* xn; int ldc; const float* bias; PanelStats st1, st2; unsigned poison;
    __device__ __forceinline__ void fused(f32x4 (&acc)[2][2][4][2], const Unit& u, int wr, int wc, int fr, int fq, PG8_LAS unsigned char* lds, int wid, int lane) const {
        typedef float f32x2v __attribute__((ext_vector_type(2))); typedef unsigned u32x2v __attribute__((ext_vector_type(2)));
        const PG8_LAS f32x2v* S = (const PG8_LAS f32x2v*)(lds + 8192);
        const int col0 = u.pn * BM + wc * 32 + 4 * fq;
#pragma unroll
        for (int bj = 0; bj < 2; ++bj)
#pragma unroll
            for (int n = 0; n < 2; ++n) { const f32x4 bv = bias ? *(const f32x4*)(bias + col0 + bj * HALF + n * 16) : (f32x4){0.f, 0.f, 0.f, 0.f};
#pragma unroll
                for (int ai = 0; ai < 2; ++ai)
#pragma unroll
                    for (int m = 0; m < 4; ++m) acc[ai][bj][m][n] += bv; }
        bool bad = st1.run(acc, u, wr, wc, fr, fq, lds, wid, lane) || poison != 0u;
        const float qnan = __builtin_nanf("");
#pragma unroll
        for (int ai = 0; ai < 2; ++ai)
#pragma unroll
            for (int m = 0; m < 4; ++m) { const int r = ai * HALF + wr * 64 + m * 16 + fr; const f32x2v sr = S[r]; const size_t off = (size_t)(u.pm * BM + r) * ldc + col0;
#pragma unroll
                for (int bj = 0; bj < 2; ++bj)
#pragma unroll
                    for (int n = 0; n < 2; ++n) { const f32x4 bs = *(const f32x4*)(base + off + bj * HALF + n * 16); acc[ai][bj][m][n] = bs + (acc[ai][bj][m][n] - sr.x) * sr.y; }
                asm volatile("" : "+v"(acc[ai][0][m][0]), "+v"(acc[ai][0][m][1]), "+v"(acc[ai][1][m][0]), "+v"(acc[ai][1][m][1]));
                if (m & 1) asm volatile("" ::: "memory"); }
        const bool bad1 = bad;
        bad = st2.run(acc, u, wr, wc, fr, fq, lds, wid, lane) || bad;
#pragma unroll
        for (int ai = 0; ai < 2; ++ai)
#pragma unroll
            for (int m = 0; m < 4; ++m) { const int r = ai * HALF + wr * 64 + m * 16 + fr; const f32x2v sr = S[r]; const size_t off = (size_t)(u.pm * BM + r) * ldc + col0;
#pragma unroll
                for (int bj = 0; bj < 2; ++bj)
#pragma unroll
                    for (int n = 0; n < 2; ++n) { const f32x4 x1 = acc[ai][bj][m][n]; *(f32x4*)(out + off + bj * HALF + n * 16) = bad1 ? (f32x4){qnan, qnan, qnan, qnan} : x1;
                        const f32x4 o = (x1 - sr.x) * sr.y; u32x2v w; w.x = cvt_pk_bf16(o[0], o[1]); w.y = cvt_pk_bf16(o[2], o[3]);
                        if (bad) { w.x = 0x7fc07fc0u; w.y = 0x7fc07fc0u; } *(u32x2v*)(xn + off + bj * HALF + n * 16) = w; }
                asm volatile("" ::: "memory"); }
    }
};

template <class Epi, class Sched, bool ALIGN_EPI = false, bool SP2 = false>
__device__ __forceinline__ void gemm_phase(PG8_LAS unsigned char* lds, const Gemm g, const Sched& S, const Epi& E, const int wave_id) {
    const int lane = __builtin_amdgcn_mbcnt_hi(~0u, __builtin_amdgcn_mbcnt_lo(~0u, 0u)), wid = wave_id, tid = wid * 64 + lane, wr = wid >> 2, wc = wid & 3, fr = lane & 15, fq = lane >> 4;
    const int K = g.K, nt = K / BK;
    unsigned voffA[2], voffB[2];
#pragma unroll
    for (int i = 0; i < 2; ++i) { int R, C; stage_rc(tid * 16 + i * 8192, R, C); const int Rb = Epi::PERM ? ((R & ~31) + perm32(R & 31)) : R;
        voffA[i] = (unsigned)(R * K + C) * 2u; voffB[i] = (unsigned)(Rb * K + C) * 2u; }
    const size_t kstep = (size_t)(BK * 2);
    const size_t hstep = (size_t)HALF * K * 2;
    const size_t tstep = 2 * hstep;
    const unsigned ldsw = (unsigned)wid * 1024u;
    const int aoff = lds_byte(wr * 64 + fr, fq * 8), boff = lds_byte(wc * 32 + fr, fq * 8);
#define PG8_SA(b, h) (((b) * 2 + (h)) * HTB)
#define PG8_SB(b, h) ((4 + (b) * 2 + (h)) * HTB)
#define PG8_STAGE(bufoff, gbase, voff) do { _Pragma("unroll") for (int _i = 0; _i < 2; ++_i) \
        __builtin_amdgcn_global_load_lds((const unsigned*)((const char*)(gbase) + (voff)[_i]), (PG8_LAS unsigned*)(lds + (bufoff) + ldsw + _i * 8192), 16, 0, 0); } while (0)
#define PG8_LDA(dst, b, h) do { _Pragma("unroll") for (int m = 0; m < 4; ++m) _Pragma("unroll") for (int k = 0; k < 2; ++k) dst[m][k] = *(const PG8_LAS bf16x8*)(lds + PG8_SA(b, h) + aoff + m * 2048 + k * 1024); } while (0)
#define PG8_LDB(dst, b, h) do { _Pragma("unroll") for (int n = 0; n < 2; ++n) _Pragma("unroll") for (int k = 0; k < 2; ++k) dst[n][k] = *(const PG8_LAS bf16x8*)(lds + PG8_SB(b, h) + boff + n * 2048 + k * 1024); } while (0)
#define PG8_MMA(ai, bj, At, Bt) do { __builtin_amdgcn_s_setprio(1); _Pragma("unroll") for (int m = 0; m < 4; ++m) _Pragma("unroll") for (int n = 0; n < 2; ++n) _Pragma("unroll") for (int k = 0; k < 2; ++k) \
        acc[ai][bj][m][n] = __builtin_amdgcn_mfma_f32_16x16x32_bf16(Bt[n][k], At[m][k], acc[ai][bj][m][n], 0, 0, 0); __builtin_amdgcn_s_setprio(0); } while (0)
#define PG8_WAIT_V(n) asm volatile("s_waitcnt vmcnt(" #n ")" ::: "memory")
#define PG8_WAIT_L(n) asm volatile("s_waitcnt lgkmcnt(" #n ")" ::: "memory")
#define PG8_BAR __builtin_amdgcn_s_barrier()
#define PG8_SCHED __builtin_amdgcn_sched_barrier(0)
    Unit cur, nxt; int ui = 0;
    if (!S.next(0, cur)) return;
    f32x4 acc[2][2][4][2];
#pragma unroll
    for (int a = 0; a < 2; ++a)
#pragma unroll
        for (int b = 0; b < 2; ++b)
#pragma unroll
            for (int m = 0; m < 4; ++m)
#pragma unroll
                for (int n = 0; n < 2; ++n) acc[a][b][m][n] = (f32x4){0.f, 0.f, 0.f, 0.f};
    bf16x8 At[4][2], B0[2][2], B1[2][2];
    const char* cA = (const char*)g.A + (size_t)cur.pm * tstep; const char* cB = (const char*)g.Bt + (size_t)cur.pn * tstep;
    S.a_ready(cur);
    if constexpr (SP2) {
        PG8_STAGE(PG8_SB(0, 0), cB, voffB); PG8_STAGE(PG8_SB(0, 1), cB + hstep, voffB); PG8_STAGE(PG8_SA(0, 0), cA, voffA); PG8_STAGE(PG8_SA(0, 1), cA + hstep, voffA);
        if (wr == 1) PG8_BAR;
        PG8_WAIT_V(2); PG8_BAR;
        PG8_STAGE(PG8_SB(1, 0), cB + kstep, voffB); PG8_STAGE(PG8_SA(1, 0), cA + kstep, voffA); PG8_STAGE(PG8_SB(1, 1), cB + hstep + kstep, voffB);
        PG8_WAIT_V(6); PG8_BAR;
    } else {
        PG8_STAGE(PG8_SB(0, 0), cB, voffB); PG8_STAGE(PG8_SA(0, 0), cA, voffA); PG8_STAGE(PG8_SB(0, 1), cB + hstep, voffB); PG8_STAGE(PG8_SA(0, 1), cA + hstep, voffA);
        if (wr == 1) PG8_BAR;
        PG8_WAIT_V(4); PG8_BAR;
        PG8_STAGE(PG8_SB(1, 0), cB + kstep, voffB); PG8_STAGE(PG8_SA(1, 0), cA + kstep, voffA); PG8_STAGE(PG8_SB(1, 1), cB + hstep + kstep, voffB);
        PG8_WAIT_V(6); PG8_BAR;
    }
    for (;;) {
        const bool has_next = S.next(ui + 1, nxt);
        const char* nA = has_next ? (const char*)g.A + (size_t)nxt.pm * tstep : cA; const char* nB = has_next ? (const char*)g.Bt + (size_t)nxt.pn * tstep : cB;
        for (int t = 0; t < nt; t += 2) {
            if constexpr (Epi::HAS_MID) { if (t == E.mid_t) E.mid(acc, cur, wr, wc, fr, fq); }
            const bool last = (t == nt - 2);
            const char* a1 = cA + (size_t)(t + 1) * kstep;
            const char* a2 = last ? nA : cA + (size_t)(t + 2) * kstep; const char* b2 = last ? nB : cB + (size_t)(t + 2) * kstep;
            const char* a3 = a2 + kstep; const char* b3 = b2 + kstep;
            if (last && has_next) S.a_ready(nxt);
            if constexpr (SP2) {
            PG8_LDB(B0, 0, 0); PG8_LDB(B1, 0, 1); PG8_SCHED; PG8_LDA(At, 0, 0); PG8_STAGE(PG8_SA(1, 1), a1 + hstep, voffA);
            PG8_WAIT_V(8); PG8_WAIT_L(0); PG8_BAR; PG8_MMA(0, 0, At, B0); PG8_MMA(0, 1, At, B1); PG8_BAR; PG8_SCHED;
            PG8_LDA(At, 0, 1); PG8_STAGE(PG8_SB(0, 0), b2, voffB); PG8_STAGE(PG8_SB(0, 1), b2 + hstep, voffB); PG8_STAGE(PG8_SA(0, 0), a2, voffA);
            PG8_WAIT_V(8); PG8_WAIT_L(0); PG8_BAR; PG8_MMA(1, 0, At, B0); PG8_MMA(1, 1, At, B1); PG8_BAR; PG8_SCHED;
            PG8_LDB(B0, 1, 0); PG8_LDB(B1, 1, 1); PG8_SCHED; PG8_LDA(At, 1, 0); PG8_STAGE(PG8_SA(0, 1), a2 + hstep, voffA);
            PG8_WAIT_V(8); PG8_WAIT_L(0); PG8_BAR; PG8_MMA(0, 0, At, B0); PG8_MMA(0, 1, At, B1); PG8_BAR; PG8_SCHED;
            PG8_LDA(At, 1, 1); PG8_STAGE(PG8_SB(1, 0), b3, voffB); PG8_STAGE(PG8_SB(1, 1), b3 + hstep, voffB); PG8_STAGE(PG8_SA(1, 0), a3, voffA);
            PG8_WAIT_V(8); PG8_WAIT_L(0); PG8_BAR; PG8_MMA(1, 0, At, B0); PG8_MMA(1, 1, At, B1); PG8_BAR; PG8_SCHED;
            } else {
            PG8_LDB(B0, 0, 0); PG8_SCHED; PG8_LDA(At, 0, 0); PG8_STAGE(PG8_SA(1, 1), a1 + hstep, voffA);
            PG8_WAIT_L(8); PG8_BAR; PG8_WAIT_L(0); PG8_MMA(0, 0, At, B0); PG8_BAR; PG8_SCHED;
            PG8_LDB(B1, 0, 1); PG8_STAGE(PG8_SB(0, 0), b2, voffB);
            PG8_BAR; PG8_WAIT_L(0); PG8_MMA(0, 1, At, B1); PG8_BAR;
            PG8_LDA(At, 0, 1); PG8_STAGE(PG8_SA(0, 0), a2, voffA);
            PG8_BAR; PG8_WAIT_L(0); PG8_MMA(1, 0, At, B0); PG8_BAR; PG8_SCHED;
            PG8_STAGE(PG8_SB(0, 1), b2 + hstep, voffB);
            PG8_WAIT_V(6); PG8_BAR; PG8_MMA(1, 1, At, B1); PG8_BAR;
            PG8_LDB(B0, 1, 0); PG8_SCHED; PG8_LDA(At, 1, 0); PG8_STAGE(PG8_SA(0, 1), a2 + hstep, voffA);
            PG8_WAIT_L(8); PG8_BAR; PG8_WAIT_L(0); PG8_MMA(0, 0, At, B0); PG8_BAR; PG8_SCHED;
            PG8_LDB(B1, 1, 1); PG8_STAGE(PG8_SB(1, 0), b3, voffB);
            PG8_BAR; PG8_WAIT_L(0); PG8_MMA(0, 1, At, B1); PG8_BAR;
            PG8_LDA(At, 1, 1); PG8_STAGE(PG8_SA(1, 0), a3, voffA);
            PG8_BAR; PG8_WAIT_L(0); PG8_MMA(1, 0, At, B0); PG8_BAR; PG8_SCHED;
            PG8_STAGE(PG8_SB(1, 1), b3 + hstep, voffB);
            PG8_WAIT_V(6); PG8_BAR; PG8_MMA(1, 1, At, B1); PG8_BAR;
            }
        }
        if constexpr (ALIGN_EPI) { if (wr == 0) PG8_BAR; }
        if constexpr (!Epi::AFTER_DRAIN) { E(acc, cur, wr, wc, fr, fq); S.done(cur); }
        if (!has_next) break;
#pragma unroll
        for (int a = 0; a < 2; ++a)
#pragma unroll
            for (int b = 0; b < 2; ++b)
#pragma unroll
                for (int m = 0; m < 4; ++m)
#pragma unroll
                    for (int n = 0; n < 2; ++n) acc[a][b][m][n] = (f32x4){0.f, 0.f, 0.f, 0.f};
        cur = nxt; cA = nA; cB = nB; ++ui;
        if constexpr (ALIGN_EPI) { if (wr == 1) PG8_BAR; }
    }
    PG8_WAIT_V(0);
    if constexpr (!ALIGN_EPI) { if (wr == 0) PG8_BAR; }
    PG8_BAR;
    if constexpr (Epi::AFTER_DRAIN) { E.fused(acc, cur, wr, wc, fr, fq, lds, wid, lane); S.done(cur); }
#undef PG8_SA
#undef PG8_SB
#undef PG8_STAGE
#undef PG8_LDA
#undef PG8_LDB
#undef PG8_MMA
#undef PG8_WAIT_V
#undef PG8_WAIT_L
#undef PG8_BAR
#undef PG8_SCHED
}
}

typedef __attribute__((address_space(1))) unsigned gu32;
#define RLX_AGENT __ATOMIC_RELAXED, __HIP_MEMORY_SCOPE_AGENT
#define XB_TMO      128
#define XB_XCNT(j)  (256  + 64 * (j))
#define XB_XSUB(j)  (1280 + 64 * (j))
#define XB_XGEN(j)  (2304 + 64 * (j))
#define XB_TOP      3328
#define XB_TOPGEN   3392
#define XCD_BAR_WORDS 3456
#define XB_SPIN_CAP (1u << 18)

__device__ __forceinline__ unsigned xb_ld(unsigned* p)              { return __hip_atomic_load(p, __ATOMIC_RELAXED, __HIP_MEMORY_SCOPE_AGENT); }
__device__ __forceinline__ unsigned xb_add(unsigned* p, unsigned v) { return __hip_atomic_fetch_add(p, v, __ATOMIC_RELAXED, __HIP_MEMORY_SCOPE_AGENT); }
__device__ __forceinline__ unsigned xb_xcc_id() { return (unsigned)__builtin_amdgcn_s_getreg((3 << 11) | 20) & 0xFu; }
#define XB_SPIN(cond, bar) do { unsigned _sp = 0; while (cond) { __builtin_amdgcn_s_sleep(1); \
    if ((++_sp & 255u) == 0u) { if (xb_ld(&(bar)[XB_TMO])) break; if (_sp > XB_SPIN_CAP) { atomicAdd(&(bar)[XB_TMO], 1u); break; } } } } while (0)

struct XcdBarrier {
    unsigned* bar; unsigned x;
    volatile LAS unsigned* st;
};

__device__ __forceinline__ XcdBarrier xcd_barrier_post(unsigned* bar, volatile LAS unsigned* st, bool leader) {
    XcdBarrier b; b.bar = bar; b.x = xb_xcc_id(); b.st = st;
    if (leader) (void)xb_add(&bar[XB_XCNT(b.x)], 1u);
    return b;
}
__device__ __forceinline__ void xcd_barrier_complete(unsigned* bar, unsigned x, unsigned& nloc, unsigned& nx) {
    const unsigned G = gridDim.x * gridDim.y * gridDim.z;
    unsigned sum, cnt, mine, sp = 0u;
    for (;;) {
        sum = 0u; cnt = 0u; mine = 0u;
#pragma unroll
        for (unsigned j = 0; j < 16; ++j) { const unsigned c = xb_ld(&bar[XB_XCNT(j)]); sum += c; cnt += (c > 0u) ? 1u : 0u; mine = (j == x) ? c : mine; }
        if (sum == G) break;
        __builtin_amdgcn_s_sleep(1);
        if ((++sp & 255u) == 0u) { if (xb_ld(&bar[XB_TMO])) break; if (sp > XB_SPIN_CAP) { atomicAdd(&bar[XB_TMO], 1u); break; } }
    }
    nloc = mine > 0u ? mine : 1u; nx = cnt > 0u ? cnt : 1u;
}

__device__ __forceinline__ void xcd_barrier(const XcdBarrier& b, bool leader) {
    asm volatile("s_waitcnt vmcnt(0)" ::: "memory");
    __syncthreads();
    if (leader) {
        unsigned* bar = b.bar;
        __builtin_amdgcn_s_waitcnt(0);
        unsigned nloc = b.st[0], nx = b.st[1];
        if (nloc == 0u) { xcd_barrier_complete(bar, b.x, nloc, nx); b.st[0] = nloc; b.st[1] = nx; }
        const unsigned old = xb_add(&bar[XB_XSUB(b.x)], 1u);
        const unsigned gen = old / nloc;
        if (old + 1u == (gen + 1u) * nloc) {
            __builtin_amdgcn_fence(__ATOMIC_RELEASE, "agent");
            asm volatile("s_waitcnt vmcnt(0)" ::: "memory");
            const unsigned og = xb_add(&bar[XB_TOP], 1u);
            const unsigned tg = og / nx;
            if (og + 1u == (tg + 1u) * nx) xb_add(&bar[XB_TOPGEN], 1u);
            else XB_SPIN(xb_ld(&bar[XB_TOPGEN]) == tg, bar);
            __builtin_amdgcn_fence(__ATOMIC_ACQUIRE, "agent");
            xb_add(&bar[XB_XGEN(b.x)], 1u);
            asm volatile("s_waitcnt vmcnt(0)" ::: "memory");
        } else {
            XB_SPIN(xb_ld(&bar[XB_XGEN(b.x)]) == gen, bar);
            __builtin_amdgcn_fence(__ATOMIC_ACQUIRE, "agent");
            asm volatile("s_waitcnt vmcnt(0)" ::: "memory");
        }
    }
    __syncthreads();
}

#define DI __device__ __forceinline__

typedef unsigned short bf16_t;
typedef short bf16x8 __attribute__((ext_vector_type(8)));
typedef short bf16x4 __attribute__((ext_vector_type(4)));
typedef float f32x2 __attribute__((ext_vector_type(2)));
typedef float f32x4 __attribute__((ext_vector_type(4)));
typedef float f32x16 __attribute__((ext_vector_type(16)));
typedef unsigned u32x2 __attribute__((ext_vector_type(2)));
typedef unsigned u32x4 __attribute__((ext_vector_type(4)));
typedef __bf16 hwbf16x2 __attribute__((ext_vector_type(2)));

constexpr int DM = 1024, NB = 4, SEQ = 8192, DB = 32, DS = 8;
constexpr int MP = NB * SEQ;
constexpr int MS = DB * DS;
constexpr int MT = MP + MS;
constexpr int NIN_SRC = 9744, NIN = 9984;
constexpr int DFF = 2816;
constexpr float EPS = 1e-6f;
constexpr float LOG2E = 1.4426950408889634f;
constexpr float QA_SCALE = 0.08838834764831845f * LOG2E;
constexpr float QB_SCALE = 0.08838834764831845f;
constexpr float Q2_SCALE = 0.0625f * LOG2E;

constexpr size_t O_Y = 0, O_W1P = 33816576, O_W2P = 34340864, O_W3P = 36438016, O_GLAP = 44826624, O_MEMP = 45350912,
                 O_W1S = 47448064, O_W2S = 47710208, O_W3S = 47972352, O_GLAS = 48234496, O_TOTAL = 52428800;

constexpr size_t MiB = 1u << 20;
constexpr size_t WS_CTL = 0, WS_WIN = 1 * MiB, WS_WMKV = 21 * MiB, WS_WPA = 25 * MiB, WS_WPB = 26 * MiB, WS_WOUT = 28 * MiB, WS_WMQ = 30 * MiB,
                 WS_WMO = 32 * MiB, WS_WGU = 34 * MiB, WS_WDN = 45 * MiB, WS_XB = 51 * MiB, WS_MEMB = 116 * MiB, WS_RS = 118 * MiB, WS_SSQ = 119 * MiB,
                 WS_FB = 122 * MiB, WS_MK = 125 * MiB, WS_MVT = 127 * MiB, WS_LSE = 129 * MiB, WS_QA = 131 * MiB, WS_KA = 228 * MiB, WS_VA = 325 * MiB,
                 WS_QB = 422 * MiB, WS_KB = 455 * MiB, WS_VB = 488 * MiB, WS_SGB = 553 * MiB, WS_SGA = 618 * MiB, WS_SGBT = 683 * MiB, WS_OAG = 748 * MiB,
                 WS_YAIN = 845 * MiB, WS_OBN = 878 * MiB, WS_END = 943 * MiB;
constexpr size_t WS_TMP = 131 * MiB, WS_MIXIN = 196 * MiB, WS_MIX = 261 * MiB, WS_Q2 = 326 * MiB, WS_O2 = 391 * MiB, WS_H = 488 * MiB;
constexpr size_t WS_RSMEM = WS_RS + 512 * 1024;
static_assert(WS_WIN + (size_t)NIN * 1024 * 2 <= WS_WMKV && WS_WDN + (size_t)1024 * DFF * 2 <= WS_XB && WS_XB + (size_t)MT * 1024 * 2 <= WS_MEMB, "ws map 1");
static_assert(WS_QA + (size_t)MT * 1536 * 2 <= WS_KA && WS_QB + (size_t)MT * 512 * 2 <= WS_KB && WS_VB + (size_t)MT * 1024 * 2 <= WS_SGB, "ws map 2");
static_assert(WS_OAG + (size_t)3 * MT * 512 * 2 <= WS_YAIN && WS_YAIN + (size_t)MT * 512 * 2 <= WS_OBN && WS_OBN + (size_t)MT * 1024 * 2 <= WS_END, "ws map 3");
static_assert(WS_H + (size_t)MT * DFF * 2 <= WS_OAG && WS_O2 + (size_t)MT * 1024 * 2 <= WS_VB && WS_SSQ + (size_t)MT * 16 * 4 <= WS_FB && WS_LSE + (size_t)MT * 12 * 4 <= WS_QA, "ws map 4");

constexpr int LDS_BYTES = 147456;
constexpr int NTHREADS = 512;

DI unsigned pk2(float lo, float hi) { f32x2 v = {lo, hi}; hwbf16x2 b = __builtin_convertvector(v, hwbf16x2); return __builtin_bit_cast(unsigned, b); }
DI float bflo(unsigned w) { return __uint_as_float(w << 16); }
DI float bfhi(unsigned w) { return __uint_as_float(w & 0xffff0000u); }
DI float bf1(bf16_t h) { return __uint_as_float((unsigned)h << 16); }
DI bf16_t f2bf(float f) { return (bf16_t)(pk2(f, 0.f) & 0xffffu); }
template <int CTRL, int ROW_MASK> DI float dpp_f(float v) {
    return __builtin_bit_cast(float, __builtin_amdgcn_update_dpp(0, __builtin_bit_cast(int, v), CTRL, ROW_MASK, 0xf, false));
}
DI float wave_sum(float v) {
    v += dpp_f<0xB1, 0xf>(v);
    v += dpp_f<0x4E, 0xf>(v);
    v += dpp_f<0x141, 0xf>(v);
    v += dpp_f<0x140, 0xf>(v);
    v += dpp_f<0x142, 0xa>(v);
    v += dpp_f<0x143, 0xc>(v);
    return __builtin_bit_cast(float, __builtin_amdgcn_ds_bpermute(63 * 4, __builtin_bit_cast(int, v)));
}
template <int CTRL, int ROW_MASK> DI float dpp_keep(float v) {
    return __builtin_bit_cast(float, __builtin_amdgcn_update_dpp(__builtin_bit_cast(int, v), __builtin_bit_cast(int, v), CTRL, ROW_MASK, 0xf, false));
}
DI float wave_max(float v) {
    v = fmaxf(v, dpp_keep<0xB1, 0xf>(v));
    v = fmaxf(v, dpp_keep<0x4E, 0xf>(v));
    v = fmaxf(v, dpp_keep<0x141, 0xf>(v));
    v = fmaxf(v, dpp_keep<0x140, 0xf>(v));
    v = fmaxf(v, dpp_keep<0x142, 0xa>(v));
    v = fmaxf(v, dpp_keep<0x143, 0xc>(v));
    return __builtin_bit_cast(float, __builtin_amdgcn_readlane(__builtin_bit_cast(int, v), 63));
}
DI float fsigmoid(float x) { return __builtin_amdgcn_rcpf(1.f + __expf(-x)); }
#define LDS_WAIT() asm volatile("s_waitcnt lgkmcnt(0)" ::: "memory")
#define LDS_BARRIER() do { asm volatile("s_waitcnt lgkmcnt(0)" ::: "memory"); __builtin_amdgcn_s_barrier(); asm volatile("" ::: "memory"); } while (0)
#define MFMA32(a, b, c) __builtin_amdgcn_mfma_f32_32x32x16_bf16((a), (b), (c), 0, 0, 0)
DI int crow(int reg, int h) { return (reg & 3) + 8 * (reg >> 2) + 4 * h; }
DI bf16x8 pack_step(const f32x16& x, int s) {
    u32x4 p;
    p[0] = pk2(x[8 * s + 0], x[8 * s + 1]); p[1] = pk2(x[8 * s + 2], x[8 * s + 3]); p[2] = pk2(x[8 * s + 4], x[8 * s + 5]); p[3] = pk2(x[8 * s + 6], x[8 * s + 7]);
    return __builtin_bit_cast(bf16x8, p);
}
DI bf16x8 cat8(u32x2 lo, u32x2 hi) { u32x4 p; p[0] = lo[0]; p[1] = lo[1]; p[2] = hi[0]; p[3] = hi[1]; return __builtin_bit_cast(bf16x8, p); }

struct Args {
    const float* in[30];
    float* out;
    unsigned char* ws;
    int ph_lo, ph_hi;
};

struct Ctx {
    const float* const* in;
    float* out; unsigned char* ws;
    LAS unsigned char* lds;
    int wave, G, bid;
};
DI int lane_id() { return __builtin_amdgcn_mbcnt_hi(~0u, __builtin_amdgcn_mbcnt_lo(~0u, 0u)); }
DI int lane_id_here() { int l = lane_id(); asm volatile("" : "+v"(l)); return l; }

DI void p0_transpose_item(const float* __restrict__ W, int ldw, int src_col0, int nvalid, const float* __restrict__ gain,
                          bf16_t* __restrict__ WT, int K, int dst_row0, int kb, LAS float* scr, int lane, int kofs = 0) {
    const int k0 = 64 * kb;
    {
        const int kr = lane >> 3, n4 = 4 * (lane & 7);
        f32x4 v[8];
        float gv[8];
#pragma unroll
        for (int i = 0; i < 8; ++i) gv[i] = 1.f;
        if (gain) {
#pragma unroll
            for (int i = 0; i < 8; ++i) gv[i] = gain[k0 + kr + 8 * i];
        }
        if (nvalid > 0) {
            const float* wp = W + (size_t)(k0 + kr) * ldw + src_col0 + (n4 < nvalid ? n4 : 0);
#pragma unroll
            for (int i = 0; i < 8; ++i) v[i] = __builtin_nontemporal_load((const f32x4*)(wp + (size_t)(8 * i) * ldw));
        }
#pragma unroll
        for (int i = 0; i < 8; ++i) {
            const int kk = kr + 8 * i;
            f32x4 t = (nvalid > 0 && n4 < nvalid) ? v[i] : (f32x4){0.f, 0.f, 0.f, 0.f};
            t = t * gv[i];
            LAS float* d = scr + kk * 33 + n4;
            d[0] = t[0]; d[1] = t[1]; d[2] = t[2]; d[3] = t[3];
        }
    }
    LDS_WAIT(); asm volatile("" ::: "memory");
    const int c = lane & 7;
#pragma unroll
    for (int j = 0; j < 4; ++j) {
        const int n = (lane >> 3) + 8 * j; const LAS float* s = scr + (8 * c) * 33 + n;
        u32x4 o; o.x = pk2(s[0 * 33], s[1 * 33]); o.y = pk2(s[2 * 33], s[3 * 33]); o.z = pk2(s[4 * 33], s[5 * 33]); o.w = pk2(s[6 * 33], s[7 * 33]);
        *(u32x4*)(WT + (size_t)(dst_row0 + n) * K + kofs + k0 + 8 * c) = o;
    }
    LDS_WAIT(); asm volatile("" ::: "memory");
}
template <int NR> DI void p0_rows(const float* const (&xrow)[NR], bf16_t* const (&orow)[NR], float* const (&rs_out)[NR], int lane) {
    f32x4 v[NR][4];
#pragma unroll
    for (int q = 0; q < NR; ++q)
#pragma unroll
        for (int j = 0; j < 4; ++j) v[q][j] = __builtin_nontemporal_load((const f32x4*)xrow[q] + lane + 64 * j);
#pragma unroll
    for (int q = 0; q < NR; ++q) {
        float s = 0.f;
#pragma unroll
        for (int j = 0; j < 4; ++j) s += (v[q][j].x * v[q][j].x + v[q][j].y * v[q][j].y) + (v[q][j].z * v[q][j].z + v[q][j].w * v[q][j].w);
        s = wave_sum(s);
        const float r = rsqrtf(s * (1.f / 1024.f) + EPS);
        u32x2* o8 = (u32x2*)orow[q] + lane;
#pragma unroll
        for (int j = 0; j < 4; ++j) { u32x2 w; w.x = pk2(v[q][j].x * r, v[q][j].y * r); w.y = pk2(v[q][j].z * r, v[q][j].w * r); o8[64 * j] = w; }
        if (lane == 0) *rs_out[q] = r;
    }
}
DI void p0_prologue(const Ctx& C) {
    const int lane = lane_id();
    LAS float* scr = (LAS float*)(C.lds + C.wave * 16384);
    const int gw = C.bid * 8 + C.wave, NGW = C.G * 8;
    const float* const* in = C.in;
    unsigned char* ws = C.ws;
    constexpr int I_IN = 16 * 312, I_MK = 16 * 32, I_PA = 8 * 32, I_SQ = 16 * 32, I_GU = 16 * 176, I_DN = 44 * 32;
    constexpr int NITEMS = I_IN + 2 * I_MK + I_PA + 4 * I_SQ + I_GU + I_DN;
    for (int it = gw; it < NITEMS; it += NGW) {
        int r = it;
        if (r < I_IN) {
            const int G = r % 312, kb = r / 312; int src, nv;
            if (G < 240) { src = 32 * G; nv = 32; } else if (G < 304) { src = 7696 + 32 * (G - 240); nv = 32; } else if (G == 304) { src = 7680; nv = 16; } else { src = 0; nv = 0; }
            p0_transpose_item(in[11], NIN_SRC, src, nv, in[9], (bf16_t*)(ws + WS_WIN), 1024, 32 * G, kb, scr, lane); continue; }
        r -= I_IN;
        if (r < I_MK) { p0_transpose_item(in[19], 1024, 32 * (r % 32), 32, in[18], (bf16_t*)(ws + WS_WMKV), 1024, 32 * (r % 32), r / 32, scr, lane); continue; } r -= I_MK;
        if (r < I_MK) { p0_transpose_item(in[20], 1024, 32 * (r % 32), 32, in[18], (bf16_t*)(ws + WS_WMKV), 1024, 1024 + 32 * (r % 32), r / 32, scr, lane); continue; } r -= I_MK;
        if (r < I_PA) { p0_transpose_item(in[15], 1024, 32 * (r % 32), 32, nullptr, (bf16_t*)(ws + WS_WPA), 1536, 32 * (r % 32), r / 32, scr, lane, 0); continue; } r -= I_PA;
        if (r < I_SQ) { p0_transpose_item(in[16], 1024, 32 * (r % 32), 32, nullptr, (bf16_t*)(ws + WS_WPA), 1536, 32 * (r % 32), r / 32, scr, lane, 512); continue; } r -= I_SQ;
        if (r < I_SQ) { p0_transpose_item(in[17], 1024, 32 * (r % 32), 32, nullptr, (bf16_t*)(ws + WS_WOUT), 1024, 32 * (r % 32), r / 32, scr, lane); continue; } r -= I_SQ;
        if (r < I_SQ) { p0_transpose_item(in[23], 1024, 32 * (r % 32), 32, in[21], (bf16_t*)(ws + WS_WMQ), 1024, 32 * (r % 32), r / 32, scr, lane); continue; } r -= I_SQ;
        if (r < I_SQ) { p0_transpose_item(in[24], 1024, 32 * (r % 32), 32, nullptr, (bf16_t*)(ws + WS_WMO), 1024, 32 * (r % 32), r / 32, scr, lane); continue; } r -= I_SQ;
        if (r < I_GU) {
            const int G = r % 176, kb = r / 176, j = G >> 3, sub = G & 7;
            const float* W = sub < 4 ? in[27] : in[28];
            p0_transpose_item(W, DFF, 128 * j + 32 * (sub & 3), 32, in[25], (bf16_t*)(ws + WS_WGU), 1024, 32 * G, kb, scr, lane); continue; }
        r -= I_GU;
        p0_transpose_item(in[29], 1024, 32 * (r % 32), 32, nullptr, (bf16_t*)(ws + WS_WDN), DFF, 32 * (r % 32), r / 32, scr, lane);
    }
    bf16_t* XB = (bf16_t*)(ws + WS_XB); float* RS = (float*)(ws + WS_RS);
    for (int m = gw; m < MT; m += 4 * NGW) {
        if (m + 3 * NGW < MT) {
            const float* src[4]; bf16_t* dst[4]; float* rsp[4];
#pragma unroll
            for (int q = 0; q < 4; ++q) { const int mm = m + q * NGW; src[q] = mm < MP ? in[0] + (size_t)mm * 1024 : in[1] + (size_t)(mm - MP) * 1024; dst[q] = XB + (size_t)mm * 1024; rsp[q] = RS + mm; }
            p0_rows<4>(src, dst, rsp, lane);
        } else {
            for (int mm = m; mm < MT; mm += NGW) {
                const float* src[1] = {mm < MP ? in[0] + (size_t)mm * 1024 : in[1] + (size_t)(mm - MP) * 1024}; bf16_t* dst[1] = {XB + (size_t)mm * 1024}; float* rsp[1] = {RS + mm};
                p0_rows<1>(src, dst, rsp, lane);
            }
        }
    }
    bf16_t* MEMB = (bf16_t*)(ws + WS_MEMB); float* RSM = (float*)(ws + WS_RSMEM);
    for (int m = gw; m < 1024; m += NGW) { const float* src[1] = {in[7] + (size_t)m * 1024}; bf16_t* dst[1] = {MEMB + (size_t)m * 1024}; float* rsp[1] = {RSM + m}; p0_rows<1>(src, dst, rsp, lane); }
}

DI void st_bf16x8(bf16_t* p, f32x4 v0, f32x4 v1) {
    u32x4 w; w.x = pk2(v0[0], v0[1]); w.y = pk2(v0[2], v0[3]); w.z = pk2(v1[0], v1[1]); w.w = pk2(v1[2], v1[3]);
    *(u32x4*)p = w;
}
DI void st_rowpair(bf16_t* row_base, int k, u32x2 a, u32x2 b, int hh) {
    const auto r0 = __builtin_amdgcn_permlane32_swap(a.x, b.x, false, false);
    const auto r1 = __builtin_amdgcn_permlane32_swap(a.y, b.y, false, false);
    u32x4 w; w.x = r0[0]; w.y = r1[0]; w.z = r0[1]; w.w = r1[1];
    *(u32x4*)(row_base + 8 * k + 8 * hh) = w;
}
DI void st_bf16x8_nt(bf16_t* p, f32x4 v0, f32x4 v1) {
    u32x4 w; w.x = pk2(v0[0], v0[1]); w.y = pk2(v0[2], v0[3]); w.z = pk2(v1[0], v1[1]); w.w = pk2(v1[2], v1[3]);
    __builtin_nontemporal_store(w, (u32x4*)p);
}
DI int attn_prow(int row, int g) {
    if (row >= MP) return row;
    const int t = row & 8191, sh = 2 * g;
    return (row & ~8191) + ((t & ((1 << sh) - 1)) << (13 - sh)) + (t >> sh);
}
struct EpiIn {
    static constexpr bool PERM = true, AFTER_DRAIN = false, HAS_MID = false;
    const float* rs; unsigned char* ws; float* out;
    DI void operator()(const f32x4 (&acc)[2][2][4][2], const pg8::Unit& u, int wr, int wc, int fr, int fq) const {
        const int pn = u.pn, rbase = u.pm * 256 + wr * 64 + fr, cl = wc * 32 + 8 * fq;
        if (pn == 38) {
            if (wc == 0 && fq < 2) {
                float* FB = (float*)(ws + WS_FB);
#pragma unroll
                for (int ai = 0; ai < 2; ++ai)
#pragma unroll
                    for (int m = 0; m < 4; ++m) { const int row = rbase + ai * 128 + m * 16;
                        *(f32x4*)(FB + (size_t)row * 16 + 8 * fq) = acc[ai][0][m][0]; *(f32x4*)(FB + (size_t)row * 16 + 8 * fq + 4) = acc[ai][0][m][1]; }
            }
            return;
        }
        bf16_t* dst; int ldc, cbase; float sc = 1.f; int act = 0;
        int perm_g = -1;
        if (pn < 6)       { perm_g = pn >> 1; dst = (bf16_t*)(ws + WS_QA) + (size_t)(4 * perm_g + 2 * (pn & 1)) * MT * 128; ldc = 128; cbase = 0; sc = QA_SCALE; }
        else if (pn < 12) { perm_g = (pn - 6) >> 1; dst = (bf16_t*)(ws + WS_KA) + (size_t)(4 * perm_g + 2 * (pn & 1)) * MT * 128; ldc = 128; cbase = 0; }
        else if (pn < 18) { perm_g = (pn - 12) >> 1; dst = (bf16_t*)(ws + WS_VA) + (size_t)(4 * perm_g + 2 * (pn & 1)) * MT * 128; ldc = 128; cbase = 0; }
        else if (pn < 20) { dst = (bf16_t*)(ws + WS_QB); ldc = 512; cbase = (pn - 18) * 256; sc = QB_SCALE; }
        else if (pn < 22) { dst = (bf16_t*)(ws + WS_KB); ldc = 512; cbase = (pn - 20) * 256; }
        else if (pn < 26) { dst = (bf16_t*)(ws + WS_VB); ldc = 1024; cbase = (pn - 22) * 256; }
        else if (pn < 30) { dst = (bf16_t*)(ws + WS_SGB); ldc = 1024; cbase = (pn - 26) * 256; act = 1; }
        else if (pn < 34) { dst = (bf16_t*)(ws + WS_SGA); ldc = 1024; cbase = (pn - 30) * 256; act = 2; }
        else              { dst = (bf16_t*)(ws + WS_SGBT); ldc = 1024; cbase = (pn - 34) * 256; act = 2; }
        const bool iskv = (pn >= 6 && pn < 18);
        const bool maywin = iskv && (u.pm == 128 || (u.pm & 31) >= 24);
        const int kv = pn >= 12 ? 1 : 0, pc = (pn - 6) % 6, g = pc >> 1, cg0 = (pc & 1) * 256, keep = 128 << (2 * g);
        const size_t offp = g == 0 ? O_W1P : (g == 1 ? O_W2P : O_W3P), offs = g == 0 ? O_W1S : (g == 1 ? O_W2S : O_W3S);
#pragma unroll
        for (int ai = 0; ai < 2; ++ai)
#pragma unroll
            for (int m = 0; m < 4; ++m) {
                const int row = rbase + ai * 128 + m * 16;
                bf16_t* rowp = dst + (size_t)(perm_g >= 0 ? attn_prow(row, perm_g) : row) * ldc + cbase + cl;
                float* wp = nullptr;
                if (maywin) {
                    if (row >= MP) wp = out + offs + ((size_t)(row - MP) * 2 + kv) * 512 + cg0 + cl;
                    else { const int b = row >> 13, t = row & 8191; if (t >= SEQ - keep) wp = out + offp + ((size_t)(b * keep + t - (SEQ - keep)) * 2 + kv) * 512 + cg0 + cl; }
                }
#pragma unroll
                for (int bj = 0; bj < 2; ++bj) {
                    f32x4 v0 = acc[ai][bj][m][0], v1 = acc[ai][bj][m][1];
                    if (wp) { *(f32x4*)(wp + bj * 128) = v0; *(f32x4*)(wp + bj * 128 + 4) = v1; }
                    if (act) {
#pragma unroll
                        for (int i = 0; i < 4; ++i) { const float s0 = fsigmoid(v0[i]), s1 = fsigmoid(v1[i]); v0[i] = act == 1 ? v0[i] * s0 : s0; v1[i] = act == 1 ? v1[i] * s1 : s1; }
                    }
                    st_bf16x8_nt(rowp + (perm_g >= 0 ? (size_t)bj * MT * 128 : (size_t)bj * 128), v0 * sc, v1 * sc);
                }
            }
    }
};
struct EpiMemKV {
    static constexpr bool PERM = true, AFTER_DRAIN = false, HAS_MID = false;
    const float* rs; unsigned char* ws; float* out;
    DI void operator()(const f32x4 (&acc)[2][2][4][2], const pg8::Unit& u, int wr, int wc, int fr, int fq) const {
        const int pn = u.pn, rbase = u.pm * 256 + wr * 64 + fr, cl = wc * 32 + 8 * fq, kv = pn >> 2, c0 = (pn & 3) * 256 + cl;
        bf16_t* MK = (bf16_t*)(ws + WS_MK); bf16_t* MVT = (bf16_t*)(ws + WS_MVT);
#pragma unroll
        for (int ai = 0; ai < 2; ++ai)
#pragma unroll
            for (int m = 0; m < 4; ++m) {
                const int row = rbase + ai * 128 + m * 16;
                float* op = out + O_MEMP + ((size_t)row * 2 + kv) * 1024 + c0;
#pragma unroll
                for (int bj = 0; bj < 2; ++bj) {
                    const f32x4 v0 = acc[ai][bj][m][0], v1 = acc[ai][bj][m][1];
                    *(f32x4*)(op + bj * 128) = v0; *(f32x4*)(op + bj * 128 + 4) = v1;
                    if (kv == 0) st_bf16x8(MK + (size_t)row * 1024 + c0 + bj * 128, v0, v1);
                    else {
                        bf16_t* vp = MVT + ((size_t)(row >> 8) * 1024 + c0 + bj * 128) * 256 + (row & 255);
#pragma unroll
                        for (int i = 0; i < 4; ++i) { vp[(size_t)i * 256] = f2bf(v0[i]); vp[(size_t)(i + 4) * 256] = f2bf(v1[i]); }
                    }
                }
            }
    }
};

struct EpiNull {
    static constexpr bool PERM = true, AFTER_DRAIN = false, HAS_MID = false;
    float* sink;
    DI void operator()(const f32x4 (&acc)[2][2][4][2], const pg8::Unit& u, int wr, int wc, int fr, int fq) const {
        float s = 0.f;
#pragma unroll
        for (int ai = 0; ai < 2; ++ai)
#pragma unroll
            for (int bj = 0; bj < 2; ++bj)
#pragma unroll
                for (int m = 0; m < 4; ++m)
#pragma unroll
                    for (int n = 0; n < 2; ++n) s += acc[ai][bj][m][n][0] + acc[ai][bj][m][n][1] + acc[ai][bj][m][n][2] + acc[ai][bj][m][n][3];
        if (fr == 0 && fq == 0) sink[(u.pm * 64 + u.pn) * 8 + wr * 4 + wc] = s;
    }
};

constexpr int GL_QP = 0, GL_KP = 17408, GL_KPT = 34816, GL_VT = 53248, GL_OT = 90112, GL_FB = 123904, GL_PFX = 128000, GL_EBL = 136192,
              GL_WF2 = 136704, GL_BF2 = 144896, GL_GN = 145408, GL_END = 146432;
constexpr int QP_PITCH = 272, KT_PITCH = 144, OT_PITCH = 528;
static_assert(GL_END <= LDS_BYTES, "gla lds");

DI float logsig16(float z) {
    const float a = fabsf(z);
    return (fminf(z, 0.f) - __logf(1.f + __expf(-a))) * 0.0625f;
}

constexpr int GL_XF = GL_OT;
constexpr size_t WS_OIG = WS_XB, WS_DSG = 943 * MiB, WS_QPG = 959 * MiB, WS_EBLG = 991 * MiB, WS_END2 = 992 * MiB;
static_assert(WS_OIG + (size_t)2048 * 32768 <= WS_MEMB && WS_DSG >= WS_END && WS_DSG + (size_t)256 * 65536 <= WS_QPG && WS_QPG + (size_t)2048 * 16384 <= WS_EBLG && WS_EBLG + MiB <= WS_END2, "gla ws map");

DI void gla_load_consts(const Ctx& C, int h, int tid) {
    LAS unsigned char* lds = C.lds;
    const float* wf2 = C.in[12]; const float* bf2 = C.in[13]; const float* gn = C.in[14];
    LAS float* WF = (LAS float*)(lds + GL_WF2);
    float wv[4];
#pragma unroll
    for (int k = 0; k < 4; ++k) { const int i = tid + NTHREADS * k; wv[k] = wf2[(size_t)(i >> 7) * 512 + h * 128 + (i & 127)]; }
    const float bfv = tid < 128 ? bf2[h * 128 + tid] : 0.f, gnv = tid < 256 ? gn[tid] : 0.f;
#pragma unroll
    for (int k = 0; k < 4; ++k) WF[tid + NTHREADS * k] = wv[k];
    if (tid < 128) ((LAS float*)(lds + GL_BF2))[tid] = bfv;
    if (tid < 256) ((LAS float*)(lds + GL_GN))[tid] = gnv;
}

constexpr int NSUB = 8, NUNIT = 16 * (128 / NSUB);
constexpr int GL_CUM = GL_GN;
DI void gla_pass_a_unit(const Ctx& C, int unit) {
    LAS unsigned char* lds = C.lds;
    const int lane = lane_id_here(), w = C.wave, tid = w * 64 + lane, r = lane & 31, hh = lane >> 5;
    const int bh = unit / (128 / NSUB), sc = unit % (128 / NSUB), b = bh >> 2, h = bh & 3;
    unsigned char* ws = C.ws;
    const bf16_t* QB = (const bf16_t*)(ws + WS_QB); const bf16_t* KB = (const bf16_t*)(ws + WS_KB); const bf16_t* VB = (const bf16_t*)(ws + WS_VB);
    const float* FB = (const float*)(ws + WS_FB);
    const size_t tok0 = (size_t)b * SEQ + (size_t)sc * NSUB * 64;
    const int cg = tid & 31, rg = tid >> 5;
    u32x2 q4[4], k4[4]; u32x4 vreg[4]; f32x4 fbreg = {0.f, 0.f, 0.f, 0.f};
#define GLA_ISSUE_LOADS(jn) do { const size_t t0_ = tok0 + (size_t)(jn) * 64; \
        _Pragma("unroll") for (int i = 0; i < 4; ++i) { \
            q4[i] = *(const u32x2*)(QB + (t0_ + 4 * rg + i) * 512 + h * 128 + 4 * cg); \
            k4[i] = *(const u32x2*)(KB + (t0_ + 4 * rg + i) * 512 + h * 128 + 4 * cg); \
            vreg[i] = *(const u32x4*)(VB + (t0_ + lane) * 1024 + h * 256 + 32 * w + 8 * i); } \
        if (tid < 256) fbreg = *(const f32x4*)(FB + t0_ * 16 + tid * 4); } while (0)
    GLA_ISSUE_LOADS(0);
    LDS_BARRIER();
    gla_load_consts(C, h, tid);
    if (tid < 128) ((LAS float*)(lds + GL_CUM))[tid] = 1.f;
    f32x16 S[4];
#pragma unroll
    for (int i = 0; i < 4; ++i)
#pragma unroll
        for (int j = 0; j < 16; ++j) S[i][j] = 0.f;
    for (int jc = 0; jc < NSUB; ++jc) {
        const size_t cunit = (size_t)bh * 128 + sc * NSUB + jc;
        if (tid < 256) *(LAS f32x4*)(lds + GL_FB + tid * 16) = fbreg;
        {
            LAS bf16_t* VT = (LAS bf16_t*)(lds + GL_VT);
#pragma unroll
            for (int i = 0; i < 4; ++i)
#pragma unroll
                for (int j = 0; j < 4; ++j) {
                    const unsigned wv = vreg[i][j]; const int e = 32 * w + 8 * i + 2 * j;
                    VT[e * (KT_PITCH / 2) + lane] = (bf16_t)(wv & 0xffffu); VT[(e + 1) * (KT_PITCH / 2) + lane] = (bf16_t)(wv >> 16);
                }
        }
        LDS_BARRIER();
        float bl[4][4];
        {
            const LAS float* WF = (const LAS float*)(lds + GL_WF2); const LAS float* FBs = (const LAS float*)(lds + GL_FB);
            const f32x4 bb = *(const LAS f32x4*)(lds + GL_BF2 + 16 * cg);
            f32x4 z[4] = {bb, bb, bb, bb};
#pragma unroll
            for (int j4 = 0; j4 < 4; ++j4) {
                f32x4 f[4];
#pragma unroll
                for (int i = 0; i < 4; ++i) f[i] = *(const LAS f32x4*)(FBs + (4 * rg + i) * 16 + 4 * j4);
#pragma unroll
                for (int jj = 0; jj < 4; ++jj) {
                    const f32x4 wv = *(const LAS f32x4*)(WF + (4 * j4 + jj) * 128 + 4 * cg);
#pragma unroll
                    for (int i = 0; i < 4; ++i) z[i] += wv * f[i][jj];
                }
            }
#pragma unroll
            for (int c = 0; c < 4; ++c) {
                float run = 0.f;
#pragma unroll
                for (int i = 0; i < 4; ++i) { run += logsig16(z[i][c]); bl[i][c] = run; }
            }
            *(LAS f32x4*)(lds + GL_PFX + (rg * 128 + 4 * cg) * 4) = (f32x4){bl[3][0], bl[3][1], bl[3][2], bl[3][3]};
        }
        LDS_BARRIER();
        f32x4 ebnew = {1.f, 1.f, 1.f, 1.f};
        {
            f32x4 pre = {0.f, 0.f, 0.f, 0.f}, tot = {0.f, 0.f, 0.f, 0.f};
#pragma unroll
            for (int g = 0; g < 16; ++g) { const f32x4 p = *(const LAS f32x4*)(lds + GL_PFX + (g * 128 + 4 * cg) * 4); tot += p; if (g < rg) pre += p; }
            const f32x4 cum = *(const LAS f32x4*)(lds + GL_CUM + 16 * cg);
            ebnew = (f32x4){__expf(tot[0]), __expf(tot[1]), __expf(tot[2]), __expf(tot[3])};
            if (rg == 0) *(LAS f32x4*)(lds + GL_EBL + 16 * cg) = ebnew;
            float kq[4][4];
            bf16_t* QPG = (bf16_t*)(ws + WS_QPG) + cunit * 8192;
#pragma unroll
            for (int i = 0; i < 4; ++i) {
                float qv[4] = {bflo(q4[i][0]), bfhi(q4[i][0]), bflo(q4[i][1]), bfhi(q4[i][1])};
                float kv[4] = {bflo(k4[i][0]), bfhi(k4[i][0]), bflo(k4[i][1]), bfhi(k4[i][1])};
                float qo[4];
#pragma unroll
                for (int c = 0; c < 4; ++c) { const float bv = pre[c] + bl[i][c]; const float e = __expf(bv); qo[c] = qv[c] * e; kq[i][c] = kv[c] * __builtin_amdgcn_rcpf(e); }
                u32x2 wq; wq.x = pk2(qo[0], qo[1]); wq.y = pk2(qo[2], qo[3]);
                u32x2 wk; wk.x = pk2(kq[i][0], kq[i][1]); wk.y = pk2(kq[i][2], kq[i][3]);
                u32x2 wg; wg.x = pk2(qo[0] * cum[0], qo[1] * cum[1]); wg.y = pk2(qo[2] * cum[2], qo[3] * cum[3]);
                *(LAS u32x2*)(lds + GL_QP + (4 * rg + i) * QP_PITCH + 8 * cg) = wq;
                *(LAS u32x2*)(lds + GL_KP + (4 * rg + i) * QP_PITCH + 8 * cg) = wk;
                *(u32x2*)(QPG + (4 * rg + i) * 128 + 4 * cg) = wg;
            }
#pragma unroll
            for (int c = 0; c < 4; ++c) { u32x2 wt; wt.x = pk2(kq[0][c], kq[1][c]); wt.y = pk2(kq[2][c], kq[3][c]);
                *(LAS u32x2*)(lds + GL_KPT + (4 * cg + c) * KT_PITCH + 8 * rg) = wt; }
        }
        LDS_BARRIER();
        if (rg == 0) { const f32x4 cum = *(const LAS f32x4*)(lds + GL_CUM + 16 * cg); *(LAS f32x4*)(lds + GL_CUM + 16 * cg) = cum * ebnew; }
        f32x16 O[2];
#pragma unroll
        for (int i = 0; i < 2; ++i)
#pragma unroll
            for (int j = 0; j < 16; ++j) O[i][j] = 0.f;
        if (jc > 0) {
#pragma unroll
            for (int dt = 0; dt < 4; ++dt)
#pragma unroll
                for (int s = 0; s < 2; ++s) {
                    const bf16x8 sb = pack_step(S[dt], s);
#pragma unroll
                    for (int ct = 0; ct < 2; ++ct) {
                        const LAS unsigned char* p = lds + GL_QP + (32 * ct + r) * QP_PITCH + (32 * dt + 16 * s + 4 * hh) * 2;
                        const bf16x8 a = cat8(*(const LAS u32x2*)p, *(const LAS u32x2*)(p + 16));
                        O[ct] = MFMA32(a, sb, O[ct]);
                    }
                    __builtin_amdgcn_sched_barrier(0);
                }
        }
        if (w < 3) {
            const int jt = w == 2 ? 1 : 0, ct = w == 0 ? 0 : 1;
            f32x16 X;
#pragma unroll
            for (int j = 0; j < 16; ++j) X[j] = 0.f;
#pragma unroll
            for (int s8 = 0; s8 < 8; ++s8) {
                const bf16x8 a = *(const LAS bf16x8*)(lds + GL_KP + (32 * jt + r) * QP_PITCH + (16 * s8 + 8 * hh) * 2);
                const bf16x8 bq = *(const LAS bf16x8*)(lds + GL_QP + (32 * ct + r) * QP_PITCH + (16 * s8 + 8 * hh) * 2);
                X = MFMA32(a, bq, X);
            }
            if (jt == ct) {
#pragma unroll
                for (int j = 0; j < 16; ++j) if (crow(j, hh) > r) X[j] = 0.f;
            }
            *(LAS u32x4*)(lds + GL_XF + ((w * 2 + 0) * 64 + lane) * 16) = __builtin_bit_cast(u32x4, pack_step(X, 0));
            *(LAS u32x4*)(lds + GL_XF + ((w * 2 + 1) * 64 + lane) * 16) = __builtin_bit_cast(u32x4, pack_step(X, 1));
        }
        __builtin_amdgcn_sched_barrier(0);
        if (jc + 1 < NSUB) GLA_ISSUE_LOADS(jc + 1);
        __builtin_amdgcn_sched_barrier(0);
        {
#pragma unroll
            for (int dt = 0; dt < 4; ++dt) {
#pragma unroll
                for (int s = 0; s < 4; ++s) {
                    const bf16x8 a = *(const LAS bf16x8*)(lds + GL_KPT + (32 * dt + r) * KT_PITCH + (16 * s + 8 * hh) * 2);
                    const bf16x8 vb = *(const LAS bf16x8*)(lds + GL_VT + (32 * w + r) * KT_PITCH + (16 * s + 8 * hh) * 2);
                    S[dt] = MFMA32(a, vb, S[dt]);
                }
#pragma unroll
                for (int g4 = 0; g4 < 4; ++g4) {
                    const f32x4 e = *(const LAS f32x4*)(lds + GL_EBL + (32 * dt + 8 * g4 + 4 * hh) * 4);
#pragma unroll
                    for (int i = 0; i < 4; ++i) S[dt][4 * g4 + i] *= e[i];
                }
                __builtin_amdgcn_sched_barrier(0);
            }
        }
        LDS_BARRIER();
        {
#pragma unroll
            for (int ct = 0; ct < 2; ++ct)
#pragma unroll
                for (int jt = 0; jt <= ct; ++jt) {
                    const int tile = ct == 0 ? 0 : (jt == 0 ? 1 : 2);
#pragma unroll
                    for (int s = 0; s < 2; ++s) {
                        const bf16x8 xa = *(const LAS bf16x8*)(lds + GL_XF + ((tile * 2 + s) * 64 + lane) * 16);
                        const LAS unsigned char* p = lds + GL_VT + (32 * w + r) * KT_PITCH + (32 * jt + 16 * s + 4 * hh) * 2;
                        const bf16x8 vb = cat8(*(const LAS u32x2*)p, *(const LAS u32x2*)(p + 16));
                        O[ct] = MFMA32(xa, vb, O[ct]);
                    }
                }
            u32x2* OIG = (u32x2*)(ws + WS_OIG) + cunit * 4096 + w * 64 + lane;
#pragma unroll
            for (int ct = 0; ct < 2; ++ct)
#pragma unroll
                for (int g4 = 0; g4 < 4; ++g4) { u32x2 o; o.x = pk2(O[ct][4 * g4], O[ct][4 * g4 + 1]); o.y = pk2(O[ct][4 * g4 + 2], O[ct][4 * g4 + 3]); OIG[(ct * 4 + g4) * 512] = o; }
        }
    }
#undef GLA_ISSUE_LOADS
    {
        int l2 = lane_id_here(); const int w2 = w;
        u32x4* DSG = (u32x4*)(ws + WS_DSG) + (size_t)unit * 4096 + w2 * 64 + l2;
#pragma unroll
        for (int dt = 0; dt < 4; ++dt) { DSG[(dt * 2 + 0) * 512] = __builtin_bit_cast(u32x4, pack_step(S[dt], 0)); DSG[(dt * 2 + 1) * 512] = __builtin_bit_cast(u32x4, pack_step(S[dt], 1)); }
        const int t2 = w2 * 64 + l2;
        if (t2 < 128) ((float*)(ws + WS_EBLG))[(size_t)unit * 128 + t2] = ((const LAS float*)(lds + GL_CUM))[t2];
    }
}

DI void gla_pass_b(const Ctx& C) {
    const int lane = lane_id_here(), tid = C.wave * 64 + lane, gid = C.bid * NTHREADS + tid;
    unsigned char* ws = C.ws;
    constexpr int UPB = 128 / NSUB;
    for (int id = gid; id < 16 * 8192; id += C.G * NTHREADS) {
        const int bh = id >> 13, f = (id >> 1) & 4095, half = id & 1;
        const int fl = f & 63, fw = (f >> 6) & 7, fs = (f >> 9) & 1, fdt = f >> 10;
        const int d0 = 32 * fdt + 16 * fs + 8 * half + 4 * (fl >> 5), e = 32 * fw + (fl & 31);
        u32x2* p = (u32x2*)(ws + WS_DSG) + ((size_t)bh * UPB * 4096 + f) * 2 + half;
        const float* eb = (const float*)(ws + WS_EBLG) + (size_t)bh * UPB * 128 + d0;
        float s0 = 0.f, s1 = 0.f, s2 = 0.f, s3 = 0.f;
#pragma unroll
        for (int u = 0; u < UPB; ++u) {
            const u32x2 ds = p[(size_t)u * 8192];
            const f32x4 ev = *(const f32x4*)(eb + u * 128);
            u32x2 st; st.x = pk2(s0, s1); st.y = pk2(s2, s3);
            p[(size_t)u * 8192] = st;
            s0 = ev[0] * s0 + bflo(ds.x); s1 = ev[1] * s1 + bfhi(ds.x); s2 = ev[2] * s2 + bflo(ds.y); s3 = ev[3] * s3 + bfhi(ds.y);
        }
        float* gp = C.out + O_GLAP + ((size_t)bh * 128 + d0) * 256 + e;
        gp[0] = s0; gp[256] = s1; gp[512] = s2; gp[768] = s3;
    }
}

DI void gla_pass_c(const Ctx& C) {
    LAS unsigned char* lds = C.lds;
    const int lane = lane_id_here(), w = C.wave, tid = w * 64 + lane, r = lane & 31, hh = lane >> 5;
    unsigned char* ws = C.ws;
    const int orow = tid >> 3, occ = tid & 7;
#define GLC_QLOAD(un) do { const u32x4* q_ = (const u32x4*)((const bf16_t*)(ws + WS_QPG) + (size_t)(un) * 8192); qst0 = q_[tid]; qst1 = q_[tid + 512]; } while (0)
#define GLC_QWRITE() do { *(LAS u32x4*)(lds + GL_QP + (tid >> 4) * QP_PITCH + 16 * (tid & 15)) = qst0; *(LAS u32x4*)(lds + GL_QP + (32 + (tid >> 4)) * QP_PITCH + 16 * (tid & 15)) = qst1; } while (0)
    const bool xs = C.G == 256;
#define GLC_UNIT(li) (xs ? (((li) & ~255) | (((li) & 7) << 5) | (((li) >> 3) & 31)) : (li))
    int li = C.bid;
    int unit = GLC_UNIT(li);
    u32x4 qst0 = {0u, 0u, 0u, 0u}, qst1 = {0u, 0u, 0u, 0u};
    if (li < 2048) GLC_QLOAD(unit);
    LDS_BARRIER();
    GLC_QWRITE();
    if (tid < 256) ((LAS float*)(lds + GL_GN))[tid] = C.in[14][tid];
    LDS_BARRIER();
    for (; li < 2048; li += C.G, unit = GLC_UNIT(li)) {
        const int bh = unit >> 7, ch = unit & 127, b = bh >> 2, h = bh & 3;
        const size_t t0 = (size_t)b * SEQ + (size_t)ch * 64;
        const int nli = li + C.G, nxt = nli < 2048 ? GLC_UNIT(nli) : 2048;
        u32x4 sgb[4];
#pragma unroll
        for (int i = 0; i < 4; ++i) sgb[i] = *(const u32x4*)((const bf16_t*)(ws + WS_SGB) + (t0 + orow) * 1024 + h * 256 + 32 * occ + 8 * i);
        f32x16 O[2];
        {
            const u32x2* OIG = (const u32x2*)(ws + WS_OIG) + (size_t)unit * 4096 + w * 64 + lane;
#pragma unroll
            for (int ct = 0; ct < 2; ++ct)
#pragma unroll
                for (int g4 = 0; g4 < 4; ++g4) { const u32x2 o = OIG[(ct * 4 + g4) * 512]; O[ct][4 * g4] = bflo(o.x); O[ct][4 * g4 + 1] = bfhi(o.x); O[ct][4 * g4 + 2] = bflo(o.y); O[ct][4 * g4 + 3] = bfhi(o.y); }
        }
        {
            const u32x4* SCG = (const u32x4*)(ws + WS_DSG) + (size_t)(bh * (128 / NSUB) + ch / NSUB) * 4096 + w * 64 + lane;
            u32x4 scg[8];
#pragma unroll
            for (int i = 0; i < 8; ++i) scg[i] = SCG[i * 512];
            if (nxt < 2048) GLC_QLOAD(nxt);
#pragma unroll
            for (int dt = 0; dt < 4; ++dt)
#pragma unroll
                for (int s = 0; s < 2; ++s) {
                    const bf16x8 sb = __builtin_bit_cast(bf16x8, scg[dt * 2 + s]);
#pragma unroll
                    for (int ct = 0; ct < 2; ++ct) {
                        const LAS unsigned char* p = lds + GL_QP + (32 * ct + r) * QP_PITCH + (32 * dt + 16 * s + 4 * hh) * 2;
                        const bf16x8 a = cat8(*(const LAS u32x2*)p, *(const LAS u32x2*)(p + 16));
                        O[ct] = MFMA32(a, sb, O[ct]);
                    }
                }
        }
        LDS_BARRIER();
        if (nxt < 2048) GLC_QWRITE();
        {
            LAS bf16_t* OT = (LAS bf16_t*)(lds + GL_OT);
#pragma unroll
            for (int ct = 0; ct < 2; ++ct)
#pragma unroll
                for (int j = 0; j < 16; ++j) OT[(32 * ct + crow(j, hh)) * (OT_PITCH / 2) + 32 * w + r] = f2bf(O[ct][j]);
        }
        LDS_BARRIER();
        {
            float v[32]; float ss = 0.f;
#pragma unroll
            for (int i = 0; i < 4; ++i) {
                const u32x4 wv = *(const LAS u32x4*)(lds + GL_OT + orow * OT_PITCH + 64 * occ + 16 * i);
#pragma unroll
                for (int j = 0; j < 4; ++j) { v[8 * i + 2 * j] = bflo(wv[j]); v[8 * i + 2 * j + 1] = bfhi(wv[j]); }
            }
#pragma unroll
            for (int i = 0; i < 32; ++i) ss += v[i] * v[i];
            ss += __shfl_xor(ss, 1); ss += __shfl_xor(ss, 2); ss += __shfl_xor(ss, 4);
            const float rinv = rsqrtf(ss * (1.f / 256.f) + EPS);
            bf16_t* op = (bf16_t*)(ws + WS_YAIN) + (t0 + orow) * 1536 + 512 + h * 256 + 32 * occ;
#pragma unroll
            for (int i = 0; i < 4; ++i) {
                const f32x4 g0 = *(const LAS f32x4*)(lds + GL_GN + (32 * occ + 8 * i) * 4), g1 = *(const LAS f32x4*)(lds + GL_GN + (32 * occ + 8 * i + 4) * 4);
                const u32x4 sg = sgb[i];
                u32x4 o;
                o[0] = pk2(v[8 * i + 0] * rinv * g0[0] * bflo(sg[0]), v[8 * i + 1] * rinv * g0[1] * bfhi(sg[0]));
                o[1] = pk2(v[8 * i + 2] * rinv * g0[2] * bflo(sg[1]), v[8 * i + 3] * rinv * g0[3] * bfhi(sg[1]));
                o[2] = pk2(v[8 * i + 4] * rinv * g1[0] * bflo(sg[2]), v[8 * i + 5] * rinv * g1[1] * bfhi(sg[2]));
                o[3] = pk2(v[8 * i + 6] * rinv * g1[2] * bflo(sg[3]), v[8 * i + 7] * rinv * g1[3] * bfhi(sg[3]));
                *(u32x4*)(op + 8 * i) = o;
            }
        }
    }
#undef GLC_QLOAD
#undef GLC_QWRITE
#undef GLC_UNIT
}

constexpr int GS_QP = 0, GS_KM = 4096, GS_EBL = 8192, GS_AM = 8704, GS_VS = 8960, GS_OS = 34304, GS_RED = 33536, GS_FB = 33792, GS_OS2 = 85248, GS_END = GS_OS2 + 32768;
static_assert(GS_OS + 32768 <= 69632 && GS_END <= LDS_BYTES - 64, "gla sample lds");
DI void gla_sample_item(const Ctx& C, int b, int h) {
    LAS unsigned char* lds = C.lds; const int tid = C.wave * 64 + lane_id_here(); unsigned char* ws = C.ws;
    const bf16_t* QB = (const bf16_t*)(ws + WS_QB); const bf16_t* KB = (const bf16_t*)(ws + WS_KB); const bf16_t* VB = (const bf16_t*)(ws + WS_VB);
    const bf16_t* SGB = (const bf16_t*)(ws + WS_SGB); const float* FB = (const float*)(ws + WS_FB); bf16_t* OBN = (bf16_t*)(ws + WS_YAIN) + 512;
    const size_t row0 = (size_t)MP + (size_t)b * 8;
    LAS float* QPt = (LAS float*)(lds + GS_QP); LAS float* KMt = (LAS float*)(lds + GS_KM); LAS float* EBLs = (LAS float*)(lds + GS_EBL);
    LAS float* AM = (LAS float*)(lds + GS_AM); LAS float* VS = (LAS float*)(lds + GS_VS); LAS float* OS = (LAS float*)(lds + GS_OS);
    LAS float* RED = (LAS float*)(lds + GS_RED); LAS float* FBs = (LAS float*)(lds + GS_FB);
    const int e4 = 4 * (tid & 63), grp = C.wave;
    const float* S0 = C.in[5] + ((size_t)(b * 4 + h) * 128) * 256; float* S1 = C.out + O_GLAS + ((size_t)(b * 4 + h) * 128) * 256;
    f32x4 st[16];
#pragma unroll
    for (int i = 0; i < 16; ++i) st[i] = __builtin_nontemporal_load((const f32x4*)(S0 + (size_t)(grp * 16 + i) * 256 + e4));
    float fbv = 0.f, bb = 0.f, wcol[16]; bf16_t vsv[4], qv[8], kv[8];
#pragma unroll
    for (int k = 0; k < 4; ++k) { const int i = tid + NTHREADS * k; vsv[k] = VB[(row0 + (i >> 8)) * 1024 + h * 256 + (i & 255)]; }
#pragma unroll
    for (int j = 0; j < 16; ++j) wcol[j] = 0.f;
#pragma unroll
    for (int c = 0; c < 8; ++c) { qv[c] = 0; kv[c] = 0; }
    if (tid < 128) {
        const float* wf2 = C.in[12]; const float* bf2 = C.in[13];
        fbv = FB[row0 * 16 + tid];
#pragma unroll
        for (int j = 0; j < 16; ++j) wcol[j] = wf2[(size_t)j * 512 + h * 128 + tid];
        bb = bf2[h * 128 + tid];
#pragma unroll
        for (int c = 0; c < 8; ++c) { qv[c] = QB[(row0 + c) * 512 + h * 128 + tid]; kv[c] = KB[(row0 + c) * 512 + h * 128 + tid]; }
    }
    LDS_BARRIER();
    if (tid < 128) FBs[tid] = fbv;
#pragma unroll
    for (int k = 0; k < 4; ++k) VS[tid + NTHREADS * k] = bf1(vsv[k]);
    LDS_BARRIER();
    if (tid < 128) {
        const int d = tid;
        float run = 0.f;
#pragma unroll
        for (int c = 0; c < 8; ++c) {
            float z = bb;
#pragma unroll
            for (int j = 0; j < 16; ++j) z += FBs[c * 16 + j] * wcol[j];
            run += logsig16(z);
            const float e = __expf(run);
            QPt[d * 8 + c] = bf1(qv[c]) * e;
            KMt[d * 8 + c] = bf1(kv[c]) / e;
        }
        EBLs[d] = __expf(run);
    }
    LDS_BARRIER();
    if (tid < 64) {
        const int c = tid >> 3, j = tid & 7; float a = 0.f;
        for (int d = 0; d < 128; ++d) a += QPt[d * 8 + c] * KMt[d * 8 + j];
        AM[c * 8 + j] = j <= c ? a : 0.f;
    }
    f32x4 vv[8], oo[8];
#pragma unroll
    for (int c = 0; c < 8; ++c) { vv[c] = *(const LAS f32x4*)(VS + c * 256 + e4); oo[c] = f32x4{0.f, 0.f, 0.f, 0.f}; }
#pragma unroll
    for (int i = 0; i < 16; ++i) {
        const int d = grp * 16 + i;
        const f32x4 s4 = st[i];
        const f32x4 qa = *(const LAS f32x4*)(QPt + d * 8), qb = *(const LAS f32x4*)(QPt + d * 8 + 4);
        const f32x4 ka = *(const LAS f32x4*)(KMt + d * 8), kb = *(const LAS f32x4*)(KMt + d * 8 + 4);
        f32x4 acc = s4;
#pragma unroll
        for (int c = 0; c < 4; ++c) { oo[c] += qa[c] * s4; oo[c + 4] += qb[c] * s4; acc += ka[c] * vv[c]; acc += kb[c] * vv[c + 4]; }
        const float eb = EBLs[d];
        __builtin_nontemporal_store(acc * eb, (f32x4*)(S1 + (size_t)d * 256 + e4));
    }
    {
        LAS float* OSg = (LAS float*)(lds + (grp < 4 ? GS_OS + grp * 8192 : GS_OS2 + (grp - 4) * 8192));
#pragma unroll
        for (int c = 0; c < 8; ++c) *(LAS f32x4*)(OSg + c * 256 + e4) = oo[c];
    }
    LDS_BARRIER();
    {
        const int c = tid >> 6, l = tid & 63;
        float o[4]; float ss = 0.f;
#pragma unroll
        for (int i = 0; i < 4; ++i) {
            const int ee = 4 * l + i; float a = 0.f;
#pragma unroll
            for (int g2 = 0; g2 < 8; ++g2) a += ((const LAS float*)(lds + (g2 < 4 ? GS_OS + g2 * 8192 : GS_OS2 + (g2 - 4) * 8192)))[c * 256 + ee];
#pragma unroll
            for (int j = 0; j < 8; ++j) a += AM[c * 8 + j] * VS[j * 256 + ee];
            o[i] = a; ss += a * a;
        }
        ss = wave_sum(ss);
        const float rinv = rsqrtf(ss * (1.f / 256.f) + EPS);
        const float* gn = C.in[14];
        u32x2 wv;
        const bf16_t* sg = SGB + (row0 + c) * 1024 + h * 256 + 4 * l;
        wv.x = pk2(o[0] * rinv * gn[4 * l] * bf1(sg[0]), o[1] * rinv * gn[4 * l + 1] * bf1(sg[1]));
        wv.y = pk2(o[2] * rinv * gn[4 * l + 2] * bf1(sg[2]), o[3] * rinv * gn[4 * l + 3] * bf1(sg[3]));
        *(u32x2*)(OBN + (row0 + c) * 1536 + h * 256 + 4 * l) = wv;
    }
    LDS_BARRIER();
}

__device__ const unsigned char T5_BUCKET[387] = {0,1,2,3,4,5,6,7,8,9,10,11,12,13,14,15,16,16,16,16,16,16,17,17,17,17,17,17,17,17,18,18,18,18,18,18,18,18,18,18,19,19,19,19,19,19,19,19,19,19,19,19,19,19,20,20,20,20,20,20,20,20,20,20,20,20,20,20,20,20,20,20,20,21,21,21,21,21,21,21,21,21,21,21,21,21,21,21,21,21,21,21,21,21,21,21,21,21,21,22,22,22,22,22,22,22,22,22,22,22,22,22,22,22,22,22,22,22,22,22,22,22,22,22,22,22,22,22,22,0,4,8,12,16,16,17,17,18,18,19,19,19,19,20,20,20,20,20,21,21,21,21,21,21,22,22,22,22,22,22,22,22,22,23,23,23,23,23,23,23,23,23,23,23,23,24,24,24,24,24,24,24,24,24,24,24,24,24,24,24,24,25,25,25,25,25,25,25,25,25,25,25,25,25,25,25,25,25,25,25,25,25,26,26,26,26,26,26,26,26,26,26,26,26,26,26,26,26,26,26,26,26,26,26,26,26,26,26,26,26,26,26,27,27,27,27,27,27,27,27,27,27,27,27,27,27,27,27,0,16,18,19,20,21,21,22,22,23,23,23,24,24,24,24,25,25,25,25,25,26,26,26,26,26,26,26,26,27,27,27,27,27,27,27,27,27,27,28,28,28,28,28,28,28,28,28,28,28,28,28,29,29,29,29,29,29,29,29,29,29,29,29,29,29,29,29,29,29,30,30,30,30,30,30,30,30,30,30,30,30,30,30,30,30,30,30,30,30,30,30,30,30,30,31,31,31,31,31,31,31,31,31,31,31,31,31,31,31,31,31,31,31,31,31,31,31,31,31,31,31,31,31,31,31,31,31,31};

constexpr int AT_V = 0, AT_VP = 272, AT_VW = 32 * AT_VP, AT_BT = 8 * AT_VW, AT_RT = AT_BT + 12 * 129 * 4, AT_END = AT_RT + 12 * 192 * 4;
static_assert(AT_END <= LDS_BYTES, "attn lds");

constexpr int AT_NTAB = 12 * 129 + 12 * 192;
constexpr size_t WS_TAB = WS_CTL + 32768;
static_assert(AT_RT == AT_BT + 12 * 129 * 4 && AT_NTAB * 4 <= 32768, "bias table map");
DI void attn_bias_tables_global(const Ctx& C, int e) {
    float* TAB = (float*)(C.ws + WS_TAB);
    if (e < 12 * 129) { const int hd = e / 129, ds = e % 129; TAB[e] = C.in[8][(int)T5_BUCKET[(hd >> 2) * 129 + ds] * 12 + hd] * LOG2E; }
    else { const int i = e - 12 * 129, hd = i / 192, k = i % 192, dsub = 159 - k;
        TAB[e] = (dsub >= 0 && dsub <= 128) ? C.in[8][(int)T5_BUCKET[(hd >> 2) * 129 + dsub] * 12 + hd] * LOG2E : -1e30f; }
}
DI void attn_bias_tables(const Ctx& C, int tid) {
    const float* TAB = (const float*)(C.ws + WS_TAB);
    LAS float* BT = (LAS float*)(C.lds + AT_BT);
    float v[8];
#pragma unroll
    for (int k = 0; k < 8; ++k) { const int i = tid + NTHREADS * k; v[k] = TAB[i < AT_NTAB ? i : 0]; }
#pragma unroll
    for (int k = 0; k < 8; ++k) { const int i = tid + NTHREADS * k; if (i < AT_NTAB) BT[i] = v[k]; }
}

DI void attn_prompt_wave(const Ctx& C, int b, int slot, int g, int res, int m0, int lane) {
    const int r = lane & 31, hh = lane >> 5, dil = 1 << (2 * g), hd = 4 * g + slot;
    unsigned char* ws = C.ws;
    const bf16_t* QA = (const bf16_t*)(ws + WS_QA) + (size_t)hd * MT * 128; const bf16_t* KA = (const bf16_t*)(ws + WS_KA) + (size_t)hd * MT * 128;
    const bf16_t* VA = (const bf16_t*)(ws + WS_VA) + (size_t)hd * MT * 128;
    LAS unsigned char* VL = C.lds + AT_V + C.wave * AT_VW;
    const size_t rowb = (size_t)b * SEQ + (size_t)res * (SEQ >> (2 * g));
    bf16x8 qf[8];
    {
        const bf16_t* qp = QA + (rowb + (size_t)(m0 + r)) * 128 + 8 * hh;
#pragma unroll
        for (int s = 0; s < 8; ++s) qf[s] = *(const bf16x8*)(qp + 16 * s);
    }
    f32x16 P[5];
    u32x4 ka[8], kb[8];
    const size_t lane_off = (size_t)(lane >> 4) * 128 + 8 * (lane & 15);
#define ATT_LOADROWS(dst, base, kt_) do { const int mkb_ = (m0 - 128 + 32 * (kt_)) < 0 ? 0 : (m0 - 128 + 32 * (kt_)); \
        const bf16_t* tp_ = base + (rowb + (size_t)mkb_) * 128 + lane_off; \
        _Pragma("unroll") for (int i = 0; i < 8; ++i) dst[i] = *(const u32x4*)(tp_ + (size_t)i * 512); } while (0)
#define ATT_STAGE(src) do { LDS_WAIT(); asm volatile("" ::: "memory"); \
        _Pragma("unroll") for (int i = 0; i < 8; ++i) *(LAS u32x4*)(VL + (4 * i + (lane >> 4)) * AT_VP + 16 * (lane & 15)) = src[i]; \
        LDS_WAIT(); asm volatile("" ::: "memory"); } while (0)
#define ATT_QK(kt_) do { f32x16 acc_; _Pragma("unroll") for (int j = 0; j < 16; ++j) acc_[j] = 0.f; \
        _Pragma("unroll") for (int s = 0; s < 8; ++s) { const bf16x8 kf_ = *(const LAS bf16x8*)(VL + r * AT_VP + (16 * s + 8 * hh) * 2); acc_ = MFMA32(kf_, qf[s], acc_); } P[kt_] = acc_; } while (0)
    ATT_LOADROWS(ka, KA, 0); ATT_LOADROWS(kb, KA, 1); __builtin_amdgcn_sched_barrier(0);
    ATT_STAGE(ka); ATT_LOADROWS(ka, KA, 2); __builtin_amdgcn_sched_barrier(0); ATT_QK(0); __builtin_amdgcn_sched_barrier(0);
    ATT_STAGE(kb); ATT_LOADROWS(kb, KA, 3); __builtin_amdgcn_sched_barrier(0); ATT_QK(1); __builtin_amdgcn_sched_barrier(0);
    ATT_STAGE(ka); ATT_LOADROWS(ka, KA, 4); __builtin_amdgcn_sched_barrier(0); ATT_QK(2); __builtin_amdgcn_sched_barrier(0);
    ATT_STAGE(kb); __builtin_amdgcn_sched_barrier(0); ATT_QK(3); __builtin_amdgcn_sched_barrier(0);
    ATT_STAGE(ka); __builtin_amdgcn_sched_barrier(0); ATT_QK(4); __builtin_amdgcn_sched_barrier(0);
#undef ATT_QK
    u32x4 vv[8], vw[8];
#define ATT_LOADV(dst, kt_) ATT_LOADROWS(dst, VA, kt_)
    ATT_LOADV(vv, 0); ATT_LOADV(vw, 1);
    __builtin_amdgcn_sched_barrier(0);
    float mx = -1e30f;
    {
        const LAS float* rt = (const LAS float*)(C.lds + AT_RT) + hd * 192 + (31 - r + 4 * hh);
#pragma unroll
        for (int kt = 0; kt < 5; ++kt)
#pragma unroll
            for (int j = 0; j < 16; ++j) { const float sv = P[kt][j] + rt[32 * kt + (j & 3) + 8 * (j >> 2)]; P[kt][j] = sv; }
        if (m0 < 128) {
#pragma unroll
            for (int kt = 0; kt < 5; ++kt)
#pragma unroll
                for (int j = 0; j < 16; ++j) if (m0 - 128 + 32 * kt + crow(j, hh) < 0) P[kt][j] = -1e30f;
        }
#pragma unroll
        for (int kt = 0; kt < 5; ++kt)
#pragma unroll
            for (int j = 0; j < 16; ++j) mx = fmaxf(mx, P[kt][j]);
    }
    mx = fmaxf(mx, __shfl_xor(mx, 32));
    float den = 0.f;
#pragma unroll
    for (int kt = 0; kt < 5; ++kt)
#pragma unroll
        for (int j = 0; j < 16; ++j) { const float p = __builtin_amdgcn_exp2f(P[kt][j] - mx); P[kt][j] = p; den += p; }
    den += __shfl_xor(den, 32);
    f32x16 O[4];
#pragma unroll
    for (int i = 0; i < 4; ++i)
#pragma unroll
        for (int j = 0; j < 16; ++j) O[i][j] = 0.f;
#pragma unroll
    for (int kt = 0; kt < 5; ++kt) {
        __builtin_amdgcn_sched_barrier(0);
        LDS_WAIT(); asm volatile("" ::: "memory");
        if ((kt & 1) == 0) {
#pragma unroll
            for (int i = 0; i < 8; ++i) *(LAS u32x4*)(VL + (4 * i + (lane >> 4)) * AT_VP + 16 * (lane & 15)) = vv[i];
            LDS_WAIT(); asm volatile("" ::: "memory");
            if (kt + 2 < 5) ATT_LOADV(vv, kt + 2);
        } else {
#pragma unroll
            for (int i = 0; i < 8; ++i) *(LAS u32x4*)(VL + (4 * i + (lane >> 4)) * AT_VP + 16 * (lane & 15)) = vw[i];
            LDS_WAIT(); asm volatile("" ::: "memory");
            if (kt + 2 < 5) ATT_LOADV(vw, kt + 2);
        }
        __builtin_amdgcn_sched_barrier(0);
        {
            u32x2 tl[2][4], th[2][4];
            const unsigned va = (unsigned)(size_t)VL + (unsigned)((4 * hh + ((lane & 15) >> 2)) * AT_VP + (16 * ((lane >> 4) & 1) + 4 * (lane & 3)) * 2);
            asm volatile(
                "ds_read_b64_tr_b16 %0, %16\n\tds_read_b64_tr_b16 %1, %16 offset:64\n\tds_read_b64_tr_b16 %2, %16 offset:128\n\tds_read_b64_tr_b16 %3, %16 offset:192\n\t"
                "ds_read_b64_tr_b16 %4, %16 offset:2176\n\tds_read_b64_tr_b16 %5, %16 offset:2240\n\tds_read_b64_tr_b16 %6, %16 offset:2304\n\tds_read_b64_tr_b16 %7, %16 offset:2368\n\t"
                "ds_read_b64_tr_b16 %8, %16 offset:4352\n\tds_read_b64_tr_b16 %9, %16 offset:4416\n\tds_read_b64_tr_b16 %10, %16 offset:4480\n\tds_read_b64_tr_b16 %11, %16 offset:4544\n\t"
                "ds_read_b64_tr_b16 %12, %16 offset:6528\n\tds_read_b64_tr_b16 %13, %16 offset:6592\n\tds_read_b64_tr_b16 %14, %16 offset:6656\n\tds_read_b64_tr_b16 %15, %16 offset:6720\n\t"
                "s_waitcnt lgkmcnt(0)"
                : "=&v"(tl[0][0]), "=&v"(tl[0][1]), "=&v"(tl[0][2]), "=&v"(tl[0][3]), "=&v"(th[0][0]), "=&v"(th[0][1]), "=&v"(th[0][2]), "=&v"(th[0][3]),
                  "=&v"(tl[1][0]), "=&v"(tl[1][1]), "=&v"(tl[1][2]), "=&v"(tl[1][3]), "=&v"(th[1][0]), "=&v"(th[1][1]), "=&v"(th[1][2]), "=&v"(th[1][3])
                : "v"(va) : "memory");
            __builtin_amdgcn_sched_barrier(0);
#pragma unroll
            for (int s = 0; s < 2; ++s) {
                const bf16x8 pb = pack_step(P[kt], s);
#pragma unroll
                for (int dt = 0; dt < 4; ++dt) O[dt] = MFMA32(cat8(tl[s][dt], th[s][dt]), pb, O[dt]);
            }
            __builtin_amdgcn_sched_barrier(0);
        }
    }
#undef ATT_LOADV
#undef ATT_LOADROWS
#undef ATT_STAGE
    const float inv = __builtin_amdgcn_rcpf(den);
    const size_t qrow = rowb + (size_t)(m0 + r);
    bf16_t* op = (bf16_t*)(ws + WS_OAG) + ((size_t)hd * MT + qrow) * 128;
#pragma unroll
    for (int dt = 0; dt < 4; ++dt)
#pragma unroll
        for (int g4 = 0; g4 < 4; g4 += 2) {
            u32x2 wa, wb;
            wa.x = pk2(O[dt][4 * g4] * inv, O[dt][4 * g4 + 1] * inv); wa.y = pk2(O[dt][4 * g4 + 2] * inv, O[dt][4 * g4 + 3] * inv);
            wb.x = pk2(O[dt][4 * g4 + 4] * inv, O[dt][4 * g4 + 5] * inv); wb.y = pk2(O[dt][4 * g4 + 6] * inv, O[dt][4 * g4 + 7] * inv);
            st_rowpair(op, 4 * dt + g4, wa, wb, hh);
        }
    if (hh == 0) ((float*)(ws + WS_LSE))[((size_t)g * MT + qrow) * 4 + slot] = mx + __builtin_amdgcn_logf(den);
}

DI void attn_combine_chunk(unsigned char* ws, size_t row, int slot, int ck) {
    const size_t r0 = row, r1 = (size_t)attn_prow((int)row, 1), r2 = (size_t)attn_prow((int)row, 2);
    const float* lse = (const float*)(ws + WS_LSE) + slot;
    const float l0 = lse[r0 * 4], l1 = lse[((size_t)MT + r1) * 4], l2 = lse[((size_t)2 * MT + r2) * 4];
    const float lm = fmaxf(l0, fmaxf(l1, l2));
    float w0 = __builtin_amdgcn_exp2f(l0 - lm), w1 = __builtin_amdgcn_exp2f(l1 - lm), w2 = __builtin_amdgcn_exp2f(l2 - lm);
    const float ws_ = __builtin_amdgcn_rcpf(w0 + w1 + w2); w0 *= ws_; w1 *= ws_; w2 *= ws_;
    const bf16_t* ob = (const bf16_t*)(ws + WS_OAG) + 8 * ck;
    const u32x4 a = *(const u32x4*)(ob + ((size_t)slot * MT + r0) * 128), bq = *(const u32x4*)(ob + ((size_t)(4 + slot) * MT + r1) * 128), c = *(const u32x4*)(ob + ((size_t)(8 + slot) * MT + r2) * 128);
    u32x4 o;
#pragma unroll
    for (int j = 0; j < 4; ++j) o[j] = pk2(w0 * bflo(a[j]) + w1 * bflo(bq[j]) + w2 * bflo(c[j]), w0 * bfhi(a[j]) + w1 * bfhi(bq[j]) + w2 * bfhi(c[j]));
    *(u32x4*)((bf16_t*)(ws + WS_YAIN) + row * 1536 + slot * 128 + 8 * ck) = o;
}

DI void attn_prompt_item(const Ctx& C, int it) {
    const int bs = it / 96, rem = it % 96, g = rem >> 5, q = rem & 31;
    const int res = g == 0 ? 0 : (g == 1 ? q >> 3 : q >> 1), blk = g == 0 ? q : (g == 1 ? q & 7 : q & 1);
    attn_prompt_wave(C, bs >> 2, bs & 3, g, res, 256 * blk + 32 * C.wave, lane_id_here());
}

DI float half_sum(float v) {
    v += dpp_f<0xB1, 0xf>(v); v += dpp_f<0x4E, 0xf>(v); v += dpp_f<0x141, 0xf>(v); v += dpp_f<0x140, 0xf>(v); v += dpp_f<0x142, 0xa>(v);
    return v;
}
DI void attn_sample_item(const Ctx& C, int b, int slot, int g) {
    const int lane = lane_id_here(), t = C.wave;
    const int hh = lane >> 5, l4 = 4 * (lane & 31);
    unsigned char* ws = C.ws;
    const int dil = 1 << (2 * g), wb = 128 << (2 * g), hd = 4 * g + slot;
    const LAS float* BT = (const LAS float*)(C.lds + AT_BT) + hd * 129;
    const float* cache = C.in[2 + g] + (size_t)b * wb * 1024 + slot * 128 + l4;
    const float* neww = C.out + (g == 0 ? O_W1S : (g == 1 ? O_W2S : O_W3S)) + (size_t)b * 8 * 1024 + slot * 128 + l4;
    const size_t row = (size_t)MP + b * 8 + t;
    const u32x2 qraw = *(const u32x2*)((const bf16_t*)(ws + WS_QA) + ((size_t)hd * MT + row) * 128 + l4);
    const float q0 = bflo(qraw.x), q1 = bfhi(qraw.x), q2 = bflo(qraw.y), q3 = bfhi(qraw.y);
    const f32x4 kt = __builtin_nontemporal_load((const f32x4*)(cache + (size_t)t * 1024));
    const f32x4 vt = __builtin_nontemporal_load((const f32x4*)(cache + (size_t)t * 1024 + 512));
    float m = -1e30f, l = 0.f;
    f32x4 o = {0.f, 0.f, 0.f, 0.f};
#pragma unroll 1
    for (int jb = 0; jb < 128; jb += 32) {
        f32x4 kk[16], vv[16];
#pragma unroll
        for (int u = 0; u < 16; ++u) {
            const int j = jb + 2 * u + hh; const int id = wb + t - j * dil;
            const float* kr = id >= wb ? neww + (size_t)(id - wb) * 1024 : cache + (size_t)id * 1024;
            kk[u] = *(const f32x4*)kr;
            vv[u] = *(const f32x4*)(kr + 512);
        }
        unsigned sbits = __float_as_uint(-1e30f);
#pragma unroll
        for (int u = 0; u < 16; ++u) {
            const float d = half_sum(q0 * kk[u].x + q1 * kk[u].y + q2 * kk[u].z + q3 * kk[u].w);
            const unsigned se = __builtin_amdgcn_readlane(__float_as_uint(d), 31), so = __builtin_amdgcn_readlane(__float_as_uint(d), 63);
            sbits = lane == 2 * u ? se : sbits;
            sbits = lane == 2 * u + 1 ? so : sbits;
        }
        const float sb = lane < 32 ? __uint_as_float(sbits) + BT[jb + (lane & 31)] : -1e30f;
        const float mn = fmaxf(m, wave_max(sb));
        const float alpha = __builtin_amdgcn_exp2f(m - mn);
        const float pb = lane < 32 ? __builtin_amdgcn_exp2f(sb - mn) : 0.f;
        l = l * alpha + wave_sum(pb); m = mn;
        o.x *= alpha; o.y *= alpha; o.z *= alpha; o.w *= alpha;
#pragma unroll
        for (int u = 0; u < 16; ++u) {
            const float pe = __uint_as_float(__builtin_amdgcn_readlane(__float_as_uint(pb), 2 * u));
            const float po = __uint_as_float(__builtin_amdgcn_readlane(__float_as_uint(pb), 2 * u + 1));
            const float p = hh ? po : pe;
            o.x += p * vv[u].x; o.y += p * vv[u].y; o.z += p * vv[u].z; o.w += p * vv[u].w;
        }
    }
    {
        const float d = half_sum(q0 * kt.x + q1 * kt.y + q2 * kt.z + q3 * kt.w);
        const float sT = __uint_as_float(__builtin_amdgcn_readlane(__float_as_uint(d), 31)) + BT[128];
        const float mn = fmaxf(m, sT);
        const float alpha = __builtin_amdgcn_exp2f(m - mn), pT = __builtin_amdgcn_exp2f(sT - mn);
        l = l * alpha + pT; m = mn;
        const float p = hh ? 0.f : pT;
        o.x = o.x * alpha + p * vt.x; o.y = o.y * alpha + p * vt.y; o.z = o.z * alpha + p * vt.z; o.w = o.w * alpha + p * vt.w;
    }
    o.x += __shfl_xor(o.x, 32); o.y += __shfl_xor(o.y, 32); o.z += __shfl_xor(o.z, 32); o.w += __shfl_xor(o.w, 32);
    const float inv = 1.f / l;
    if (lane < 32) { u32x2 w2; w2.x = pk2(o.x * inv, o.y * inv); w2.y = pk2(o.z * inv, o.w * inv); *(u32x2*)((bf16_t*)(ws + WS_OAG) + ((size_t)hd * MT + row) * 128 + l4) = w2; }
    if (lane == 0) ((float*)(ws + WS_LSE))[((size_t)g * MT + row) * 4 + slot] = m + __builtin_amdgcn_logf(l);
}

DI float rs_from4(const float* ssq4, int row) { const f32x4 p = *(const f32x4*)(ssq4 + (size_t)row * 4); return rsqrtf(((p[0] + p[1]) + (p[2] + p[3])) * (1.f / 1024.f) + EPS); }

DI void ld_bf16x8(const bf16_t* p, f32x4& a, f32x4& b) {
    const u32x4 w = *(const u32x4*)p;
    a = (f32x4){bflo(w.x), bfhi(w.x), bflo(w.y), bfhi(w.y)}; b = (f32x4){bflo(w.z), bfhi(w.z), bflo(w.w), bfhi(w.w)};
}
template <int MODE> struct EpiGate {
    static constexpr bool PERM = true, AFTER_DRAIN = false, HAS_MID = false;
    const bf16_t* G; const bf16_t* T; bf16_t* D;
    DI void operator()(const f32x4 (&acc)[2][2][4][2], const pg8::Unit& u, int wr, int wc, int fr, int fq) const {
        const int rbase = u.pm * 256 + wr * 64 + fr, c0 = u.pn * 256 + wc * 32 + 8 * fq;
#pragma unroll
        for (int ai = 0; ai < 2; ++ai)
#pragma unroll
            for (int m = 0; m < 4; ++m) {
                const size_t off = (size_t)(rbase + ai * 128 + m * 16) * 1024 + c0;
#pragma unroll
                for (int bj = 0; bj < 2; ++bj) {
                    f32x4 g0, g1; ld_bf16x8(G + off + bj * 128, g0, g1);
                    f32x4 v0 = acc[ai][bj][m][0] * g0, v1 = acc[ai][bj][m][1] * g1;
                    if (MODE == 1) { f32x4 t0, t1; ld_bf16x8(T + off + bj * 128, t0, t1); v0 += t0; v1 += t1; }
                    st_bf16x8(D + off + bj * 128, v0, v1);
                }
            }
    }
};
struct EpiGate2 {
    static constexpr bool PERM = true, AFTER_DRAIN = false, HAS_MID = true;
    const bf16_t* GA; const bf16_t* GB; bf16_t* D; int mid_t;
    DI void mid(f32x4 (&acc)[2][2][4][2], const pg8::Unit& u, int wr, int wc, int fr_, int fq_) const {
        const int lane = lane_id_here(), fr = lane & 15, fq = lane >> 4;
        const int rbase = u.pm * 256 + wr * 64 + fr, c0 = u.pn * 256 + wc * 32 + 8 * fq;
#pragma unroll
        for (int ai = 0; ai < 2; ++ai) {
            u32x4 ga[4][2], gb[4][2];
#pragma unroll
            for (int m = 0; m < 4; ++m)
#pragma unroll
                for (int bj = 0; bj < 2; ++bj) {
                    const size_t off = (size_t)(rbase + ai * 128 + m * 16) * 1024 + c0 + bj * 128;
                    ga[m][bj] = *(const u32x4*)(GA + off); gb[m][bj] = *(const u32x4*)(GB + off);
                }
            __builtin_amdgcn_sched_barrier(0);
#pragma unroll
            for (int m = 0; m < 4; ++m)
#pragma unroll
                for (int bj = 0; bj < 2; ++bj) {
                    const u32x4 wa = ga[m][bj], wb = gb[m][bj];
                    const f32x4 a0 = (f32x4){bflo(wa.x), bfhi(wa.x), bflo(wa.y), bfhi(wa.y)}, a1 = (f32x4){bflo(wa.z), bfhi(wa.z), bflo(wa.w), bfhi(wa.w)};
                    const f32x4 b0 = (f32x4){bflo(wb.x), bfhi(wb.x), bflo(wb.y), bfhi(wb.y)}, b1 = (f32x4){bflo(wb.z), bfhi(wb.z), bflo(wb.w), bfhi(wb.w)};
#pragma unroll
                    for (int i = 0; i < 4; ++i) { acc[ai][bj][m][0][i] *= a0[i] * __builtin_amdgcn_rcpf(fmaxf(b0[i], 1e-30f)); acc[ai][bj][m][1][i] *= a1[i] * __builtin_amdgcn_rcpf(fmaxf(b1[i], 1e-30f)); }
                }
            __builtin_amdgcn_sched_barrier(0);
        }
    }
    DI void operator()(const f32x4 (&acc)[2][2][4][2], const pg8::Unit& u, int wr, int wc, int fr, int fq) const {
        const int rbase = u.pm * 256 + wr * 64 + fr, c0 = u.pn * 256 + wc * 32 + 8 * fq;
#pragma unroll
        for (int ai = 0; ai < 2; ++ai) {
            u32x4 gw[4][2];
#pragma unroll
            for (int m = 0; m < 4; ++m)
#pragma unroll
                for (int bj = 0; bj < 2; ++bj) gw[m][bj] = *(const u32x4*)(GB + (size_t)(rbase + ai * 128 + m * 16) * 1024 + c0 + bj * 128);
#pragma unroll
            for (int m = 0; m < 4; ++m) {
                const size_t off = (size_t)(rbase + ai * 128 + m * 16) * 1024 + c0;
#pragma unroll
                for (int bj = 0; bj < 2; ++bj) {
                    const u32x4 w = gw[m][bj];
                    const f32x4 b0 = (f32x4){bflo(w.x), bfhi(w.x), bflo(w.y), bfhi(w.y)}, b1 = (f32x4){bflo(w.z), bfhi(w.z), bflo(w.w), bfhi(w.w)};
                    st_bf16x8(D + off + bj * 128, acc[ai][bj][m][0] * b0, acc[ai][bj][m][1] * b1);
                }
            }
        }
    }
};
struct EpiBranch {
    static constexpr bool PERM = true, AFTER_DRAIN = false, HAS_MID = false;
    bf16_t* D; float* ssq;
    DI void operator()(const f32x4 (&acc)[2][2][4][2], const pg8::Unit& u, int wr, int wc, int fr, int fq) const {
        const int rbase = u.pm * 256 + wr * 64 + fr, c0 = u.pn * 256 + wc * 32 + 8 * fq;
#pragma unroll
        for (int ai = 0; ai < 2; ++ai)
#pragma unroll
            for (int m = 0; m < 4; ++m) {
                const int row = rbase + ai * 128 + m * 16; const size_t off = (size_t)row * 1024 + c0;
                float s = 0.f;
#pragma unroll
                for (int bj = 0; bj < 2; ++bj) {
                    const f32x4 v0 = acc[ai][bj][m][0], v1 = acc[ai][bj][m][1];
                    s += (v0[0] * v0[0] + v0[1] * v0[1]) + (v0[2] * v0[2] + v0[3] * v0[3]) + (v1[0] * v1[0] + v1[1] * v1[1]) + (v1[2] * v1[2] + v1[3] * v1[3]);
                    st_bf16x8(D + off + bj * 128, v0, v1);
                }
                s += __shfl_xor(s, 16); s += __shfl_xor(s, 32);
                if (fq == 0) ssq[(size_t)row * 16 + 4 * u.pn + wc] = s;
            }
    }
};
struct EpiRowScale {
    static constexpr bool PERM = true, AFTER_DRAIN = false, HAS_MID = false;
    const float* rs; bf16_t* D; float scale;
    DI void operator()(const f32x4 (&acc)[2][2][4][2], const pg8::Unit& u, int wr, int wc, int fr, int fq) const {
        const int rbase = u.pm * 256 + wr * 64 + fr, c0 = u.pn * 256 + wc * 32 + 8 * fq;
        float rsv[2][4];
#pragma unroll
        for (int ai = 0; ai < 2; ++ai)
#pragma unroll
            for (int m = 0; m < 4; ++m) rsv[ai][m] = rs[rbase + ai * 128 + m * 16];
#pragma unroll
        for (int ai = 0; ai < 2; ++ai)
#pragma unroll
            for (int m = 0; m < 4; ++m) {
                const int row = rbase + ai * 128 + m * 16; const float r = rsv[ai][m] * scale; const size_t off = (size_t)row * 1024 + c0;
#pragma unroll
                for (int bj = 0; bj < 2; ++bj) st_bf16x8(D + off + bj * 128, acc[ai][bj][m][0] * r, acc[ai][bj][m][1] * r);
            }
    }
};
struct EpiGateUp {
    static constexpr bool PERM = true, AFTER_DRAIN = false, HAS_MID = false;
    const float* rs; bf16_t* H;
    DI void operator()(const f32x4 (&acc)[2][2][4][2], const pg8::Unit& u, int wr, int wc, int fr, int fq) const {
        const int rbase = u.pm * 256 + wr * 64 + fr, c0 = u.pn * 128 + wc * 32 + 8 * fq;
        float rsv[2][4];
#pragma unroll
        for (int ai = 0; ai < 2; ++ai)
#pragma unroll
            for (int m = 0; m < 4; ++m) rsv[ai][m] = rs[rbase + ai * 128 + m * 16];
#pragma unroll
        for (int ai = 0; ai < 2; ++ai)
#pragma unroll
            for (int m = 0; m < 4; ++m) {
                const int row = rbase + ai * 128 + m * 16; const float r = rsv[ai][m];
                f32x4 g0 = acc[ai][0][m][0] * r, g1 = acc[ai][0][m][1] * r; const f32x4 u0 = acc[ai][1][m][0] * r, u1 = acc[ai][1][m][1] * r;
#pragma unroll
                for (int i = 0; i < 4; ++i) { g0[i] = g0[i] * fsigmoid(g0[i]) * u0[i]; g1[i] = g1[i] * fsigmoid(g1[i]) * u1[i]; }
                st_bf16x8(H + (size_t)row * DFF + c0, g0, g1);
            }
    }
};

template <bool FIRST, bool LAST> DI void resid_pass(const Ctx& C, const float* gain) {
    const int lane = lane_id_here(); const int gw = C.bid * 8 + C.wave, NGW = C.G * 8;
    unsigned char* ws = C.ws;
    const bf16_t* BR = (const bf16_t*)(ws + WS_MIX); const float* SSQ = (const float*)(ws + WS_SSQ);
    bf16_t* XB = (bf16_t*)(ws + WS_XB); float* RS = (float*)(ws + WS_RS);
    f32x4 gv[4];
#pragma unroll
    for (int j = 0; j < 4; ++j) gv[j] = ((const f32x4*)gain)[lane + 64 * j];
    u32x2 bw[4]; f32x4 xv[4]; u32x2 xbv[4]; float sq = 0.f;
#define RESID_LOAD(m_) do { const int mm_ = (m_); \
        sq = mm_ < MP ? (lane < 16 ? SSQ[(size_t)mm_ * 16 + lane] : 0.f) : (lane < 32 ? ((const float*)(ws + WS_SSQ + 2560 * 1024))[(size_t)(mm_ - MP) * 32 + lane] : 0.f); \
        _Pragma("unroll") for (int j = 0; j < 4; ++j) { bw[j] = ((const u32x2*)(BR + (size_t)mm_ * 1024))[lane + 64 * j]; \
            if (FIRST) { const float* xo_ = mm_ < MP ? C.in[0] + (size_t)mm_ * 1024 : C.in[1] + (size_t)(mm_ - MP) * 1024; xv[j] = __builtin_nontemporal_load((const f32x4*)xo_ + lane + 64 * j); } \
            else xbv[j] = ((const u32x2*)(XB + (size_t)mm_ * 1024))[lane + 64 * j]; } } while (0)
    if (gw < MT) RESID_LOAD(gw);
    for (int m = gw; m < MT; m += NGW) {
        u32x2 cb[4]; f32x4 cx[4]; const float csq = sq;
#pragma unroll
        for (int j = 0; j < 4; ++j) { cb[j] = bw[j]; cx[j] = FIRST ? xv[j] : (f32x4){bflo(xbv[j].x), bfhi(xbv[j].x), bflo(xbv[j].y), bfhi(xbv[j].y)}; }
        if (m + NGW < MT) RESID_LOAD(m + NGW);
        const float rb = rsqrtf(wave_sum(csq) * (1.f / 1024.f) + EPS);
        f32x4 v[4]; float s = 0.f;
#pragma unroll
        for (int j = 0; j < 4; ++j) {
            const f32x4 bv = (f32x4){bflo(cb[j].x), bfhi(cb[j].x), bflo(cb[j].y), bfhi(cb[j].y)};
            v[j] = cx[j] + bv * rb * gv[j];
            s += (v[j].x * v[j].x + v[j].y * v[j].y) + (v[j].z * v[j].z + v[j].w * v[j].w);
        }
        if (LAST) {
#pragma unroll
            for (int j = 0; j < 4; ++j) __builtin_nontemporal_store(v[j], (f32x4*)(C.out + (size_t)m * 1024) + lane + 64 * j);
        } else {
            s = wave_sum(s);
#pragma unroll
            for (int j = 0; j < 4; ++j) { u32x2 w; w.x = pk2(v[j].x, v[j].y); w.y = pk2(v[j].z, v[j].w); ((u32x2*)(XB + (size_t)m * 1024))[lane + 64 * j] = w; }
            if (lane == 0) RS[m] = rsqrtf(s * (1.f / 1024.f) + EPS);
        }
    }
#undef RESID_LOAD
}

constexpr int XA_PITCH = 528, XA_BUF = 128 * XA_PITCH;
#ifndef XREP_S
#define XREP_S 1
#endif
#ifndef XREP_PV
#define XREP_PV 1
#endif
static_assert(2 * XA_BUF <= LDS_BYTES - 64, "xattn lds");
DI void xattn_prompt_item(const Ctx& C, int item) {
    const int lane = lane_id_here(), w = C.wave, tid = w * 64 + lane, r = lane & 31, hh = lane >> 5;
    const int bh = item >> 5, tb = item & 31, b = bh >> 2, h = bh & 3;
    unsigned char* ws = C.ws; LAS unsigned char* lds = C.lds;
    const size_t row0 = (size_t)b * SEQ + (size_t)tb * 256 + 32 * w;
    const bf16_t* Kg = (const bf16_t*)(ws + WS_MK) + (size_t)b * 256 * 1024 + h * 256;
    const bf16_t* Vg = (const bf16_t*)(ws + WS_MVT) + ((size_t)b * 1024 + h * 256) * 256;
    u32x4 st[16];
    const bf16_t* kld = Kg + (size_t)(tid >> 5) * 1024 + 8 * (tid & 31);
    const bf16_t* vld = Vg + (size_t)(tid >> 5) * 256 + 8 * (tid & 31);
    LAS unsigned char* wst = lds + (tid >> 5) * XA_PITCH + 16 * (tid & 31);
#define XA_WRITE_ALL() do { _Pragma("unroll") for (int i = 0; i < 16; ++i) *(LAS u32x4*)(wst + (i >> 3) * XA_BUF + 16 * (i & 7) * XA_PITCH) = st[i]; } while (0)
#pragma unroll
    for (int i = 0; i < 16; ++i) st[i] = *(const u32x4*)(kld + (size_t)(16 * i) * 1024);
    bf16x8 qf[16];
    {
        const bf16_t* Q = (const bf16_t*)(ws + WS_Q2) + (row0 + r) * 1024 + h * 256 + 8 * hh;
#pragma unroll
        for (int s = 0; s < 16; ++s) qf[s] = *(const bf16x8*)(Q + 16 * s);
    }
    LDS_BARRIER();
    XA_WRITE_ALL();
    LDS_BARRIER();
    f32x16 P[8];
#pragma unroll
    for (int kh = 0; kh < 2; ++kh) {
        f32x16 acc[4];
#pragma unroll
        for (int kt = 0; kt < 4; ++kt)
#pragma unroll
            for (int j = 0; j < 16; ++j) acc[kt][j] = 0.f;
        const LAS unsigned char* kb_ = lds + kh * XA_BUF + r * XA_PITCH + 16 * hh;
        bf16x8 fa[4], fb[4];
#pragma unroll
        for (int kt = 0; kt < 4; ++kt) fa[kt] = *(const LAS bf16x8*)(kb_ + 32 * kt * XA_PITCH);
#pragma unroll
        for (int s = 0; s < 16; s += 2) {
#pragma unroll
            for (int kt = 0; kt < 4; ++kt) fb[kt] = *(const LAS bf16x8*)(kb_ + 32 * kt * XA_PITCH + 32 * (s + 1));
#pragma unroll
            for (int kt = 0; kt < 4; ++kt) acc[kt] = MFMA32(fa[kt], qf[s], acc[kt]);
            if (s + 2 < 16) {
#pragma unroll
                for (int kt = 0; kt < 4; ++kt) fa[kt] = *(const LAS bf16x8*)(kb_ + 32 * kt * XA_PITCH + 32 * (s + 2));
            }
#pragma unroll
            for (int kt = 0; kt < 4; ++kt) acc[kt] = MFMA32(fb[kt], qf[s + 1], acc[kt]);
        }
#pragma unroll
        for (int kt = 0; kt < 4; ++kt) P[4 * kh + kt] = acc[kt];
    }
    float mx = -1e30f;
#pragma unroll
    for (int kt = 0; kt < 8; ++kt)
#pragma unroll
        for (int j = 0; j < 16; ++j) mx = fmaxf(mx, P[kt][j]);
    mx = fmaxf(mx, __shfl_xor(mx, 32));
    float den = 0.f;
    bf16x8 pb[8][2];
#pragma unroll
    for (int kt = 0; kt < 8; ++kt) {
#pragma unroll
        for (int j = 0; j < 16; ++j) { const float p = __builtin_amdgcn_exp2f(P[kt][j] - mx); P[kt][j] = p; den += p; }
        pb[kt][0] = pack_step(P[kt], 0); pb[kt][1] = pack_step(P[kt], 1);
    }
    den += __shfl_xor(den, 32);
    const float inv = __builtin_amdgcn_rcpf(den);
    bf16_t* op = (bf16_t*)(ws + WS_O2) + (row0 + r) * 1024 + h * 256;
#pragma unroll
    for (int i = 0; i < 16; ++i) st[i] = *(const u32x4*)(vld + (size_t)(16 * i) * 256);
    LDS_BARRIER();
    XA_WRITE_ALL();
    LDS_BARRIER();
#pragma unroll
    for (int dh = 0; dh < 2; ++dh) {
        f32x16 O[4];
#pragma unroll
        for (int i = 0; i < 4; ++i)
#pragma unroll
            for (int j = 0; j < 16; ++j) O[i][j] = 0.f;
        {
            const LAS unsigned char* vb_ = lds + dh * XA_BUF + r * XA_PITCH + 8 * hh;
            u32x2 va[4][2], vb2[4][2];
#define XA_VREAD(dst, st_) do { _Pragma("unroll") for (int dt = 0; dt < 4; ++dt) { const LAS unsigned char* p_ = vb_ + 32 * dt * XA_PITCH + 32 * (st_); \
                dst[dt][0] = *(const LAS u32x2*)p_; dst[dt][1] = *(const LAS u32x2*)(p_ + 16); } } while (0)
            XA_VREAD(va, 0);
#pragma unroll
            for (int st2 = 0; st2 < 16; st2 += 2) {
                XA_VREAD(vb2, st2 + 1);
#pragma unroll
                for (int dt = 0; dt < 4; ++dt) O[dt] = MFMA32(cat8(va[dt][0], va[dt][1]), pb[st2 >> 1][0], O[dt]);
                if (st2 + 2 < 16) XA_VREAD(va, st2 + 2);
#pragma unroll
                for (int dt = 0; dt < 4; ++dt) O[dt] = MFMA32(cat8(vb2[dt][0], vb2[dt][1]), pb[st2 >> 1][1], O[dt]);
            }
#undef XA_VREAD
        }
#pragma unroll
        for (int dt = 0; dt < 4; ++dt)
#pragma unroll
            for (int g4 = 0; g4 < 4; g4 += 2) {
                u32x2 wa, wb;
                wa.x = pk2(O[dt][4 * g4] * inv, O[dt][4 * g4 + 1] * inv); wa.y = pk2(O[dt][4 * g4 + 2] * inv, O[dt][4 * g4 + 3] * inv);
                wb.x = pk2(O[dt][4 * g4 + 4] * inv, O[dt][4 * g4 + 5] * inv); wb.y = pk2(O[dt][4 * g4 + 6] * inv, O[dt][4 * g4 + 7] * inv);
                st_rowpair(op + 128 * dh, 4 * dt + g4, wa, wb, hh);
            }
    }
#undef XA_WRITE_ALL
}
constexpr int XS_Q = 0, XS_SC = 4096, XS_PART = 8192, XS_END = 8192 + 32768;
DI void xattn_sample_item(const Ctx& C, int b, int h, int th) {
    const int lane = lane_id_here(), w = C.wave, tid = w * 64 + lane;
    unsigned char* ws = C.ws;
    LAS float* QS = (LAS float*)(C.lds + XS_Q); LAS float* SC = (LAS float*)(C.lds + XS_SC); LAS float* PART = (LAS float*)(C.lds + XS_PART);
    const float* cache = C.in[6] + (size_t)b * 256 * 2048 + h * 256;
    const size_t row0 = (size_t)MP + b * 8 + 4 * th;
    bf16_t qsv[2];
#pragma unroll
    for (int k = 0; k < 2; ++k) { const int i = tid + NTHREADS * k; qsv[k] = ((const bf16_t*)(ws + WS_Q2))[(row0 + (i >> 8)) * 1024 + h * 256 + (i & 255)]; }
    LDS_BARRIER();
#pragma unroll
    for (int k = 0; k < 2; ++k) QS[tid + NTHREADS * k] = bf1(qsv[k]);
    LDS_BARRIER();
    {
        f32x4 q[4];
#pragma unroll
        for (int t = 0; t < 4; ++t) q[t] = *(const LAS f32x4*)(QS + t * 256 + 4 * lane);
        for (int mb = 0; mb < 32; mb += 16) {
            f32x4 kk[16];
#pragma unroll
            for (int u = 0; u < 16; ++u) kk[u] = __builtin_nontemporal_load((const f32x4*)(cache + (size_t)(32 * w + mb + u) * 2048 + 4 * lane));
#pragma unroll
            for (int u = 0; u < 16; ++u) {
#pragma unroll
                for (int t = 0; t < 4; ++t) {
                    const float s = wave_sum(q[t].x * kk[u].x + q[t].y * kk[u].y + q[t].z * kk[u].z + q[t].w * kk[u].w);
                    if (lane == 0) SC[t * 256 + 32 * w + mb + u] = s;
                }
            }
        }
    }
    LDS_BARRIER();
    if (w < 4) {
        float v[4]; float mx = -1e30f;
#pragma unroll
        for (int i = 0; i < 4; ++i) { v[i] = SC[w * 256 + lane + 64 * i]; mx = fmaxf(mx, v[i]); }
        mx = wave_max(mx);
        float den = 0.f;
#pragma unroll
        for (int i = 0; i < 4; ++i) { v[i] = __builtin_amdgcn_exp2f(v[i] - mx); den += v[i]; }
        den = wave_sum(den);
        const float inv = 1.f / den;
#pragma unroll
        for (int i = 0; i < 4; ++i) SC[w * 256 + lane + 64 * i] = v[i] * inv;
    }
    LDS_BARRIER();
    {
        f32x4 o[4];
#pragma unroll
        for (int t = 0; t < 4; ++t) o[t] = f32x4{0.f, 0.f, 0.f, 0.f};
        for (int mb = 0; mb < 32; mb += 16) {
            f32x4 vv[16];
#pragma unroll
            for (int u = 0; u < 16; ++u) vv[u] = __builtin_nontemporal_load((const f32x4*)(cache + (size_t)(32 * w + mb + u) * 2048 + 1024 + 4 * lane));
#pragma unroll
            for (int u4 = 0; u4 < 4; ++u4) {
#pragma unroll
                for (int t = 0; t < 4; ++t) {
                    const f32x4 pv = *(const LAS f32x4*)(SC + t * 256 + 32 * w + mb + 4 * u4);
#pragma unroll
                    for (int i = 0; i < 4; ++i) o[t] += pv[i] * vv[4 * u4 + i];
                }
            }
        }
#pragma unroll
        for (int t = 0; t < 4; ++t) *(LAS f32x4*)(PART + (w * 4 + t) * 256 + 4 * lane) = o[t];
    }
    LDS_BARRIER();
    {
        const int t = tid >> 7, d2 = 2 * (tid & 127);
        float a0 = 0.f, a1 = 0.f;
#pragma unroll
        for (int g = 0; g < 8; ++g) { const f32x2 pp = *(const LAS f32x2*)(PART + (g * 4 + t) * 256 + d2); a0 += pp.x; a1 += pp.y; }
        *(unsigned*)((bf16_t*)(ws + WS_O2) + (row0 + t) * 1024 + h * 256 + d2) = pk2(a0, a1);
    }
    LDS_BARRIER();
}

template <int NACC, class F> DI void sgemm_unit(const Ctx& C, const bf16_t* __restrict__ A, const bf16_t* __restrict__ B0, const bf16_t* __restrict__ B1, int K, int tm, const F& fin, int lda = 0, int ldb = 0) {
    if (lda == 0) lda = K;
    if (ldb == 0) ldb = K;
    const int lane = lane_id_here(), w = C.wave, r = lane & 31, hh = lane >> 5;
    LAS float* PT = (LAS float*)C.lds;
    f32x16 acc[NACC];
#pragma unroll
    for (int i = 0; i < NACC; ++i)
#pragma unroll
        for (int j = 0; j < 16; ++j) acc[i][j] = 0.f;
    const int ksl = K / 8;
    const bf16_t* ap = A + (size_t)(32 * tm + r) * lda + w * ksl + 8 * hh;
    const bf16_t* bp0 = B0 + (size_t)r * ldb + w * ksl + 8 * hh;
    const bf16_t* bp1 = B1 + (size_t)r * ldb + w * ksl + 8 * hh;
#pragma unroll 8
    for (int k = 0; k < ksl; k += 16) {
        const bf16x8 a = *(const bf16x8*)(ap + k);
        acc[0] = MFMA32(a, *(const bf16x8*)(bp0 + k), acc[0]);
        if (NACC == 2) acc[1] = MFMA32(a, *(const bf16x8*)(bp1 + k), acc[1]);
    }
    LDS_BARRIER();
#pragma unroll
    for (int i = 0; i < NACC; ++i)
#pragma unroll
        for (int j = 0; j < 16; ++j) PT[((i * 8 + w) * 32 + crow(j, hh)) * 33 + r] = acc[i][j];
    LDS_BARRIER();
    const int tid = w * 64 + lane, row = tid >> 4, c2 = 2 * (tid & 15);
    float v[NACC][2];
#pragma unroll
    for (int i = 0; i < NACC; ++i) {
        float s0 = 0.f, s1 = 0.f;
#pragma unroll
        for (int ww = 0; ww < 8; ++ww) { s0 += PT[((i * 8 + ww) * 32 + row) * 33 + c2]; s1 += PT[((i * 8 + ww) * 32 + row) * 33 + c2 + 1]; }
        v[i][0] = s0; v[i][1] = s1;
    }
    fin(32 * tm + row, c2, v);
}

constexpr size_t WS_SSQS = WS_SSQ + 2560 * 1024;
static_assert(WS_SSQ + (size_t)MT * 16 * 4 <= WS_SSQS && WS_SSQS + 256 * 32 * 4 <= WS_FB, "ssqs map");
DI void sgemm_branch(const Ctx& C, const bf16_t* A, const bf16_t* Bt, int K, int tm, int tn) {
    unsigned char* ws = C.ws; bf16_t* MIX = (bf16_t*)(ws + WS_MIX); float* SSQS = (float*)(ws + WS_SSQS);
    sgemm_unit<1>(C, A, Bt + (size_t)32 * tn * K, nullptr, K, tm,
        [&](int row, int c2, const float (&v)[1][2]) {
            *(unsigned*)(MIX + ((size_t)MP + row) * 1024 + 32 * tn + c2) = pk2(v[0][0], v[0][1]);
            float s = v[0][0] * v[0][0] + v[0][1] * v[0][1];
            s += __shfl_xor(s, 1); s += __shfl_xor(s, 2); s += __shfl_xor(s, 4); s += __shfl_xor(s, 8);
            if ((c2 >> 1) == 0) SSQS[row * 32 + tn] = s; });
}

#ifndef MK_N_LAUNCHES
#define MK_N_LAUNCHES 1
#endif
constexpr int N_PHASES = 16;
#define REP_A 1
#define STAGGER_US 0
#define REP_X 1
#define REP_XS 1
#define EXTRA_BARS 0
#define PROBE_NULLGEMM 0
#define REP_B 1
#define REP_C 1
#define REP_PA 1
#ifndef REP_MASK
#define REP_MASK 0
#endif
#define NREP(k) (((REP_MASK) >> (k)) & 1 ? 2 : 1)

__global__ void __launch_bounds__(NTHREADS, 2) fwd_megakernel(Args args) {
    extern __shared__ __attribute__((aligned(16))) unsigned char lds_raw[];
    cg::grid_group grid = cg::this_grid();
    Ctx C;
    C.in = args.in; C.out = args.out; C.ws = args.ws;
    C.lds = (LAS unsigned char*)lds_raw;
    C.wave = __builtin_amdgcn_readfirstlane(threadIdx.x >> 6);
    C.G = gridDim.x; C.bid = blockIdx.x;
    const int lo = args.ph_lo, hi = args.ph_hi;
    unsigned char* ws = args.ws;
#define IN(k) (lo <= (k) && (k) < hi)
    volatile LAS unsigned* MISC = (volatile LAS unsigned*)(C.lds + LDS_BYTES - 64);
    const bool leader = (C.wave == 0) && (lane_id() == 0);
    if (leader) { MISC[0] = 0u; MISC[1] = 0u; }
    __syncthreads();
    XcdBarrier xbar = xcd_barrier_post((unsigned*)(ws + WS_CTL), MISC, leader);
#define SEAM(k) do { if (IN(k) && IN((k) + 1)) { if ((k) == 0 && lo < 0) grid.sync(); else xcd_barrier(xbar, (C.wave == 0) && (lane_id() == 0)); } } while (0)

    if (IN(0)) for (int rep_ = 0; rep_ < NREP(0); ++rep_) { { const int e_ = C.bid * NTHREADS + C.wave * 64 + lane_id_here(); if (e_ < AT_NTAB) attn_bias_tables_global(C, e_); } p0_prologue(C); }
    SEAM(0);
    if (IN(1)) for (int rep_ = 0; rep_ < NREP(1); ++rep_) {
        {
            if (STAGGER_US > 0 && ((C.bid >> 3) & 1)) { const unsigned long long t0 = __builtin_amdgcn_s_memrealtime(); while (__builtin_amdgcn_s_memrealtime() - t0 < (unsigned long long)(STAGGER_US * 100)) __builtin_amdgcn_s_sleep(32); }
            pg8::Gemm g{(const bf16_t*)(ws + WS_XB), (const bf16_t*)(ws + WS_WIN), MT, NIN, 1024};
            pg8::StaticOrder S; S.init(MT, NIN, C.G, C.bid);
            EpiIn E{(const float*)(ws + WS_RS), ws, args.out};
            pg8::gemm_phase<EpiIn, pg8::StaticOrder, true, true>(C.lds, g, S, E, C.wave);
        }
        {
            pg8::Gemm g{(const bf16_t*)(ws + WS_MEMB), (const bf16_t*)(ws + WS_WMKV), 1024, 2048, 1024};
            pg8::StaticOrder S; S.init(1024, 2048, C.G, C.G - 1 - C.bid);
            EpiMemKV E{(const float*)(ws + WS_RSMEM), ws, args.out};
            pg8::gemm_phase<EpiMemKV, pg8::StaticOrder, true, true>(C.lds, g, S, E, C.wave);
        }
    }
#if PROBE_NULLGEMM
    {
        pg8::Gemm g{(const bf16_t*)(ws + WS_XB), (const bf16_t*)(ws + WS_WIN), MT, NIN, 1024};
        pg8::StaticOrder S; S.init(MT, NIN, C.G, C.bid);
        EpiNull E{(float*)(ws + WS_SSQ)};
        pg8::gemm_phase<EpiNull, pg8::StaticOrder, true, true>(C.lds, g, S, E, C.wave);
    }
#endif
    SEAM(1);
#if EXTRA_BARS
    for (int q_ = 0; q_ < EXTRA_BARS; ++q_) xcd_barrier(xbar, (C.wave == 0) && (lane_id() == 0));
#endif
    if (IN(2)) for (int rep_ = 0; rep_ < NREP(2); ++rep_) {
        LDS_BARRIER();
        attn_bias_tables(C, C.wave * 64 + lane_id_here());
        LDS_BARRIER();
        const bool rev = ((C.bid >> 3) & 1) != 0;
        for (int ord = 0; ord < 4; ++ord) {
            const int kind = (ord + ((C.bid >> 3) & 3)) & 3;
            if (kind == 0) {
                const bool split57 = C.G == 256;
                const int per = (1536 + C.G - 1) / C.G;
                const int i0 = split57 ? (C.bid < 128 ? C.bid * 5 : 640 + (C.bid - 128) * 7) : C.bid * per;
                const int i1e = split57 ? i0 + (C.bid < 128 ? 5 : 7) : i0 + per, i1 = i1e < 1536 ? i1e : 1536;
                for (int q_ = 0; q_ < REP_A; ++q_) for (int it = i0; it < i1; ++it) attn_prompt_item(C, it);
            } else if (kind == 1) {
                for (int q_ = 0; q_ < REP_B; ++q_) for (int it = C.bid; it < 384; it += C.G) attn_sample_item(C, it / 12, (it % 12) & 3, (it % 12) >> 2);
            } else if (kind == 2) {
                for (int it = C.G - 1 - C.bid; it < 128; it += C.G) { for (int q_ = 0; q_ < REP_C; ++q_) gla_sample_item(C, it >> 2, it & 3); }
            } else {
                LDS_BARRIER();
                for (int q_ = 0; q_ < REP_PA; ++q_) for (int u = C.bid; u < NUNIT; u += C.G) gla_pass_a_unit(C, u);
                LDS_BARRIER();
                attn_bias_tables(C, C.wave * 64 + lane_id_here());
                LDS_BARRIER();
            }
        }
    }
    SEAM(2);
    if (IN(3)) for (int rep_ = 0; rep_ < NREP(3); ++rep_) {
        gla_pass_b(C);
        const int gid = C.bid * NTHREADS + C.wave * 64 + lane_id_here();
        for (int id = gid; id < MT * 64; id += C.G * NTHREADS) attn_combine_chunk(ws, (size_t)(id >> 6), (id >> 4) & 3, id & 15);
    }
    SEAM(3);
    if (IN(4)) for (int rep_ = 0; rep_ < NREP(4); ++rep_) { gla_pass_c(C); }
    if (IN(5)) { }
    SEAM(5);
    if (IN(6)) for (int rep_ = 0; rep_ < NREP(6); ++rep_) {
        for (int u = C.bid; u < 256; u += C.G) {
            const int tm = u >> 5, tn = u & 31;
            const bf16_t* SGA = (const bf16_t*)(ws + WS_SGA); const bf16_t* SGBT = (const bf16_t*)(ws + WS_SGBT);
            bf16_t* TMP = (bf16_t*)(ws + WS_TMP); bf16_t* MIXIN = (bf16_t*)(ws + WS_MIXIN);
            sgemm_unit<1>(C, (const bf16_t*)(ws + WS_YAIN) + (size_t)MP * 1536, (const bf16_t*)(ws + WS_WPA) + (size_t)32 * tn * 1536, nullptr, 512, tm,
                [&](int row, int c2, const float (&v)[1][2]) { const size_t o = ((size_t)MP + row) * 1024 + 32 * tn + c2; const unsigned g = *(const unsigned*)(SGA + o);
                    *(unsigned*)(TMP + o) = pk2(bflo(g) * v[0][0], bfhi(g) * v[0][1]); }, 1536, 1536);
            sgemm_unit<1>(C, (const bf16_t*)(ws + WS_YAIN) + (size_t)MP * 1536 + 512, (const bf16_t*)(ws + WS_WPA) + (size_t)32 * tn * 1536 + 512, nullptr, 1024, tm,
                [&](int row, int c2, const float (&v)[1][2]) { const size_t o = ((size_t)MP + row) * 1024 + 32 * tn + c2; const unsigned g = *(const unsigned*)(SGBT + o), t = *(const unsigned*)(TMP + o);
                    *(unsigned*)(MIXIN + o) = pk2(bflo(t) + bflo(g) * v[0][0], bfhi(t) + bfhi(g) * v[0][1]); }, 1536, 1536);
        }
        LDS_BARRIER();
        {
            pg8::Gemm g{(const bf16_t*)(ws + WS_YAIN), (const bf16_t*)(ws + WS_WPA), MP, 1024, 1536};
            pg8::StaticOrder S; S.init(MP, 1024, C.G, C.bid);
            EpiGate2 E{(const bf16_t*)(ws + WS_SGA), (const bf16_t*)(ws + WS_SGBT), (bf16_t*)(ws + WS_MIXIN), 8};
            pg8::gemm_phase<EpiGate2, pg8::StaticOrder, true, true>(C.lds, g, S, E, C.wave);
        }
    }
    SEAM(6);
    if (IN(7)) for (int rep_ = 0; rep_ < NREP(7); ++rep_) {
        for (int u = C.bid; u < 256; u += C.G) sgemm_branch(C, (const bf16_t*)(ws + WS_MIXIN) + (size_t)MP * 1024, (const bf16_t*)(ws + WS_WOUT), 1024, u >> 5, u & 31);
        LDS_BARRIER();
        pg8::Gemm g{(const bf16_t*)(ws + WS_MIXIN), (const bf16_t*)(ws + WS_WOUT), MP, 1024, 1024};
        pg8::StaticOrder S; S.init(MP, 1024, C.G, C.bid);
        EpiBranch E{(bf16_t*)(ws + WS_MIX), (float*)(ws + WS_SSQ)};
        pg8::gemm_phase<EpiBranch, pg8::StaticOrder, true, true>(C.lds, g, S, E, C.wave);
    }
    SEAM(7);
    if (IN(8)) for (int rep_ = 0; rep_ < NREP(8); ++rep_) resid_pass<true, false>(C, args.in[10]);
    SEAM(8);
    if (IN(9)) for (int rep_ = 0; rep_ < NREP(9); ++rep_) {
        for (int u = C.bid; u < 256; u += C.G) {
            const int tm = u >> 5, tn = u & 31; const float* RS = (const float*)(ws + WS_RS); bf16_t* Q2 = (bf16_t*)(ws + WS_Q2);
            sgemm_unit<1>(C, (const bf16_t*)(ws + WS_XB) + (size_t)MP * 1024, (const bf16_t*)(ws + WS_WMQ) + (size_t)32 * tn * 1024, nullptr, 1024, tm,
                [&](int row, int c2, const float (&v)[1][2]) { const float r = RS[MP + row] * Q2_SCALE; *(unsigned*)(Q2 + ((size_t)MP + row) * 1024 + 32 * tn + c2) = pk2(v[0][0] * r, v[0][1] * r); });
        }
        LDS_BARRIER();
        pg8::Gemm g{(const bf16_t*)(ws + WS_XB), (const bf16_t*)(ws + WS_WMQ), MP, 1024, 1024};
        pg8::StaticOrder S; S.init(MP, 1024, C.G, C.bid);
        EpiRowScale E{(const float*)(ws + WS_RS), (bf16_t*)(ws + WS_Q2), Q2_SCALE};
        pg8::gemm_phase<EpiRowScale, pg8::StaticOrder, true, true>(C.lds, g, S, E, C.wave);
    }
    SEAM(9);
    if (IN(10)) for (int rep_ = 0; rep_ < NREP(10); ++rep_) {
        const bool xs = C.G == 256;
#define XS_IT(i) (xs ? 2 * (((i) & 7) * 16 + (((i) >> 3) & 15)) + ((i) >> 7) : (i))
#define XP_IT(i) (xs ? ((((i) & 7) + 8 * ((i) >> 8)) << 5) | (((i) >> 3) & 31) : (i))
        if (xs) {
            const int mode10 = ((C.bid >> 3) & 15) % 3; int k_ = 0;
#pragma unroll 1
            for (int s_ = 0; s_ < 3; ++s_) {
                if (s_ == mode10) { const int it = XS_IT(C.bid); xattn_sample_item(C, it >> 3, (it >> 1) & 3, it & 1); }
                else { xattn_prompt_item(C, XP_IT(C.bid + 256 * k_)); ++k_; }
            }
        } else {
            for (int i = C.bid; i < 256; i += C.G) xattn_sample_item(C, i >> 3, (i >> 1) & 3, i & 1);
            for (int i = C.bid; i < 512; i += C.G) xattn_prompt_item(C, i);
        }
#undef XS_IT
#undef XP_IT
    }
    SEAM(10);
    if (IN(11)) for (int rep_ = 0; rep_ < NREP(11); ++rep_) {
        for (int u = C.bid; u < 256; u += C.G) sgemm_branch(C, (const bf16_t*)(ws + WS_O2) + (size_t)MP * 1024, (const bf16_t*)(ws + WS_WMO), 1024, u >> 5, u & 31);
        LDS_BARRIER();
        pg8::Gemm g{(const bf16_t*)(ws + WS_O2), (const bf16_t*)(ws + WS_WMO), MP, 1024, 1024};
        pg8::StaticOrder S; S.init(MP, 1024, C.G, C.bid);
        EpiBranch E{(bf16_t*)(ws + WS_MIX), (float*)(ws + WS_SSQ)};
        pg8::gemm_phase<EpiBranch, pg8::StaticOrder, true, true>(C.lds, g, S, E, C.wave);
    }
    SEAM(11);
    if (IN(12)) resid_pass<false, false>(C, args.in[22]);
    SEAM(12);
    if (IN(13)) for (int rep_ = 0; rep_ < NREP(13); ++rep_) {
        for (int u = C.bid; u < 704; u += C.G) {
            const int tm = u / 88, tg = u % 88, jj = (32 * tg) >> 7, off = (32 * tg) & 127; const float* RS = (const float*)(ws + WS_RS); bf16_t* H = (bf16_t*)(ws + WS_H);
            const bf16_t* WG = (const bf16_t*)(ws + WS_WGU) + (size_t)(256 * jj + off) * 1024;
            sgemm_unit<2>(C, (const bf16_t*)(ws + WS_XB) + (size_t)MP * 1024, WG, WG + (size_t)128 * 1024, 1024, tm,
                [&](int row, int c2, const float (&v)[2][2]) { const float r = RS[MP + row]; const float g0 = v[0][0] * r, g1 = v[0][1] * r;
                    *(unsigned*)(H + ((size_t)MP + row) * DFF + 32 * tg + c2) = pk2(g0 * fsigmoid(g0) * (v[1][0] * r), g1 * fsigmoid(g1) * (v[1][1] * r)); });
        }
        LDS_BARRIER();
        pg8::Gemm g{(const bf16_t*)(ws + WS_XB), (const bf16_t*)(ws + WS_WGU), MP, 2 * DFF, 1024};
        pg8::StaticOrder S; S.init(MP, 2 * DFF, C.G, C.bid);
        EpiGateUp E{(const float*)(ws + WS_RS), (bf16_t*)(ws + WS_H)};
        pg8::gemm_phase<EpiGateUp, pg8::StaticOrder, true, true>(C.lds, g, S, E, C.wave);
    }
    SEAM(13);
    if (IN(14)) for (int rep_ = 0; rep_ < NREP(14); ++rep_) {
        for (int u = C.bid; u < 256; u += C.G) sgemm_branch(C, (const bf16_t*)(ws + WS_H) + (size_t)MP * DFF, (const bf16_t*)(ws + WS_WDN), DFF, u >> 5, u & 31);
        LDS_BARRIER();
        pg8::Gemm g{(const bf16_t*)(ws + WS_H), (const bf16_t*)(ws + WS_WDN), MP, 1024, DFF};
        pg8::StaticOrder S; S.init(MP, 1024, C.G, C.bid);
        EpiBranch E{(bf16_t*)(ws + WS_MIX), (float*)(ws + WS_SSQ)};
        pg8::gemm_phase<EpiBranch, pg8::StaticOrder, true, true>(C.lds, g, S, E, C.wave);
    }
    SEAM(14);
    if (IN(15)) resid_pass<false, true>(C, args.in[26]);
#undef IN
#undef SEAM
}

extern "C" void kernel_launch(void* const* d_in, const int* in_sizes, int n_in, void* d_out, int out_size, void* d_ws, size_t ws_size, hipStream_t stream) {
    static int grid = 0;
    if (grid == 0) {
        if (n_in != 30 || out_size != (int)O_TOTAL || ws_size < WS_END2) {
            fprintf(stderr, "kernel_launch: unexpected problem (n_in %d, out %d, ws %zu; need ws >= %zu); nothing launched\n", n_in, out_size, ws_size, (size_t)WS_END2);
            grid = -1; return;
        }
        int dev = 0, cus = 0, per_cu = 0;
        (void)hipGetDevice(&dev);
        (void)hipDeviceGetAttribute(&cus, hipDeviceAttributeMultiprocessorCount, dev);
        (void)hipFuncSetAttribute((const void*)fwd_megakernel, hipFuncAttributeMaxDynamicSharedMemorySize, LDS_BYTES);
        (void)hipOccupancyMaxActiveBlocksPerMultiprocessor(&per_cu, (const void*)fwd_megakernel, NTHREADS, LDS_BYTES);
        if (per_cu < 1) { fprintf(stderr, "kernel_launch: occupancy query says %d blocks per CU\n", per_cu); per_cu = 1; }
        (void)hipGetLastError();
        grid = cus;
        if (grid > 256) grid = 256;
    }
    if (grid < 0) return;
    (void)hipMemsetAsync((char*)d_ws + WS_CTL, 0, 65536, stream);
    Args a{};
    for (int i = 0; i < 30; ++i) a.in[i] = (const float*)d_in[i];
    a.out = (float*)d_out; a.ws = (unsigned char*)d_ws;
#if MK_N_LAUNCHES == 1
    a.ph_lo = 0; a.ph_hi = N_PHASES;
    void* kargs[] = {&a};
    hipError_t e = hipLaunchCooperativeKernel((const void*)fwd_megakernel, dim3(grid), dim3(NTHREADS), kargs, LDS_BYTES, stream);
    if (e != hipSuccess) fprintf(stderr, "cooperative launch failed: %s (grid %d)\n", hipGetErrorString(e), grid);
#else
    for (int p = 0; p < N_PHASES; ++p) {
        a.ph_lo = p; a.ph_hi = p + 1;
        hipLaunchKernelGGL(fwd_megakernel, dim3(grid), dim3(NTHREADS), LDS_BYTES, stream, a);
    }
#endif
}
```
